# Optimizing an MI355X kernel written in HIP

```python
import jax, jax.numpy as jnp
from jax import lax
import numpy as np

D_MODEL = 1024
BATCH = 8
SEQ = 4096
DEPTH = 2

CTX_LEN = 256
GRID_W = 64
EPS = 1e-6
NA_HEADS = 8
NA_HEAD_DIM = 64
NA_WIDTH = NA_HEADS * NA_HEAD_DIM
NA_WIN_ROWS = 8
NA_WIN_COLS = 16
ROPE_THETA = 10000.0
ROT_HALF = NA_HEAD_DIM // 2
HG_HEADS = 4
HG_KEY_DIM = 128
HG_VAL_DIM = 128
HG_KEY_WIDTH = HG_HEADS * HG_KEY_DIM
HG_VAL_WIDTH = HG_HEADS * HG_VAL_DIM
HG_CHUNK = 64
GATE_FLOOR = 1e-30
IN_WIDTH = 3 * NA_WIDTH + 3 * HG_KEY_WIDTH + 2 * HG_VAL_WIDTH + 2 * D_MODEL
N_EXPERTS = 16
N_GROUPS = 4
EXPERTS_PER_GROUP = N_EXPERTS // N_GROUPS
TOP_K = 2
EXPERT_FF = 512
MASK_VALUE = -1e9

kernel_name = "hybrid_na_hgrn2_grouped_moe_dit"


def rms_norm(x, g):
    xf = x.astype(jnp.float32)
    y = xf * lax.rsqrt(jnp.mean(xf * xf, axis=-1, keepdims=True) + EPS)
    return (y * g.astype(jnp.float32)).astype(x.dtype)


def modulate(h, shift, scale):
    return h * (1 + scale) + shift


def to_heads(t, n):
    B, L, _ = t.shape
    return t.reshape(B, L, n, -1).transpose(0, 2, 1, 3)


def from_heads(t):
    B, H, L, d = t.shape
    return t.transpose(0, 2, 1, 3).reshape(B, L, H * d)


def split_columns(p):
    widths = (NA_WIDTH,) * 3 + (HG_KEY_WIDTH,) * 3 + (HG_VAL_WIDTH,) * 2 + (D_MODEL,) * 2
    offs = np.cumsum(widths)[:-1].tolist()
    return jnp.split(p, offs, axis=-1)


def axial_rope(L):
    t = jnp.arange(L, dtype=jnp.int32)
    row = (t // GRID_W).astype(jnp.float32)
    col = (t % GRID_W).astype(jnp.float32)
    inv = ROPE_THETA ** (-jnp.arange(0, ROT_HALF, 2, dtype=jnp.float32) / ROT_HALF)
    ang = jnp.concatenate([row[:, None] * inv, col[:, None] * inv], axis=-1)
    return jnp.cos(ang), jnp.sin(ang)


def apply_rope(x, cos, sin):
    xp = x.astype(jnp.float32).reshape(*x.shape[:-1], NA_HEAD_DIM // 2, 2)
    x1, x2 = xp[..., 0], xp[..., 1]
    out = jnp.stack([x1 * cos - x2 * sin, x1 * sin + x2 * cos], axis=-1)
    return out.reshape(x.shape).astype(x.dtype)


def na_indices(rows):
    wr = min(NA_WIN_ROWS, rows)
    L = rows * GRID_W
    t = jnp.arange(L, dtype=jnp.int32)
    r, col = t // GRID_W, t % GRID_W
    rs = jnp.clip(r - wr // 2, 0, rows - wr)
    cs = jnp.clip(col - NA_WIN_COLS // 2, 0, GRID_W - NA_WIN_COLS)
    kr = rs[:, None, None] + jnp.arange(wr, dtype=jnp.int32)[None, :, None]
    kc = cs[:, None, None] + jnp.arange(NA_WIN_COLS, dtype=jnp.int32)[None, None, :]
    full = (L, wr, NA_WIN_COLS)
    shape = (rows, GRID_W, wr * NA_WIN_COLS)
    idx = jnp.broadcast_to(kr * GRID_W + kc, full).reshape(shape)
    dr = jnp.broadcast_to(kr - r[:, None, None] + NA_WIN_ROWS - 1, full).reshape(shape)
    dc = jnp.broadcast_to(kc - col[:, None, None] + NA_WIN_COLS - 1, full).reshape(shape)
    return idx, dr, dc


def neighbourhood_attention(q_l, k_l, v_l, k_c, v_c, rel_bias, rows):
    B, H, L, dh = q_l.shape
    idx, dr, dc = na_indices(rows)
    scale = dh ** -0.5
    q_blocks = jnp.moveaxis(q_l.reshape(B, H, rows, GRID_W, dh), 2, 0)

    def block(args):
        q_b, idx_b, dr_b, dc_b = args
        k_g = k_l[:, :, idx_b]
        v_g = v_l[:, :, idx_b]
        s_win = jnp.einsum('bhqd,bhqkd->bhqk', q_b, k_g).astype(jnp.float32) * scale \
            + rel_bias[:, dr_b, dc_b].astype(jnp.float32)[None]
        s_ctx = jnp.einsum('bhqd,bhkd->bhqk', q_b, k_c).astype(jnp.float32) * scale
        p = jax.nn.softmax(jnp.concatenate([s_win, s_ctx], axis=-1), axis=-1).astype(v_l.dtype)
        nk = idx_b.shape[-1]
        return jnp.einsum('bhqk,bhqkd->bhqd', p[..., :nk], v_g) + jnp.einsum('bhqk,bhkd->bhqd', p[..., nk:], v_c)

    o = lax.map(block, (q_blocks, idx, dr, dc))
    return jnp.moveaxis(o, 0, 2).reshape(B, H, L, dh)


def context_attention(q_c, k_c, v_c):
    s = jnp.einsum('bhqd,bhkd->bhqk', q_c, k_c).astype(jnp.float32) * (q_c.shape[-1] ** -0.5)
    p = jax.nn.softmax(s, axis=-1).astype(v_c.dtype)
    return jnp.einsum('bhqk,bhkd->bhqd', p, v_c)


def layer_lower_bounds(raw):
    p = jax.nn.softmax(raw.astype(jnp.float32), axis=0)
    return jnp.cumsum(p, axis=0) - p[0:1]


def hgrn2_gates(f, lb):
    lb = lb.astype(jnp.float32).reshape(HG_HEADS, 1, HG_KEY_DIM)
    f = f.astype(jnp.float32)
    g = lb + (1 - lb) * jax.nn.sigmoid(f)
    log_g = jnp.log(jnp.maximum(g, GATE_FLOOR))
    k = (1 - lb) * jax.nn.sigmoid(-f)
    return k, log_g


def gla_chunked(q, k, v, log_g, s0):
    B, H, L, dk = q.shape
    n = L // HG_CHUNK
    out_dtype = v.dtype

    def chunks(t):
        return jnp.moveaxis(t.astype(jnp.float32).reshape(B, H, n, HG_CHUNK, t.shape[-1]), 2, 0)

    incl = jnp.tril(jnp.ones((HG_CHUNK, HG_CHUNK), dtype=bool))[..., None]

    def step(S, xs):
        qc, kc, vc, gc = xs
        b = jnp.cumsum(gc, axis=2)
        diff = b[:, :, :, None, :] - b[:, :, None, :, :]
        decay = jnp.where(incl, jnp.exp(jnp.where(incl, diff, 0.0)), 0.0)
        A = jnp.einsum('bhtsk,bhsk->bhts', decay * qc[:, :, :, None, :], kc)
        o = jnp.einsum('bhts,bhsv->bhtv', A, vc) + jnp.einsum('bhtk,bhkv->bhtv', qc * jnp.exp(b), S)
        b_last = b[:, :, -1:, :]
        S_new = jnp.exp(b_last[:, :, 0, :])[..., None] * S \
            + jnp.einsum('bhsk,bhsv->bhkv', kc * jnp.exp(b_last - b), vc)
        return S_new, o

    s_fin, o = lax.scan(step, s0, (chunks(q), chunks(k), chunks(v), chunks(log_g)))
    o = jnp.moveaxis(o, 0, 2).reshape(B, H, L, v.shape[-1])
    return o.astype(out_dtype), s_fin


def hgrn2_bidirectional(q_l, i_l, q_c, i_c, dirs):
    B = q_l.shape[0]
    o_lat, o_ctx = [], []
    for f_l, f_c, lb, flip in dirs:
        rev = (lambda t: t[:, :, ::-1]) if flip else (lambda t: t)
        k_c, lg_c = hgrn2_gates(f_c, lb)
        k_l, lg_l = hgrn2_gates(f_l, lb)
        s0 = jnp.zeros((B, HG_HEADS, HG_KEY_DIM, HG_VAL_DIM), jnp.float32)
        oc, s_ctx = gla_chunked(rev(q_c), rev(k_c), rev(i_c), rev(lg_c), s0)
        ol, _ = gla_chunked(rev(q_l), rev(k_l), rev(i_l), rev(lg_l), s_ctx)
        o_lat.append(rev(ol))
        o_ctx.append(rev(oc))
    return o_lat[0] + o_lat[1], o_ctx[0] + o_ctx[1]


def gated_head_norm(o, gate, gain):
    return from_heads(rms_norm(o, gain)) * jax.nn.silu(gate)


def merge_branches(o_na, o_hg, hg_gate, gate_na, gate_hg, hg_gain, w_na_o, w_hg_o, w_out):
    y_na = from_heads(o_na) @ w_na_o
    y_hg = gated_head_norm(o_hg, hg_gate, hg_gain) @ w_hg_o
    return (jax.nn.sigmoid(gate_na) * y_na + jax.nn.sigmoid(gate_hg) * y_hg) @ w_out


def parallel_mixer(h_lat, h_ctx, w_in, rel_bias, lb_f, lb_b, hg_gain, w_na_o, w_hg_o, w_out, with_ctx_out):
    B, L, _ = h_lat.shape
    rows = L // GRID_W
    (na_q_l, na_k_l, na_v_l, hq_l, hf_l, hb_l, hi_l, hg_l, ga_l, gh_l) = split_columns(h_lat @ w_in)
    (na_q_c, na_k_c, na_v_c, hq_c, hf_c, hb_c, hi_c, hg_c, ga_c, gh_c) = split_columns(h_ctx @ w_in)
    cos, sin = axial_rope(L)
    q_l = apply_rope(to_heads(na_q_l, NA_HEADS), cos, sin)
    k_l = apply_rope(to_heads(na_k_l, NA_HEADS), cos, sin)
    v_l = to_heads(na_v_l, NA_HEADS)
    k_c = to_heads(na_k_c, NA_HEADS)
    v_c = to_heads(na_v_c, NA_HEADS)
    o_na_l = neighbourhood_attention(q_l, k_l, v_l, k_c, v_c, rel_bias, rows)
    dirs = ((to_heads(hf_l, HG_HEADS), to_heads(hf_c, HG_HEADS), lb_f, False),
            (to_heads(hb_l, HG_HEADS), to_heads(hb_c, HG_HEADS), lb_b, True))
    o_hg_l, o_hg_c = hgrn2_bidirectional(to_heads(jax.nn.silu(hq_l), HG_HEADS), to_heads(hi_l, HG_HEADS),
                                         to_heads(jax.nn.silu(hq_c), HG_HEADS), to_heads(hi_c, HG_HEADS), dirs)
    y_l = merge_branches(o_na_l, o_hg_l, hg_l, ga_l, gh_l, hg_gain, w_na_o, w_hg_o, w_out)
    if not with_ctx_out:
        return y_l, None
    o_na_c = context_attention(to_heads(na_q_c, NA_HEADS), k_c, v_c)
    y_c = merge_branches(o_na_c, o_hg_c, hg_c, ga_c, gh_c, hg_gain, w_na_o, w_hg_o, w_out)
    return y_l, y_c


def grouped_moe(h, w_router, router_bias, w_gate, w_up, w_down):
    shp = h.shape
    t = h.reshape(-1, shp[-1])
    scores = jax.nn.sigmoid((t @ w_router).astype(jnp.float32))
    grouped = (scores + router_bias.astype(jnp.float32)).reshape(-1, N_GROUPS, EXPERTS_PER_GROUP)
    group_score = lax.top_k(grouped, TOP_K)[0].sum(-1)
    g_sel = jnp.argmax(group_score, axis=-1)
    in_group = (jnp.arange(N_GROUPS) == g_sel[:, None])[..., None]
    cand = jnp.where(in_group, grouped, MASK_VALUE).reshape(-1, N_EXPERTS)
    _, e_idx = lax.top_k(cand, TOP_K)
    w = jnp.take_along_axis(scores, e_idx, axis=-1)
    w = w / jnp.sum(w, axis=-1, keepdims=True)
    combine = jnp.sum(jax.nn.one_hot(e_idx, N_EXPERTS, dtype=jnp.float32) * w[..., None], axis=1).astype(t.dtype)
    out = jnp.zeros_like(t)
    for e in range(N_EXPERTS):
        h_e = jax.nn.silu(t @ w_gate[e]) * (t @ w_up[e])
        out = out + combine[:, e:e + 1] * (h_e @ w_down[e])
    return out.reshape(shp)


def setup_inputs(seed: int = 0) -> dict:
    key = jax.random.key(seed)
    ks = jax.random.split(key, 24)
    D = D_MODEL

    def nrm(k, shape, scale):
        return jax.random.normal(k, shape, jnp.float32) * scale

    return {
        'x': nrm(ks[0], (BATCH, SEQ, D), 1.0),
        'c': nrm(ks[1], (BATCH, D), 1.0),
        'ctx': nrm(ks[2], (BATCH, CTX_LEN, D), 1.0),
        'c_ctx': nrm(ks[3], (D,), 1.0),
        'w_ada': nrm(ks[4], (DEPTH, D, 6 * D), 0.5 * D ** -0.5),
        'b_ada': nrm(ks[5], (DEPTH, 6 * D), 0.02),
        'norm1_g': 1.0 + nrm(ks[6], (DEPTH, D), 0.02),
        'w_in': nrm(ks[7], (DEPTH, D, IN_WIDTH), D ** -0.5),
        'na_rel_bias': nrm(ks[8], (DEPTH, NA_HEADS, 2 * NA_WIN_ROWS - 1, 2 * NA_WIN_COLS - 1), 0.1),
        'hg_lower_fwd': nrm(ks[9], (DEPTH, HG_KEY_WIDTH), 0.1),
        'hg_lower_bwd': nrm(ks[10], (DEPTH, HG_KEY_WIDTH), 0.1),
        'hg_norm_g': 1.0 + nrm(ks[11], (DEPTH, HG_VAL_DIM), 0.02),
        'w_na_o': nrm(ks[12], (DEPTH, NA_WIDTH, D), NA_WIDTH ** -0.5),
        'w_hg_o': nrm(ks[13], (DEPTH, HG_VAL_WIDTH, D), HG_VAL_WIDTH ** -0.5),
        'w_out': nrm(ks[14], (DEPTH, D, D), D ** -0.5),
        'norm2_g': 1.0 + nrm(ks[15], (DEPTH, D), 0.02),
        'w_router': nrm(ks[16], (D, N_EXPERTS), D ** -0.5),
        'router_bias': nrm(ks[17], (N_EXPERTS,), 0.01),
        'w_gate': nrm(ks[18], (DEPTH, N_EXPERTS, D, EXPERT_FF), D ** -0.5),
        'w_up': nrm(ks[19], (DEPTH, N_EXPERTS, D, EXPERT_FF), D ** -0.5),
        'w_down': nrm(ks[20], (DEPTH, N_EXPERTS, EXPERT_FF, D), EXPERT_FF ** -0.5),
        'final_g': 1.0 + nrm(ks[21], (D,), 0.02),
    }


def reference(x, c, ctx, c_ctx, w_ada, b_ada, norm1_g, w_in, na_rel_bias, hg_lower_fwd, hg_lower_bwd,
              hg_norm_g, w_na_o, w_hg_o, w_out, norm2_g, w_router, router_bias, w_gate, w_up, w_down, final_g):
    n_ctx = ctx.shape[1]
    lb_f = layer_lower_bounds(hg_lower_fwd)
    lb_b = layer_lower_bounds(hg_lower_bwd)
    for l in range(DEPTH):
        last = l == DEPTH - 1
        sh1, sc1, g1, sh2, sc2, g2 = [m[:, None, :] for m in jnp.split(jax.nn.silu(c) @ w_ada[l] + b_ada[l], 6, axis=-1)]
        csh1, csc1, cg1, csh2, csc2, cg2 = jnp.split(jax.nn.silu(c_ctx) @ w_ada[l] + b_ada[l], 6, axis=-1)
        h_lat = modulate(rms_norm(x, norm1_g[l]), sh1, sc1)
        h_ctx = modulate(rms_norm(ctx, norm1_g[l]), csh1, csc1)
        y_lat, y_ctx = parallel_mixer(h_lat, h_ctx, w_in[l], na_rel_bias[l], lb_f[l], lb_b[l], hg_norm_g[l],
                                      w_na_o[l], w_hg_o[l], w_out[l], with_ctx_out=not last)
        x = x + g1 * y_lat
        h2_lat = modulate(rms_norm(x, norm2_g[l]), sh2, sc2)
        if last:
            x = x + g2 * grouped_moe(h2_lat, w_router, router_bias, w_gate[l], w_up[l], w_down[l])
        else:
            ctx = ctx + cg1 * y_ctx
            h2_ctx = modulate(rms_norm(ctx, norm2_g[l]), csh2, csc2)
            f = grouped_moe(jnp.concatenate([h2_ctx, h2_lat], axis=1), w_router, router_bias,
                            w_gate[l], w_up[l], w_down[l])
            ctx = ctx + cg2 * f[:, :n_ctx]
            x = x + g2 * f[:, n_ctx:]
    return rms_norm(x, final_g)
```

```cpp
#include <hip/hip_runtime.h>
#include <cstdio>
#include <cstdint>
namespace pg8 {
#define PG8_LAS __attribute__((address_space(3)))
typedef unsigned short bf16_t;
typedef short bf16x8 __attribute__((ext_vector_type(8)));
typedef float f32x4 __attribute__((ext_vector_type(4)));
typedef unsigned u32x4 __attribute__((ext_vector_type(4)));
constexpr int BM = 256, BK = 64, HALF = 128, HTB = HALF * BK * 2  , STAGE_BYTES = 8 * HTB, NXCD = 8, WGM = 8;

__host__ __device__ __forceinline__ int lds_byte(int r, int c) { const int st = (r >> 4) * 2 + (c >> 5), rr = r & 15, cc = c & 31, ob = rr * 64 + cc * 2; return st * 1024 + (ob ^ (((ob >> 9) & 1) << 5)); }
__host__ __device__ __forceinline__ void stage_rc(int b, int& R, int& C) { const int st = b / 1024, sb = b % 1024, swz = sb ^ (((sb >> 9) & 1) << 5); R = (st >> 1) * 16 + swz / 64; C = (st & 1) * 32 + (swz % 64) / 2; }
__host__ __device__ __forceinline__ int perm32(int rho) { const int n = rho >> 4, i = rho & 15; return 8 * (i >> 2) + 4 * n + (i & 3); }

struct Unit { int pm, pn; };
struct Gemm { const bf16_t* A; const bf16_t* Bt; int M, N, K; };

struct StaticOrder {
    int nM, nN, nwg, G, c;
    __host__ __device__ void init(int M, int N, int G_, int c_) { nM = M / BM; nN = N / BM; nwg = nM * nN; G = G_; c = c_; }
    __host__ __device__ bool next(int i, Unit& u) const {
        const long L = (long)i * G + c; if (L >= nwg) return false;
        int wgid = (int)L; { const int q = nwg / NXCD, r = nwg % NXCD, xcd = wgid % NXCD, off = wgid / NXCD; wgid = (xcd < r ? xcd * (q + 1) : r * (q + 1) + (xcd - r) * q) + off; }
        const int nig = WGM * nN, gid = wgid / nig, fm = gid * WGM, gsz = (nM - fm) < WGM ? (nM - fm) : WGM;
        u.pm = fm + ((wgid % nig) % gsz); u.pn = (wgid % nig) / gsz; return true;
    }
    __device__ __forceinline__ void a_ready(const Unit&) const {}
    __device__ __forceinline__ void done(const Unit&) const {}
};

__device__ __forceinline__ unsigned cvt_pk_bf16(float lo, float hi) { unsigned r; asm volatile("v_cvt_pk_bf16_f32 %0, %1, %2" : "=v"(r) : "v"(lo), "v"(hi)); return r; }
template <class Epi, class Sched, bool ALIGN_EPI = false, bool SP2 = false>
__device__ __forceinline__ void gemm_phase(PG8_LAS unsigned char* lds, const Gemm g, const Sched& S, const Epi& E) {
    int tid_ = threadIdx.x; asm volatile("" : "+v"(tid_));
    const int tid = tid_, wid = __builtin_amdgcn_readfirstlane(tid >> 6), lane = tid & 63, wr = wid >> 2, wc = wid & 3, fr = lane & 15, fq = lane >> 4;
    const int K = g.K, nt = K / BK;
    unsigned voffA[2], voffB[2];
#pragma unroll
    for (int i = 0; i < 2; ++i) { int R, C; stage_rc(tid * 16 + i * 8192, R, C); const int Rb = Epi::PERM ? ((R & ~31) + perm32(R & 31)) : R;
        voffA[i] = (unsigned)(R * K + C) * 2u; voffB[i] = (unsigned)(Rb * K + C) * 2u; }
    const size_t kstep = (size_t)(BK * 2);
    const size_t hstep = (size_t)HALF * K * 2;
    const size_t tstep = 2 * hstep;
    const unsigned ldsw = (unsigned)wid * 1024u;
    const int aoff = lds_byte(wr * 64 + fr, fq * 8), boff = lds_byte(wc * 32 + fr, fq * 8);
#define PG8_SA(b, h) (((b) * 2 + (h)) * HTB)
#define PG8_SB(b, h) ((4 + (b) * 2 + (h)) * HTB)
#define PG8_STAGE(bufoff, gbase, voff) do { _Pragma("unroll") for (int _i = 0; _i < 2; ++_i) \
        __builtin_amdgcn_global_load_lds((const unsigned*)((const char*)(gbase) + (voff)[_i]), (PG8_LAS unsigned*)(lds + (bufoff) + ldsw + _i * 8192), 16, 0, 0); } while (0)
#define PG8_LDA(dst, b, h) do { _Pragma("unroll") for (int m = 0; m < 4; ++m) _Pragma("unroll") for (int k = 0; k < 2; ++k) dst[m][k] = *(const PG8_LAS bf16x8*)(lds + PG8_SA(b, h) + aoff + m * 2048 + k * 1024); } while (0)
#define PG8_LDB(dst, b, h) do { _Pragma("unroll") for (int n = 0; n < 2; ++n) _Pragma("unroll") for (int k = 0; k < 2; ++k) dst[n][k] = *(const PG8_LAS bf16x8*)(lds + PG8_SB(b, h) + boff + n * 2048 + k * 1024); } while (0)
#define PG8_MMA(ai, bj, At, Bt) do { __builtin_amdgcn_s_setprio(1); _Pragma("unroll") for (int m = 0; m < 4; ++m) _Pragma("unroll") for (int n = 0; n < 2; ++n) _Pragma("unroll") for (int k = 0; k < 2; ++k) \
        acc[ai][bj][m][n] = __builtin_amdgcn_mfma_f32_16x16x32_bf16(Bt[n][k], At[m][k], acc[ai][bj][m][n], 0, 0, 0); __builtin_amdgcn_s_setprio(0); } while (0)
#define PG8_WAIT_V(n) asm volatile("s_waitcnt vmcnt(" #n ")" ::: "memory")
#define PG8_WAIT_L(n) asm volatile("s_waitcnt lgkmcnt(" #n ")" ::: "memory")
#define PG8_BAR __builtin_amdgcn_s_barrier()
#define PG8_SCHED __builtin_amdgcn_sched_barrier(0)
    Unit cur, nxt; int ui = 0;
    if (!S.next(0, cur)) return;
    f32x4 acc[2][2][4][2];
#pragma unroll
    for (int a = 0; a < 2; ++a)
#pragma unroll
        for (int b = 0; b < 2; ++b)
#pragma unroll
            for (int m = 0; m < 4; ++m)
#pragma unroll
                for (int n = 0; n < 2; ++n) acc[a][b][m][n] = (f32x4){0.f, 0.f, 0.f, 0.f};
    bf16x8 At[4][2], B0[2][2], B1[2][2];
    const char* cA = (const char*)g.A + (size_t)cur.pm * tstep; const char* cB = (const char*)g.Bt + (size_t)cur.pn * tstep;
    S.a_ready(cur);
    if constexpr (SP2) {
        PG8_STAGE(PG8_SB(0, 0), cB, voffB); PG8_STAGE(PG8_SB(0, 1), cB + hstep, voffB); PG8_STAGE(PG8_SA(0, 0), cA, voffA); PG8_STAGE(PG8_SA(0, 1), cA + hstep, voffA);
        if (wr == 1) PG8_BAR;
        PG8_WAIT_V(2); PG8_BAR;
        PG8_STAGE(PG8_SB(1, 0), cB + kstep, voffB); PG8_STAGE(PG8_SA(1, 0), cA + kstep, voffA); PG8_STAGE(PG8_SB(1, 1), cB + hstep + kstep, voffB);
        PG8_WAIT_V(6); PG8_BAR;
    } else {
        PG8_STAGE(PG8_SB(0, 0), cB, voffB); PG8_STAGE(PG8_SA(0, 0), cA, voffA); PG8_STAGE(PG8_SB(0, 1), cB + hstep, voffB); PG8_STAGE(PG8_SA(0, 1), cA + hstep, voffA);
        if (wr == 1) PG8_BAR;
        PG8_WAIT_V(4); PG8_BAR;
        PG8_STAGE(PG8_SB(1, 0), cB + kstep, voffB); PG8_STAGE(PG8_SA(1, 0), cA + kstep, voffA); PG8_STAGE(PG8_SB(1, 1), cB + hstep + kstep, voffB);
        PG8_WAIT_V(6); PG8_BAR;
    }
    for (;;) {
        const bool has_next = S.next(ui + 1, nxt);
        const char* nA = has_next ? (const char*)g.A + (size_t)nxt.pm * tstep : cA; const char* nB = has_next ? (const char*)g.Bt + (size_t)nxt.pn * tstep : cB;
        for (int t = 0; t < nt; t += 2) {
            const bool last = (t == nt - 2);
            const char* a1 = cA + (size_t)(t + 1) * kstep;
            const char* a2 = last ? nA : cA + (size_t)(t + 2) * kstep; const char* b2 = last ? nB : cB + (size_t)(t + 2) * kstep;
            const char* a3 = a2 + kstep; const char* b3 = b2 + kstep;
            if (last && has_next) S.a_ready(nxt);
            if constexpr (SP2) {
            PG8_LDB(B0, 0, 0); PG8_LDB(B1, 0, 1); PG8_SCHED; PG8_LDA(At, 0, 0); PG8_STAGE(PG8_SA(1, 1), a1 + hstep, voffA);
            PG8_WAIT_V(8); PG8_WAIT_L(0); PG8_BAR; PG8_MMA(0, 0, At, B0); PG8_MMA(0, 1, At, B1); PG8_BAR; PG8_SCHED;
            PG8_LDA(At, 0, 1); PG8_STAGE(PG8_SB(0, 0), b2, voffB); PG8_STAGE(PG8_SB(0, 1), b2 + hstep, voffB); PG8_STAGE(PG8_SA(0, 0), a2, voffA);
            PG8_WAIT_V(8); PG8_WAIT_L(0); PG8_BAR; PG8_MMA(1, 0, At, B0); PG8_MMA(1, 1, At, B1); PG8_BAR; PG8_SCHED;
            PG8_LDB(B0, 1, 0); PG8_LDB(B1, 1, 1); PG8_SCHED; PG8_LDA(At, 1, 0); PG8_STAGE(PG8_SA(0, 1), a2 + hstep, voffA);
            PG8_WAIT_V(8); PG8_WAIT_L(0); PG8_BAR; PG8_MMA(0, 0, At, B0); PG8_MMA(0, 1, At, B1); PG8_BAR; PG8_SCHED;
            PG8_LDA(At, 1, 1); PG8_STAGE(PG8_SB(1, 0), b3, voffB); PG8_STAGE(PG8_SB(1, 1), b3 + hstep, voffB); PG8_STAGE(PG8_SA(1, 0), a3, voffA);
            PG8_WAIT_V(8); PG8_WAIT_L(0); PG8_BAR; PG8_MMA(1, 0, At, B0); PG8_MMA(1, 1, At, B1); PG8_BAR; PG8_SCHED;
            } else {
            PG8_LDB(B0, 0, 0); PG8_SCHED; PG8_LDA(At, 0, 0); PG8_STAGE(PG8_SA(1, 1), a1 + hstep, voffA);
            PG8_WAIT_L(8); PG8_BAR; PG8_WAIT_L(0); PG8_MMA(0, 0, At, B0); PG8_BAR; PG8_SCHED;
            PG8_LDB(B1, 0, 1); PG8_STAGE(PG8_SB(0, 0), b2, voffB);
            PG8_BAR; PG8_WAIT_L(0); PG8_MMA(0, 1, At, B1); PG8_BAR;
            PG8_LDA(At, 0, 1); PG8_STAGE(PG8_SA(0, 0), a2, voffA);
            PG8_BAR; PG8_WAIT_L(0); PG8_MMA(1, 0, At, B0); PG8_BAR; PG8_SCHED;
            PG8_STAGE(PG8_SB(0, 1), b2 + hstep, voffB);
            PG8_WAIT_V(6); PG8_BAR; PG8_MMA(1, 1, At, B1); PG8_BAR;
            PG8_LDB(B0, 1, 0); PG8_SCHED; PG8_LDA(At, 1, 0); PG8_STAGE(PG8_SA(0, 1), a2 + hstep, voffA);
            PG8_WAIT_L(8); PG8_BAR; PG8_WAIT_L(0); PG8_MMA(0, 0, At, B0); PG8_BAR; PG8_SCHED;
            PG8_LDB(B1, 1, 1); PG8_STAGE(PG8_SB(1, 0), b3, voffB);
            PG8_BAR; PG8_WAIT_L(0); PG8_MMA(0, 1, At, B1); PG8_BAR;
            PG8_LDA(At, 1, 1); PG8_STAGE(PG8_SA(1, 0), a3, voffA);
            PG8_BAR; PG8_WAIT_L(0); PG8_MMA(1, 0, At, B0); PG8_BAR; PG8_SCHED;
            PG8_STAGE(PG8_SB(1, 1), b3 + hstep, voffB);
            PG8_WAIT_V(6); PG8_BAR; PG8_MMA(1, 1, At, B1); PG8_BAR;
            }
        }
        if constexpr (ALIGN_EPI) { if (wr == 0) PG8_BAR; }
        if constexpr (!Epi::AFTER_DRAIN) { E(acc, cur, wr, wc, fr, fq); S.done(cur); }
        if (!has_next) break;
#pragma unroll
        for (int a = 0; a < 2; ++a)
#pragma unroll
            for (int b = 0; b < 2; ++b)
#pragma unroll
                for (int m = 0; m < 4; ++m)
#pragma unroll
                    for (int n = 0; n < 2; ++n) acc[a][b][m][n] = (f32x4){0.f, 0.f, 0.f, 0.f};
        cur = nxt; cA = nA; cB = nB; ++ui;
        if constexpr (ALIGN_EPI) { if (wr == 1) PG8_BAR; }
    }
    PG8_WAIT_V(0);
    if constexpr (!ALIGN_EPI) { if (wr == 0) PG8_BAR; }
    PG8_BAR;
    if constexpr (Epi::AFTER_DRAIN) { E.fused(acc, cur, wr, wc, fr, fq, lds, wid, lane); S.done(cur); }
#undef PG8_SA
#undef PG8_SB
#undef PG8_STAGE
#undef PG8_LDA
#undef PG8_LDB
#undef PG8_MMA
#undef PG8_WAIT_V
#undef PG8_WAIT_L
#undef PG8_BAR
#undef PG8_SCHED
}
}
#define XB_TMO      128
#define XB_XCNT(j)  (256  + 64 * (j))
#define XB_XSUB(j)  (1280 + 64 * (j))
#define XB_XGEN(j)  (2304 + 64 * (j))
#define XB_TOP      3328
#define XB_TOPGEN   3392
#define XCD_BAR_WORDS 3456
#define XB_SPIN_CAP (1u << 18)
#define LAS __attribute__((address_space(3)))

__device__ __forceinline__ unsigned xb_ld(unsigned* p)              { return __hip_atomic_load(p, __ATOMIC_RELAXED, __HIP_MEMORY_SCOPE_AGENT); }
__device__ __forceinline__ unsigned xb_add(unsigned* p, unsigned v) { return __hip_atomic_fetch_add(p, v, __ATOMIC_RELAXED, __HIP_MEMORY_SCOPE_AGENT); }
__device__ __forceinline__ unsigned xb_xcc_id() { return (unsigned)__builtin_amdgcn_s_getreg((3 << 11) | 20) & 0xFu; }
#define XB_SPIN(cond, bar) do { unsigned _sp = 0; while (cond) { __builtin_amdgcn_s_sleep(1); \
    if ((++_sp & 255u) == 0u) { if (xb_ld(&(bar)[XB_TMO])) break; if (_sp > XB_SPIN_CAP) { atomicAdd(&(bar)[XB_TMO], 1u); break; } } } } while (0)

struct XcdBarrier {
    unsigned* bar; unsigned x;
    volatile LAS unsigned* st;
};

__device__ __forceinline__ XcdBarrier xcd_barrier_post(unsigned* bar, volatile LAS unsigned* st) {
    XcdBarrier b; b.bar = bar; b.x = xb_xcc_id(); b.st = st;
    if (threadIdx.x == 0) (void)xb_add(&bar[XB_XCNT(b.x)], 1u);
    return b;
}
__device__ __forceinline__ void xcd_barrier_complete(unsigned* bar, unsigned x, unsigned& nloc, unsigned& nx) {
    const unsigned G = gridDim.x * gridDim.y * gridDim.z;
    unsigned sum, cnt, mine, sp = 0u;
    for (;;) {
        sum = 0u; cnt = 0u; mine = 0u;
#pragma unroll
        for (unsigned j = 0; j < 16; ++j) { const unsigned c = xb_ld(&bar[XB_XCNT(j)]); sum += c; cnt += (c > 0u) ? 1u : 0u; mine = (j == x) ? c : mine; }
        if (sum == G) break;
        __builtin_amdgcn_s_sleep(1);
        if ((++sp & 255u) == 0u) { if (xb_ld(&bar[XB_TMO])) break; if (sp > XB_SPIN_CAP) { atomicAdd(&bar[XB_TMO], 1u); break; } }
    }
    nloc = mine > 0u ? mine : 1u; nx = cnt > 0u ? cnt : 1u;
}

__device__ __forceinline__ void xcd_barrier(const XcdBarrier& b) {
    asm volatile("s_waitcnt vmcnt(0)" ::: "memory");
    __syncthreads();
    if (threadIdx.x == 0) {
        unsigned* bar = b.bar;
        __builtin_amdgcn_s_waitcnt(0);
        unsigned nloc = b.st[0], nx = b.st[1];
        if (nloc == 0u) { xcd_barrier_complete(bar, b.x, nloc, nx); b.st[0] = nloc; b.st[1] = nx; }
        const unsigned old = xb_add(&bar[XB_XSUB(b.x)], 1u);
        const unsigned gen = old / nloc;
        if (old + 1u == (gen + 1u) * nloc) {
            __builtin_amdgcn_fence(__ATOMIC_RELEASE, "agent");
            asm volatile("s_waitcnt vmcnt(0)" ::: "memory");
            const unsigned og = xb_add(&bar[XB_TOP], 1u);
            const unsigned tg = og / nx;
            if (og + 1u == (tg + 1u) * nx) xb_add(&bar[XB_TOPGEN], 1u);
            else XB_SPIN(xb_ld(&bar[XB_TOPGEN]) == tg, bar);
            __builtin_amdgcn_fence(__ATOMIC_ACQUIRE, "agent");
            xb_add(&bar[XB_XGEN(b.x)], 1u);
            asm volatile("s_waitcnt vmcnt(0)" ::: "memory");
        } else {
            XB_SPIN(xb_ld(&bar[XB_XGEN(b.x)]) == gen, bar);
            __builtin_amdgcn_fence(__ATOMIC_ACQUIRE, "agent");
            asm volatile("s_waitcnt vmcnt(0)" ::: "memory");
        }
    }
    __syncthreads();
}


typedef unsigned short bf16;
typedef pg8::f32x4 f32x4;
typedef pg8::u32x4 u32x4;
constexpr int NB = 8, SEQ = 4096, DM = 1024, NCTX = 256;
constexpr int TL = NB * SEQ, TC = NB * NCTX, TA = TL + TC;
constexpr int INW = 6144, GW = 512, NGRP = 12;
constexpr size_t GSTRIDE = (size_t)TA * GW;
constexpr float EPS = 1e-6f;
constexpr int SLOT_ROWS = 73728;

constexpr size_t MiB = (size_t)1 << 20;
constexpr size_t WS_CTL = 0, CTL_BYTES = 1 * MiB;
constexpr size_t WS_MOD = 1 * MiB;
constexpr size_t WS_LB = 1 * MiB + 512 * 1024;
constexpr size_t WS_ROPE = 2 * MiB;
constexpr size_t WS_TOK = 3 * MiB;
constexpr size_t WS_CTXS = 4 * MiB;
constexpr size_t WS_WB = 12 * MiB;
constexpr size_t WS_H = 28 * MiB;
constexpr size_t WS_P = 96 * MiB;
constexpr size_t P_M = 34 * MiB, P_WEGU = 102 * MiB, P_WED = 134 * MiB, P_XS = 150 * MiB, P_ACT = 294 * MiB;
constexpr size_t WS_END = 504 * MiB;
constexpr int CW_BAR = 4096, CW_CNT = 131072;

constexpr int LDS_STAGE = 131072, LDS_BYTES = 147456;
constexpr int LDSW_BAR = 0, LDSW_TAB = 16;

struct Params {
    const float* x; const float* c; const float* ctx; const float* c_ctx; const float* w_ada; const float* b_ada; const float* norm1_g; const float* w_in;
    const float* rel_bias; const float* lowf; const float* lowb; const float* hg_norm_g; const float* w_na_o; const float* w_hg_o; const float* w_out; const float* norm2_g;
    const float* w_router; const float* router_bias; const float* w_gate; const float* w_up; const float* w_down; const float* final_g;
    float* out; unsigned char* ws; int lo, hi, li, pad;
};

__device__ __forceinline__ float bf2f(unsigned b) { return __uint_as_float(b << 16); }
__device__ __forceinline__ float bflo(unsigned w) { return __uint_as_float(w << 16); }
__device__ __forceinline__ float bfhi(unsigned w) { return __uint_as_float(w & 0xffff0000u); }
__device__ __forceinline__ unsigned f2bf(float f) { unsigned u = __float_as_uint(f); u += 0x7FFFu + ((u >> 16) & 1u); return u >> 16; }
__device__ __forceinline__ unsigned pk2(float lo, float hi) { return f2bf(lo) | (f2bf(hi) << 16); }
__device__ __forceinline__ float sigm(float x) { return 1.f / (1.f + __expf(-x)); }
__device__ __forceinline__ float silu(float x) { return x / (1.f + __expf(-x)); }
__device__ __forceinline__ float wave_sum(float v) {
#pragma unroll
    for (int o = 32; o >= 1; o >>= 1) v += __shfl_xor(v, o);
    return v; }
__device__ __forceinline__ float wave_max(float v) {
#pragma unroll
    for (int o = 32; o >= 1; o >>= 1) v = fmaxf(v, __shfl_xor(v, o));
    return v; }
__device__ __forceinline__ void unpack8(const uint4 w, float (&f)[8]) {
    f[0] = bflo(w.x); f[1] = bfhi(w.x); f[2] = bflo(w.y); f[3] = bfhi(w.y); f[4] = bflo(w.z); f[5] = bfhi(w.z); f[6] = bflo(w.w); f[7] = bfhi(w.w); }

typedef const __attribute__((address_space(4))) Params* ParamsK;
struct PView { ParamsK q; __device__ __forceinline__ const __attribute__((address_space(4))) Params* operator->() const { return q; } };
struct Ctx {
    PView p; unsigned char* ws; unsigned char* lds; int tid, lane, wave, G, bid, gw, nw;
    __device__ __forceinline__ float* MOD() const { return (float*)(ws + WS_MOD); }
    __device__ __forceinline__ float* LB() const { return (float*)(ws + WS_LB); }
    __device__ __forceinline__ float2* ROPE() const { return (float2*)(ws + WS_ROPE); }
    __device__ __forceinline__ int* TOKE() const { return (int*)(ws + WS_TOK); }
    __device__ __forceinline__ float* TOKW() const { return (float*)(ws + WS_TOK) + 2 * TA; }
    __device__ __forceinline__ int* TOKS() const { return (int*)(ws + WS_TOK) + 4 * TA; }
    __device__ __forceinline__ float* CTXS() const { return (float*)(ws + WS_CTXS); }
    __device__ __forceinline__ bf16* WIN_T() const { return (bf16*)(ws + WS_WB); }
    __device__ __forceinline__ bf16* WNA_T() const { return (bf16*)(ws + WS_WB + 12 * MiB); }
    __device__ __forceinline__ bf16* WHG_T() const { return (bf16*)(ws + WS_WB + 13 * MiB); }
    __device__ __forceinline__ bf16* WOUT_T() const { return (bf16*)(ws + WS_WB + 14 * MiB); }
    __device__ __forceinline__ bf16* H() const { return (bf16*)(ws + WS_H); }
    __device__ __forceinline__ bf16* GRP(int g) const { return (bf16*)(ws + WS_P) + (size_t)g * GSTRIDE; }
    __device__ __forceinline__ bf16* MB() const { return (bf16*)(ws + WS_P + P_M); }
    __device__ __forceinline__ bf16* WEGU() const { return (bf16*)(ws + WS_P + P_WEGU); }
    __device__ __forceinline__ bf16* WED() const { return (bf16*)(ws + WS_P + P_WED); }
    __device__ __forceinline__ bf16* XS() const { return (bf16*)(ws + WS_P + P_XS); }
    __device__ __forceinline__ bf16* ACT() const { return (bf16*)(ws + WS_P + P_ACT); }
    __device__ __forceinline__ unsigned* CTL() const { return (unsigned*)(ws + WS_CTL); }
    __device__ __forceinline__ unsigned* CNT(int l) const { return (unsigned*)(ws + WS_CTL) + CW_CNT + l * 64; }
    __device__ __forceinline__ int* TAB() const { return (int*)(lds + LDS_STAGE) + LDSW_TAB; }
};

template <class RowMap>
__device__ __forceinline__ void tconv_tile(const float* __restrict__ src, int ldsrc, int k0, int n0, bf16* __restrict__ dst, int ldd, int lane, RowMap rm) {
    float v[64];
    const float* s = src + (size_t)k0 * ldsrc + n0 + lane;
#pragma unroll
    for (int k = 0; k < 64; ++k) { v[k] = *s; s += ldsrc; asm volatile("" : "+v"(s)); }
    bf16* d = dst + (size_t)rm(n0 + lane) * ldd + k0;
#pragma unroll
    for (int j = 0; j < 8; ++j) { uint4 w; w.x = pk2(v[8 * j], v[8 * j + 1]); w.y = pk2(v[8 * j + 2], v[8 * j + 3]); w.z = pk2(v[8 * j + 4], v[8 * j + 5]); w.w = pk2(v[8 * j + 6], v[8 * j + 7]);
        *(uint4*)(d + 8 * j) = w; }
}
struct RmId { __device__ __forceinline__ int operator()(int n) const { return n; } };
struct RmGU { int base; __device__ __forceinline__ int operator()(int n) const { return base + (n >> 7) * 256 + (n & 127); } };

__device__ __forceinline__ void conv_mixer(const Ctx& C, int l) {
    for (int id = C.gw; id < 2048; id += C.nw) {
        if (id < 1536) { const int kt = id & 15, nt = id >> 4; tconv_tile(C.p->w_in + (size_t)l * DM * INW, INW, kt * 64, nt * 64, C.WIN_T(), DM, C.lane, RmId()); }
        else if (id < 1664) { const int j = id - 1536, kt = j & 7, nt = j >> 3; tconv_tile(C.p->w_na_o + (size_t)l * 512 * DM, DM, kt * 64, nt * 64, C.WNA_T(), 512, C.lane, RmId()); }
        else if (id < 1792) { const int j = id - 1664, kt = j & 7, nt = j >> 3; tconv_tile(C.p->w_hg_o + (size_t)l * 512 * DM, DM, kt * 64, nt * 64, C.WHG_T(), 512, C.lane, RmId()); }
        else { const int j = id - 1792, kt = j & 15, nt = j >> 4; tconv_tile(C.p->w_out + (size_t)l * DM * DM, DM, kt * 64, nt * 64, C.WOUT_T(), DM, C.lane, RmId()); }
    }
}
__device__ __forceinline__ void conv_experts(const Ctx& C, int l) {
    for (int id = C.gw; id < 6144; id += C.nw) {
        const int e = id / 384, j = id % 384;
        if (j < 128) { const int kt = j & 15, nt = j >> 4; tconv_tile(C.p->w_gate + ((size_t)l * 16 + e) * DM * 512, 512, kt * 64, nt * 64, C.WEGU(), DM, C.lane, RmGU{e * 1024}); }
        else if (j < 256) { const int jj = j - 128, kt = jj & 15, nt = jj >> 4; tconv_tile(C.p->w_up + ((size_t)l * 16 + e) * DM * 512, 512, kt * 64, nt * 64, C.WEGU(), DM, C.lane, RmGU{e * 1024 + 128}); }
        else { const int jj = j - 256, kt = jj & 7, nt = jj >> 3; tconv_tile(C.p->w_down + ((size_t)l * 16 + e) * 512 * DM, DM, kt * 64, nt * 64, C.WED() + (size_t)e * 1024 * 512, 512, C.lane, RmId()); }
    }
}

__device__ __forceinline__ void p0_prologue(const Ctx& C) {
    for (int u = C.bid; u < 24; u += C.G) {
        float* sl = (float*)C.lds;
        for (int i = C.tid; i < 9 * 1024; i += 512) { const int r = i >> 10, k = i & 1023; const float v = (r < 8) ? C.p->c[r * 1024 + k] : C.p->c_ctx[k]; sl[i] = v / (1.f + expf(-v)); }
        __syncthreads();
        const int l = u / 12, n = (u % 12) * 512 + C.tid;
        const float* w = C.p->w_ada + (size_t)l * DM * INW + n;
        float acc[9];
#pragma unroll
        for (int r = 0; r < 9; ++r) acc[r] = 0.f;
#pragma unroll 8
        for (int k = 0; k < 1024; ++k) { const float wv = w[(size_t)k * INW];
#pragma unroll
            for (int r = 0; r < 9; ++r) acc[r] += sl[r * 1024 + k] * wv; }
        const float bb = C.p->b_ada[l * INW + n];
#pragma unroll
        for (int r = 0; r < 9; ++r) C.MOD()[(size_t)(l * 9 + r) * INW + n] = acc[r] + bb;
        __syncthreads();
    }
    const int gt = C.bid * 512 + C.tid, nthr = C.G * 512;
    for (int i = gt; i < 4096 * 32; i += nthr) { const int t = i >> 5, pr = i & 31; const float pos = (float)((pr < 16) ? (t >> 6) : (t & 63)); const int j = pr & 15;
        const float inv = powf(10000.f, -(float)(2 * j) / 32.f); const float ang = pos * inv; C.ROPE()[i] = make_float2(cosf(ang), sinf(ang)); }
    for (int i = gt; i < 1024; i += nthr) { const int dir = i >> 9, ch = i & 511; const float* raw = dir ? C.p->lowb : C.p->lowf; const float r0 = raw[ch], r1 = raw[512 + ch];
        const float p1 = 1.f / (1.f + expf(r0 - r1)); C.LB()[(0 * 2 + dir) * 512 + ch] = 0.f; C.LB()[(1 * 2 + dir) * 512 + ch] = p1; }
    conv_mixer(C, 0);
}

__device__ __forceinline__ void load_row(const float* xr, int lane, float (&v)[16]) {
#pragma unroll
    for (int j = 0; j < 4; ++j) { const float4 t = *(const float4*)(xr + j * 256 + lane * 4); v[4 * j] = t.x; v[4 * j + 1] = t.y; v[4 * j + 2] = t.z; v[4 * j + 3] = t.w; }
}
__device__ __forceinline__ float row_rinv(const float (&v)[16]) {
    float ss = 0.f;
#pragma unroll
    for (int i = 0; i < 16; ++i) ss += v[i] * v[i];
    ss = wave_sum(ss);
    return rsqrtf(ss * (1.f / 1024.f) + EPS);
}
__device__ __forceinline__ void norm_mod(const float (&v)[16], float rinv, const float* gam, const float* sc, const float* sh, int lane, float (&h)[16]) {
#pragma unroll
    for (int j = 0; j < 4; ++j) { const int c = j * 256 + lane * 4; const float4 g = *(const float4*)(gam + c), s = *(const float4*)(sc + c), b = *(const float4*)(sh + c);
        h[4 * j] = v[4 * j] * rinv * g.x * (1.f + s.x) + b.x; h[4 * j + 1] = v[4 * j + 1] * rinv * g.y * (1.f + s.y) + b.y;
        h[4 * j + 2] = v[4 * j + 2] * rinv * g.z * (1.f + s.z) + b.z; h[4 * j + 3] = v[4 * j + 3] * rinv * g.w * (1.f + s.w) + b.w; }
}
__device__ __forceinline__ void store_row_bf16(bf16* hr, int lane, const float (&h)[16]) {
#pragma unroll
    for (int j = 0; j < 4; ++j) { uint2 w; w.x = pk2(h[4 * j], h[4 * j + 1]); w.y = pk2(h[4 * j + 2], h[4 * j + 3]); *(uint2*)(hr + j * 256 + lane * 4) = w; }
}
__device__ __forceinline__ int modrow_of(int r) { return r < TL ? (r >> 12) : 8; }

__device__ __forceinline__ void p1_norm1(const Ctx& C, int l, const float* xl, const float* xc) {
    for (int r = C.gw; r < TA; r += C.nw) {
        const float* xr = r < TL ? xl + (size_t)r * DM : xc + (size_t)(r - TL) * DM;
        float v[16], h[16]; load_row(xr, C.lane, v);
        const float rinv = row_rinv(v);
        const float* mod = C.MOD() + (size_t)(l * 9 + modrow_of(r)) * INW;
        norm_mod(v, rinv, C.p->norm1_g + l * DM, mod + 1024, mod, C.lane, h);
        store_row_bf16(C.H() + (size_t)r * DM, C.lane, h);
    }
}

struct EpiInProj {
    static constexpr bool PERM = true, AFTER_DRAIN = false;
    bf16* P; const float2* rope;
    __device__ __forceinline__ void operator()(const f32x4 (&acc)[2][2][4][2], const pg8::Unit& u, int wr, int wc, int fr, int fq) const {
        const int grp = u.pn >> 1; bf16* base = P + (size_t)grp * GSTRIDE;
        const int colb = (u.pn & 1) * 256 + wc * 32 + 8 * fq;
        const bool do_rope = (grp < 2) && (u.pm < TL / 256);
#pragma unroll
        for (int ai = 0; ai < 2; ++ai)
#pragma unroll
            for (int m = 0; m < 4; ++m) { const int row = u.pm * 256 + ai * 128 + wr * 64 + m * 16 + fr;
#pragma unroll
                for (int bj = 0; bj < 2; ++bj) { const int col = colb + bj * 128; f32x4 v0 = acc[ai][bj][m][0], v1 = acc[ai][bj][m][1];
                    if (do_rope) { const float4* rp = (const float4*)(rope + (size_t)(row & 4095) * 32 + ((col & 63) >> 1)); const float4 c01 = rp[0], c23 = rp[1];
                        const f32x4 a = v0, b = v1;
                        v0[0] = a[0] * c01.x - a[1] * c01.y; v0[1] = a[0] * c01.y + a[1] * c01.x; v0[2] = a[2] * c01.z - a[3] * c01.w; v0[3] = a[2] * c01.w + a[3] * c01.z;
                        v1[0] = b[0] * c23.x - b[1] * c23.y; v1[1] = b[0] * c23.y + b[1] * c23.x; v1[2] = b[2] * c23.z - b[3] * c23.w; v1[3] = b[2] * c23.w + b[3] * c23.z; }
                    u32x4 w; w.x = pg8::cvt_pk_bf16(v0[0], v0[1]); w.y = pg8::cvt_pk_bf16(v0[2], v0[3]); w.z = pg8::cvt_pk_bf16(v1[0], v1[1]); w.w = pg8::cvt_pk_bf16(v1[2], v1[3]);
                    *(u32x4*)(base + (size_t)row * GW + col) = w; } }
    }
};
template <int PASS> struct EpiMerge {
    static constexpr bool PERM = true, AFTER_DRAIN = false;
    bf16* M; const bf16* G;
    __device__ __forceinline__ void operator()(const f32x4 (&acc)[2][2][4][2], const pg8::Unit& u, int wr, int wc, int fr, int fq) const {
        const bf16* gb = G + (size_t)(u.pn >> 1) * GSTRIDE; const int gcol = (u.pn & 1) * 256 + wc * 32 + 8 * fq, mcol = u.pn * 256 + wc * 32 + 8 * fq;
#pragma unroll
        for (int ai = 0; ai < 2; ++ai)
#pragma unroll
            for (int m = 0; m < 4; ++m) { const int row = u.pm * 256 + ai * 128 + wr * 64 + m * 16 + fr;
#pragma unroll
                for (int bj = 0; bj < 2; ++bj) { const uint4 gw = *(const uint4*)(gb + (size_t)row * GW + gcol + bj * 128); float g[8]; unpack8(gw, g);
                    bf16* mp = M + (size_t)row * DM + mcol + bj * 128; const f32x4 v0 = acc[ai][bj][m][0], v1 = acc[ai][bj][m][1];
                    float o[8];
#pragma unroll
                    for (int i = 0; i < 4; ++i) { o[i] = sigm(g[i]) * v0[i]; o[4 + i] = sigm(g[4 + i]) * v1[i]; }
                    if (PASS == 1) { const uint4 mw = *(const uint4*)mp; float pm_[8]; unpack8(mw, pm_);
#pragma unroll
                        for (int i = 0; i < 8; ++i) o[i] += pm_[i]; }
                    u32x4 w; w.x = pg8::cvt_pk_bf16(o[0], o[1]); w.y = pg8::cvt_pk_bf16(o[2], o[3]); w.z = pg8::cvt_pk_bf16(o[4], o[5]); w.w = pg8::cvt_pk_bf16(o[6], o[7]);
                    *(u32x4*)mp = w; } }
    }
};
struct EpiOut {
    static constexpr bool PERM = false, AFTER_DRAIN = false;
    const float* xl_src; float* xl_dst; const float* xc_src; float* xc_dst; const float* mod;
    __device__ __forceinline__ void operator()(const f32x4 (&acc)[2][2][4][2], const pg8::Unit& u, int wr, int wc, int fr, int fq) const {
        const bool lat = u.pm < TL / 256; const int mr = lat ? (u.pm >> 4) : 8;
        const float* gate = mod + (size_t)mr * INW + 2048; const int col0 = u.pn * 256 + wc * 32 + 4 * fq;
        const float* src = lat ? xl_src : xc_src - (size_t)TL * DM; float* dst = lat ? xl_dst : xc_dst - (size_t)TL * DM;
        f32x4 gv[2][2];
#pragma unroll
        for (int bj = 0; bj < 2; ++bj)
#pragma unroll
            for (int n = 0; n < 2; ++n) gv[bj][n] = *(const f32x4*)(gate + col0 + bj * 128 + n * 16);
#pragma unroll
        for (int ai = 0; ai < 2; ++ai)
#pragma unroll
            for (int m = 0; m < 4; ++m) { const size_t off = (size_t)(u.pm * 256 + ai * 128 + wr * 64 + m * 16 + fr) * DM + col0;
#pragma unroll
                for (int bj = 0; bj < 2; ++bj)
#pragma unroll
                    for (int n = 0; n < 2; ++n) { const f32x4 xo = *(const f32x4*)(src + off + bj * 128 + n * 16); *(f32x4*)(dst + off + bj * 128 + n * 16) = xo + gv[bj][n] * acc[ai][bj][m][n]; } }
    }
};
struct EpiGateUp {
    static constexpr bool PERM = true, AFTER_DRAIN = false;
    bf16* A;
    __device__ __forceinline__ void operator()(const f32x4 (&acc)[2][2][4][2], const pg8::Unit& u, int wr, int wc, int fr, int fq) const {
        const int col = (u.pn & 3) * 128 + wc * 32 + 8 * fq;
#pragma unroll
        for (int ai = 0; ai < 2; ++ai)
#pragma unroll
            for (int m = 0; m < 4; ++m) { const int row = u.pm * 256 + ai * 128 + wr * 64 + m * 16 + fr; float o[8];
#pragma unroll
                for (int i = 0; i < 4; ++i) { o[i] = silu(acc[ai][0][m][0][i]) * acc[ai][1][m][0][i]; o[4 + i] = silu(acc[ai][0][m][1][i]) * acc[ai][1][m][1][i]; }
                u32x4 w; w.x = pg8::cvt_pk_bf16(o[0], o[1]); w.y = pg8::cvt_pk_bf16(o[2], o[3]); w.z = pg8::cvt_pk_bf16(o[4], o[5]); w.w = pg8::cvt_pk_bf16(o[6], o[7]);
                *(u32x4*)(A + (size_t)row * 512 + col) = w; }
    }
};
struct EpiDown {
    static constexpr bool PERM = true, AFTER_DRAIN = false;
    bf16* Y;
    __device__ __forceinline__ void operator()(const f32x4 (&acc)[2][2][4][2], const pg8::Unit& u, int wr, int wc, int fr, int fq) const {
        const int col = (u.pn & 3) * 256 + wc * 32 + 8 * fq;
#pragma unroll
        for (int ai = 0; ai < 2; ++ai)
#pragma unroll
            for (int m = 0; m < 4; ++m) { const int row = u.pm * 256 + ai * 128 + wr * 64 + m * 16 + fr;
#pragma unroll
                for (int bj = 0; bj < 2; ++bj) { const f32x4 v0 = acc[ai][bj][m][0], v1 = acc[ai][bj][m][1];
                    u32x4 w; w.x = pg8::cvt_pk_bf16(v0[0], v0[1]); w.y = pg8::cvt_pk_bf16(v0[2], v0[3]); w.z = pg8::cvt_pk_bf16(v1[0], v1[1]); w.w = pg8::cvt_pk_bf16(v1[2], v1[3]);
                    *(u32x4*)(Y + (size_t)row * DM + col + bj * 128) = w; } }
    }
};
struct MoeOrder {
    const int* tab; int G, c;
    __device__ __forceinline__ bool next(int i, pg8::Unit& u) const {
        const int L = i * G + c, MT = tab[16]; if (L >= MT * 4) return false;
        const int mt = L >> 2; int e = 0;
#pragma unroll
        for (int j = 1; j < 16; ++j) e += (mt >= tab[j]) ? 1 : 0;
        u.pm = mt; u.pn = e * 4 + (L & 3); return true;
    }
    __device__ __forceinline__ void a_ready(const pg8::Unit&) const {}
    __device__ __forceinline__ void done(const pg8::Unit&) const {}
};
__device__ __forceinline__ void moe_table(const Ctx& C, int l) {
    __syncthreads();
    if (C.tid == 0) { int acc = 0; const unsigned* cnt = C.CNT(l);
        for (int e = 0; e < 16; ++e) { C.TAB()[e] = acc; acc += (int)((__hip_atomic_load(cnt + e, __ATOMIC_RELAXED, __HIP_MEMORY_SCOPE_AGENT) + 255u) >> 8); }
        C.TAB()[16] = acc; }
    __syncthreads();
}

__device__ __forceinline__ void p3_attn_naive(const Ctx& C, int l) {
    float* pl = (float*)C.lds + C.wave * 768; int* kl = (int*)(pl + 384);
    const bf16* Q = C.GRP(0); const bf16* K = C.GRP(1); const bf16* V = C.GRP(2); bf16* O = C.GRP(0);
    const int nq = (l == 0 ? TA : TL) * 8;
    for (int wq = C.gw; wq < nq; wq += C.nw) {
        const int r = wq >> 3, h = wq & 7; const bool lat = r < TL;
        const int b = lat ? (r >> 12) : ((r - TL) >> 8);
        float q[64];
        { const uint4* qp = (const uint4*)(Q + (size_t)r * GW + h * 64);
#pragma unroll
          for (int j = 0; j < 8; ++j) { float t[8]; unpack8(qp[j], t);
#pragma unroll
              for (int i = 0; i < 8; ++i) q[8 * j + i] = t[i]; } }
        const int t = r & 4095, gr = t >> 6, gc = t & 63;
        const int rs = min(max(gr - 4, 0), 56), cs = min(max(gc - 8, 0), 48);
        float s[6]; int krow[6];
#pragma unroll
        for (int i = 0; i < 6; ++i) {
            float bias = 0.f; bool valid = true;
            if (i < 2) { const int j = C.lane + 64 * i, kr = rs + (j >> 4), kc = cs + (j & 15); krow[i] = b * 4096 + kr * 64 + kc; valid = lat;
                if (lat) bias = C.p->rel_bias[((size_t)(l * 8 + h) * 15 + (kr - gr + 7)) * 31 + (kc - gc + 15)]; if (!lat) krow[i] = TL + b * 256; }
            else krow[i] = TL + b * 256 + C.lane + 64 * (i - 2);
            const uint4* kp = (const uint4*)(K + (size_t)krow[i] * GW + h * 64); float d = 0.f;
#pragma unroll
            for (int j = 0; j < 8; ++j) { float tk[8]; unpack8(kp[j], tk);
#pragma unroll
                for (int ii = 0; ii < 8; ++ii) d += q[8 * j + ii] * tk[ii]; }
            s[i] = valid ? d * 0.125f + bias : -1e30f;
        }
        float mx = s[0];
#pragma unroll
        for (int i = 1; i < 6; ++i) mx = fmaxf(mx, s[i]);
        mx = wave_max(mx);
        float sum = 0.f;
#pragma unroll
        for (int i = 0; i < 6; ++i) { s[i] = (s[i] > -1e29f) ? __expf(s[i] - mx) : 0.f; sum += s[i]; }
        sum = wave_sum(sum); const float inv = 1.f / sum;
#pragma unroll
        for (int i = 0; i < 6; ++i) { pl[C.lane + 64 * i] = s[i] * inv; kl[C.lane + 64 * i] = krow[i]; }
        float acc = 0.f;
        for (int j = lat ? 0 : 128; j < 384; ++j) acc += pl[j] * bf2f(V[(size_t)kl[j] * GW + h * 64 + C.lane]);
        O[(size_t)r * GW + h * 64 + C.lane] = (bf16)f2bf(acc);
    }
}

__device__ __forceinline__ int scan_row(int b, int dir, int s) { return dir == 0 ? (s < NCTX ? TL + b * NCTX + s : b * SEQ + (s - NCTX)) : (s < NCTX ? TL + b * NCTX + (NCTX - 1 - s) : b * SEQ + (SEQ - 1 - (s - NCTX))); }
__device__ __forceinline__ void p3_scan_naive(const Ctx& C, int l) {
    const bf16* HQ = C.GRP(3); const bf16* HI = C.GRP(6);
    for (int u = C.gw; u < 2048; u += C.nw) {
        const int dv4 = u & 31, dir = (u >> 5) & 1, h = (u >> 6) & 3, b = u >> 8;
        const bf16* HF = C.GRP(dir ? 5 : 4); bf16* OUT = C.H() + (size_t)dir * GSTRIDE;
        const float lb0 = C.LB()[(l * 2 + dir) * 512 + h * 128 + C.lane], lb1 = C.LB()[(l * 2 + dir) * 512 + h * 128 + 64 + C.lane];
        float S0[4] = {0.f, 0.f, 0.f, 0.f}, S1[4] = {0.f, 0.f, 0.f, 0.f};
        const int NS = NCTX + SEQ;
        int row = scan_row(b, dir, 0);
        unsigned q0 = HQ[(size_t)row * GW + h * 128 + C.lane], q1 = HQ[(size_t)row * GW + h * 128 + 64 + C.lane], f0 = HF[(size_t)row * GW + h * 128 + C.lane], f1 = HF[(size_t)row * GW + h * 128 + 64 + C.lane];
        uint2 vv = *(const uint2*)(HI + (size_t)row * GW + h * 128 + dv4 * 4);
        for (int s = 0; s < NS; ++s) {
            const int nrow = scan_row(b, dir, (s + 1 < NS) ? s + 1 : s);
            const unsigned nq0 = HQ[(size_t)nrow * GW + h * 128 + C.lane], nq1 = HQ[(size_t)nrow * GW + h * 128 + 64 + C.lane], nf0 = HF[(size_t)nrow * GW + h * 128 + C.lane], nf1 = HF[(size_t)nrow * GW + h * 128 + 64 + C.lane];
            const uint2 nvv = *(const uint2*)(HI + (size_t)nrow * GW + h * 128 + dv4 * 4);
            const float qa = silu(bf2f(q0)), qb = silu(bf2f(q1));
            const float fa = fminf(fmaxf(bf2f(f0), -30.f), 30.f), fb = fminf(fmaxf(bf2f(f1), -30.f), 30.f);
            const float ea = __expf(-fa), eb = __expf(-fb);
            const float sga = 1.f / (1.f + ea), sgb = 1.f / (1.f + eb);
            const float ga = fmaxf(lb0 + (1.f - lb0) * sga, 1e-30f), gb = fmaxf(lb1 + (1.f - lb1) * sgb, 1e-30f);
            const float ka = (1.f - lb0) * (ea * sga), kb = (1.f - lb1) * (eb * sgb);
            const float v[4] = {bflo(vv.x), bfhi(vv.x), bflo(vv.y), bfhi(vv.y)};
            float o[4];
#pragma unroll
            for (int j = 0; j < 4; ++j) { S0[j] = ga * S0[j] + ka * v[j]; S1[j] = gb * S1[j] + kb * v[j]; o[j] = wave_sum(qa * S0[j] + qb * S1[j]); }
            if (C.lane == 0) { uint2 w; w.x = pk2(o[0], o[1]); w.y = pk2(o[2], o[3]); *(uint2*)(OUT + (size_t)row * GW + h * 128 + dv4 * 4) = w; }
            row = nrow; q0 = nq0; q1 = nq1; f0 = nf0; f1 = nf1; vv = nvv;
        }
    }
}

__device__ __forceinline__ void p3c_headnorm(const Ctx& C, int l) {
    const int nrows = (l == 0) ? TA : TL;
    bf16* OF = C.H(); const bf16* OB = C.H() + GSTRIDE; const bf16* HG = C.GRP(7);
    const float* gain = C.p->hg_norm_g + l * 128;
    for (int r = C.gw; r < nrows; r += C.nw) {
        const size_t off = (size_t)r * GW + C.lane * 8;
        float a[8], b[8], g[8]; unpack8(*(const uint4*)(OF + off), a); unpack8(*(const uint4*)(OB + off), b); unpack8(*(const uint4*)(HG + off), g);
        float ss = 0.f;
#pragma unroll
        for (int i = 0; i < 8; ++i) { a[i] += b[i]; ss += a[i] * a[i]; }
        ss += __shfl_xor(ss, 1); ss += __shfl_xor(ss, 2); ss += __shfl_xor(ss, 4); ss += __shfl_xor(ss, 8);
        const float rinv = rsqrtf(ss * (1.f / 128.f) + EPS);
        const int cg = (C.lane & 15) * 8; float o[8];
#pragma unroll
        for (int i = 0; i < 8; ++i) o[i] = a[i] * rinv * gain[cg + i] * silu(g[i]);
        uint4 w; w.x = pk2(o[0], o[1]); w.y = pk2(o[2], o[3]); w.z = pk2(o[4], o[5]); w.w = pk2(o[6], o[7]);
        *(uint4*)(OF + off) = w;
    }
}

__device__ __forceinline__ void p5_norm2_router(const Ctx& C, int l) {
    float* wr = (float*)C.lds;
    for (int i = C.tid; i < 1024 * 16; i += 512) wr[(i & 15) * 1024 + (i >> 4)] = C.p->w_router[i];
    __syncthreads();
    const int nrows = (l == 0) ? TA : TL;
    float rb[16];
#pragma unroll
    for (int e = 0; e < 16; ++e) rb[e] = C.p->router_bias[e];
    for (int r = C.gw; r < nrows; r += C.nw) {
        const float* xr = r < TL ? C.p->out + (size_t)r * DM : C.CTXS() + (size_t)(r - TL) * DM;
        float v[16], h[16]; load_row(xr, C.lane, v);
        const float rinv = row_rinv(v);
        const float* mod = C.MOD() + (size_t)(l * 9 + modrow_of(r)) * INW;
        norm_mod(v, rinv, C.p->norm2_g + l * DM, mod + 4096, mod + 3072, C.lane, h);
        store_row_bf16(C.H() + (size_t)r * DM, C.lane, h);
        float lgv = 0.f;
#pragma unroll 1
        for (int e = 0; e < 16; ++e) { const float* we = wr + e * 1024 + C.lane * 4; float a = 0.f;
#pragma unroll
            for (int j = 0; j < 4; ++j) { const float4 ww = *(const float4*)(we + j * 256); a += h[4 * j] * ww.x + h[4 * j + 1] * ww.y + h[4 * j + 2] * ww.z + h[4 * j + 3] * ww.w; }
            a = wave_sum(a); lgv = (C.lane == e) ? a : lgv; }
        float lg[16];
#pragma unroll
        for (int e = 0; e < 16; ++e) lg[e] = __shfl(lgv, e);
        float bestg = -1e30f; int e0 = 0, e1 = 1; float s0 = 0.f, s1 = 0.f;
#pragma unroll
        for (int g = 0; g < 4; ++g) {
            float sc[4], gbv[4];
#pragma unroll
            for (int j = 0; j < 4; ++j) { sc[j] = 1.f / (1.f + expf(-lg[4 * g + j])); gbv[j] = sc[j] + rb[4 * g + j]; }
            int i0 = 0; float b0 = gbv[0], u0 = sc[0];
#pragma unroll
            for (int j = 1; j < 4; ++j) if (gbv[j] > b0) { b0 = gbv[j]; i0 = j; u0 = sc[j]; }
            int i1 = -1; float b1 = -1e30f, u1 = 0.f;
#pragma unroll
            for (int j = 0; j < 4; ++j) if (j != i0 && gbv[j] > b1) { b1 = gbv[j]; i1 = j; u1 = sc[j]; }
            const float gs = b0 + b1;
            if (gs > bestg) { bestg = gs; e0 = 4 * g + i0; e1 = 4 * g + i1; s0 = u0; s1 = u1; }
        }
        if (C.lane == 0) {
            const float den = s0 + s1; unsigned* cnt = C.CNT(l);
            const int r0 = (int)atomicAdd(cnt + e0, 1u), r1 = (int)atomicAdd(cnt + e1, 1u);
            C.TOKE()[2 * r] = e0; C.TOKE()[2 * r + 1] = e1; C.TOKW()[2 * r] = s0 / den; C.TOKW()[2 * r + 1] = s1 / den; C.TOKS()[2 * r] = r0; C.TOKS()[2 * r + 1] = r1;
        }
    }
    __syncthreads();
}

__device__ __forceinline__ void p6_permute(const Ctx& C, int l) {
    moe_table(C, l);
    const int nrows = (l == 0) ? TA : TL;
    for (int r = C.gw; r < nrows; r += C.nw) {
        const int e0 = C.TOKE()[2 * r], e1 = C.TOKE()[2 * r + 1];
        const int sl0 = C.TAB()[e0] * 256 + C.TOKS()[2 * r], sl1 = C.TAB()[e1] * 256 + C.TOKS()[2 * r + 1];
        const uint4* src = (const uint4*)(C.H() + (size_t)r * DM);
        const uint4 a = src[C.lane], b = src[64 + C.lane];
        uint4* d0 = (uint4*)(C.XS() + (size_t)sl0 * DM); uint4* d1 = (uint4*)(C.XS() + (size_t)sl1 * DM);
        d0[C.lane] = a; d0[64 + C.lane] = b; d1[C.lane] = a; d1[64 + C.lane] = b;
        if (C.lane == 0) { C.TOKS()[2 * r] = sl0; C.TOKS()[2 * r + 1] = sl1; }
    }
}

__device__ __forceinline__ void p9_combine(const Ctx& C, int l) {
    const int nrows = (l == 0) ? TA : TL; const bf16* YS = C.XS();
    for (int r = C.gw; r < nrows; r += C.nw) {
        float* xr = r < TL ? C.p->out + (size_t)r * DM : C.CTXS() + (size_t)(r - TL) * DM;
        float v[16]; load_row(xr, C.lane, v);
        const int s0 = C.TOKS()[2 * r], s1 = C.TOKS()[2 * r + 1]; const float w0 = C.TOKW()[2 * r], w1 = C.TOKW()[2 * r + 1];
        const float* mod = C.MOD() + (size_t)(l * 9 + modrow_of(r)) * INW;
#pragma unroll
        for (int j = 0; j < 4; ++j) { const int c = j * 256 + C.lane * 4; const uint2 a = *(const uint2*)(YS + (size_t)s0 * DM + c), b = *(const uint2*)(YS + (size_t)s1 * DM + c); const float4 g = *(const float4*)(mod + 5120 + c);
            v[4 * j] += g.x * (w0 * bflo(a.x) + w1 * bflo(b.x)); v[4 * j + 1] += g.y * (w0 * bfhi(a.x) + w1 * bfhi(b.x));
            v[4 * j + 2] += g.z * (w0 * bflo(a.y) + w1 * bflo(b.y)); v[4 * j + 3] += g.w * (w0 * bfhi(a.y) + w1 * bfhi(b.y)); }
        const float rinv = row_rinv(v);
        if (l == 0) {
#pragma unroll
            for (int j = 0; j < 4; ++j) *(float4*)(xr + j * 256 + C.lane * 4) = make_float4(v[4 * j], v[4 * j + 1], v[4 * j + 2], v[4 * j + 3]);
            float h[16]; const float* mod1 = C.MOD() + (size_t)(9 + modrow_of(r)) * INW;
            norm_mod(v, rinv, C.p->norm1_g + DM, mod1 + 1024, mod1, C.lane, h);
            store_row_bf16(C.H() + (size_t)r * DM, C.lane, h);
        } else {
#pragma unroll
            for (int j = 0; j < 4; ++j) { const int c = j * 256 + C.lane * 4; const float4 g = *(const float4*)(C.p->final_g + c);
                *(float4*)(xr + c) = make_float4(v[4 * j] * rinv * g.x, v[4 * j + 1] * rinv * g.y, v[4 * j + 2] * rinv * g.z, v[4 * j + 3] * rinv * g.w); }
        }
    }
}

#ifndef PHMASK
#define PHMASK 0xFFFFu
#endif
#define PHON(i) (((PHMASK) >> (i)) & 1u)
constexpr int NPH = 22;
__global__ void __launch_bounds__(512, 2) mk_fwd(Params p) {
    extern __shared__ __attribute__((aligned(16))) unsigned char lds_raw[];
    LAS unsigned char* ldsl = (LAS unsigned char*)lds_raw;
    if (threadIdx.x < 64) ((LAS unsigned*)(ldsl + LDS_STAGE))[threadIdx.x] = 0u;
    __syncthreads();
    XcdBarrier bar = xcd_barrier_post((unsigned*)(p.ws + WS_CTL) + CW_BAR + p.li * XCD_BAR_WORDS, (volatile LAS unsigned*)(ldsl + LDS_STAGE) + LDSW_BAR);
#define MKCTX() Ctx C; { unsigned long long kp_ = (unsigned long long)__builtin_amdgcn_kernarg_segment_ptr(); asm volatile("" : "+s"(kp_)); C.p.q = (ParamsK)kp_; } \
    C.ws = C.p->ws; C.lds = lds_raw; { int t_ = threadIdx.x, g_ = gridDim.x, b_ = blockIdx.x; asm volatile("" : "+v"(t_), "+s"(g_), "+s"(b_)); C.tid = t_; C.G = g_; C.bid = b_; } \
    C.lane = C.tid & 63; C.wave = __builtin_amdgcn_readfirstlane(C.tid >> 6); C.gw = C.bid * 8 + C.wave; C.nw = C.G * 8;
    const int lo = p.lo, hi = p.hi;
#define IN(k) (lo <= (k) && (k) < hi)
#define SEAM(k) do { if (IN((k) + 1)) xcd_barrier(bar); } while (0)

    if (PHON(0) && IN(0)) { MKCTX(); p0_prologue(C); SEAM(0); }
    if (PHON(1) && IN(1)) { MKCTX(); p1_norm1(C, 0, C.p->x, C.p->ctx); SEAM(1); }
    for (int l = 0; l < 2; ++l) {
        const int pb = 2 + 10 * l;
        const int mrows = (l == 0) ? TA : TL;
        if (PHON(2) && IN(pb + 0)) {
            MKCTX();
            pg8::Gemm g{C.H(), C.WIN_T(), TA, INW, DM}; pg8::StaticOrder S; S.init(TA, INW, C.G, C.bid);
            EpiInProj E{C.GRP(0), C.ROPE()};
            pg8::gemm_phase<EpiInProj, pg8::StaticOrder, true, true>(ldsl, g, S, E);
            SEAM(pb + 0);
        }
        if (PHON(3) && IN(pb + 1)) {
            MKCTX();
            p3_scan_naive(C, l);
            p3_attn_naive(C, l);
            SEAM(pb + 1);
        }
        if (PHON(4) && IN(pb + 2)) { MKCTX(); p3c_headnorm(C, l); SEAM(pb + 2); }
        if (PHON(5) && IN(pb + 3)) {
            MKCTX();
            pg8::StaticOrder S; S.init(mrows, DM, C.G, C.bid);
            { pg8::Gemm g{C.GRP(0), C.WNA_T(), mrows, DM, 512}; EpiMerge<0> E{C.MB(), C.GRP(8)}; pg8::gemm_phase<EpiMerge<0>, pg8::StaticOrder, true, true>(ldsl, g, S, E); }
            __syncthreads();
            { pg8::Gemm g{C.H(), C.WHG_T(), mrows, DM, 512}; EpiMerge<1> E{C.MB(), C.GRP(10)}; pg8::gemm_phase<EpiMerge<1>, pg8::StaticOrder, true, true>(ldsl, g, S, E); }
            SEAM(pb + 3);
        }
        if (PHON(6) && IN(pb + 4)) {
            MKCTX();
            pg8::StaticOrder S; S.init(mrows, DM, C.G, C.bid);
            pg8::Gemm g{C.MB(), C.WOUT_T(), mrows, DM, DM};
            EpiOut E{l == 0 ? C.p->x : (const float*)C.p->out, C.p->out, C.p->ctx, C.CTXS(), C.MOD() + (size_t)l * 9 * INW};
            pg8::gemm_phase<EpiOut, pg8::StaticOrder, true, true>(ldsl, g, S, E);
            conv_experts(C, l);
            SEAM(pb + 4);
        }
        if (PHON(7) && IN(pb + 5)) { MKCTX(); p5_norm2_router(C, l); SEAM(pb + 5); }
        if (PHON(8) && IN(pb + 6)) { MKCTX(); p6_permute(C, l); SEAM(pb + 6); }
        if (PHON(9) && IN(pb + 7)) {
            MKCTX();
            moe_table(C, l);
            MoeOrder S{C.TAB(), C.G, C.bid};
            pg8::Gemm g{C.XS(), C.WEGU(), SLOT_ROWS, 16384, DM}; EpiGateUp E{C.ACT()};
            pg8::gemm_phase<EpiGateUp, MoeOrder, true, true>(ldsl, g, S, E);
            SEAM(pb + 7);
        }
        if (PHON(10) && IN(pb + 8)) {
            MKCTX();
            moe_table(C, l);
            MoeOrder S{C.TAB(), C.G, C.bid};
            pg8::Gemm g{C.ACT(), C.WED(), SLOT_ROWS, 16384, 512}; EpiDown E{C.XS()};
            pg8::gemm_phase<EpiDown, MoeOrder, true, true>(ldsl, g, S, E);
            SEAM(pb + 8);
        }
        if (PHON(11) && IN(pb + 9)) { MKCTX(); p9_combine(C, l); if (l == 0) conv_mixer(C, 1); SEAM(pb + 9); }
    }
#undef IN
#undef SEAM
}

#ifndef MK_SPLIT
#define MK_SPLIT 1
#endif
extern "C" void kernel_launch(void* const* d_in, const int* in_sizes, int n_in, void* d_out, int out_size, void* d_ws, size_t ws_size, hipStream_t stream) {
    static int grid = 0;
    if (grid == 0) {
        if (n_in != 22 || ws_size < WS_END) { fprintf(stderr, "kernel_launch: unexpected n_in %d / ws_size %zu (need %zu)\n", n_in, ws_size, (size_t)WS_END); grid = -1; return; }
        int dev = 0, cus = 0, per_cu = 0;
        if (hipGetDevice(&dev) != hipSuccess || hipDeviceGetAttribute(&cus, hipDeviceAttributeMultiprocessorCount, dev) != hipSuccess) { grid = -1; return; }
        if (hipFuncSetAttribute((const void*)mk_fwd, hipFuncAttributeMaxDynamicSharedMemorySize, LDS_BYTES) != hipSuccess) { fprintf(stderr, "kernel_launch: hipFuncSetAttribute failed\n"); grid = -1; return; }
        if (hipOccupancyMaxActiveBlocksPerMultiprocessor(&per_cu, (const void*)mk_fwd, 512, LDS_BYTES) != hipSuccess || per_cu < 1) fprintf(stderr, "kernel_launch: occupancy query says %d\n", per_cu);
        (void)hipGetLastError();
        grid = cus;
    }
    if (grid < 0) return;
    if (hipMemsetAsync((char*)d_ws + WS_CTL, 0, CTL_BYTES, stream) != hipSuccess) return;
    Params p{};
    const float** pp = (const float**)&p;
    for (int i = 0; i < 22; ++i) pp[i] = (const float*)d_in[i];
    p.out = (float*)d_out; p.ws = (unsigned char*)d_ws; p.pad = 0;
#if MK_SPLIT
    for (int k = 0; k < NPH; ++k) { p.lo = k; p.hi = k + 1; p.li = k; hipLaunchKernelGGL(mk_fwd, dim3(grid), dim3(512), LDS_BYTES, stream, p); }
#else
    p.lo = 0; p.hi = NPH; p.li = 0;
    hipLaunchKernelGGL(mk_fwd, dim3(grid), dim3(512), LDS_BYTES, stream, p);
#endif
}
```

```cpp
#include <hip/hip_runtime.h>
#include <cstdio>
#include <cstdint>
namespace pg8 {
#define PG8_LAS __attribute__((address_space(3)))
typedef unsigned short bf16_t;
typedef short bf16x8 __attribute__((ext_vector_type(8)));
typedef float f32x4 __attribute__((ext_vector_type(4)));
typedef unsigned u32x4 __attribute__((ext_vector_type(4)));
constexpr int BM = 256, BK = 64, HALF = 128, HTB = HALF * BK * 2  , STAGE_BYTES = 8 * HTB, NXCD = 8, WGM = 8;

__host__ __device__ __forceinline__ int lds_byte(int r, int c) { const int st = (r >> 4) * 2 + (c >> 5), rr = r & 15, cc = c & 31, ob = rr * 64 + cc * 2; return st * 1024 + (ob ^ (((ob >> 9) & 1) << 5)); }
__host__ __device__ __forceinline__ void stage_rc(int b, int& R, int& C) { const int st = b / 1024, sb = b % 1024, swz = sb ^ (((sb >> 9) & 1) << 5); R = (st >> 1) * 16 + swz / 64; C = (st & 1) * 32 + (swz % 64) / 2; }
__host__ __device__ __forceinline__ int perm32(int rho) { const int n = rho >> 4, i = rho & 15; return 8 * (i >> 2) + 4 * n + (i & 3); }

struct Unit { int pm, pn; };
struct Gemm { const bf16_t* A; const bf16_t* Bt; int M, N, K; };

struct StaticOrder {
    int nM, nN, nwg, G, c;
    __host__ __device__ void init(int M, int N, int G_, int c_) { nM = M / BM; nN = N / BM; nwg = nM * nN; G = G_; c = c_; }
    __host__ __device__ bool next(int i, Unit& u) const {
        const long L = (long)i * G + c; if (L >= nwg) return false;
        int wgid = (int)L; { const int q = nwg / NXCD, r = nwg % NXCD, xcd = wgid % NXCD, off = wgid / NXCD; wgid = (xcd < r ? xcd * (q + 1) : r * (q + 1) + (xcd - r) * q) + off; }
        const int nig = WGM * nN, gid = wgid / nig, fm = gid * WGM, gsz = (nM - fm) < WGM ? (nM - fm) : WGM;
        u.pm = fm + ((wgid % nig) % gsz); u.pn = (wgid % nig) / gsz; return true;
    }
    __device__ __forceinline__ void a_ready(const Unit&) const {}
    __device__ __forceinline__ void done(const Unit&) const {}
};

__device__ __forceinline__ unsigned cvt_pk_bf16(float lo, float hi) { unsigned r; asm volatile("v_cvt_pk_bf16_f32 %0, %1, %2" : "=v"(r) : "v"(lo), "v"(hi)); return r; }
template <class Epi, class Sched, bool ALIGN_EPI = false, bool SP2 = false>
__device__ __forceinline__ void gemm_phase(PG8_LAS unsigned char* lds, const Gemm g, const Sched& S, const Epi& E) {
    int tid_ = threadIdx.x; asm volatile("" : "+v"(tid_));
    const int tid = tid_, wid = __builtin_amdgcn_readfirstlane(tid >> 6), lane = tid & 63, wr = wid >> 2, wc = wid & 3, fr = lane & 15, fq = lane >> 4;
    const int K = g.K, nt = K / BK;
    unsigned voffA[2], voffB[2];
#pragma unroll
    for (int i = 0; i < 2; ++i) { int R, C; stage_rc(tid * 16 + i * 8192, R, C); const int Rb = Epi::PERM ? ((R & ~31) + perm32(R & 31)) : R;
        voffA[i] = (unsigned)(R * K + C) * 2u; voffB[i] = (unsigned)(Rb * K + C) * 2u; }
    const size_t kstep = (size_t)(BK * 2);
    const size_t hstep = (size_t)HALF * K * 2;
    const size_t tstep = 2 * hstep;
    const unsigned ldsw = (unsigned)wid * 1024u;
    const int aoff = lds_byte(wr * 64 + fr, fq * 8), boff = lds_byte(wc * 32 + fr, fq * 8);
#define PG8_SA(b, h) (((b) * 2 + (h)) * HTB)
#define PG8_SB(b, h) ((4 + (b) * 2 + (h)) * HTB)
#define PG8_STAGE(bufoff, gbase, voff) do { _Pragma("unroll") for (int _i = 0; _i < 2; ++_i) \
        __builtin_amdgcn_global_load_lds((const unsigned*)((const char*)(gbase) + (voff)[_i]), (PG8_LAS unsigned*)(lds + (bufoff) + ldsw + _i * 8192), 16, 0, 0); } while (0)
#define PG8_LDA(dst, b, h) do { _Pragma("unroll") for (int m = 0; m < 4; ++m) _Pragma("unroll") for (int k = 0; k < 2; ++k) dst[m][k] = *(const PG8_LAS bf16x8*)(lds + PG8_SA(b, h) + aoff + m * 2048 + k * 1024); } while (0)
#define PG8_LDB(dst, b, h) do { _Pragma("unroll") for (int n = 0; n < 2; ++n) _Pragma("unroll") for (int k = 0; k < 2; ++k) dst[n][k] = *(const PG8_LAS bf16x8*)(lds + PG8_SB(b, h) + boff + n * 2048 + k * 1024); } while (0)
#define PG8_MMA(ai, bj, At, Bt) do { __builtin_amdgcn_s_setprio(1); _Pragma("unroll") for (int m = 0; m < 4; ++m) _Pragma("unroll") for (int n = 0; n < 2; ++n) _Pragma("unroll") for (int k = 0; k < 2; ++k) \
        acc[ai][bj][m][n] = __builtin_amdgcn_mfma_f32_16x16x32_bf16(Bt[n][k], At[m][k], acc[ai][bj][m][n], 0, 0, 0); __builtin_amdgcn_s_setprio(0); } while (0)
#define PG8_WAIT_V(n) asm volatile("s_waitcnt vmcnt(" #n ")" ::: "memory")
#define PG8_WAIT_L(n) asm volatile("s_waitcnt lgkmcnt(" #n ")" ::: "memory")
#define PG8_BAR __builtin_amdgcn_s_barrier()
#define PG8_SCHED __builtin_amdgcn_sched_barrier(0)
    Unit cur, nxt; int ui = 0;
    if (!S.next(0, cur)) return;
    f32x4 acc[2][2][4][2];
#pragma unroll
    for (int a = 0; a < 2; ++a)
#pragma unroll
        for (int b = 0; b < 2; ++b)
#pragma unroll
            for (int m = 0; m < 4; ++m)
#pragma unroll
                for (int n = 0; n < 2; ++n) acc[a][b][m][n] = (f32x4){0.f, 0.f, 0.f, 0.f};
    bf16x8 At[4][2], B0[2][2], B1[2][2];
    const char* cA = (const char*)g.A + (size_t)cur.pm * tstep; const char* cB = (const char*)g.Bt + (size_t)cur.pn * tstep;
    S.a_ready(cur);
    if constexpr (SP2) {
        PG8_STAGE(PG8_SB(0, 0), cB, voffB); PG8_STAGE(PG8_SB(0, 1), cB + hstep, voffB); PG8_STAGE(PG8_SA(0, 0), cA, voffA); PG8_STAGE(PG8_SA(0, 1), cA + hstep, voffA);
        if (wr == 1) PG8_BAR;
        PG8_WAIT_V(2); PG8_BAR;
        PG8_STAGE(PG8_SB(1, 0), cB + kstep, voffB); PG8_STAGE(PG8_SA(1, 0), cA + kstep, voffA); PG8_STAGE(PG8_SB(1, 1), cB + hstep + kstep, voffB);
        PG8_WAIT_V(6); PG8_BAR;
    } else {
        PG8_STAGE(PG8_SB(0, 0), cB, voffB); PG8_STAGE(PG8_SA(0, 0), cA, voffA); PG8_STAGE(PG8_SB(0, 1), cB + hstep, voffB); PG8_STAGE(PG8_SA(0, 1), cA + hstep, voffA);
        if (wr == 1) PG8_BAR;
        PG8_WAIT_V(4); PG8_BAR;
        PG8_STAGE(PG8_SB(1, 0), cB + kstep, voffB); PG8_STAGE(PG8_SA(1, 0), cA + kstep, voffA); PG8_STAGE(PG8_SB(1, 1), cB + hstep + kstep, voffB);
        PG8_WAIT_V(6); PG8_BAR;
    }
    for (;;) {
        const bool has_next = S.next(ui + 1, nxt);
        const char* nA = has_next ? (const char*)g.A + (size_t)nxt.pm * tstep : cA; const char* nB = has_next ? (const char*)g.Bt + (size_t)nxt.pn * tstep : cB;
        for (int t = 0; t < nt; t += 2) {
            const bool last = (t == nt - 2);
            const char* a1 = cA + (size_t)(t + 1) * kstep;
            const char* a2 = last ? nA : cA + (size_t)(t + 2) * kstep; const char* b2 = last ? nB : cB + (size_t)(t + 2) * kstep;
            const char* a3 = a2 + kstep; const char* b3 = b2 + kstep;
            if (last && has_next) S.a_ready(nxt);
            if constexpr (SP2) {
            PG8_LDB(B0, 0, 0); PG8_LDB(B1, 0, 1); PG8_SCHED; PG8_LDA(At, 0, 0); PG8_STAGE(PG8_SA(1, 1), a1 + hstep, voffA);
            PG8_WAIT_V(8); PG8_WAIT_L(0); PG8_BAR; PG8_MMA(0, 0, At, B0); PG8_MMA(0, 1, At, B1); PG8_BAR; PG8_SCHED;
            PG8_LDA(At, 0, 1); PG8_STAGE(PG8_SB(0, 0), b2, voffB); PG8_STAGE(PG8_SB(0, 1), b2 + hstep, voffB); PG8_STAGE(PG8_SA(0, 0), a2, voffA);
            PG8_WAIT_V(8); PG8_WAIT_L(0); PG8_BAR; PG8_MMA(1, 0, At, B0); PG8_MMA(1, 1, At, B1); PG8_BAR; PG8_SCHED;
            PG8_LDB(B0, 1, 0); PG8_LDB(B1, 1, 1); PG8_SCHED; PG8_LDA(At, 1, 0); PG8_STAGE(PG8_SA(0, 1), a2 + hstep, voffA);
            PG8_WAIT_V(8); PG8_WAIT_L(0); PG8_BAR; PG8_MMA(0, 0, At, B0); PG8_MMA(0, 1, At, B1); PG8_BAR; PG8_SCHED;
            PG8_LDA(At, 1, 1); PG8_STAGE(PG8_SB(1, 0), b3, voffB); PG8_STAGE(PG8_SB(1, 1), b3 + hstep, voffB); PG8_STAGE(PG8_SA(1, 0), a3, voffA);
            PG8_WAIT_V(8); PG8_WAIT_L(0); PG8_BAR; PG8_MMA(1, 0, At, B0); PG8_MMA(1, 1, At, B1); PG8_BAR; PG8_SCHED;
            } else {
            PG8_LDB(B0, 0, 0); PG8_SCHED; PG8_LDA(At, 0, 0); PG8_STAGE(PG8_SA(1, 1), a1 + hstep, voffA);
            PG8_WAIT_L(8); PG8_BAR; PG8_WAIT_L(0); PG8_MMA(0, 0, At, B0); PG8_BAR; PG8_SCHED;
            PG8_LDB(B1, 0, 1); PG8_STAGE(PG8_SB(0, 0), b2, voffB);
            PG8_BAR; PG8_WAIT_L(0); PG8_MMA(0, 1, At, B1); PG8_BAR;
            PG8_LDA(At, 0, 1); PG8_STAGE(PG8_SA(0, 0), a2, voffA);
            PG8_BAR; PG8_WAIT_L(0); PG8_MMA(1, 0, At, B0); PG8_BAR; PG8_SCHED;
            PG8_STAGE(PG8_SB(0, 1), b2 + hstep, voffB);
            PG8_WAIT_V(6); PG8_BAR; PG8_MMA(1, 1, At, B1); PG8_BAR;
            PG8_LDB(B0, 1, 0); PG8_SCHED; PG8_LDA(At, 1, 0); PG8_STAGE(PG8_SA(0, 1), a2 + hstep, voffA);
            PG8_WAIT_L(8); PG8_BAR; PG8_WAIT_L(0); PG8_MMA(0, 0, At, B0); PG8_BAR; PG8_SCHED;
            PG8_LDB(B1, 1, 1); PG8_STAGE(PG8_SB(1, 0), b3, voffB);
            PG8_BAR; PG8_WAIT_L(0); PG8_MMA(0, 1, At, B1); PG8_BAR;
            PG8_LDA(At, 1, 1); PG8_STAGE(PG8_SA(1, 0), a3, voffA);
            PG8_BAR; PG8_WAIT_L(0); PG8_MMA(1, 0, At, B0); PG8_BAR; PG8_SCHED;
            PG8_STAGE(PG8_SB(1, 1), b3 + hstep, voffB);
            PG8_WAIT_V(6); PG8_BAR; PG8_MMA(1, 1, At, B1); PG8_BAR;
            }
        }
        if constexpr (ALIGN_EPI) { if (wr == 0) PG8_BAR; }
        if constexpr (!Epi::AFTER_DRAIN) { E(acc, cur, wr, wc, fr, fq); S.done(cur); }
        if (!has_next) break;
#pragma unroll
        for (int a = 0; a < 2; ++a)
#pragma unroll
            for (int b = 0; b < 2; ++b)
#pragma unroll
                for (int m = 0; m < 4; ++m)
#pragma unroll
                    for (int n = 0; n < 2; ++n) acc[a][b][m][n] = (f32x4){0.f, 0.f, 0.f, 0.f};
        cur = nxt; cA = nA; cB = nB; ++ui;
        if constexpr (ALIGN_EPI) { if (wr == 1) PG8_BAR; }
    }
    PG8_WAIT_V(0);
    if constexpr (!ALIGN_EPI) { if (wr == 0) PG8_BAR; }
    PG8_BAR;
    if constexpr (Epi::AFTER_DRAIN) { E.fused(acc, cur, wr, wc, fr, fq, lds, wid, lane); S.done(cur); }
#undef PG8_SA
#undef PG8_SB
#undef PG8_STAGE
#undef PG8_LDA
#undef PG8_LDB
#undef PG8_MMA
#undef PG8_WAIT_V
#undef PG8_WAIT_L
#undef PG8_BAR
#undef PG8_SCHED
}
}
#define XB_TMO      128
#define XB_XCNT(j)  (256  + 64 * (j))
#define XB_XSUB(j)  (1280 + 64 * (j))
#define XB_XGEN(j)  (2304 + 64 * (j))
#define XB_TOP      3328
#define XB_TOPGEN   3392
#define XCD_BAR_WORDS 3456
#define XB_SPIN_CAP (1u << 18)
#define LAS __attribute__((address_space(3)))

__device__ __forceinline__ unsigned xb_ld(unsigned* p)              { return __hip_atomic_load(p, __ATOMIC_RELAXED, __HIP_MEMORY_SCOPE_AGENT); }
__device__ __forceinline__ unsigned xb_add(unsigned* p, unsigned v) { return __hip_atomic_fetch_add(p, v, __ATOMIC_RELAXED, __HIP_MEMORY_SCOPE_AGENT); }
__device__ __forceinline__ unsigned xb_xcc_id() { return (unsigned)__builtin_amdgcn_s_getreg((3 << 11) | 20) & 0xFu; }
#define XB_SPIN(cond, bar) do { unsigned _sp = 0; while (cond) { __builtin_amdgcn_s_sleep(1); \
    if ((++_sp & 255u) == 0u) { if (xb_ld(&(bar)[XB_TMO])) break; if (_sp > XB_SPIN_CAP) { atomicAdd(&(bar)[XB_TMO], 1u); break; } } } } while (0)

struct XcdBarrier {
    unsigned* bar; unsigned x;
    volatile LAS unsigned* st;
};

__device__ __forceinline__ XcdBarrier xcd_barrier_post(unsigned* bar, volatile LAS unsigned* st) {
    XcdBarrier b; b.bar = bar; b.x = xb_xcc_id(); b.st = st;
    if (threadIdx.x == 0) (void)xb_add(&bar[XB_XCNT(b.x)], 1u);
    return b;
}
__device__ __forceinline__ void xcd_barrier_complete(unsigned* bar, unsigned x, unsigned& nloc, unsigned& nx) {
    const unsigned G = gridDim.x * gridDim.y * gridDim.z;
    unsigned sum, cnt, mine, sp = 0u;
    for (;;) {
        sum = 0u; cnt = 0u; mine = 0u;
#pragma unroll
        for (unsigned j = 0; j < 16; ++j) { const unsigned c = xb_ld(&bar[XB_XCNT(j)]); sum += c; cnt += (c > 0u) ? 1u : 0u; mine = (j == x) ? c : mine; }
        if (sum == G) break;
        __builtin_amdgcn_s_sleep(1);
        if ((++sp & 255u) == 0u) { if (xb_ld(&bar[XB_TMO])) break; if (sp > XB_SPIN_CAP) { atomicAdd(&bar[XB_TMO], 1u); break; } }
    }
    nloc = mine > 0u ? mine : 1u; nx = cnt > 0u ? cnt : 1u;
}

__device__ __forceinline__ void xcd_barrier(const XcdBarrier& b) {
    asm volatile("s_waitcnt vmcnt(0)" ::: "memory");
    __syncthreads();
    if (threadIdx.x == 0) {
        unsigned* bar = b.bar;
        __builtin_amdgcn_s_waitcnt(0);
        unsigned nloc = b.st[0], nx = b.st[1];
        if (nloc == 0u) { xcd_barrier_complete(bar, b.x, nloc, nx); b.st[0] = nloc; b.st[1] = nx; }
        const unsigned old = xb_add(&bar[XB_XSUB(b.x)], 1u);
        const unsigned gen = old / nloc;
        if (old + 1u == (gen + 1u) * nloc) {
            __builtin_amdgcn_fence(__ATOMIC_RELEASE, "agent");
            asm volatile("s_waitcnt vmcnt(0)" ::: "memory");
            const unsigned og = xb_add(&bar[XB_TOP], 1u);
            const unsigned tg = og / nx;
            if (og + 1u == (tg + 1u) * nx) xb_add(&bar[XB_TOPGEN], 1u);
            else XB_SPIN(xb_ld(&bar[XB_TOPGEN]) == tg, bar);
            __builtin_amdgcn_fence(__ATOMIC_ACQUIRE, "agent");
            xb_add(&bar[XB_XGEN(b.x)], 1u);
            asm volatile("s_waitcnt vmcnt(0)" ::: "memory");
        } else {
            XB_SPIN(xb_ld(&bar[XB_XGEN(b.x)]) == gen, bar);
            __builtin_amdgcn_fence(__ATOMIC_ACQUIRE, "agent");
            asm volatile("s_waitcnt vmcnt(0)" ::: "memory");
        }
    }
    __syncthreads();
}


typedef unsigned short bf16;
typedef pg8::f32x4 f32x4;
typedef pg8::u32x4 u32x4;
constexpr int NB = 8, SEQ = 4096, DM = 1024, NCTX = 256;
constexpr int TL = NB * SEQ, TC = NB * NCTX, TA = TL + TC;
constexpr int INW = 6144, GW = 512, NGRP = 12;
constexpr size_t GSTRIDE = (size_t)TA * GW;
constexpr float EPS = 1e-6f;
constexpr int SLOT_ROWS = 73728;

constexpr size_t MiB = (size_t)1 << 20;
constexpr size_t WS_CTL = 0, CTL_BYTES = 1 * MiB;
constexpr size_t WS_MOD = 1 * MiB;
constexpr size_t WS_LB = 1 * MiB + 512 * 1024;
constexpr size_t WS_ROPE = 2 * MiB;
constexpr size_t WS_TOK = 3 * MiB;
constexpr size_t WS_CTXS = 4 * MiB;
constexpr size_t WS_WB = 12 * MiB;
constexpr size_t WS_H = 28 * MiB;
constexpr size_t WS_P = 96 * MiB;
constexpr size_t P_M = 34 * MiB, P_WEGU = 102 * MiB, P_WED = 134 * MiB, P_XS = 150 * MiB, P_ACT = 294 * MiB;
constexpr size_t WS_END = 504 * MiB;
constexpr int CW_BAR = 4096, CW_CNT = 131072;

constexpr int LDS_STAGE = 131072, LDS_BYTES = 147456;
constexpr int LDSW_BAR = 0, LDSW_TAB = 16;

struct Params {
    const float* x; const float* c; const float* ctx; const float* c_ctx; const float* w_ada; const float* b_ada; const float* norm1_g; const float* w_in;
    const float* rel_bias; const float* lowf; const float* lowb; const float* hg_norm_g; const float* w_na_o; const float* w_hg_o; const float* w_out; const float* norm2_g;
    const float* w_router; const float* router_bias; const float* w_gate; const float* w_up; const float* w_down; const float* final_g;
    float* out; unsigned char* ws; int lo, hi, li, pad;
};

__device__ __forceinline__ float bf2f(unsigned b) { return __uint_as_float(b << 16); }
__device__ __forceinline__ float bflo(unsigned w) { return __uint_as_float(w << 16); }
__device__ __forceinline__ float bfhi(unsigned w) { return __uint_as_float(w & 0xffff0000u); }
__device__ __forceinline__ unsigned f2bf(float f) { unsigned u = __float_as_uint(f); u += 0x7FFFu + ((u >> 16) & 1u); return u >> 16; }
__device__ __forceinline__ unsigned pk2(float lo, float hi) { return f2bf(lo) | (f2bf(hi) << 16); }
__device__ __forceinline__ float sigm(float x) { return 1.f / (1.f + __expf(-x)); }
__device__ __forceinline__ float silu(float x) { return x / (1.f + __expf(-x)); }
__device__ __forceinline__ float wave_sum(float v) {
#pragma unroll
    for (int o = 32; o >= 1; o >>= 1) v += __shfl_xor(v, o);
    return v; }
__device__ __forceinline__ float wave_max(float v) {
#pragma unroll
    for (int o = 32; o >= 1; o >>= 1) v = fmaxf(v, __shfl_xor(v, o));
    return v; }
__device__ __forceinline__ void unpack8(const uint4 w, float (&f)[8]) {
    f[0] = bflo(w.x); f[1] = bfhi(w.x); f[2] = bflo(w.y); f[3] = bfhi(w.y); f[4] = bflo(w.z); f[5] = bfhi(w.z); f[6] = bflo(w.w); f[7] = bfhi(w.w); }

typedef const __attribute__((address_space(4))) Params* ParamsK;
struct PView { ParamsK q; __device__ __forceinline__ const __attribute__((address_space(4))) Params* operator->() const { return q; } };
struct Ctx {
    PView p; unsigned char* ws; unsigned char* lds; int tid, lane, wave, G, bid, gw, nw;
    __device__ __forceinline__ float* MOD() const { return (float*)(ws + WS_MOD); }
    __device__ __forceinline__ float* LB() const { return (float*)(ws + WS_LB); }
    __device__ __forceinline__ float2* ROPE() const { return (float2*)(ws + WS_ROPE); }
    __device__ __forceinline__ int* TOKE() const { return (int*)(ws + WS_TOK); }
    __device__ __forceinline__ float* TOKW() const { return (float*)(ws + WS_TOK) + 2 * TA; }
    __device__ __forceinline__ int* TOKS() const { return (int*)(ws + WS_TOK) + 4 * TA; }
    __device__ __forceinline__ float* CTXS() const { return (float*)(ws + WS_CTXS); }
    __device__ __forceinline__ bf16* WIN_T() const { return (bf16*)(ws + WS_WB); }
    __device__ __forceinline__ bf16* WNA_T() const { return (bf16*)(ws + WS_WB + 12 * MiB); }
    __device__ __forceinline__ bf16* WHG_T() const { return (bf16*)(ws + WS_WB + 13 * MiB); }
    __device__ __forceinline__ bf16* WOUT_T() const { return (bf16*)(ws + WS_WB + 14 * MiB); }
    __device__ __forceinline__ bf16* H() const { return (bf16*)(ws + WS_H); }
    __device__ __forceinline__ bf16* GRP(int g) const { return (bf16*)(ws + WS_P) + (size_t)g * GSTRIDE; }
    __device__ __forceinline__ bf16* MB() const { return (bf16*)(ws + WS_P + P_M); }
    __device__ __forceinline__ bf16* WEGU() const { return (bf16*)(ws + WS_P + P_WEGU); }
    __device__ __forceinline__ bf16* WED() const { return (bf16*)(ws + WS_P + P_WED); }
    __device__ __forceinline__ bf16* XS() const { return (bf16*)(ws + WS_P + P_XS); }
    __device__ __forceinline__ bf16* ACT() const { return (bf16*)(ws + WS_P + P_ACT); }
    __device__ __forceinline__ unsigned* CTL() const { return (unsigned*)(ws + WS_CTL); }
    __device__ __forceinline__ unsigned* CNT(int l) const { return (unsigned*)(ws + WS_CTL) + CW_CNT + l * 64; }
    __device__ __forceinline__ int* TAB() const { return (int*)(lds + LDS_STAGE) + LDSW_TAB; }
};

template <class RowMap>
__device__ __forceinline__ void tconv_tile(const float* __restrict__ src, int ldsrc, int k0, int n0, bf16* __restrict__ dst, int ldd, int lane, RowMap rm) {
    float v[64];
    const float* s = src + (size_t)k0 * ldsrc + n0 + lane;
#pragma unroll
    for (int k = 0; k < 64; ++k) { v[k] = *s; s += ldsrc; asm volatile("" : "+v"(s)); }
    bf16* d = dst + (size_t)rm(n0 + lane) * ldd + k0;
#pragma unroll
    for (int j = 0; j < 8; ++j) { uint4 w; w.x = pk2(v[8 * j], v[8 * j + 1]); w.y = pk2(v[8 * j + 2], v[8 * j + 3]); w.z = pk2(v[8 * j + 4], v[8 * j + 5]); w.w = pk2(v[8 * j + 6], v[8 * j + 7]);
        *(uint4*)(d + 8 * j) = w; }
}
struct RmId { __device__ __forceinline__ int operator()(int n) const { return n; } };
struct RmGU { int base; __device__ __forceinline__ int operator()(int n) const { return base + (n >> 7) * 256 + (n & 127); } };

__device__ __forceinline__ void conv_mixer(const Ctx& C, int l) {
    for (int id = C.gw; id < 2048; id += C.nw) {
        if (id < 1536) { const int kt = id & 15, nt = id >> 4; tconv_tile(C.p->w_in + (size_t)l * DM * INW, INW, kt * 64, nt * 64, C.WIN_T(), DM, C.lane, RmId()); }
        else if (id < 1664) { const int j = id - 1536, kt = j & 7, nt = j >> 3; tconv_tile(C.p->w_na_o + (size_t)l * 512 * DM, DM, kt * 64, nt * 64, C.WNA_T(), 512, C.lane, RmId()); }
        else if (id < 1792) { const int j = id - 1664, kt = j & 7, nt = j >> 3; tconv_tile(C.p->w_hg_o + (size_t)l * 512 * DM, DM, kt * 64, nt * 64, C.WHG_T(), 512, C.lane, RmId()); }
        else { const int j = id - 1792, kt = j & 15, nt = j >> 4; tconv_tile(C.p->w_out + (size_t)l * DM * DM, DM, kt * 64, nt * 64, C.WOUT_T(), DM, C.lane, RmId()); }
    }
}
__device__ __forceinline__ void conv_experts(const Ctx& C, int l) {
    for (int id = C.gw; id < 6144; id += C.nw) {
        const int e = id / 384, j = id % 384;
        if (j < 128) { const int kt = j & 15, nt = j >> 4; tconv_tile(C.p->w_gate + ((size_t)l * 16 + e) * DM * 512, 512, kt * 64, nt * 64, C.WEGU(), DM, C.lane, RmGU{e * 1024}); }
        else if (j < 256) { const int jj = j - 128, kt = jj & 15, nt = jj >> 4; tconv_tile(C.p->w_up + ((size_t)l * 16 + e) * DM * 512, 512, kt * 64, nt * 64, C.WEGU(), DM, C.lane, RmGU{e * 1024 + 128}); }
        else { const int jj = j - 256, kt = jj & 7, nt = jj >> 3; tconv_tile(C.p->w_down + ((size_t)l * 16 + e) * 512 * DM, DM, kt * 64, nt * 64, C.WED() + (size_t)e * 1024 * 512, 512, C.lane, RmId()); }
    }
}

__device__ __forceinline__ void p0_prologue(const Ctx& C) {
    for (int u = C.bid; u < 24; u += C.G) {
        float* sl = (float*)C.lds;
        for (int i = C.tid; i < 9 * 1024; i += 512) { const int r = i >> 10, k = i & 1023; const float v = (r < 8) ? C.p->c[r * 1024 + k] : C.p->c_ctx[k]; sl[i] = v / (1.f + expf(-v)); }
        __syncthreads();
        const int l = u / 12, n = (u % 12) * 512 + C.tid;
        const float* w = C.p->w_ada + (size_t)l * DM * INW + n;
        float acc[9];
#pragma unroll
        for (int r = 0; r < 9; ++r) acc[r] = 0.f;
#pragma unroll 8
        for (int k = 0; k < 1024; ++k) { const float wv = w[(size_t)k * INW];
#pragma unroll
            for (int r = 0; r < 9; ++r) acc[r] += sl[r * 1024 + k] * wv; }
        const float bb = C.p->b_ada[l * INW + n];
#pragma unroll
        for (int r = 0; r < 9; ++r) C.MOD()[(size_t)(l * 9 + r) * INW + n] = acc[r] + bb;
        __syncthreads();
    }
    const int gt = C.bid * 512 + C.tid, nthr = C.G * 512;
    for (int i = gt; i < 4096 * 32; i += nthr) { const int t = i >> 5, pr = i & 31; const float pos = (float)((pr < 16) ? (t >> 6) : (t & 63)); const int j = pr & 15;
        const float inv = powf(10000.f, -(float)(2 * j) / 32.f); const float ang = pos * inv; C.ROPE()[i] = make_float2(cosf(ang), sinf(ang)); }
    for (int i = gt; i < 1024; i += nthr) { const int dir = i >> 9, ch = i & 511; const float* raw = dir ? C.p->lowb : C.p->lowf; const float r0 = raw[ch], r1 = raw[512 + ch];
        const float p1 = 1.f / (1.f + expf(r0 - r1)); C.LB()[(0 * 2 + dir) * 512 + ch] = 0.f; C.LB()[(1 * 2 + dir) * 512 + ch] = p1; }
    conv_mixer(C, 0);
}

__device__ __forceinline__ void load_row(const float* xr, int lane, float (&v)[16]) {
#pragma unroll
    for (int j = 0; j < 4; ++j) { const float4 t = *(const float4*)(xr + j * 256 + lane * 4); v[4 * j] = t.x; v[4 * j + 1] = t.y; v[4 * j + 2] = t.z; v[4 * j + 3] = t.w; }
}
__device__ __forceinline__ float row_rinv(const float (&v)[16]) {
    float ss = 0.f;
#pragma unroll
    for (int i = 0; i < 16; ++i) ss += v[i] * v[i];
    ss = wave_sum(ss);
    return rsqrtf(ss * (1.f / 1024.f) + EPS);
}
__device__ __forceinline__ void norm_mod(const float (&v)[16], float rinv, const float* gam, const float* sc, const float* sh, int lane, float (&h)[16]) {
#pragma unroll
    for (int j = 0; j < 4; ++j) { const int c = j * 256 + lane * 4; const float4 g = *(const float4*)(gam + c), s = *(const float4*)(sc + c), b = *(const float4*)(sh + c);
        h[4 * j] = v[4 * j] * rinv * g.x * (1.f + s.x) + b.x; h[4 * j + 1] = v[4 * j + 1] * rinv * g.y * (1.f + s.y) + b.y;
        h[4 * j + 2] = v[4 * j + 2] * rinv * g.z * (1.f + s.z) + b.z; h[4 * j + 3] = v[4 * j + 3] * rinv * g.w * (1.f + s.w) + b.w; }
}
__device__ __forceinline__ void store_row_bf16(bf16* hr, int lane, const float (&h)[16]) {
#pragma unroll
    for (int j = 0; j < 4; ++j) { uint2 w; w.x = pk2(h[4 * j], h[4 * j + 1]); w.y = pk2(h[4 * j + 2], h[4 * j + 3]); *(uint2*)(hr + j * 256 + lane * 4) = w; }
}
__device__ __forceinline__ int modrow_of(int r) { return r < TL ? (r >> 12) : 8; }

__device__ __forceinline__ void p1_norm1(const Ctx& C, int l, const float* xl, const float* xc) {
    for (int r = C.gw; r < TA; r += C.nw) {
        const float* xr = r < TL ? xl + (size_t)r * DM : xc + (size_t)(r - TL) * DM;
        float v[16], h[16]; load_row(xr, C.lane, v);
        const float rinv = row_rinv(v);
        const float* mod = C.MOD() + (size_t)(l * 9 + modrow_of(r)) * INW;
        norm_mod(v, rinv, C.p->norm1_g + l * DM, mod + 1024, mod, C.lane, h);
        store_row_bf16(C.H() + (size_t)r * DM, C.lane, h);
    }
}

struct EpiInProj {
    static constexpr bool PERM = true, AFTER_DRAIN = false;
    bf16* P; const float2* rope;
    __device__ __forceinline__ void operator()(const f32x4 (&acc)[2][2][4][2], const pg8::Unit& u, int wr, int wc, int fr, int fq) const {
        const int grp = u.pn >> 1; bf16* base = P + (size_t)grp * GSTRIDE;
        const int colb = (u.pn & 1) * 256 + wc * 32 + 8 * fq;
        const bool do_rope = (grp < 2) && (u.pm < TL / 256);
#pragma unroll
        for (int ai = 0; ai < 2; ++ai)
#pragma unroll
            for (int m = 0; m < 4; ++m) { const int row = u.pm * 256 + ai * 128 + wr * 64 + m * 16 + fr;
#pragma unroll
                for (int bj = 0; bj < 2; ++bj) { const int col = colb + bj * 128; f32x4 v0 = acc[ai][bj][m][0], v1 = acc[ai][bj][m][1];
                    if (do_rope) { const float4* rp = (const float4*)(rope + (size_t)(row & 4095) * 32 + ((col & 63) >> 1)); const float4 c01 = rp[0], c23 = rp[1];
                        const f32x4 a = v0, b = v1;
                        v0[0] = a[0] * c01.x - a[1] * c01.y; v0[1] = a[0] * c01.y + a[1] * c01.x; v0[2] = a[2] * c01.z - a[3] * c01.w; v0[3] = a[2] * c01.w + a[3] * c01.z;
                        v1[0] = b[0] * c23.x - b[1] * c23.y; v1[1] = b[0] * c23.y + b[1] * c23.x; v1[2] = b[2] * c23.z - b[3] * c23.w; v1[3] = b[2] * c23.w + b[3] * c23.z; }
                    u32x4 w; w.x = pg8::cvt_pk_bf16(v0[0], v0[1]); w.y = pg8::cvt_pk_bf16(v0[2], v0[3]); w.z = pg8::cvt_pk_bf16(v1[0], v1[1]); w.w = pg8::cvt_pk_bf16(v1[2], v1[3]);
                    *(u32x4*)(base + (size_t)row * GW + col) = w; } }
    }
};
template <int PASS> struct EpiMerge {
    static constexpr bool PERM = true, AFTER_DRAIN = false;
    bf16* M; const bf16* G;
    __device__ __forceinline__ void operator()(const f32x4 (&acc)[2][2][4][2], const pg8::Unit& u, int wr, int wc, int fr, int fq) const {
        const bf16* gb = G + (size_t)(u.pn >> 1) * GSTRIDE; const int gcol = (u.pn & 1) * 256 + wc * 32 + 8 * fq, mcol = u.pn * 256 + wc * 32 + 8 * fq;
#pragma unroll
        for (int ai = 0; ai < 2; ++ai)
#pragma unroll
            for (int m = 0; m < 4; ++m) { const int row = u.pm * 256 + ai * 128 + wr * 64 + m * 16 + fr;
#pragma unroll
                for (int bj = 0; bj < 2; ++bj) { const uint4 gw = *(const uint4*)(gb + (size_t)row * GW + gcol + bj * 128); float g[8]; unpack8(gw, g);
                    bf16* mp = M + (size_t)row * DM + mcol + bj * 128; const f32x4 v0 = acc[ai][bj][m][0], v1 = acc[ai][bj][m][1];
                    float o[8];
#pragma unroll
                    for (int i = 0; i < 4; ++i) { o[i] = sigm(g[i]) * v0[i]; o[4 + i] = sigm(g[4 + i]) * v1[i]; }
                    if (PASS == 1) { const uint4 mw = *(const uint4*)mp; float pm_[8]; unpack8(mw, pm_);
#pragma unroll
                        for (int i = 0; i < 8; ++i) o[i] += pm_[i]; }
                    u32x4 w; w.x = pg8::cvt_pk_bf16(o[0], o[1]); w.y = pg8::cvt_pk_bf16(o[2], o[3]); w.z = pg8::cvt_pk_bf16(o[4], o[5]); w.w = pg8::cvt_pk_bf16(o[6], o[7]);
                    *(u32x4*)mp = w; } }
    }
};
struct EpiOut {
    static constexpr bool PERM = false, AFTER_DRAIN = false;
    const float* xl_src; float* xl_dst; const float* xc_src; float* xc_dst; const float* mod;
    __device__ __forceinline__ void operator()(const f32x4 (&acc)[2][2][4][2], const pg8::Unit& u, int wr, int wc, int fr, int fq) const {
        const bool lat = u.pm < TL / 256; const int mr = lat ? (u.pm >> 4) : 8;
        const float* gate = mod + (size_t)mr * INW + 2048; const int col0 = u.pn * 256 + wc * 32 + 4 * fq;
        const float* src = lat ? xl_src : xc_src - (size_t)TL * DM; float* dst = lat ? xl_dst : xc_dst - (size_t)TL * DM;
        f32x4 gv[2][2];
#pragma unroll
        for (int bj = 0; bj < 2; ++bj)
#pragma unroll
            for (int n = 0; n < 2; ++n) gv[bj][n] = *(const f32x4*)(gate + col0 + bj * 128 + n * 16);
#pragma unroll
        for (int ai = 0; ai < 2; ++ai)
#pragma unroll
            for (int m = 0; m < 4; ++m) { const size_t off = (size_t)(u.pm * 256 + ai * 128 + wr * 64 + m * 16 + fr) * DM + col0;
#pragma unroll
                for (int bj = 0; bj < 2; ++bj)
#pragma unroll
                    for (int n = 0; n < 2; ++n) { const f32x4 xo = *(const f32x4*)(src + off + bj * 128 + n * 16); *(f32x4*)(dst + off + bj * 128 + n * 16) = xo + gv[bj][n] * acc[ai][bj][m][n]; } }
    }
};
struct EpiGateUp {
    static constexpr bool PERM = true, AFTER_DRAIN = false;
    bf16* A;
    __device__ __forceinline__ void operator()(const f32x4 (&acc)[2][2][4][2], const pg8::Unit& u, int wr, int wc, int fr, int fq) const {
        const int col = (u.pn & 3) * 128 + wc * 32 + 8 * fq;
#pragma unroll
        for (int ai = 0; ai < 2; ++ai)
#pragma unroll
            for (int m = 0; m < 4; ++m) { const int row = u.pm * 256 + ai * 128 + wr * 64 + m * 16 + fr; float o[8];
#pragma unroll
                for (int i = 0; i < 4; ++i) { o[i] = silu(acc[ai][0][m][0][i]) * acc[ai][1][m][0][i]; o[4 + i] = silu(acc[ai][0][m][1][i]) * acc[ai][1][m][1][i]; }
                u32x4 w; w.x = pg8::cvt_pk_bf16(o[0], o[1]); w.y = pg8::cvt_pk_bf16(o[2], o[3]); w.z = pg8::cvt_pk_bf16(o[4], o[5]); w.w = pg8::cvt_pk_bf16(o[6], o[7]);
                *(u32x4*)(A + (size_t)row * 512 + col) = w; }
    }
};
struct EpiDown {
    static constexpr bool PERM = true, AFTER_DRAIN = false;
    bf16* Y;
    __device__ __forceinline__ void operator()(const f32x4 (&acc)[2][2][4][2], const pg8::Unit& u, int wr, int wc, int fr, int fq) const {
        const int col = (u.pn & 3) * 256 + wc * 32 + 8 * fq;
#pragma unroll
        for (int ai = 0; ai < 2; ++ai)
#pragma unroll
            for (int m = 0; m < 4; ++m) { const int row = u.pm * 256 + ai * 128 + wr * 64 + m * 16 + fr;
#pragma unroll
                for (int bj = 0; bj < 2; ++bj) { const f32x4 v0 = acc[ai][bj][m][0], v1 = acc[ai][bj][m][1];
                    u32x4 w; w.x = pg8::cvt_pk_bf16(v0[0], v0[1]); w.y = pg8::cvt_pk_bf16(v0[2], v0[3]); w.z = pg8::cvt_pk_bf16(v1[0], v1[1]); w.w = pg8::cvt_pk_bf16(v1[2], v1[3]);
                    *(u32x4*)(Y + (size_t)row * DM + col + bj * 128) = w; } }
    }
};
struct MoeOrder {
    const int* tab; int G, c;
    __device__ __forceinline__ bool next(int i, pg8::Unit& u) const {
        const int L = i * G + c, MT = tab[16]; if (L >= MT * 4) return false;
        const int mt = L >> 2; int e = 0;
#pragma unroll
        for (int j = 1; j < 16; ++j) e += (mt >= tab[j]) ? 1 : 0;
        u.pm = mt; u.pn = e * 4 + (L & 3); return true;
    }
    __device__ __forceinline__ void a_ready(const pg8::Unit&) const {}
    __device__ __forceinline__ void done(const pg8::Unit&) const {}
};
__device__ __forceinline__ void moe_table(const Ctx& C, int l) {
    __syncthreads();
    if (C.tid == 0) { int acc = 0; const unsigned* cnt = C.CNT(l);
        for (int e = 0; e < 16; ++e) { C.TAB()[e] = acc; acc += (int)((__hip_atomic_load(cnt + e, __ATOMIC_RELAXED, __HIP_MEMORY_SCOPE_AGENT) + 255u) >> 8); }
        C.TAB()[16] = acc; }
    __syncthreads();
}

__device__ __forceinline__ void p3_attn_naive(const Ctx& C, int l) {
    float* pl = (float*)C.lds + C.wave * 768; int* kl = (int*)(pl + 384);
    const bf16* Q = C.GRP(0); const bf16* K = C.GRP(1); const bf16* V = C.GRP(2); bf16* O = C.GRP(0);
    const int nq = (l == 0 ? TA : TL) * 8;
    for (int wq = C.gw; wq < nq; wq += C.nw) {
        const int r = wq >> 3, h = wq & 7; const bool lat = r < TL;
        const int b = lat ? (r >> 12) : ((r - TL) >> 8);
        float q[64];
        { const uint4* qp = (const uint4*)(Q + (size_t)r * GW + h * 64);
#pragma unroll
          for (int j = 0; j < 8; ++j) { float t[8]; unpack8(qp[j], t);
#pragma unroll
              for (int i = 0; i < 8; ++i) q[8 * j + i] = t[i]; } }
        const int t = r & 4095, gr = t >> 6, gc = t & 63;
        const int rs = min(max(gr - 4, 0), 56), cs = min(max(gc - 8, 0), 48);
        float s[6]; int krow[6];
#pragma unroll
        for (int i = 0; i < 6; ++i) {
            float bias = 0.f; bool valid = true;
            if (i < 2) { const int j = C.lane + 64 * i, kr = rs + (j >> 4), kc = cs + (j & 15); krow[i] = b * 4096 + kr * 64 + kc; valid = lat;
                if (lat) bias = C.p->rel_bias[((size_t)(l * 8 + h) * 15 + (kr - gr + 7)) * 31 + (kc - gc + 15)]; if (!lat) krow[i] = TL + b * 256; }
            else krow[i] = TL + b * 256 + C.lane + 64 * (i - 2);
            const uint4* kp = (const uint4*)(K + (size_t)krow[i] * GW + h * 64); float d = 0.f;
#pragma unroll
            for (int j = 0; j < 8; ++j) { float tk[8]; unpack8(kp[j], tk);
#pragma unroll
                for (int ii = 0; ii < 8; ++ii) d += q[8 * j + ii] * tk[ii]; }
            s[i] = valid ? d * 0.125f + bias : -1e30f;
        }
        float mx = s[0];
#pragma unroll
        for (int i = 1; i < 6; ++i) mx = fmaxf(mx, s[i]);
        mx = wave_max(mx);
        float sum = 0.f;
#pragma unroll
        for (int i = 0; i < 6; ++i) { s[i] = (s[i] > -1e29f) ? __expf(s[i] - mx) : 0.f; sum += s[i]; }
        sum = wave_sum(sum); const float inv = 1.f / sum;
#pragma unroll
        for (int i = 0; i < 6; ++i) { pl[C.lane + 64 * i] = s[i] * inv; kl[C.lane + 64 * i] = krow[i]; }
        float acc = 0.f;
        for (int j = lat ? 0 : 128; j < 384; ++j) acc += pl[j] * bf2f(V[(size_t)kl[j] * GW + h * 64 + C.lane]);
        O[(size_t)r * GW + h * 64 + C.lane] = (bf16)f2bf(acc);
    }
}

__device__ __forceinline__ int scan_row(int b, int dir, int s) { return dir == 0 ? (s < NCTX ? TL + b * NCTX + s : b * SEQ + (s - NCTX)) : (s < NCTX ? TL + b * NCTX + (NCTX - 1 - s) : b * SEQ + (SEQ - 1 - (s - NCTX))); }
__device__ __forceinline__ void p3_scan_naive(const Ctx& C, int l) {
    const bf16* HQ = C.GRP(3); const bf16* HI = C.GRP(6);
    for (int u = C.gw; u < 2048; u += C.nw) {
        const int dv4 = u & 31, dir = (u >> 5) & 1, h = (u >> 6) & 3, b = u >> 8;
        const bf16* HF = C.GRP(dir ? 5 : 4); bf16* OUT = C.H() + (size_t)dir * GSTRIDE;
        const float lb0 = C.LB()[(l * 2 + dir) * 512 + h * 128 + C.lane], lb1 = C.LB()[(l * 2 + dir) * 512 + h * 128 + 64 + C.lane];
        float S0[4] = {0.f, 0.f, 0.f, 0.f}, S1[4] = {0.f, 0.f, 0.f, 0.f};
        const int NS = NCTX + SEQ;
        int row = scan_row(b, dir, 0);
        unsigned q0 = HQ[(size_t)row * GW + h * 128 + C.lane], q1 = HQ[(size_t)row * GW + h * 128 + 64 + C.lane], f0 = HF[(size_t)row * GW + h * 128 + C.lane], f1 = HF[(size_t)row * GW + h * 128 + 64 + C.lane];
        uint2 vv = *(const uint2*)(HI + (size_t)row * GW + h * 128 + dv4 * 4);
        for (int s = 0; s < NS; ++s) {
            const int nrow = scan_row(b, dir, (s + 1 < NS) ? s + 1 : s);
            const unsigned nq0 = HQ[(size_t)nrow * GW + h * 128 + C.lane], nq1 = HQ[(size_t)nrow * GW + h * 128 + 64 + C.lane], nf0 = HF[(size_t)nrow * GW + h * 128 + C.lane], nf1 = HF[(size_t)nrow * GW + h * 128 + 64 + C.lane];
            const uint2 nvv = *(const uint2*)(HI + (size_t)nrow * GW + h * 128 + dv4 * 4);
            const float qa = silu(bf2f(q0)), qb = silu(bf2f(q1));
            const float fa = fminf(fmaxf(bf2f(f0), -30.f), 30.f), fb = fminf(fmaxf(bf2f(f1), -30.f), 30.f);
            const float ea = __expf(-fa), eb = __expf(-fb);
            const float sga = 1.f / (1.f + ea), sgb = 1.f / (1.f + eb);
            const float ga = fmaxf(lb0 + (1.f - lb0) * sga, 1e-30f), gb = fmaxf(lb1 + (1.f - lb1) * sgb, 1e-30f);
            const float ka = (1.f - lb0) * (ea * sga), kb = (1.f - lb1) * (eb * sgb);
            const float v[4] = {bflo(vv.x), bfhi(vv.x), bflo(vv.y), bfhi(vv.y)};
            float o[4];
#pragma unroll
            for (int j = 0; j < 4; ++j) { S0[j] = ga * S0[j] + ka * v[j]; S1[j] = gb * S1[j] + kb * v[j]; o[j] = wave_sum(qa * S0[j] + qb * S1[j]); }
            if (C.lane == 0) { uint2 w; w.x = pk2(o[0], o[1]); w.y = pk2(o[2], o[3]); *(uint2*)(OUT + (size_t)row * GW + h * 128 + dv4 * 4) = w; }
            row = nrow; q0 = nq0; q1 = nq1; f0 = nf0; f1 = nf1; vv = nvv;
        }
    }
}

__device__ __forceinline__ void p3c_headnorm(const Ctx& C, int l) {
    const int nrows = (l == 0) ? TA : TL;
    bf16* OF = C.H(); const bf16* OB = C.H() + GSTRIDE; const bf16* HG = C.GRP(7);
    const float* gain = C.p->hg_norm_g + l * 128;
    for (int r = C.gw; r < nrows; r += C.nw) {
        const size_t off = (size_t)r * GW + C.lane * 8;
        float a[8], b[8], g[8]; unpack8(*(const uint4*)(OF + off), a); unpack8(*(const uint4*)(OB + off), b); unpack8(*(const uint4*)(HG + off), g);
        float ss = 0.f;
#pragma unroll
        for (int i = 0; i < 8; ++i) { a[i] += b[i]; ss += a[i] * a[i]; }
        ss += __shfl_xor(ss, 1); ss += __shfl_xor(ss, 2); ss += __shfl_xor(ss, 4); ss += __shfl_xor(ss, 8);
        const float rinv = rsqrtf(ss * (1.f / 128.f) + EPS);
        const int cg = (C.lane & 15) * 8; float o[8];
#pragma unroll
        for (int i = 0; i < 8; ++i) o[i] = a[i] * rinv * gain[cg + i] * silu(g[i]);
        uint4 w; w.x = pk2(o[0], o[1]); w.y = pk2(o[2], o[3]); w.z = pk2(o[4], o[5]); w.w = pk2(o[6], o[7]);
        *(uint4*)(OF + off) = w;
    }
}

__device__ __forceinline__ void p5_norm2_router(const Ctx& C, int l) {
    float* wr = (float*)C.lds;
    for (int i = C.tid; i < 1024 * 16; i += 512) wr[(i & 15) * 1024 + (i >> 4)] = C.p->w_router[i];
    __syncthreads();
    const int nrows = (l == 0) ? TA : TL;
    float rb[16];
#pragma unroll
    for (int e = 0; e < 16; ++e) rb[e] = C.p->router_bias[e];
    for (int r = C.gw; r < nrows; r += C.nw) {
        const float* xr = r < TL ? C.p->out + (size_t)r * DM : C.CTXS() + (size_t)(r - TL) * DM;
        float v[16], h[16]; load_row(xr, C.lane, v);
        const float rinv = row_rinv(v);
        const float* mod = C.MOD() + (size_t)(l * 9 + modrow_of(r)) * INW;
        norm_mod(v, rinv, C.p->norm2_g + l * DM, mod + 4096, mod + 3072, C.lane, h);
        store_row_bf16(C.H() + (size_t)r * DM, C.lane, h);
        float lgv = 0.f;
#pragma unroll 1
        for (int e = 0; e < 16; ++e) { const float* we = wr + e * 1024 + C.lane * 4; float a = 0.f;
#pragma unroll
            for (int j = 0; j < 4; ++j) { const float4 ww = *(const float4*)(we + j * 256); a += h[4 * j] * ww.x + h[4 * j + 1] * ww.y + h[4 * j + 2] * ww.z + h[4 * j + 3] * ww.w; }
            a = wave_sum(a); lgv = (C.lane == e) ? a : lgv; }
        float lg[16];
#pragma unroll
        for (int e = 0; e < 16; ++e) lg[e] = __shfl(lgv, e);
        float bestg = -1e30f; int e0 = 0, e1 = 1; float s0 = 0.f, s1 = 0.f;
#pragma unroll
        for (int g = 0; g < 4; ++g) {
            float sc[4], gbv[4];
#pragma unroll
            for (int j = 0; j < 4; ++j) { sc[j] = 1.f / (1.f + expf(-lg[4 * g + j])); gbv[j] = sc[j] + rb[4 * g + j]; }
            int i0 = 0; float b0 = gbv[0], u0 = sc[0];
#pragma unroll
            for (int j = 1; j < 4; ++j) if (gbv[j] > b0) { b0 = gbv[j]; i0 = j; u0 = sc[j]; }
            int i1 = -1; float b1 = -1e30f, u1 = 0.f;
#pragma unroll
            for (int j = 0; j < 4; ++j) if (j != i0 && gbv[j] > b1) { b1 = gbv[j]; i1 = j; u1 = sc[j]; }
            const float gs = b0 + b1;
            if (gs > bestg) { bestg = gs; e0 = 4 * g + i0; e1 = 4 * g + i1; s0 = u0; s1 = u1; }
        }
        if (C.lane == 0) {
            const float den = s0 + s1; unsigned* cnt = C.CNT(l);
            const int r0 = (int)atomicAdd(cnt + e0, 1u), r1 = (int)atomicAdd(cnt + e1, 1u);
            C.TOKE()[2 * r] = e0; C.TOKE()[2 * r + 1] = e1; C.TOKW()[2 * r] = s0 / den; C.TOKW()[2 * r + 1] = s1 / den; C.TOKS()[2 * r] = r0; C.TOKS()[2 * r + 1] = r1;
        }
    }
    __syncthreads();
}

__device__ __forceinline__ void p6_permute(const Ctx& C, int l) {
    moe_table(C, l);
    const int nrows = (l == 0) ? TA : TL;
    for (int r = C.gw; r < nrows; r += C.nw) {
        const int e0 = C.TOKE()[2 * r], e1 = C.TOKE()[2 * r + 1];
        const int sl0 = C.TAB()[e0] * 256 + C.TOKS()[2 * r], sl1 = C.TAB()[e1] * 256 + C.TOKS()[2 * r + 1];
        const uint4* src = (const uint4*)(C.H() + (size_t)r * DM);
        const uint4 a = src[C.lane], b = src[64 + C.lane];
        uint4* d0 = (uint4*)(C.XS() + (size_t)sl0 * DM); uint4* d1 = (uint4*)(C.XS() + (size_t)sl1 * DM);
        d0[C.lane] = a; d0[64 + C.lane] = b; d1[C.lane] = a; d1[64 + C.lane] = b;
        if (C.lane == 0) { C.TOKS()[2 * r] = sl0; C.TOKS()[2 * r + 1] = sl1; }
    }
}

__device__ __forceinline__ void p9_combine(const Ctx& C, int l) {
    const int nrows = (l == 0) ? TA : TL; const bf16* YS = C.XS();
    for (int r = C.gw; r < nrows; r += C.nw) {
        float* xr = r < TL ? C.p->out + (size_t)r * DM : C.CTXS() + (size_t)(r - TL) * DM;
        float v[16]; load_row(xr, C.lane, v);
        const int s0 = C.TOKS()[2 * r], s1 = C.TOKS()[2 * r + 1]; const float w0 = C.TOKW()[2 * r], w1 = C.TOKW()[2 * r + 1];
        const float* mod = C.MOD() + (size_t)(l * 9 + modrow_of(r)) * INW;
#pragma unroll
        for (int j = 0; j < 4; ++j) { const int c = j * 256 + C.lane * 4; const uint2 a = *(const uint2*)(YS + (size_t)s0 * DM + c), b = *(const uint2*)(YS + (size_t)s1 * DM + c); const float4 g = *(const float4*)(mod + 5120 + c);
            v[4 * j] += g.x * (w0 * bflo(a.x) + w1 * bflo(b.x)); v[4 * j + 1] += g.y * (w0 * bfhi(a.x) + w1 * bfhi(b.x));
            v[4 * j + 2] += g.z * (w0 * bflo(a.y) + w1 * bflo(b.y)); v[4 * j + 3] += g.w * (w0 * bfhi(a.y) + w1 * bfhi(b.y)); }
        const float rinv = row_rinv(v);
        if (l == 0) {
#pragma unroll
            for (int j = 0; j < 4; ++j) *(float4*)(xr + j * 256 + C.lane * 4) = make_float4(v[4 * j], v[4 * j + 1], v[4 * j + 2], v[4 * j + 3]);
            float h[16]; const float* mod1 = C.MOD() + (size_t)(9 + modrow_of(r)) * INW;
            norm_mod(v, rinv, C.p->norm1_g + DM, mod1 + 1024, mod1, C.lane, h);
            store_row_bf16(C.H() + (size_t)r * DM, C.lane, h);
        } else {
#pragma unroll
            for (int j = 0; j < 4; ++j) { const int c = j * 256 + C.lane * 4; const float4 g = *(const float4*)(C.p->final_g + c);
                *(float4*)(xr + c) = make_float4(v[4 * j] * rinv * g.x, v[4 * j + 1] * rinv * g.y, v[4 * j + 2] * rinv * g.z, v[4 * j + 3] * rinv * g.w); }
        }
    }
}

#ifndef PHMASK
#define PHMASK 0xFFFFu
#endif
#define PHON(i) (((PHMASK) >> (i)) & 1u)
constexpr int NPH = 22;
__global__ void __launch_bounds__(512, 2) mk_fwd(Params p) {
    extern __shared__ __attribute__((aligned(16))) unsigned char lds_raw[];
    LAS unsigned char* ldsl = (LAS unsigned char*)lds_raw;
    if (threadIdx.x < 64) ((LAS unsigned*)(ldsl + LDS_STAGE))[threadIdx.x] = 0u;
    __syncthreads();
    XcdBarrier bar = xcd_barrier_post((unsigned*)(p.ws + WS_CTL) + CW_BAR + p.li * XCD_BAR_WORDS, (volatile LAS unsigned*)(ldsl + LDS_STAGE) + LDSW_BAR);
#define MKCTX() Ctx C; { unsigned long long kp_ = (unsigned long long)__builtin_amdgcn_kernarg_segment_ptr(); asm volatile("" : "+s"(kp_)); C.p.q = (ParamsK)kp_; } \
    C.ws = C.p->ws; C.lds = lds_raw; { int t_ = threadIdx.x, g_ = gridDim.x, b_ = blockIdx.x; asm volatile("" : "+v"(t_), "+s"(g_), "+s"(b_)); C.tid = t_; C.G = g_; C.bid = b_; } \
    C.lane = C.tid & 63; C.wave = __builtin_amdgcn_readfirstlane(C.tid >> 6); C.gw = C.bid * 8 + C.wave; C.nw = C.G * 8;
    const int lo = p.lo, hi = p.hi;
#define IN(k) (lo <= (k) && (k) < hi)
#define SEAM(k) do { if (IN((k) + 1)) xcd_barrier(bar); } while (0)

    if (PHON(0) && IN(0)) { MKCTX(); p0_prologue(C); SEAM(0); }
    if (PHON(1) && IN(1)) { MKCTX(); p1_norm1(C, 0, C.p->x, C.p->ctx); SEAM(1); }
    for (int l = 0; l < 2; ++l) {
        const int pb = 2 + 10 * l;
        const int mrows = (l == 0) ? TA : TL;
        if (PHON(2) && IN(pb + 0)) {
            MKCTX();
            pg8::Gemm g{C.H(), C.WIN_T(), TA, INW, DM}; pg8::StaticOrder S; S.init(TA, INW, C.G, C.bid);
            EpiInProj E{C.GRP(0), C.ROPE()};
            pg8::gemm_phase<EpiInProj, pg8::StaticOrder, true, true>(ldsl, g, S, E);
            SEAM(pb + 0);
        }
        if (PHON(3) && IN(pb + 1)) {
            MKCTX();
            p3_scan_naive(C, l);
            p3_attn_naive(C, l);
            SEAM(pb + 1);
        }
        if (PHON(4) && IN(pb + 2)) { MKCTX(); p3c_headnorm(C, l); SEAM(pb + 2); }
        if (PHON(5) && IN(pb + 3)) {
            MKCTX();
            pg8::StaticOrder S; S.init(mrows, DM, C.G, C.bid);
            { pg8::Gemm g{C.GRP(0), C.WNA_T(), mrows, DM, 512}; EpiMerge<0> E{C.MB(), C.GRP(8)}; pg8::gemm_phase<EpiMerge<0>, pg8::StaticOrder, true, true>(ldsl, g, S, E); }
            __syncthreads();
            { pg8::Gemm g{C.H(), C.WHG_T(), mrows, DM, 512}; EpiMerge<1> E{C.MB(), C.GRP(10)}; pg8::gemm_phase<EpiMerge<1>, pg8::StaticOrder, true, true>(ldsl, g, S, E); }
            SEAM(pb + 3);
        }
        if (PHON(6) && IN(pb + 4)) {
            MKCTX();
            pg8::StaticOrder S; S.init(mrows, DM, C.G, C.bid);
            pg8::Gemm g{C.MB(), C.WOUT_T(), mrows, DM, DM};
            EpiOut E{l == 0 ? C.p->x : (const float*)C.p->out, C.p->out, C.p->ctx, C.CTXS(), C.MOD() + (size_t)l * 9 * INW};
            pg8::gemm_phase<EpiOut, pg8::StaticOrder, true, true>(ldsl, g, S, E);
            conv_experts(C, l);
            SEAM(pb + 4);
        }
        if (PHON(7) && IN(pb + 5)) { MKCTX(); p5_norm2_router(C, l); SEAM(pb + 5); }
        if (PHON(8) && IN(pb + 6)) { MKCTX(); p6_permute(C, l); SEAM(pb + 6); }
        if (PHON(9) && IN(pb + 7)) {
            MKCTX();
            moe_table(C, l);
            MoeOrder S{C.TAB(), C.G, C.bid};
            pg8::Gemm g{C.XS(), C.WEGU(), SLOT_ROWS, 16384, DM}; EpiGateUp E{C.ACT()};
            pg8::gemm_phase<EpiGateUp, MoeOrder, true, true>(ldsl, g, S, E);
            SEAM(pb + 7);
        }
        if (PHON(10) && IN(pb + 8)) {
            MKCTX();
            moe_table(C, l);
            MoeOrder S{C.TAB(), C.G, C.bid};
            pg8::Gemm g{C.ACT(), C.WED(), SLOT_ROWS, 16384, 512}; EpiDown E{C.XS()};
            pg8::gemm_phase<EpiDown, MoeOrder, true, true>(ldsl, g, S, E);
            SEAM(pb + 8);
        }
        if (PHON(11) && IN(pb + 9)) { MKCTX(); p9_combine(C, l); if (l == 0) conv_mixer(C, 1); SEAM(pb + 9); }
    }
#undef IN
#undef SEAM
}

#ifndef MK_SPLIT
#define MK_SPLIT 0
#endif
extern "C" void kernel_launch(void* const* d_in, const int* in_sizes, int n_in, void* d_out, int out_size, void* d_ws, size_t ws_size, hipStream_t stream) {
    static int grid = 0;
    if (grid == 0) {
        if (n_in != 22 || ws_size < WS_END) { fprintf(stderr, "kernel_launch: unexpected n_in %d / ws_size %zu (need %zu)\n", n_in, ws_size, (size_t)WS_END); grid = -1; return; }
        int dev = 0, cus = 0, per_cu = 0;
        if (hipGetDevice(&dev) != hipSuccess || hipDeviceGetAttribute(&cus, hipDeviceAttributeMultiprocessorCount, dev) != hipSuccess) { grid = -1; return; }
        if (hipFuncSetAttribute((const void*)mk_fwd, hipFuncAttributeMaxDynamicSharedMemorySize, LDS_BYTES) != hipSuccess) { fprintf(stderr, "kernel_launch: hipFuncSetAttribute failed\n"); grid = -1; return; }
        if (hipOccupancyMaxActiveBlocksPerMultiprocessor(&per_cu, (const void*)mk_fwd, 512, LDS_BYTES) != hipSuccess || per_cu < 1) fprintf(stderr, "kernel_launch: occupancy query says %d\n", per_cu);
        (void)hipGetLastError();
        grid = cus;
    }
    if (grid < 0) return;
    if (hipMemsetAsync((char*)d_ws + WS_CTL, 0, CTL_BYTES, stream) != hipSuccess) return;
    Params p{};
    const float** pp = (const float**)&p;
    for (int i = 0; i < 22; ++i) pp[i] = (const float*)d_in[i];
    p.out = (float*)d_out; p.ws = (unsigned char*)d_ws; p.pad = 0;
#if MK_SPLIT
    for (int k = 0; k < NPH; ++k) { p.lo = k; p.hi = k + 1; p.li = k; hipLaunchKernelGGL(mk_fwd, dim3(grid), dim3(512), LDS_BYTES, stream, p); }
#else
    p.lo = 0; p.hi = NPH; p.li = 0;
    hipLaunchKernelGGL(mk_fwd, dim3(grid), dim3(512), LDS_BYTES, stream, p);
#endif
}
```

```cpp
#include <hip/hip_runtime.h>
#include <cstdio>
#include <cstdint>
namespace pg8 {
#define PG8_LAS __attribute__((address_space(3)))
typedef unsigned short bf16_t;
typedef short bf16x8 __attribute__((ext_vector_type(8)));
typedef float f32x4 __attribute__((ext_vector_type(4)));
typedef unsigned u32x4 __attribute__((ext_vector_type(4)));
constexpr int BM = 256, BK = 64, HALF = 128, HTB = HALF * BK * 2  , STAGE_BYTES = 8 * HTB, NXCD = 8, WGM = 8;

__host__ __device__ __forceinline__ int lds_byte(int r, int c) { const int st = (r >> 4) * 2 + (c >> 5), rr = r & 15, cc = c & 31, ob = rr * 64 + cc * 2; return st * 1024 + (ob ^ (((ob >> 9) & 1) << 5)); }
__host__ __device__ __forceinline__ void stage_rc(int b, int& R, int& C) { const int st = b / 1024, sb = b % 1024, swz = sb ^ (((sb >> 9) & 1) << 5); R = (st >> 1) * 16 + swz / 64; C = (st & 1) * 32 + (swz % 64) / 2; }
__host__ __device__ __forceinline__ int perm32(int rho) { const int n = rho >> 4, i = rho & 15; return 8 * (i >> 2) + 4 * n + (i & 3); }

struct Unit { int pm, pn; };
struct Gemm { const bf16_t* A; const bf16_t* Bt; int M, N, K; };

struct StaticOrder {
    int nM, nN, nwg, G, c;
    __host__ __device__ void init(int M, int N, int G_, int c_) { nM = M / BM; nN = N / BM; nwg = nM * nN; G = G_; c = c_; }
    __host__ __device__ bool next(int i, Unit& u) const {
        const long L = (long)i * G + c; if (L >= nwg) return false;
        int wgid = (int)L; { const int q = nwg / NXCD, r = nwg % NXCD, xcd = wgid % NXCD, off = wgid / NXCD; wgid = (xcd < r ? xcd * (q + 1) : r * (q + 1) + (xcd - r) * q) + off; }
        const int nig = WGM * nN, gid = wgid / nig, fm = gid * WGM, gsz = (nM - fm) < WGM ? (nM - fm) : WGM;
        u.pm = fm + ((wgid % nig) % gsz); u.pn = (wgid % nig) / gsz; return true;
    }
    __device__ __forceinline__ void a_ready(const Unit&) const {}
    __device__ __forceinline__ void done(const Unit&) const {}
};

__device__ __forceinline__ unsigned cvt_pk_bf16(float lo, float hi) { unsigned r; asm volatile("v_cvt_pk_bf16_f32 %0, %1, %2" : "=v"(r) : "v"(lo), "v"(hi)); return r; }
template <class Epi, class Sched, bool ALIGN_EPI = false, bool SP2 = false>
__device__ __forceinline__ void gemm_phase(PG8_LAS unsigned char* lds, const Gemm g, const Sched& S, const Epi& E) {
    int tid_ = threadIdx.x; asm volatile("" : "+v"(tid_));
    const int tid = tid_, wid = __builtin_amdgcn_readfirstlane(tid >> 6), lane = tid & 63, wr = wid >> 2, wc = wid & 3, fr = lane & 15, fq = lane >> 4;
    const int K = g.K, nt = K / BK;
    unsigned voffA[2], voffB[2];
#pragma unroll
    for (int i = 0; i < 2; ++i) { int R, C; stage_rc(tid * 16 + i * 8192, R, C); const int Rb = Epi::PERM ? ((R & ~31) + perm32(R & 31)) : R;
        voffA[i] = (unsigned)(R * K + C) * 2u; voffB[i] = (unsigned)(Rb * K + C) * 2u; }
    const size_t kstep = (size_t)(BK * 2);
    const size_t hstep = (size_t)HALF * K * 2;
    const size_t tstep = 2 * hstep;
    const unsigned ldsw = (unsigned)wid * 1024u;
    const int aoff = lds_byte(wr * 64 + fr, fq * 8), boff = lds_byte(wc * 32 + fr, fq * 8);
#define PG8_SA(b, h) (((b) * 2 + (h)) * HTB)
#define PG8_SB(b, h) ((4 + (b) * 2 + (h)) * HTB)
#define PG8_STAGE(bufoff, gbase, voff) do { _Pragma("unroll") for (int _i = 0; _i < 2; ++_i) \
        __builtin_amdgcn_global_load_lds((const unsigned*)((const char*)(gbase) + (voff)[_i]), (PG8_LAS unsigned*)(lds + (bufoff) + ldsw + _i * 8192), 16, 0, 0); } while (0)
#define PG8_LDA(dst, b, h) do { _Pragma("unroll") for (int m = 0; m < 4; ++m) _Pragma("unroll") for (int k = 0; k < 2; ++k) dst[m][k] = *(const PG8_LAS bf16x8*)(lds + PG8_SA(b, h) + aoff + m * 2048 + k * 1024); } while (0)
#define PG8_LDB(dst, b, h) do { _Pragma("unroll") for (int n = 0; n < 2; ++n) _Pragma("unroll") for (int k = 0; k < 2; ++k) dst[n][k] = *(const PG8_LAS bf16x8*)(lds + PG8_SB(b, h) + boff + n * 2048 + k * 1024); } while (0)
#define PG8_MMA(ai, bj, At, Bt) do { __builtin_amdgcn_s_setprio(1); _Pragma("unroll") for (int m = 0; m < 4; ++m) _Pragma("unroll") for (int n = 0; n < 2; ++n) _Pragma("unroll") for (int k = 0; k < 2; ++k) \
        acc[ai][bj][m][n] = __builtin_amdgcn_mfma_f32_16x16x32_bf16(Bt[n][k], At[m][k], acc[ai][bj][m][n], 0, 0, 0); __builtin_amdgcn_s_setprio(0); } while (0)
#define PG8_WAIT_V(n) asm volatile("s_waitcnt vmcnt(" #n ")" ::: "memory")
#define PG8_WAIT_L(n) asm volatile("s_waitcnt lgkmcnt(" #n ")" ::: "memory")
#define PG8_BAR __builtin_amdgcn_s_barrier()
#define PG8_SCHED __builtin_amdgcn_sched_barrier(0)
    Unit cur, nxt; int ui = 0;
    if (!S.next(0, cur)) return;
    f32x4 acc[2][2][4][2];
#pragma unroll
    for (int a = 0; a < 2; ++a)
#pragma unroll
        for (int b = 0; b < 2; ++b)
#pragma unroll
            for (int m = 0; m < 4; ++m)
#pragma unroll
                for (int n = 0; n < 2; ++n) acc[a][b][m][n] = (f32x4){0.f, 0.f, 0.f, 0.f};
    bf16x8 At[4][2], B0[2][2], B1[2][2];
    const char* cA = (const char*)g.A + (size_t)cur.pm * tstep; const char* cB = (const char*)g.Bt + (size_t)cur.pn * tstep;
    S.a_ready(cur);
    if constexpr (SP2) {
        PG8_STAGE(PG8_SB(0, 0), cB, voffB); PG8_STAGE(PG8_SB(0, 1), cB + hstep, voffB); PG8_STAGE(PG8_SA(0, 0), cA, voffA); PG8_STAGE(PG8_SA(0, 1), cA + hstep, voffA);
        if (wr == 1) PG8_BAR;
        PG8_WAIT_V(2); PG8_BAR;
        PG8_STAGE(PG8_SB(1, 0), cB + kstep, voffB); PG8_STAGE(PG8_SA(1, 0), cA + kstep, voffA); PG8_STAGE(PG8_SB(1, 1), cB + hstep + kstep, voffB);
        PG8_WAIT_V(6); PG8_BAR;
    } else {
        PG8_STAGE(PG8_SB(0, 0), cB, voffB); PG8_STAGE(PG8_SA(0, 0), cA, voffA); PG8_STAGE(PG8_SB(0, 1), cB + hstep, voffB); PG8_STAGE(PG8_SA(0, 1), cA + hstep, voffA);
        if (wr == 1) PG8_BAR;
        PG8_WAIT_V(4); PG8_BAR;
        PG8_STAGE(PG8_SB(1, 0), cB + kstep, voffB); PG8_STAGE(PG8_SA(1, 0), cA + kstep, voffA); PG8_STAGE(PG8_SB(1, 1), cB + hstep + kstep, voffB);
        PG8_WAIT_V(6); PG8_BAR;
    }
    for (;;) {
        const bool has_next = S.next(ui + 1, nxt);
        const char* nA = has_next ? (const char*)g.A + (size_t)nxt.pm * tstep : cA; const char* nB = has_next ? (const char*)g.Bt + (size_t)nxt.pn * tstep : cB;
        for (int t = 0; t < nt; t += 2) {
            const bool last = (t == nt - 2);
            const char* a1 = cA + (size_t)(t + 1) * kstep;
            const char* a2 = last ? nA : cA + (size_t)(t + 2) * kstep; const char* b2 = last ? nB : cB + (size_t)(t + 2) * kstep;
            const char* a3 = a2 + kstep; const char* b3 = b2 + kstep;
            if (last && has_next) S.a_ready(nxt);
            if constexpr (SP2) {
            PG8_LDB(B0, 0, 0); PG8_LDB(B1, 0, 1); PG8_SCHED; PG8_LDA(At, 0, 0); PG8_STAGE(PG8_SA(1, 1), a1 + hstep, voffA);
            PG8_WAIT_V(8); PG8_WAIT_L(0); PG8_BAR; PG8_MMA(0, 0, At, B0); PG8_MMA(0, 1, At, B1); PG8_BAR; PG8_SCHED;
            PG8_LDA(At, 0, 1); PG8_STAGE(PG8_SB(0, 0), b2, voffB); PG8_STAGE(PG8_SB(0, 1), b2 + hstep, voffB); PG8_STAGE(PG8_SA(0, 0), a2, voffA);
            PG8_WAIT_V(8); PG8_WAIT_L(0); PG8_BAR; PG8_MMA(1, 0, At, B0); PG8_MMA(1, 1, At, B1); PG8_BAR; PG8_SCHED;
            PG8_LDB(B0, 1, 0); PG8_LDB(B1, 1, 1); PG8_SCHED; PG8_LDA(At, 1, 0); PG8_STAGE(PG8_SA(0, 1), a2 + hstep, voffA);
            PG8_WAIT_V(8); PG8_WAIT_L(0); PG8_BAR; PG8_MMA(0, 0, At, B0); PG8_MMA(0, 1, At, B1); PG8_BAR; PG8_SCHED;
            PG8_LDA(At, 1, 1); PG8_STAGE(PG8_SB(1, 0), b3, voffB); PG8_STAGE(PG8_SB(1, 1), b3 + hstep, voffB); PG8_STAGE(PG8_SA(1, 0), a3, voffA);
            PG8_WAIT_V(8); PG8_WAIT_L(0); PG8_BAR; PG8_MMA(1, 0, At, B0); PG8_MMA(1, 1, At, B1); PG8_BAR; PG8_SCHED;
            } else {
            PG8_LDB(B0, 0, 0); PG8_SCHED; PG8_LDA(At, 0, 0); PG8_STAGE(PG8_SA(1, 1), a1 + hstep, voffA);
            PG8_WAIT_L(8); PG8_BAR; PG8_WAIT_L(0); PG8_MMA(0, 0, At, B0); PG8_BAR; PG8_SCHED;
            PG8_LDB(B1, 0, 1); PG8_STAGE(PG8_SB(0, 0), b2, voffB);
            PG8_BAR; PG8_WAIT_L(0); PG8_MMA(0, 1, At, B1); PG8_BAR;
            PG8_LDA(At, 0, 1); PG8_STAGE(PG8_SA(0, 0), a2, voffA);
            PG8_BAR; PG8_WAIT_L(0); PG8_MMA(1, 0, At, B0); PG8_BAR; PG8_SCHED;
            PG8_STAGE(PG8_SB(0, 1), b2 + hstep, voffB);
            PG8_WAIT_V(6); PG8_BAR; PG8_MMA(1, 1, At, B1); PG8_BAR;
            PG8_LDB(B0, 1, 0); PG8_SCHED; PG8_LDA(At, 1, 0); PG8_STAGE(PG8_SA(0, 1), a2 + hstep, voffA);
            PG8_WAIT_L(8); PG8_BAR; PG8_WAIT_L(0); PG8_MMA(0, 0, At, B0); PG8_BAR; PG8_SCHED;
            PG8_LDB(B1, 1, 1); PG8_STAGE(PG8_SB(1, 0), b3, voffB);
            PG8_BAR; PG8_WAIT_L(0); PG8_MMA(0, 1, At, B1); PG8_BAR;
            PG8_LDA(At, 1, 1); PG8_STAGE(PG8_SA(1, 0), a3, voffA);
            PG8_BAR; PG8_WAIT_L(0); PG8_MMA(1, 0, At, B0); PG8_BAR; PG8_SCHED;
            PG8_STAGE(PG8_SB(1, 1), b3 + hstep, voffB);
            PG8_WAIT_V(6); PG8_BAR; PG8_MMA(1, 1, At, B1); PG8_BAR;
            }
        }
        if constexpr (ALIGN_EPI) { if (wr == 0) PG8_BAR; }
        if constexpr (!Epi::AFTER_DRAIN) { E(acc, cur, wr, wc, fr, fq); S.done(cur); }
        if (!has_next) break;
#pragma unroll
        for (int a = 0; a < 2; ++a)
#pragma unroll
            for (int b = 0; b < 2; ++b)
#pragma unroll
                for (int m = 0; m < 4; ++m)
#pragma unroll
                    for (int n = 0; n < 2; ++n) acc[a][b][m][n] = (f32x4){0.f, 0.f, 0.f, 0.f};
        cur = nxt; cA = nA; cB = nB; ++ui;
        if constexpr (ALIGN_EPI) { if (wr == 1) PG8_BAR; }
    }
    PG8_WAIT_V(0);
    if constexpr (!ALIGN_EPI) { if (wr == 0) PG8_BAR; }
    PG8_BAR;
    if constexpr (Epi::AFTER_DRAIN) { E.fused(acc, cur, wr, wc, fr, fq, lds, wid, lane); S.done(cur); }
#undef PG8_SA
#undef PG8_SB
#undef PG8_STAGE
#undef PG8_LDA
#undef PG8_LDB
#undef PG8_MMA
#undef PG8_WAIT_V
#undef PG8_WAIT_L
#undef PG8_BAR
#undef PG8_SCHED
}
}
#define XB_TMO      128
#define XB_XCNT(j)  (256  + 64 * (j))
#define XB_XSUB(j)  (1280 + 64 * (j))
#define XB_XGEN(j)  (2304 + 64 * (j))
#define XB_TOP      3328
#define XB_TOPGEN   3392
#define XCD_BAR_WORDS 3456
#define XB_SPIN_CAP (1u << 18)
#define LAS __attribute__((address_space(3)))

__device__ __forceinline__ unsigned xb_ld(unsigned* p)              { return __hip_atomic_load(p, __ATOMIC_RELAXED, __HIP_MEMORY_SCOPE_AGENT); }
__device__ __forceinline__ unsigned xb_add(unsigned* p, unsigned v) { return __hip_atomic_fetch_add(p, v, __ATOMIC_RELAXED, __HIP_MEMORY_SCOPE_AGENT); }
__device__ __forceinline__ unsigned xb_xcc_id() { return (unsigned)__builtin_amdgcn_s_getreg((3 << 11) | 20) & 0xFu; }
#define XB_SPIN(cond, bar) do { unsigned _sp = 0; while (cond) { __builtin_amdgcn_s_sleep(1); \
    if ((++_sp & 255u) == 0u) { if (xb_ld(&(bar)[XB_TMO])) break; if (_sp > XB_SPIN_CAP) { atomicAdd(&(bar)[XB_TMO], 1u); break; } } } } while (0)

struct XcdBarrier {
    unsigned* bar; unsigned x;
    volatile LAS unsigned* st;
};

__device__ __forceinline__ XcdBarrier xcd_barrier_post(unsigned* bar, volatile LAS unsigned* st) {
    XcdBarrier b; b.bar = bar; b.x = xb_xcc_id(); b.st = st;
    if (threadIdx.x == 0) (void)xb_add(&bar[XB_XCNT(b.x)], 1u);
    return b;
}
__device__ __forceinline__ void xcd_barrier_complete(unsigned* bar, unsigned x, unsigned& nloc, unsigned& nx) {
    const unsigned G = gridDim.x * gridDim.y * gridDim.z;
    unsigned sum, cnt, mine, sp = 0u;
    for (;;) {
        sum = 0u; cnt = 0u; mine = 0u;
#pragma unroll
        for (unsigned j = 0; j < 16; ++j) { const unsigned c = xb_ld(&bar[XB_XCNT(j)]); sum += c; cnt += (c > 0u) ? 1u : 0u; mine = (j == x) ? c : mine; }
        if (sum == G) break;
        __builtin_amdgcn_s_sleep(1);
        if ((++sp & 255u) == 0u) { if (xb_ld(&bar[XB_TMO])) break; if (sp > XB_SPIN_CAP) { atomicAdd(&bar[XB_TMO], 1u); break; } }
    }
    nloc = mine > 0u ? mine : 1u; nx = cnt > 0u ? cnt : 1u;
}

__device__ __forceinline__ void xcd_barrier(const XcdBarrier& b) {
    asm volatile("s_waitcnt vmcnt(0)" ::: "memory");
    __syncthreads();
    if (threadIdx.x == 0) {
        unsigned* bar = b.bar;
        __builtin_amdgcn_s_waitcnt(0);
        unsigned nloc = b.st[0], nx = b.st[1];
        if (nloc == 0u) { xcd_barrier_complete(bar, b.x, nloc, nx); b.st[0] = nloc; b.st[1] = nx; }
        const unsigned old = xb_add(&bar[XB_XSUB(b.x)], 1u);
        const unsigned gen = old / nloc;
        if (old + 1u == (gen + 1u) * nloc) {
            __builtin_amdgcn_fence(__ATOMIC_RELEASE, "agent");
            asm volatile("s_waitcnt vmcnt(0)" ::: "memory");
            const unsigned og = xb_add(&bar[XB_TOP], 1u);
            const unsigned tg = og / nx;
            if (og + 1u == (tg + 1u) * nx) xb_add(&bar[XB_TOPGEN], 1u);
            else XB_SPIN(xb_ld(&bar[XB_TOPGEN]) == tg, bar);
            __builtin_amdgcn_fence(__ATOMIC_ACQUIRE, "agent");
            xb_add(&bar[XB_XGEN(b.x)], 1u);
            asm volatile("s_waitcnt vmcnt(0)" ::: "memory");
        } else {
            XB_SPIN(xb_ld(&bar[XB_XGEN(b.x)]) == gen, bar);
            __builtin_amdgcn_fence(__ATOMIC_ACQUIRE, "agent");
            asm volatile("s_waitcnt vmcnt(0)" ::: "memory");
        }
    }
    __syncthreads();
}


typedef unsigned short bf16;
typedef pg8::f32x4 f32x4;
typedef pg8::u32x4 u32x4;
constexpr int NB = 8, SEQ = 4096, DM = 1024, NCTX = 256;
constexpr int TL = NB * SEQ, TC = NB * NCTX, TA = TL + TC;
constexpr int INW = 6144, GW = 512, NGRP = 12;
constexpr size_t GSTRIDE = (size_t)TA * GW;
constexpr float EPS = 1e-6f;
constexpr int SLOT_ROWS = 73728;

constexpr size_t MiB = (size_t)1 << 20;
constexpr size_t WS_CTL = 0, CTL_BYTES = 1 * MiB;
constexpr size_t WS_MOD = 1 * MiB;
constexpr size_t WS_LB = 1 * MiB + 512 * 1024;
constexpr size_t WS_ROPE = 2 * MiB;
constexpr size_t WS_TOK = 3 * MiB;
constexpr size_t WS_CTXS = 4 * MiB;
constexpr size_t WS_WB = 12 * MiB;
constexpr size_t WS_H = 28 * MiB;
constexpr size_t WS_P = 96 * MiB;
constexpr size_t P_M = 34 * MiB, P_WEGU = 102 * MiB, P_WED = 134 * MiB, P_XS = 150 * MiB, P_ACT = 294 * MiB;
constexpr size_t WS_END = 504 * MiB;
constexpr int CW_BAR = 4096, CW_CNT = 131072;

constexpr int LDS_STAGE = 131072, LDS_BYTES = 147456;
constexpr int LDSW_BAR = 0, LDSW_TAB = 16;

struct Params {
    const float* x; const float* c; const float* ctx; const float* c_ctx; const float* w_ada; const float* b_ada; const float* norm1_g; const float* w_in;
    const float* rel_bias; const float* lowf; const float* lowb; const float* hg_norm_g; const float* w_na_o; const float* w_hg_o; const float* w_out; const float* norm2_g;
    const float* w_router; const float* router_bias; const float* w_gate; const float* w_up; const float* w_down; const float* final_g;
    float* out; unsigned char* ws; int lo, hi, li, pad;
};

__device__ __forceinline__ float bf2f(unsigned b) { return __uint_as_float(b << 16); }
__device__ __forceinline__ float bflo(unsigned w) { return __uint_as_float(w << 16); }
__device__ __forceinline__ float bfhi(unsigned w) { return __uint_as_float(w & 0xffff0000u); }
__device__ __forceinline__ unsigned f2bf(float f) { unsigned u = __float_as_uint(f); u += 0x7FFFu + ((u >> 16) & 1u); return u >> 16; }
__device__ __forceinline__ unsigned pk2(float lo, float hi) { return f2bf(lo) | (f2bf(hi) << 16); }
__device__ __forceinline__ float sigm(float x) { return 1.f / (1.f + __expf(-x)); }
__device__ __forceinline__ float silu(float x) { return x / (1.f + __expf(-x)); }
__device__ __forceinline__ float wave_sum(float v) {
#pragma unroll
    for (int o = 32; o >= 1; o >>= 1) v += __shfl_xor(v, o);
    return v; }
__device__ __forceinline__ float wave_max(float v) {
#pragma unroll
    for (int o = 32; o >= 1; o >>= 1) v = fmaxf(v, __shfl_xor(v, o));
    return v; }
__device__ __forceinline__ void unpack8(const uint4 w, float (&f)[8]) {
    f[0] = bflo(w.x); f[1] = bfhi(w.x); f[2] = bflo(w.y); f[3] = bfhi(w.y); f[4] = bflo(w.z); f[5] = bfhi(w.z); f[6] = bflo(w.w); f[7] = bfhi(w.w); }

typedef const __attribute__((address_space(4))) Params* ParamsK;
struct PView { ParamsK q; __device__ __forceinline__ const __attribute__((address_space(4))) Params* operator->() const { return q; } };
struct Ctx {
    PView p; unsigned char* ws; unsigned char* lds; int tid, lane, wave, G, bid, gw, nw;
    __device__ __forceinline__ float* MOD() const { return (float*)(ws + WS_MOD); }
    __device__ __forceinline__ float* LB() const { return (float*)(ws + WS_LB); }
    __device__ __forceinline__ float2* ROPE() const { return (float2*)(ws + WS_ROPE); }
    __device__ __forceinline__ int* TOKE() const { return (int*)(ws + WS_TOK); }
    __device__ __forceinline__ float* TOKW() const { return (float*)(ws + WS_TOK) + 2 * TA; }
    __device__ __forceinline__ int* TOKS() const { return (int*)(ws + WS_TOK) + 4 * TA; }
    __device__ __forceinline__ float* CTXS() const { return (float*)(ws + WS_CTXS); }
    __device__ __forceinline__ bf16* WIN_T() const { return (bf16*)(ws + WS_WB); }
    __device__ __forceinline__ bf16* WNA_T() const { return (bf16*)(ws + WS_WB + 12 * MiB); }
    __device__ __forceinline__ bf16* WHG_T() const { return (bf16*)(ws + WS_WB + 13 * MiB); }
    __device__ __forceinline__ bf16* WOUT_T() const { return (bf16*)(ws + WS_WB + 14 * MiB); }
    __device__ __forceinline__ bf16* H() const { return (bf16*)(ws + WS_H); }
    __device__ __forceinline__ bf16* GRP(int g) const { return (bf16*)(ws + WS_P) + (size_t)g * GSTRIDE; }
    __device__ __forceinline__ bf16* MB() const { return (bf16*)(ws + WS_P + P_M); }
    __device__ __forceinline__ bf16* WEGU() const { return (bf16*)(ws + WS_P + P_WEGU); }
    __device__ __forceinline__ bf16* WED() const { return (bf16*)(ws + WS_P + P_WED); }
    __device__ __forceinline__ bf16* XS() const { return (bf16*)(ws + WS_P + P_XS); }
    __device__ __forceinline__ bf16* ACT() const { return (bf16*)(ws + WS_P + P_ACT); }
    __device__ __forceinline__ unsigned* CTL() const { return (unsigned*)(ws + WS_CTL); }
    __device__ __forceinline__ unsigned* CNT(int l) const { return (unsigned*)(ws + WS_CTL) + CW_CNT + l * 64; }
    __device__ __forceinline__ int* TAB() const { return (int*)(lds + LDS_STAGE) + LDSW_TAB; }
};

template <class RowMap>
__device__ __forceinline__ void tconv_tile(const float* __restrict__ src, int ldsrc, int k0, int n0, bf16* __restrict__ dst, int ldd, int lane, RowMap rm) {
    float v[64];
    const float* s = src + (size_t)k0 * ldsrc + n0 + lane;
#pragma unroll
    for (int k = 0; k < 64; ++k) { v[k] = *s; s += ldsrc; asm volatile("" : "+v"(s)); }
    bf16* d = dst + (size_t)rm(n0 + lane) * ldd + k0;
#pragma unroll
    for (int j = 0; j < 8; ++j) { uint4 w; w.x = pk2(v[8 * j], v[8 * j + 1]); w.y = pk2(v[8 * j + 2], v[8 * j + 3]); w.z = pk2(v[8 * j + 4], v[8 * j + 5]); w.w = pk2(v[8 * j + 6], v[8 * j + 7]);
        *(uint4*)(d + 8 * j) = w; }
}
struct RmId { __device__ __forceinline__ int operator()(int n) const { return n; } };
struct RmGU { int base; __device__ __forceinline__ int operator()(int n) const { return base + (n >> 7) * 256 + (n & 127); } };

__device__ __forceinline__ void conv_mixer(const Ctx& C, int l) {
    for (int id = C.gw; id < 2048; id += C.nw) {
        if (id < 1536) { const int kt = id & 15, nt = id >> 4; tconv_tile(C.p->w_in + (size_t)l * DM * INW, INW, kt * 64, nt * 64, C.WIN_T(), DM, C.lane, RmId()); }
        else if (id < 1664) { const int j = id - 1536, kt = j & 7, nt = j >> 3; tconv_tile(C.p->w_na_o + (size_t)l * 512 * DM, DM, kt * 64, nt * 64, C.WNA_T(), 512, C.lane, RmId()); }
        else if (id < 1792) { const int j = id - 1664, kt = j & 7, nt = j >> 3; tconv_tile(C.p->w_hg_o + (size_t)l * 512 * DM, DM, kt * 64, nt * 64, C.WHG_T(), 512, C.lane, RmId()); }
        else { const int j = id - 1792, kt = j & 15, nt = j >> 4; tconv_tile(C.p->w_out + (size_t)l * DM * DM, DM, kt * 64, nt * 64, C.WOUT_T(), DM, C.lane, RmId()); }
    }
}
__device__ __forceinline__ void conv_experts(const Ctx& C, int l) {
    for (int id = C.gw; id < 6144; id += C.nw) {
        const int e = id / 384, j = id % 384;
        if (j < 128) { const int kt = j & 15, nt = j >> 4; tconv_tile(C.p->w_gate + ((size_t)l * 16 + e) * DM * 512, 512, kt * 64, nt * 64, C.WEGU(), DM, C.lane, RmGU{e * 1024}); }
        else if (j < 256) { const int jj = j - 128, kt = jj & 15, nt = jj >> 4; tconv_tile(C.p->w_up + ((size_t)l * 16 + e) * DM * 512, 512, kt * 64, nt * 64, C.WEGU(), DM, C.lane, RmGU{e * 1024 + 128}); }
        else { const int jj = j - 256, kt = jj & 7, nt = jj >> 3; tconv_tile(C.p->w_down + ((size_t)l * 16 + e) * 512 * DM, DM, kt * 64, nt * 64, C.WED() + (size_t)e * 1024 * 512, 512, C.lane, RmId()); }
    }
}

__device__ __forceinline__ void p0_prologue(const Ctx& C) {
    for (int u = C.bid; u < 24; u += C.G) {
        float* sl = (float*)C.lds;
        for (int i = C.tid; i < 9 * 1024; i += 512) { const int r = i >> 10, k = i & 1023; const float v = (r < 8) ? C.p->c[r * 1024 + k] : C.p->c_ctx[k]; sl[i] = v / (1.f + expf(-v)); }
        __syncthreads();
        const int l = u / 12, n = (u % 12) * 512 + C.tid;
        const float* w = C.p->w_ada + (size_t)l * DM * INW + n;
        float acc[9];
#pragma unroll
        for (int r = 0; r < 9; ++r) acc[r] = 0.f;
#pragma unroll 8
        for (int k = 0; k < 1024; ++k) { const float wv = w[(size_t)k * INW];
#pragma unroll
            for (int r = 0; r < 9; ++r) acc[r] += sl[r * 1024 + k] * wv; }
        const float bb = C.p->b_ada[l * INW + n];
#pragma unroll
        for (int r = 0; r < 9; ++r) C.MOD()[(size_t)(l * 9 + r) * INW + n] = acc[r] + bb;
        __syncthreads();
    }
    const int gt = C.bid * 512 + C.tid, nthr = C.G * 512;
    for (int i = gt; i < 4096 * 32; i += nthr) { const int t = i >> 5, pr = i & 31; const float pos = (float)((pr < 16) ? (t >> 6) : (t & 63)); const int j = pr & 15;
        const float inv = powf(10000.f, -(float)(2 * j) / 32.f); const float ang = pos * inv; C.ROPE()[i] = make_float2(cosf(ang), sinf(ang)); }
    for (int i = gt; i < 1024; i += nthr) { const int dir = i >> 9, ch = i & 511; const float* raw = dir ? C.p->lowb : C.p->lowf; const float r0 = raw[ch], r1 = raw[512 + ch];
        const float p1 = 1.f / (1.f + expf(r0 - r1)); C.LB()[(0 * 2 + dir) * 512 + ch] = 0.f; C.LB()[(1 * 2 + dir) * 512 + ch] = p1; }
    conv_mixer(C, 0);
}

__device__ __forceinline__ void load_row(const float* xr, int lane, float (&v)[16]) {
#pragma unroll
    for (int j = 0; j < 4; ++j) { const float4 t = *(const float4*)(xr + j * 256 + lane * 4); v[4 * j] = t.x; v[4 * j + 1] = t.y; v[4 * j + 2] = t.z; v[4 * j + 3] = t.w; }
}
__device__ __forceinline__ float row_rinv(const float (&v)[16]) {
    float ss = 0.f;
#pragma unroll
    for (int i = 0; i < 16; ++i) ss += v[i] * v[i];
    ss = wave_sum(ss);
    return rsqrtf(ss * (1.f / 1024.f) + EPS);
}
__device__ __forceinline__ void norm_mod(const float (&v)[16], float rinv, const float* gam, const float* sc, const float* sh, int lane, float (&h)[16]) {
#pragma unroll
    for (int j = 0; j < 4; ++j) { const int c = j * 256 + lane * 4; const float4 g = *(const float4*)(gam + c), s = *(const float4*)(sc + c), b = *(const float4*)(sh + c);
        h[4 * j] = v[4 * j] * rinv * g.x * (1.f + s.x) + b.x; h[4 * j + 1] = v[4 * j + 1] * rinv * g.y * (1.f + s.y) + b.y;
        h[4 * j + 2] = v[4 * j + 2] * rinv * g.z * (1.f + s.z) + b.z; h[4 * j + 3] = v[4 * j + 3] * rinv * g.w * (1.f + s.w) + b.w; }
}
__device__ __forceinline__ void store_row_bf16(bf16* hr, int lane, const float (&h)[16]) {
#pragma unroll
    for (int j = 0; j < 4; ++j) { uint2 w; w.x = pk2(h[4 * j], h[4 * j + 1]); w.y = pk2(h[4 * j + 2], h[4 * j + 3]); *(uint2*)(hr + j * 256 + lane * 4) = w; }
}
__device__ __forceinline__ int modrow_of(int r) { return r < TL ? (r >> 12) : 8; }

__device__ __forceinline__ void p1_norm1(const Ctx& C, int l, const float* xl, const float* xc) {
    for (int r = C.gw; r < TA; r += C.nw) {
        const float* xr = r < TL ? xl + (size_t)r * DM : xc + (size_t)(r - TL) * DM;
        float v[16], h[16]; load_row(xr, C.lane, v);
        const float rinv = row_rinv(v);
        const float* mod = C.MOD() + (size_t)(l * 9 + modrow_of(r)) * INW;
        norm_mod(v, rinv, C.p->norm1_g + l * DM, mod + 1024, mod, C.lane, h);
        store_row_bf16(C.H() + (size_t)r * DM, C.lane, h);
    }
}

struct EpiInProj {
    static constexpr bool PERM = true, AFTER_DRAIN = false;
    bf16* P; const float2* rope;
    __device__ __forceinline__ void operator()(const f32x4 (&acc)[2][2][4][2], const pg8::Unit& u, int wr, int wc, int fr, int fq) const {
        const int grp = u.pn >> 1; bf16* base = P + (size_t)grp * GSTRIDE;
        const int colb = (u.pn & 1) * 256 + wc * 32 + 8 * fq;
        const bool do_rope = (grp < 2) && (u.pm < TL / 256);
#pragma unroll
        for (int ai = 0; ai < 2; ++ai)
#pragma unroll
            for (int m = 0; m < 4; ++m) { const int row = u.pm * 256 + ai * 128 + wr * 64 + m * 16 + fr;
#pragma unroll
                for (int bj = 0; bj < 2; ++bj) { const int col = colb + bj * 128; f32x4 v0 = acc[ai][bj][m][0], v1 = acc[ai][bj][m][1];
                    if (do_rope) { const float4* rp = (const float4*)(rope + (size_t)(row & 4095) * 32 + ((col & 63) >> 1)); const float4 c01 = rp[0], c23 = rp[1];
                        const f32x4 a = v0, b = v1;
                        v0[0] = a[0] * c01.x - a[1] * c01.y; v0[1] = a[0] * c01.y + a[1] * c01.x; v0[2] = a[2] * c01.z - a[3] * c01.w; v0[3] = a[2] * c01.w + a[3] * c01.z;
                        v1[0] = b[0] * c23.x - b[1] * c23.y; v1[1] = b[0] * c23.y + b[1] * c23.x; v1[2] = b[2] * c23.z - b[3] * c23.w; v1[3] = b[2] * c23.w + b[3] * c23.z; }
                    if (grp == 2) {
                        const int hh = col >> 6, d0 = col & 63; const bool lat = row < TL;
                        const int bb = lat ? (row >> 12) : ((row - TL) >> 8), tt = lat ? (row & 4095) : ((row - TL) & 255);
                        bf16* vp = lat ? base + ((size_t)((bb * 8 + hh) * 64 + d0) << 12) + tt : base + (size_t)TL * GW + ((size_t)((bb * 8 + hh) * 64 + d0) << 8) + tt;
                        const size_t st = lat ? 4096 : 256;
#pragma unroll
                        for (int i = 0; i < 4; ++i) { vp[(size_t)i * st] = (bf16)f2bf(v0[i]); vp[(size_t)(4 + i) * st] = (bf16)f2bf(v1[i]); }
                    } else {
                    u32x4 w; w.x = pg8::cvt_pk_bf16(v0[0], v0[1]); w.y = pg8::cvt_pk_bf16(v0[2], v0[3]); w.z = pg8::cvt_pk_bf16(v1[0], v1[1]); w.w = pg8::cvt_pk_bf16(v1[2], v1[3]);
                    *(u32x4*)(base + (size_t)row * GW + col) = w; } } }
    }
};
template <int PASS> struct EpiMerge {
    static constexpr bool PERM = true, AFTER_DRAIN = false;
    bf16* M; const bf16* G;
    __device__ __forceinline__ void operator()(const f32x4 (&acc)[2][2][4][2], const pg8::Unit& u, int wr, int wc, int fr, int fq) const {
        const bf16* gb = G + (size_t)(u.pn >> 1) * GSTRIDE; const int gcol = (u.pn & 1) * 256 + wc * 32 + 8 * fq, mcol = u.pn * 256 + wc * 32 + 8 * fq;
#pragma unroll
        for (int ai = 0; ai < 2; ++ai)
#pragma unroll
            for (int m = 0; m < 4; ++m) { const int row = u.pm * 256 + ai * 128 + wr * 64 + m * 16 + fr;
#pragma unroll
                for (int bj = 0; bj < 2; ++bj) { const uint4 gw = *(const uint4*)(gb + (size_t)row * GW + gcol + bj * 128); float g[8]; unpack8(gw, g);
                    bf16* mp = M + (size_t)row * DM + mcol + bj * 128; const f32x4 v0 = acc[ai][bj][m][0], v1 = acc[ai][bj][m][1];
                    float o[8];
#pragma unroll
                    for (int i = 0; i < 4; ++i) { o[i] = sigm(g[i]) * v0[i]; o[4 + i] = sigm(g[4 + i]) * v1[i]; }
                    if (PASS == 1) { const uint4 mw = *(const uint4*)mp; float pm_[8]; unpack8(mw, pm_);
#pragma unroll
                        for (int i = 0; i < 8; ++i) o[i] += pm_[i]; }
                    u32x4 w; w.x = pg8::cvt_pk_bf16(o[0], o[1]); w.y = pg8::cvt_pk_bf16(o[2], o[3]); w.z = pg8::cvt_pk_bf16(o[4], o[5]); w.w = pg8::cvt_pk_bf16(o[6], o[7]);
                    *(u32x4*)mp = w; } }
    }
};
struct EpiOut {
    static constexpr bool PERM = false, AFTER_DRAIN = false;
    const float* xl_src; float* xl_dst; const float* xc_src; float* xc_dst; const float* mod;
    __device__ __forceinline__ void operator()(const f32x4 (&acc)[2][2][4][2], const pg8::Unit& u, int wr, int wc, int fr, int fq) const {
        const bool lat = u.pm < TL / 256; const int mr = lat ? (u.pm >> 4) : 8;
        const float* gate = mod + (size_t)mr * INW + 2048; const int col0 = u.pn * 256 + wc * 32 + 4 * fq;
        const float* src = lat ? xl_src : xc_src - (size_t)TL * DM; float* dst = lat ? xl_dst : xc_dst - (size_t)TL * DM;
        f32x4 gv[2][2];
#pragma unroll
        for (int bj = 0; bj < 2; ++bj)
#pragma unroll
            for (int n = 0; n < 2; ++n) gv[bj][n] = *(const f32x4*)(gate + col0 + bj * 128 + n * 16);
#pragma unroll
        for (int ai = 0; ai < 2; ++ai)
#pragma unroll
            for (int m = 0; m < 4; ++m) { const size_t off = (size_t)(u.pm * 256 + ai * 128 + wr * 64 + m * 16 + fr) * DM + col0;
#pragma unroll
                for (int bj = 0; bj < 2; ++bj)
#pragma unroll
                    for (int n = 0; n < 2; ++n) { const f32x4 xo = *(const f32x4*)(src + off + bj * 128 + n * 16); *(f32x4*)(dst + off + bj * 128 + n * 16) = xo + gv[bj][n] * acc[ai][bj][m][n]; } }
    }
};
struct EpiGateUp {
    static constexpr bool PERM = true, AFTER_DRAIN = false;
    bf16* A;
    __device__ __forceinline__ void operator()(const f32x4 (&acc)[2][2][4][2], const pg8::Unit& u, int wr, int wc, int fr, int fq) const {
        const int col = (u.pn & 3) * 128 + wc * 32 + 8 * fq;
#pragma unroll
        for (int ai = 0; ai < 2; ++ai)
#pragma unroll
            for (int m = 0; m < 4; ++m) { const int row = u.pm * 256 + ai * 128 + wr * 64 + m * 16 + fr; float o[8];
#pragma unroll
                for (int i = 0; i < 4; ++i) { o[i] = silu(acc[ai][0][m][0][i]) * acc[ai][1][m][0][i]; o[4 + i] = silu(acc[ai][0][m][1][i]) * acc[ai][1][m][1][i]; }
                u32x4 w; w.x = pg8::cvt_pk_bf16(o[0], o[1]); w.y = pg8::cvt_pk_bf16(o[2], o[3]); w.z = pg8::cvt_pk_bf16(o[4], o[5]); w.w = pg8::cvt_pk_bf16(o[6], o[7]);
                *(u32x4*)(A + (size_t)row * 512 + col) = w; }
    }
};
struct EpiDown {
    static constexpr bool PERM = true, AFTER_DRAIN = false;
    bf16* Y;
    __device__ __forceinline__ void operator()(const f32x4 (&acc)[2][2][4][2], const pg8::Unit& u, int wr, int wc, int fr, int fq) const {
        const int col = (u.pn & 3) * 256 + wc * 32 + 8 * fq;
#pragma unroll
        for (int ai = 0; ai < 2; ++ai)
#pragma unroll
            for (int m = 0; m < 4; ++m) { const int row = u.pm * 256 + ai * 128 + wr * 64 + m * 16 + fr;
#pragma unroll
                for (int bj = 0; bj < 2; ++bj) { const f32x4 v0 = acc[ai][bj][m][0], v1 = acc[ai][bj][m][1];
                    u32x4 w; w.x = pg8::cvt_pk_bf16(v0[0], v0[1]); w.y = pg8::cvt_pk_bf16(v0[2], v0[3]); w.z = pg8::cvt_pk_bf16(v1[0], v1[1]); w.w = pg8::cvt_pk_bf16(v1[2], v1[3]);
                    *(u32x4*)(Y + (size_t)row * DM + col + bj * 128) = w; } }
    }
};
struct MoeOrder {
    const int* tab; int G, c;
    __device__ __forceinline__ bool next(int i, pg8::Unit& u) const {
        const int L = i * G + c, MT = tab[16]; if (L >= MT * 4) return false;
        const int mt = L >> 2; int e = 0;
#pragma unroll
        for (int j = 1; j < 16; ++j) e += (mt >= tab[j]) ? 1 : 0;
        u.pm = mt; u.pn = e * 4 + (L & 3); return true;
    }
    __device__ __forceinline__ void a_ready(const pg8::Unit&) const {}
    __device__ __forceinline__ void done(const pg8::Unit&) const {}
};
__device__ __forceinline__ void moe_table(const Ctx& C, int l) {
    __syncthreads();
    if (C.tid == 0) { int acc = 0; const unsigned* cnt = C.CNT(l);
        for (int e = 0; e < 16; ++e) { C.TAB()[e] = acc; acc += (int)((__hip_atomic_load(cnt + e, __ATOMIC_RELAXED, __HIP_MEMORY_SCOPE_AGENT) + 255u) >> 8); }
        C.TAB()[16] = acc; }
    __syncthreads();
}

__device__ __forceinline__ void p3_attn_naive(const Ctx& C, int l) {
    float* pl = (float*)C.lds + C.wave * 768; int* kl = (int*)(pl + 384);
    const bf16* Q = C.GRP(0); const bf16* K = C.GRP(1); const bf16* V = C.GRP(2); bf16* O = C.GRP(0);
    const int nq = (l == 0 ? TA : TL) * 8;
    for (int wq = C.gw; wq < nq; wq += C.nw) {
        const int r = wq >> 3, h = wq & 7; const bool lat = r < TL;
        const int b = lat ? (r >> 12) : ((r - TL) >> 8);
        float q[64];
        { const uint4* qp = (const uint4*)(Q + (size_t)r * GW + h * 64);
#pragma unroll
          for (int j = 0; j < 8; ++j) { float t[8]; unpack8(qp[j], t);
#pragma unroll
              for (int i = 0; i < 8; ++i) q[8 * j + i] = t[i]; } }
        const int t = r & 4095, gr = t >> 6, gc = t & 63;
        const int rs = min(max(gr - 4, 0), 56), cs = min(max(gc - 8, 0), 48);
        float s[6]; int krow[6];
#pragma unroll
        for (int i = 0; i < 6; ++i) {
            float bias = 0.f; bool valid = true;
            if (i < 2) { const int j = C.lane + 64 * i, kr = rs + (j >> 4), kc = cs + (j & 15); krow[i] = b * 4096 + kr * 64 + kc; valid = lat;
                if (lat) bias = C.p->rel_bias[((size_t)(l * 8 + h) * 15 + (kr - gr + 7)) * 31 + (kc - gc + 15)]; if (!lat) krow[i] = TL + b * 256; }
            else krow[i] = TL + b * 256 + C.lane + 64 * (i - 2);
            const uint4* kp = (const uint4*)(K + (size_t)krow[i] * GW + h * 64); float d = 0.f;
#pragma unroll
            for (int j = 0; j < 8; ++j) { float tk[8]; unpack8(kp[j], tk);
#pragma unroll
                for (int ii = 0; ii < 8; ++ii) d += q[8 * j + ii] * tk[ii]; }
            s[i] = valid ? d * 0.125f + bias : -1e30f;
        }
        float mx = s[0];
#pragma unroll
        for (int i = 1; i < 6; ++i) mx = fmaxf(mx, s[i]);
        mx = wave_max(mx);
        float sum = 0.f;
#pragma unroll
        for (int i = 0; i < 6; ++i) { s[i] = (s[i] > -1e29f) ? __expf(s[i] - mx) : 0.f; sum += s[i]; }
        sum = wave_sum(sum); const float inv = 1.f / sum;
#pragma unroll
        for (int i = 0; i < 6; ++i) { pl[C.lane + 64 * i] = s[i] * inv; kl[C.lane + 64 * i] = krow[i]; }
        float acc = 0.f;
        for (int j = lat ? 0 : 128; j < 384; ++j) acc += pl[j] * bf2f(V[(size_t)kl[j] * GW + h * 64 + C.lane]);
        O[(size_t)r * GW + h * 64 + C.lane] = (bf16)f2bf(acc);
    }
}


typedef pg8::bf16x8 bf16x8;
typedef unsigned u32x2 __attribute__((ext_vector_type(2)));
__device__ __forceinline__ bf16x8 ld16(const bf16* p) { return *(const bf16x8*)p; }
__device__ __forceinline__ bf16x8 ld8x2(const bf16* p0, const bf16* p1) { const u32x2 a = *(const u32x2*)p0, b = *(const u32x2*)p1; u32x4 w; w.x = a.x; w.y = a.y; w.z = b.x; w.w = b.y; return __builtin_bit_cast(bf16x8, w); }
__device__ __forceinline__ bf16x8 pack8(const f32x4 a, const f32x4 b) { u32x4 w; w.x = pg8::cvt_pk_bf16(a[0], a[1]); w.y = pg8::cvt_pk_bf16(a[2], a[3]); w.z = pg8::cvt_pk_bf16(b[0], b[1]); w.w = pg8::cvt_pk_bf16(b[2], b[3]); return __builtin_bit_cast(bf16x8, w); }
#define MFMA16(a, b, c) __builtin_amdgcn_mfma_f32_16x16x32_bf16(a, b, c, 0, 0, 0)

__device__ __forceinline__ void p3_attn(const Ctx& C, int l) {
    float* relb = (float*)(C.lds + 98304);
    __syncthreads();
    for (int i = C.tid; i < 8 * 15 * 32; i += 512) { const int dc = i & 31, hd = i >> 5; relb[i] = (dc < 31) ? C.p->rel_bias[(size_t)l * 8 * 15 * 31 + hd * 31 + dc] : 0.f; }
    __syncthreads();
    const bf16* Qb = C.GRP(0); const bf16* Kb = C.GRP(1); const bf16* VT = C.GRP(2); const bf16* VTc = C.GRP(2) + (size_t)TL * GW; bf16* Ob = C.GRP(0);
    const int lq = C.lane & 15, g = C.lane >> 4;
    const int nlat = 16384, nu = nlat + (l == 0 ? 1024 : 0);
    for (int u = C.gw; u < nu; u += C.nw) {
        const bool lat = u < nlat;
        int b, h, gr = 0, gc0 = 0, qrow0;
        if (lat) { const int ct = u & 3; h = (u >> 2) & 7; gr = (u >> 5) & 63; b = u >> 11; gc0 = ct * 16; qrow0 = b * 4096 + gr * 64 + gc0; }
        else { const int v = u - nlat, qt = v & 15; h = (v >> 4) & 7; b = v >> 7; qrow0 = TL + b * 256 + qt * 16; }
        const int rs = min(max(gr - 4, 0), 56), u0 = min(max(gc0 - 8, 0), 32);
        const bf16* qp = Qb + (size_t)(qrow0 + lq) * GW + h * 64 + 8 * g;
        const bf16x8 q0 = ld16(qp), q1 = ld16(qp + 32);
        f32x4 s[32];
        const f32x4 z4 = {0.f, 0.f, 0.f, 0.f};
        if (lat) {
            const int gcq = gc0 + lq, csq = min(max(gcq - 8, 0), 48);
#pragma unroll
            for (int wt = 0; wt < 16; ++wt) { const int wrow = wt >> 1, half = wt & 1;
                const bf16* kp = Kb + (size_t)(b * 4096 + (rs + wrow) * 64 + u0 + 16 * half + lq) * GW + h * 64 + 8 * g;
                f32x4 a = MFMA16(ld16(kp), q0, z4); a = MFMA16(ld16(kp + 32), q1, a);
                const float* brow = relb + (h * 15 + (rs + wrow - gr + 7)) * 32;
#pragma unroll
                for (int r = 0; r < 4; ++r) { const int kc = u0 + 16 * half + 4 * g + r; const bool valid = (kc >= csq) && (kc < csq + 16); const int dc = min(max(kc - gcq + 15, 0), 30);
                    a[r] = valid ? a[r] * 0.125f + brow[dc] : -1e30f; }
                s[wt] = a; }
        } else {
#pragma unroll
            for (int wt = 0; wt < 16; ++wt) s[wt] = (f32x4){-1e30f, -1e30f, -1e30f, -1e30f};
        }
#pragma unroll
        for (int ctile = 0; ctile < 16; ++ctile) {
            const bf16* kp = Kb + (size_t)(TL + b * 256 + ctile * 16 + lq) * GW + h * 64 + 8 * g;
            f32x4 a = MFMA16(ld16(kp), q0, z4); a = MFMA16(ld16(kp + 32), q1, a);
            s[16 + ctile] = a * 0.125f; }
        float mx = -1e30f;
#pragma unroll
        for (int i = 0; i < 32; ++i) mx = fmaxf(fmaxf(fmaxf(mx, s[i][0]), fmaxf(s[i][1], s[i][2])), s[i][3]);
        mx = fmaxf(mx, __shfl_xor(mx, 16)); mx = fmaxf(mx, __shfl_xor(mx, 32));
        float sum = 0.f;
#pragma unroll
        for (int i = 0; i < 32; ++i) {
#pragma unroll
            for (int r = 0; r < 4; ++r) { const float e = __expf(s[i][r] - mx); s[i][r] = e; sum += e; } }
        sum += __shfl_xor(sum, 16); sum += __shfl_xor(sum, 32);
        const float inv = 1.f / sum;
        f32x4 o[4] = {z4, z4, z4, z4};
        if (lat) {
#pragma unroll
            for (int wrow = 0; wrow < 8; ++wrow) { const bf16x8 pb = pack8(s[2 * wrow], s[2 * wrow + 1]);
                const bf16* vp = VT + ((size_t)((b * 8 + h) * 64 + lq) << 12) + (rs + wrow) * 64 + u0 + 4 * g;
#pragma unroll
                for (int dt = 0; dt < 4; ++dt) o[dt] = MFMA16(ld8x2(vp + ((size_t)dt << 16), vp + ((size_t)dt << 16) + 16), pb, o[dt]); }
        }
#pragma unroll
        for (int cb = 0; cb < 8; ++cb) { const bf16x8 pb = pack8(s[16 + 2 * cb], s[16 + 2 * cb + 1]);
            const bf16* vp = VTc + ((size_t)((b * 8 + h) * 64 + lq) << 8) + cb * 32 + 4 * g;
#pragma unroll
            for (int dt = 0; dt < 4; ++dt) o[dt] = MFMA16(ld8x2(vp + (dt << 12), vp + (dt << 12) + 16), pb, o[dt]); }
        bf16* op = Ob + (size_t)(qrow0 + lq) * GW + h * 64 + 4 * g;
#pragma unroll
        for (int dt = 0; dt < 4; ++dt) { u32x2 w; w.x = pg8::cvt_pk_bf16(o[dt][0] * inv, o[dt][1] * inv); w.y = pg8::cvt_pk_bf16(o[dt][2] * inv, o[dt][3] * inv); *(u32x2*)(op + 16 * dt) = w; }
    }
}

__device__ __forceinline__ int scan_row(int b, int dir, int s) { return dir == 0 ? (s < NCTX ? TL + b * NCTX + s : b * SEQ + (s - NCTX)) : (s < NCTX ? TL + b * NCTX + (NCTX - 1 - s) : b * SEQ + (SEQ - 1 - (s - NCTX))); }
__device__ __forceinline__ void p3_scan_naive(const Ctx& C, int l) {
    const bf16* HQ = C.GRP(3); const bf16* HI = C.GRP(6);
    for (int u = C.gw; u < 2048; u += C.nw) {
        const int dv4 = u & 31, dir = (u >> 5) & 1, h = (u >> 6) & 3, b = u >> 8;
        const bf16* HF = C.GRP(dir ? 5 : 4); bf16* OUT = C.H() + (size_t)dir * GSTRIDE;
        const float lb0 = C.LB()[(l * 2 + dir) * 512 + h * 128 + C.lane], lb1 = C.LB()[(l * 2 + dir) * 512 + h * 128 + 64 + C.lane];
        float S0[4] = {0.f, 0.f, 0.f, 0.f}, S1[4] = {0.f, 0.f, 0.f, 0.f};
        const int NS = NCTX + SEQ;
        int row = scan_row(b, dir, 0);
        unsigned q0 = HQ[(size_t)row * GW + h * 128 + C.lane], q1 = HQ[(size_t)row * GW + h * 128 + 64 + C.lane], f0 = HF[(size_t)row * GW + h * 128 + C.lane], f1 = HF[(size_t)row * GW + h * 128 + 64 + C.lane];
        uint2 vv = *(const uint2*)(HI + (size_t)row * GW + h * 128 + dv4 * 4);
        for (int s = 0; s < NS; ++s) {
            const int nrow = scan_row(b, dir, (s + 1 < NS) ? s + 1 : s);
            const unsigned nq0 = HQ[(size_t)nrow * GW + h * 128 + C.lane], nq1 = HQ[(size_t)nrow * GW + h * 128 + 64 + C.lane], nf0 = HF[(size_t)nrow * GW + h * 128 + C.lane], nf1 = HF[(size_t)nrow * GW + h * 128 + 64 + C.lane];
            const uint2 nvv = *(const uint2*)(HI + (size_t)nrow * GW + h * 128 + dv4 * 4);
            const float qa = silu(bf2f(q0)), qb = silu(bf2f(q1));
            const float fa = fminf(fmaxf(bf2f(f0), -30.f), 30.f), fb = fminf(fmaxf(bf2f(f1), -30.f), 30.f);
            const float ea = __expf(-fa), eb = __expf(-fb);
            const float sga = 1.f / (1.f + ea), sgb = 1.f / (1.f + eb);
            const float ga = fmaxf(lb0 + (1.f - lb0) * sga, 1e-30f), gb = fmaxf(lb1 + (1.f - lb1) * sgb, 1e-30f);
            const float ka = (1.f - lb0) * (ea * sga), kb = (1.f - lb1) * (eb * sgb);
            const float v[4] = {bflo(vv.x), bfhi(vv.x), bflo(vv.y), bfhi(vv.y)};
            float o[4];
#pragma unroll
            for (int j = 0; j < 4; ++j) { S0[j] = ga * S0[j] + ka * v[j]; S1[j] = gb * S1[j] + kb * v[j]; o[j] = wave_sum(qa * S0[j] + qb * S1[j]); }
            if (C.lane == 0) { uint2 w; w.x = pk2(o[0], o[1]); w.y = pk2(o[2], o[3]); *(uint2*)(OUT + (size_t)row * GW + h * 128 + dv4 * 4) = w; }
            row = nrow; q0 = nq0; q1 = nq1; f0 = nf0; f1 = nf1; vv = nvv;
        }
    }
}

__device__ __forceinline__ void p3c_headnorm(const Ctx& C, int l) {
    const int nrows = (l == 0) ? TA : TL;
    bf16* OF = C.H(); const bf16* OB = C.H() + GSTRIDE; const bf16* HG = C.GRP(7);
    const float* gain = C.p->hg_norm_g + l * 128;
    for (int r = C.gw; r < nrows; r += C.nw) {
        const size_t off = (size_t)r * GW + C.lane * 8;
        float a[8], b[8], g[8]; unpack8(*(const uint4*)(OF + off), a); unpack8(*(const uint4*)(OB + off), b); unpack8(*(const uint4*)(HG + off), g);
        float ss = 0.f;
#pragma unroll
        for (int i = 0; i < 8; ++i) { a[i] += b[i]; ss += a[i] * a[i]; }
        ss += __shfl_xor(ss, 1); ss += __shfl_xor(ss, 2); ss += __shfl_xor(ss, 4); ss += __shfl_xor(ss, 8);
        const float rinv = rsqrtf(ss * (1.f / 128.f) + EPS);
        const int cg = (C.lane & 15) * 8; float o[8];
#pragma unroll
        for (int i = 0; i < 8; ++i) o[i] = a[i] * rinv * gain[cg + i] * silu(g[i]);
        uint4 w; w.x = pk2(o[0], o[1]); w.y = pk2(o[2], o[3]); w.z = pk2(o[4], o[5]); w.w = pk2(o[6], o[7]);
        *(uint4*)(OF + off) = w;
    }
}

__device__ __forceinline__ void p5_norm2_router(const Ctx& C, int l) {
    float* wr = (float*)C.lds;
    for (int i = C.tid; i < 1024 * 16; i += 512) wr[(i & 15) * 1024 + (i >> 4)] = C.p->w_router[i];
    __syncthreads();
    const int nrows = (l == 0) ? TA : TL;
    float rb[16];
#pragma unroll
    for (int e = 0; e < 16; ++e) rb[e] = C.p->router_bias[e];
    for (int r = C.gw; r < nrows; r += C.nw) {
        const float* xr = r < TL ? C.p->out + (size_t)r * DM : C.CTXS() + (size_t)(r - TL) * DM;
        float v[16], h[16]; load_row(xr, C.lane, v);
        const float rinv = row_rinv(v);
        const float* mod = C.MOD() + (size_t)(l * 9 + modrow_of(r)) * INW;
        norm_mod(v, rinv, C.p->norm2_g + l * DM, mod + 4096, mod + 3072, C.lane, h);
        store_row_bf16(C.H() + (size_t)r * DM, C.lane, h);
        float lgv = 0.f;
#pragma unroll 1
        for (int e = 0; e < 16; ++e) { const float* we = wr + e * 1024 + C.lane * 4; float a = 0.f;
#pragma unroll
            for (int j = 0; j < 4; ++j) { const float4 ww = *(const float4*)(we + j * 256); a += h[4 * j] * ww.x + h[4 * j + 1] * ww.y + h[4 * j + 2] * ww.z + h[4 * j + 3] * ww.w; }
            a = wave_sum(a); lgv = (C.lane == e) ? a : lgv; }
        float lg[16];
#pragma unroll
        for (int e = 0; e < 16; ++e) lg[e] = __shfl(lgv, e);
        float bestg = -1e30f; int e0 = 0, e1 = 1; float s0 = 0.f, s1 = 0.f;
#pragma unroll
        for (int g = 0; g < 4; ++g) {
            float sc[4], gbv[4];
#pragma unroll
            for (int j = 0; j < 4; ++j) { sc[j] = 1.f / (1.f + expf(-lg[4 * g + j])); gbv[j] = sc[j] + rb[4 * g + j]; }
            int i0 = 0; float b0 = gbv[0], u0 = sc[0];
#pragma unroll
            for (int j = 1; j < 4; ++j) if (gbv[j] > b0) { b0 = gbv[j]; i0 = j; u0 = sc[j]; }
            int i1 = -1; float b1 = -1e30f, u1 = 0.f;
#pragma unroll
            for (int j = 0; j < 4; ++j) if (j != i0 && gbv[j] > b1) { b1 = gbv[j]; i1 = j; u1 = sc[j]; }
            const float gs = b0 + b1;
            if (gs > bestg) { bestg = gs; e0 = 4 * g + i0; e1 = 4 * g + i1; s0 = u0; s1 = u1; }
        }
        if (C.lane == 0) {
            const float den = s0 + s1; unsigned* cnt = C.CNT(l);
            const int r0 = (int)atomicAdd(cnt + e0, 1u), r1 = (int)atomicAdd(cnt + e1, 1u);
            C.TOKE()[2 * r] = e0; C.TOKE()[2 * r + 1] = e1; C.TOKW()[2 * r] = s0 / den; C.TOKW()[2 * r + 1] = s1 / den; C.TOKS()[2 * r] = r0; C.TOKS()[2 * r + 1] = r1;
        }
    }
    __syncthreads();
}

__device__ __forceinline__ void p6_permute(const Ctx& C, int l) {
    moe_table(C, l);
    const int nrows = (l == 0) ? TA : TL;
    for (int r = C.gw; r < nrows; r += C.nw) {
        const int e0 = C.TOKE()[2 * r], e1 = C.TOKE()[2 * r + 1];
        const int sl0 = C.TAB()[e0] * 256 + C.TOKS()[2 * r], sl1 = C.TAB()[e1] * 256 + C.TOKS()[2 * r + 1];
        const uint4* src = (const uint4*)(C.H() + (size_t)r * DM);
        const uint4 a = src[C.lane], b = src[64 + C.lane];
        uint4* d0 = (uint4*)(C.XS() + (size_t)sl0 * DM); uint4* d1 = (uint4*)(C.XS() + (size_t)sl1 * DM);
        d0[C.lane] = a; d0[64 + C.lane] = b; d1[C.lane] = a; d1[64 + C.lane] = b;
        if (C.lane == 0) { C.TOKS()[2 * r] = sl0; C.TOKS()[2 * r + 1] = sl1; }
    }
}

__device__ __forceinline__ void p9_combine(const Ctx& C, int l) {
    const int nrows = (l == 0) ? TA : TL; const bf16* YS = C.XS();
    for (int r = C.gw; r < nrows; r += C.nw) {
        float* xr = r < TL ? C.p->out + (size_t)r * DM : C.CTXS() + (size_t)(r - TL) * DM;
        float v[16]; load_row(xr, C.lane, v);
        const int s0 = C.TOKS()[2 * r], s1 = C.TOKS()[2 * r + 1]; const float w0 = C.TOKW()[2 * r], w1 = C.TOKW()[2 * r + 1];
        const float* mod = C.MOD() + (size_t)(l * 9 + modrow_of(r)) * INW;
#pragma unroll
        for (int j = 0; j < 4; ++j) { const int c = j * 256 + C.lane * 4; const uint2 a = *(const uint2*)(YS + (size_t)s0 * DM + c), b = *(const uint2*)(YS + (size_t)s1 * DM + c); const float4 g = *(const float4*)(mod + 5120 + c);
            v[4 * j] += g.x * (w0 * bflo(a.x) + w1 * bflo(b.x)); v[4 * j + 1] += g.y * (w0 * bfhi(a.x) + w1 * bfhi(b.x));
            v[4 * j + 2] += g.z * (w0 * bflo(a.y) + w1 * bflo(b.y)); v[4 * j + 3] += g.w * (w0 * bfhi(a.y) + w1 * bfhi(b.y)); }
        const float rinv = row_rinv(v);
        if (l == 0) {
#pragma unroll
            for (int j = 0; j < 4; ++j) *(float4*)(xr + j * 256 + C.lane * 4) = make_float4(v[4 * j], v[4 * j + 1], v[4 * j + 2], v[4 * j + 3]);
            float h[16]; const float* mod1 = C.MOD() + (size_t)(9 + modrow_of(r)) * INW;
            norm_mod(v, rinv, C.p->norm1_g + DM, mod1 + 1024, mod1, C.lane, h);
            store_row_bf16(C.H() + (size_t)r * DM, C.lane, h);
        } else {
#pragma unroll
            for (int j = 0; j < 4; ++j) { const int c = j * 256 + C.lane * 4; const float4 g = *(const float4*)(C.p->final_g + c);
                *(float4*)(xr + c) = make_float4(v[4 * j] * rinv * g.x, v[4 * j + 1] * rinv * g.y, v[4 * j + 2] * rinv * g.z, v[4 * j + 3] * rinv * g.w); }
        }
    }
}

#ifndef PHMASK
#define PHMASK 0xFFFFu
#endif
#define PHON(i) (((PHMASK) >> (i)) & 1u)
constexpr int NPH = 22;
__global__ void __launch_bounds__(512, 2) mk_fwd(Params p) {
    extern __shared__ __attribute__((aligned(16))) unsigned char lds_raw[];
    LAS unsigned char* ldsl = (LAS unsigned char*)lds_raw;
    if (threadIdx.x < 64) ((LAS unsigned*)(ldsl + LDS_STAGE))[threadIdx.x] = 0u;
    __syncthreads();
    XcdBarrier bar = xcd_barrier_post((unsigned*)(p.ws + WS_CTL) + CW_BAR + p.li * XCD_BAR_WORDS, (volatile LAS unsigned*)(ldsl + LDS_STAGE) + LDSW_BAR);
#define MKCTX() Ctx C; { unsigned long long kp_ = (unsigned long long)__builtin_amdgcn_kernarg_segment_ptr(); asm volatile("" : "+s"(kp_)); C.p.q = (ParamsK)kp_; } \
    C.ws = C.p->ws; C.lds = lds_raw; { int t_ = threadIdx.x, g_ = gridDim.x, b_ = blockIdx.x; asm volatile("" : "+v"(t_), "+s"(g_), "+s"(b_)); C.tid = t_; C.G = g_; C.bid = b_; } \
    C.lane = C.tid & 63; C.wave = __builtin_amdgcn_readfirstlane(C.tid >> 6); C.gw = C.bid * 8 + C.wave; C.nw = C.G * 8;
    const int lo = p.lo, hi = p.hi;
#define IN(k) (lo <= (k) && (k) < hi)
#define SEAM(k) do { if (IN((k) + 1)) xcd_barrier(bar); } while (0)

    if (PHON(0) && IN(0)) { MKCTX(); p0_prologue(C); SEAM(0); }
    if (PHON(1) && IN(1)) { MKCTX(); p1_norm1(C, 0, C.p->x, C.p->ctx); SEAM(1); }
    for (int l = 0; l < 2; ++l) {
        const int pb = 2 + 10 * l;
        const int mrows = (l == 0) ? TA : TL;
        if (PHON(2) && IN(pb + 0)) {
            MKCTX();
            pg8::Gemm g{C.H(), C.WIN_T(), TA, INW, DM}; pg8::StaticOrder S; S.init(TA, INW, C.G, C.bid);
            EpiInProj E{C.GRP(0), C.ROPE()};
            pg8::gemm_phase<EpiInProj, pg8::StaticOrder, true, true>(ldsl, g, S, E);
            SEAM(pb + 0);
        }
        if (PHON(3) && IN(pb + 1)) {
            MKCTX();
            p3_scan_naive(C, l);
            p3_attn(C, l);
            SEAM(pb + 1);
        }
        if (PHON(4) && IN(pb + 2)) { MKCTX(); p3c_headnorm(C, l); SEAM(pb + 2); }
        if (PHON(5) && IN(pb + 3)) {
            MKCTX();
            pg8::StaticOrder S; S.init(mrows, DM, C.G, C.bid);
            { pg8::Gemm g{C.GRP(0), C.WNA_T(), mrows, DM, 512}; EpiMerge<0> E{C.MB(), C.GRP(8)}; pg8::gemm_phase<EpiMerge<0>, pg8::StaticOrder, true, true>(ldsl, g, S, E); }
            __syncthreads();
            { pg8::Gemm g{C.H(), C.WHG_T(), mrows, DM, 512}; EpiMerge<1> E{C.MB(), C.GRP(10)}; pg8::gemm_phase<EpiMerge<1>, pg8::StaticOrder, true, true>(ldsl, g, S, E); }
            SEAM(pb + 3);
        }
        if (PHON(6) && IN(pb + 4)) {
            MKCTX();
            pg8::StaticOrder S; S.init(mrows, DM, C.G, C.bid);
            pg8::Gemm g{C.MB(), C.WOUT_T(), mrows, DM, DM};
            EpiOut E{l == 0 ? C.p->x : (const float*)C.p->out, C.p->out, C.p->ctx, C.CTXS(), C.MOD() + (size_t)l * 9 * INW};
            pg8::gemm_phase<EpiOut, pg8::StaticOrder, true, true>(ldsl, g, S, E);
            conv_experts(C, l);
            SEAM(pb + 4);
        }
        if (PHON(7) && IN(pb + 5)) { MKCTX(); p5_norm2_router(C, l); SEAM(pb + 5); }
        if (PHON(8) && IN(pb + 6)) { MKCTX(); p6_permute(C, l); SEAM(pb + 6); }
        if (PHON(9) && IN(pb + 7)) {
            MKCTX();
            moe_table(C, l);
            MoeOrder S{C.TAB(), C.G, C.bid};
            pg8::Gemm g{C.XS(), C.WEGU(), SLOT_ROWS, 16384, DM}; EpiGateUp E{C.ACT()};
            pg8::gemm_phase<EpiGateUp, MoeOrder, true, true>(ldsl, g, S, E);
            SEAM(pb + 7);
        }
        if (PHON(10) && IN(pb + 8)) {
            MKCTX();
            moe_table(C, l);
            MoeOrder S{C.TAB(), C.G, C.bid};
            pg8::Gemm g{C.ACT(), C.WED(), SLOT_ROWS, 16384, 512}; EpiDown E{C.XS()};
            pg8::gemm_phase<EpiDown, MoeOrder, true, true>(ldsl, g, S, E);
            SEAM(pb + 8);
        }
        if (PHON(11) && IN(pb + 9)) { MKCTX(); p9_combine(C, l); if (l == 0) conv_mixer(C, 1); SEAM(pb + 9); }
    }
#undef IN
#undef SEAM
}

#ifndef MK_SPLIT
#define MK_SPLIT 0
#endif
extern "C" void kernel_launch(void* const* d_in, const int* in_sizes, int n_in, void* d_out, int out_size, void* d_ws, size_t ws_size, hipStream_t stream) {
    static int grid = 0;
    if (grid == 0) {
        if (n_in != 22 || ws_size < WS_END) { fprintf(stderr, "kernel_launch: unexpected n_in %d / ws_size %zu (need %zu)\n", n_in, ws_size, (size_t)WS_END); grid = -1; return; }
        int dev = 0, cus = 0, per_cu = 0;
        if (hipGetDevice(&dev) != hipSuccess || hipDeviceGetAttribute(&cus, hipDeviceAttributeMultiprocessorCount, dev) != hipSuccess) { grid = -1; return; }
        if (hipFuncSetAttribute((const void*)mk_fwd, hipFuncAttributeMaxDynamicSharedMemorySize, LDS_BYTES) != hipSuccess) { fprintf(stderr, "kernel_launch: hipFuncSetAttribute failed\n"); grid = -1; return; }
        if (hipOccupancyMaxActiveBlocksPerMultiprocessor(&per_cu, (const void*)mk_fwd, 512, LDS_BYTES) != hipSuccess || per_cu < 1) fprintf(stderr, "kernel_launch: occupancy query says %d\n", per_cu);
        (void)hipGetLastError();
        grid = cus;
    }
    if (grid < 0) return;
    if (hipMemsetAsync((char*)d_ws + WS_CTL, 0, CTL_BYTES, stream) != hipSuccess) return;
    Params p{};
    const float** pp = (const float**)&p;
    for (int i = 0; i < 22; ++i) pp[i] = (const float*)d_in[i];
    p.out = (float*)d_out; p.ws = (unsigned char*)d_ws; p.pad = 0;
#if MK_SPLIT
    for (int k = 0; k < NPH; ++k) { p.lo = k; p.hi = k + 1; p.li = k; hipLaunchKernelGGL(mk_fwd, dim3(grid), dim3(512), LDS_BYTES, stream, p); }
#else
    p.lo = 0; p.hi = NPH; p.li = 0;
    hipLaunchKernelGGL(mk_fwd, dim3(grid), dim3(512), LDS_BYTES, stream, p);
#endif
}
```

```cpp
#include <hip/hip_runtime.h>
#include <cstdio>
#include <cstdint>
namespace pg8 {
#define PG8_LAS __attribute__((address_space(3)))
typedef unsigned short bf16_t;
typedef short bf16x8 __attribute__((ext_vector_type(8)));
typedef float f32x4 __attribute__((ext_vector_type(4)));
typedef unsigned u32x4 __attribute__((ext_vector_type(4)));
constexpr int BM = 256, BK = 64, HALF = 128, HTB = HALF * BK * 2  , STAGE_BYTES = 8 * HTB, NXCD = 8, WGM = 8;

__host__ __device__ __forceinline__ int lds_byte(int r, int c) { const int st = (r >> 4) * 2 + (c >> 5), rr = r & 15, cc = c & 31, ob = rr * 64 + cc * 2; return st * 1024 + (ob ^ (((ob >> 9) & 1) << 5)); }
__host__ __device__ __forceinline__ void stage_rc(int b, int& R, int& C) { const int st = b / 1024, sb = b % 1024, swz = sb ^ (((sb >> 9) & 1) << 5); R = (st >> 1) * 16 + swz / 64; C = (st & 1) * 32 + (swz % 64) / 2; }
__host__ __device__ __forceinline__ int perm32(int rho) { const int n = rho >> 4, i = rho & 15; return 8 * (i >> 2) + 4 * n + (i & 3); }

struct Unit { int pm, pn; };
struct Gemm { const bf16_t* A; const bf16_t* Bt; int M, N, K; };

struct StaticOrder {
    int nM, nN, nwg, G, c;
    __host__ __device__ void init(int M, int N, int G_, int c_) { nM = M / BM; nN = N / BM; nwg = nM * nN; G = G_; c = c_; }
    __host__ __device__ bool next(int i, Unit& u) const {
        const long L = (long)i * G + c; if (L >= nwg) return false;
        int wgid = (int)L; { const int q = nwg / NXCD, r = nwg % NXCD, xcd = wgid % NXCD, off = wgid / NXCD; wgid = (xcd < r ? xcd * (q + 1) : r * (q + 1) + (xcd - r) * q) + off; }
        const int nig = WGM * nN, gid = wgid / nig, fm = gid * WGM, gsz = (nM - fm) < WGM ? (nM - fm) : WGM;
        u.pm = fm + ((wgid % nig) % gsz); u.pn = (wgid % nig) / gsz; return true;
    }
    __device__ __forceinline__ void a_ready(const Unit&) const {}
    __device__ __forceinline__ void done(const Unit&) const {}
};

__device__ __forceinline__ unsigned cvt_pk_bf16(float lo, float hi) { unsigned r; asm volatile("v_cvt_pk_bf16_f32 %0, %1, %2" : "=v"(r) : "v"(lo), "v"(hi)); return r; }
template <class Epi, class Sched, bool ALIGN_EPI = false, bool SP2 = false>
__device__ __forceinline__ void gemm_phase(PG8_LAS unsigned char* lds, const Gemm g, const Sched& S, const Epi& E) {
    int tid_ = threadIdx.x; asm volatile("" : "+v"(tid_));
    const int tid = tid_, wid = __builtin_amdgcn_readfirstlane(tid >> 6), lane = tid & 63, wr = wid >> 2, wc = wid & 3, fr = lane & 15, fq = lane >> 4;
    const int K = g.K, nt = K / BK;
    unsigned voffA[2], voffB[2];
#pragma unroll
    for (int i = 0; i < 2; ++i) { int R, C; stage_rc(tid * 16 + i * 8192, R, C); const int Rb = Epi::PERM ? ((R & ~31) + perm32(R & 31)) : R;
        voffA[i] = (unsigned)(R * K + C) * 2u; voffB[i] = (unsigned)(Rb * K + C) * 2u; }
    const size_t kstep = (size_t)(BK * 2);
    const size_t hstep = (size_t)HALF * K * 2;
    const size_t tstep = 2 * hstep;
    const unsigned ldsw = (unsigned)wid * 1024u;
    const int aoff = lds_byte(wr * 64 + fr, fq * 8), boff = lds_byte(wc * 32 + fr, fq * 8);
#define PG8_SA(b, h) (((b) * 2 + (h)) * HTB)
#define PG8_SB(b, h) ((4 + (b) * 2 + (h)) * HTB)
#define PG8_STAGE(bufoff, gbase, voff) do { _Pragma("unroll") for (int _i = 0; _i < 2; ++_i) \
        __builtin_amdgcn_global_load_lds((const unsigned*)((const char*)(gbase) + (voff)[_i]), (PG8_LAS unsigned*)(lds + (bufoff) + ldsw + _i * 8192), 16, 0, 0); } while (0)
#define PG8_LDA(dst, b, h) do { _Pragma("unroll") for (int m = 0; m < 4; ++m) _Pragma("unroll") for (int k = 0; k < 2; ++k) dst[m][k] = *(const PG8_LAS bf16x8*)(lds + PG8_SA(b, h) + aoff + m * 2048 + k * 1024); } while (0)
#define PG8_LDB(dst, b, h) do { _Pragma("unroll") for (int n = 0; n < 2; ++n) _Pragma("unroll") for (int k = 0; k < 2; ++k) dst[n][k] = *(const PG8_LAS bf16x8*)(lds + PG8_SB(b, h) + boff + n * 2048 + k * 1024); } while (0)
#define PG8_MMA(ai, bj, At, Bt) do { __builtin_amdgcn_s_setprio(1); _Pragma("unroll") for (int m = 0; m < 4; ++m) _Pragma("unroll") for (int n = 0; n < 2; ++n) _Pragma("unroll") for (int k = 0; k < 2; ++k) \
        acc[ai][bj][m][n] = __builtin_amdgcn_mfma_f32_16x16x32_bf16(Bt[n][k], At[m][k], acc[ai][bj][m][n], 0, 0, 0); __builtin_amdgcn_s_setprio(0); } while (0)
#define PG8_WAIT_V(n) asm volatile("s_waitcnt vmcnt(" #n ")" ::: "memory")
#define PG8_WAIT_L(n) asm volatile("s_waitcnt lgkmcnt(" #n ")" ::: "memory")
#define PG8_BAR __builtin_amdgcn_s_barrier()
#define PG8_SCHED __builtin_amdgcn_sched_barrier(0)
    Unit cur, nxt; int ui = 0;
    if (!S.next(0, cur)) return;
    f32x4 acc[2][2][4][2];
#pragma unroll
    for (int a = 0; a < 2; ++a)
#pragma unroll
        for (int b = 0; b < 2; ++b)
#pragma unroll
            for (int m = 0; m < 4; ++m)
#pragma unroll
                for (int n = 0; n < 2; ++n) acc[a][b][m][n] = (f32x4){0.f, 0.f, 0.f, 0.f};
    bf16x8 At[4][2], B0[2][2], B1[2][2];
    const char* cA = (const char*)g.A + (size_t)cur.pm * tstep; const char* cB = (const char*)g.Bt + (size_t)cur.pn * tstep;
    S.a_ready(cur);
    if constexpr (SP2) {
        PG8_STAGE(PG8_SB(0, 0), cB, voffB); PG8_STAGE(PG8_SB(0, 1), cB + hstep, voffB); PG8_STAGE(PG8_SA(0, 0), cA, voffA); PG8_STAGE(PG8_SA(0, 1), cA + hstep, voffA);
        if (wr == 1) PG8_BAR;
        PG8_WAIT_V(2); PG8_BAR;
        PG8_STAGE(PG8_SB(1, 0), cB + kstep, voffB); PG8_STAGE(PG8_SA(1, 0), cA + kstep, voffA); PG8_STAGE(PG8_SB(1, 1), cB + hstep + kstep, voffB);
        PG8_WAIT_V(6); PG8_BAR;
    } else {
        PG8_STAGE(PG8_SB(0, 0), cB, voffB); PG8_STAGE(PG8_SA(0, 0), cA, voffA); PG8_STAGE(PG8_SB(0, 1), cB + hstep, voffB); PG8_STAGE(PG8_SA(0, 1), cA + hstep, voffA);
        if (wr == 1) PG8_BAR;
        PG8_WAIT_V(4); PG8_BAR;
        PG8_STAGE(PG8_SB(1, 0), cB + kstep, voffB); PG8_STAGE(PG8_SA(1, 0), cA + kstep, voffA); PG8_STAGE(PG8_SB(1, 1), cB + hstep + kstep, voffB);
        PG8_WAIT_V(6); PG8_BAR;
    }
    for (;;) {
        const bool has_next = S.next(ui + 1, nxt);
        const char* nA = has_next ? (const char*)g.A + (size_t)nxt.pm * tstep : cA; const char* nB = has_next ? (const char*)g.Bt + (size_t)nxt.pn * tstep : cB;
        for (int t = 0; t < nt; t += 2) {
            const bool last = (t == nt - 2);
            const char* a1 = cA + (size_t)(t + 1) * kstep;
            const char* a2 = last ? nA : cA + (size_t)(t + 2) * kstep; const char* b2 = last ? nB : cB + (size_t)(t + 2) * kstep;
            const char* a3 = a2 + kstep; const char* b3 = b2 + kstep;
            if (last && has_next) S.a_ready(nxt);
            if constexpr (SP2) {
            PG8_LDB(B0, 0, 0); PG8_LDB(B1, 0, 1); PG8_SCHED; PG8_LDA(At, 0, 0); PG8_STAGE(PG8_SA(1, 1), a1 + hstep, voffA);
            PG8_WAIT_V(8); PG8_WAIT_L(0); PG8_BAR; PG8_MMA(0, 0, At, B0); PG8_MMA(0, 1, At, B1); PG8_BAR; PG8_SCHED;
            PG8_LDA(At, 0, 1); PG8_STAGE(PG8_SB(0, 0), b2, voffB); PG8_STAGE(PG8_SB(0, 1), b2 + hstep, voffB); PG8_STAGE(PG8_SA(0, 0), a2, voffA);
            PG8_WAIT_V(8); PG8_WAIT_L(0); PG8_BAR; PG8_MMA(1, 0, At, B0); PG8_MMA(1, 1, At, B1); PG8_BAR; PG8_SCHED;
            PG8_LDB(B0, 1, 0); PG8_LDB(B1, 1, 1); PG8_SCHED; PG8_LDA(At, 1, 0); PG8_STAGE(PG8_SA(0, 1), a2 + hstep, voffA);
            PG8_WAIT_V(8); PG8_WAIT_L(0); PG8_BAR; PG8_MMA(0, 0, At, B0); PG8_MMA(0, 1, At, B1); PG8_BAR; PG8_SCHED;
            PG8_LDA(At, 1, 1); PG8_STAGE(PG8_SB(1, 0), b3, voffB); PG8_STAGE(PG8_SB(1, 1), b3 + hstep, voffB); PG8_STAGE(PG8_SA(1, 0), a3, voffA);
            PG8_WAIT_V(8); PG8_WAIT_L(0); PG8_BAR; PG8_MMA(1, 0, At, B0); PG8_MMA(1, 1, At, B1); PG8_BAR; PG8_SCHED;
            } else {
            PG8_LDB(B0, 0, 0); PG8_SCHED; PG8_LDA(At, 0, 0); PG8_STAGE(PG8_SA(1, 1), a1 + hstep, voffA);
            PG8_WAIT_L(8); PG8_BAR; PG8_WAIT_L(0); PG8_MMA(0, 0, At, B0); PG8_BAR; PG8_SCHED;
            PG8_LDB(B1, 0, 1); PG8_STAGE(PG8_SB(0, 0), b2, voffB);
            PG8_BAR; PG8_WAIT_L(0); PG8_MMA(0, 1, At, B1); PG8_BAR;
            PG8_LDA(At, 0, 1); PG8_STAGE(PG8_SA(0, 0), a2, voffA);
            PG8_BAR; PG8_WAIT_L(0); PG8_MMA(1, 0, At, B0); PG8_BAR; PG8_SCHED;
            PG8_STAGE(PG8_SB(0, 1), b2 + hstep, voffB);
            PG8_WAIT_V(6); PG8_BAR; PG8_MMA(1, 1, At, B1); PG8_BAR;
            PG8_LDB(B0, 1, 0); PG8_SCHED; PG8_LDA(At, 1, 0); PG8_STAGE(PG8_SA(0, 1), a2 + hstep, voffA);
            PG8_WAIT_L(8); PG8_BAR; PG8_WAIT_L(0); PG8_MMA(0, 0, At, B0); PG8_BAR; PG8_SCHED;
            PG8_LDB(B1, 1, 1); PG8_STAGE(PG8_SB(1, 0), b3, voffB);
            PG8_BAR; PG8_WAIT_L(0); PG8_MMA(0, 1, At, B1); PG8_BAR;
            PG8_LDA(At, 1, 1); PG8_STAGE(PG8_SA(1, 0), a3, voffA);
            PG8_BAR; PG8_WAIT_L(0); PG8_MMA(1, 0, At, B0); PG8_BAR; PG8_SCHED;
            PG8_STAGE(PG8_SB(1, 1), b3 + hstep, voffB);
            PG8_WAIT_V(6); PG8_BAR; PG8_MMA(1, 1, At, B1); PG8_BAR;
            }
        }
        if constexpr (ALIGN_EPI) { if (wr == 0) PG8_BAR; }
        if constexpr (!Epi::AFTER_DRAIN) { E(acc, cur, wr, wc, fr, fq); S.done(cur); }
        if (!has_next) break;
#pragma unroll
        for (int a = 0; a < 2; ++a)
#pragma unroll
            for (int b = 0; b < 2; ++b)
#pragma unroll
                for (int m = 0; m < 4; ++m)
#pragma unroll
                    for (int n = 0; n < 2; ++n) acc[a][b][m][n] = (f32x4){0.f, 0.f, 0.f, 0.f};
        cur = nxt; cA = nA; cB = nB; ++ui;
        if constexpr (ALIGN_EPI) { if (wr == 1) PG8_BAR; }
    }
    PG8_WAIT_V(0);
    if constexpr (!ALIGN_EPI) { if (wr == 0) PG8_BAR; }
    PG8_BAR;
    if constexpr (Epi::AFTER_DRAIN) { E.fused(acc, cur, wr, wc, fr, fq, lds, wid, lane); S.done(cur); }
#undef PG8_SA
#undef PG8_SB
#undef PG8_STAGE
#undef PG8_LDA
#undef PG8_LDB
#undef PG8_MMA
#undef PG8_WAIT_V
#undef PG8_WAIT_L
#undef PG8_BAR
#undef PG8_SCHED
}
}
#define XB_TMO      128
#define XB_XCNT(j)  (256  + 64 * (j))
#define XB_XSUB(j)  (1280 + 64 * (j))
#define XB_XGEN(j)  (2304 + 64 * (j))
#define XB_TOP      3328
#define XB_TOPGEN   3392
#define XCD_BAR_WORDS 3456
#define XB_SPIN_CAP (1u << 18)
#define LAS __attribute__((address_space(3)))

__device__ __forceinline__ unsigned xb_ld(unsigned* p)              { return __hip_atomic_load(p, __ATOMIC_RELAXED, __HIP_MEMORY_SCOPE_AGENT); }
__device__ __forceinline__ unsigned xb_add(unsigned* p, unsigned v) { return __hip_atomic_fetch_add(p, v, __ATOMIC_RELAXED, __HIP_MEMORY_SCOPE_AGENT); }
__device__ __forceinline__ unsigned xb_xcc_id() { return (unsigned)__builtin_amdgcn_s_getreg((3 << 11) | 20) & 0xFu; }
#define XB_SPIN(cond, bar) do { unsigned _sp = 0; while (cond) { __builtin_amdgcn_s_sleep(1); \
    if ((++_sp & 255u) == 0u) { if (xb_ld(&(bar)[XB_TMO])) break; if (_sp > XB_SPIN_CAP) { atomicAdd(&(bar)[XB_TMO], 1u); break; } } } } while (0)

struct XcdBarrier {
    unsigned* bar; unsigned x;
    volatile LAS unsigned* st;
};

__device__ __forceinline__ XcdBarrier xcd_barrier_post(unsigned* bar, volatile LAS unsigned* st) {
    XcdBarrier b; b.bar = bar; b.x = xb_xcc_id(); b.st = st;
    if (threadIdx.x == 0) (void)xb_add(&bar[XB_XCNT(b.x)], 1u);
    return b;
}
__device__ __forceinline__ void xcd_barrier_complete(unsigned* bar, unsigned x, unsigned& nloc, unsigned& nx) {
    const unsigned G = gridDim.x * gridDim.y * gridDim.z;
    unsigned sum, cnt, mine, sp = 0u;
    for (;;) {
        sum = 0u; cnt = 0u; mine = 0u;
#pragma unroll
        for (unsigned j = 0; j < 16; ++j) { const unsigned c = xb_ld(&bar[XB_XCNT(j)]); sum += c; cnt += (c > 0u) ? 1u : 0u; mine = (j == x) ? c : mine; }
        if (sum == G) break;
        __builtin_amdgcn_s_sleep(1);
        if ((++sp & 255u) == 0u) { if (xb_ld(&bar[XB_TMO])) break; if (sp > XB_SPIN_CAP) { atomicAdd(&bar[XB_TMO], 1u); break; } }
    }
    nloc = mine > 0u ? mine : 1u; nx = cnt > 0u ? cnt : 1u;
}

__device__ __forceinline__ void xcd_barrier(const XcdBarrier& b) {
    asm volatile("s_waitcnt vmcnt(0)" ::: "memory");
    __syncthreads();
    if (threadIdx.x == 0) {
        unsigned* bar = b.bar;
        __builtin_amdgcn_s_waitcnt(0);
        unsigned nloc = b.st[0], nx = b.st[1];
        if (nloc == 0u) { xcd_barrier_complete(bar, b.x, nloc, nx); b.st[0] = nloc; b.st[1] = nx; }
        const unsigned old = xb_add(&bar[XB_XSUB(b.x)], 1u);
        const unsigned gen = old / nloc;
        if (old + 1u == (gen + 1u) * nloc) {
            __builtin_amdgcn_fence(__ATOMIC_RELEASE, "agent");
            asm volatile("s_waitcnt vmcnt(0)" ::: "memory");
            const unsigned og = xb_add(&bar[XB_TOP], 1u);
            const unsigned tg = og / nx;
            if (og + 1u == (tg + 1u) * nx) xb_add(&bar[XB_TOPGEN], 1u);
            else XB_SPIN(xb_ld(&bar[XB_TOPGEN]) == tg, bar);
            __builtin_amdgcn_fence(__ATOMIC_ACQUIRE, "agent");
            xb_add(&bar[XB_XGEN(b.x)], 1u);
            asm volatile("s_waitcnt vmcnt(0)" ::: "memory");
        } else {
            XB_SPIN(xb_ld(&bar[XB_XGEN(b.x)]) == gen, bar);
            __builtin_amdgcn_fence(__ATOMIC_ACQUIRE, "agent");
            asm volatile("s_waitcnt vmcnt(0)" ::: "memory");
        }
    }
    __syncthreads();
}


typedef unsigned short bf16;
typedef pg8::f32x4 f32x4;
typedef pg8::u32x4 u32x4;
constexpr int NB = 8, SEQ = 4096, DM = 1024, NCTX = 256;
constexpr int TL = NB * SEQ, TC = NB * NCTX, TA = TL + TC;
constexpr int INW = 6144, GW = 512, NGRP = 12;
constexpr size_t GSTRIDE = (size_t)TA * GW;
constexpr float EPS = 1e-6f;
constexpr int SLOT_ROWS = 73728;

constexpr size_t MiB = (size_t)1 << 20;
constexpr size_t WS_CTL = 0, CTL_BYTES = 1 * MiB;
constexpr size_t WS_MOD = 1 * MiB;
constexpr size_t WS_LB = 1 * MiB + 512 * 1024;
constexpr size_t WS_ROPE = 2 * MiB;
constexpr size_t WS_TOK = 3 * MiB;
constexpr size_t WS_CTXS = 4 * MiB;
constexpr size_t WS_WB = 12 * MiB;
constexpr size_t WS_H = 28 * MiB;
constexpr size_t WS_P = 96 * MiB;
constexpr size_t P_M = 34 * MiB, P_WEGU = 102 * MiB, P_WED = 134 * MiB, P_XS = 150 * MiB, P_ACT = 294 * MiB;
constexpr size_t WS_END = 504 * MiB;
constexpr int CW_BAR = 4096, CW_CNT = 131072;

constexpr int LDS_STAGE = 131072, LDS_BYTES = 147456;
constexpr int LDSW_BAR = 0, LDSW_TAB = 16;

struct Params {
    const float* x; const float* c; const float* ctx; const float* c_ctx; const float* w_ada; const float* b_ada; const float* norm1_g; const float* w_in;
    const float* rel_bias; const float* lowf; const float* lowb; const float* hg_norm_g; const float* w_na_o; const float* w_hg_o; const float* w_out; const float* norm2_g;
    const float* w_router; const float* router_bias; const float* w_gate; const float* w_up; const float* w_down; const float* final_g;
    float* out; unsigned char* ws; int lo, hi, li, pad;
};

__device__ __forceinline__ float bf2f(unsigned b) { return __uint_as_float(b << 16); }
__device__ __forceinline__ float bflo(unsigned w) { return __uint_as_float(w << 16); }
__device__ __forceinline__ float bfhi(unsigned w) { return __uint_as_float(w & 0xffff0000u); }
__device__ __forceinline__ unsigned f2bf(float f) { unsigned u = __float_as_uint(f); u += 0x7FFFu + ((u >> 16) & 1u); return u >> 16; }
__device__ __forceinline__ unsigned pk2(float lo, float hi) { return f2bf(lo) | (f2bf(hi) << 16); }
__device__ __forceinline__ float sigm(float x) { return 1.f / (1.f + __expf(-x)); }
__device__ __forceinline__ float silu(float x) { return x / (1.f + __expf(-x)); }
__device__ __forceinline__ float wave_sum(float v) {
#pragma unroll
    for (int o = 32; o >= 1; o >>= 1) v += __shfl_xor(v, o);
    return v; }
__device__ __forceinline__ float wave_max(float v) {
#pragma unroll
    for (int o = 32; o >= 1; o >>= 1) v = fmaxf(v, __shfl_xor(v, o));
    return v; }
__device__ __forceinline__ void unpack8(const uint4 w, float (&f)[8]) {
    f[0] = bflo(w.x); f[1] = bfhi(w.x); f[2] = bflo(w.y); f[3] = bfhi(w.y); f[4] = bflo(w.z); f[5] = bfhi(w.z); f[6] = bflo(w.w); f[7] = bfhi(w.w); }

typedef const __attribute__((address_space(4))) Params* ParamsK;
struct PView { ParamsK q; __device__ __forceinline__ const __attribute__((address_space(4))) Params* operator->() const { return q; } };
struct Ctx {
    PView p; unsigned char* ws; unsigned char* lds; int tid, lane, wave, G, bid, gw, nw;
    __device__ __forceinline__ float* MOD() const { return (float*)(ws + WS_MOD); }
    __device__ __forceinline__ float* LB() const { return (float*)(ws + WS_LB); }
    __device__ __forceinline__ float2* ROPE() const { return (float2*)(ws + WS_ROPE); }
    __device__ __forceinline__ int* TOKE() const { return (int*)(ws + WS_TOK); }
    __device__ __forceinline__ float* TOKW() const { return (float*)(ws + WS_TOK) + 2 * TA; }
    __device__ __forceinline__ int* TOKS() const { return (int*)(ws + WS_TOK) + 4 * TA; }
    __device__ __forceinline__ float* CTXS() const { return (float*)(ws + WS_CTXS); }
    __device__ __forceinline__ bf16* WIN_T() const { return (bf16*)(ws + WS_WB); }
    __device__ __forceinline__ bf16* WNA_T() const { return (bf16*)(ws + WS_WB + 12 * MiB); }
    __device__ __forceinline__ bf16* WHG_T() const { return (bf16*)(ws + WS_WB + 13 * MiB); }
    __device__ __forceinline__ bf16* WOUT_T() const { return (bf16*)(ws + WS_WB + 14 * MiB); }
    __device__ __forceinline__ bf16* H() const { return (bf16*)(ws + WS_H); }
    __device__ __forceinline__ bf16* GRP(int g) const { return (bf16*)(ws + WS_P) + (size_t)g * GSTRIDE; }
    __device__ __forceinline__ bf16* MB() const { return (bf16*)(ws + WS_P + P_M); }
    __device__ __forceinline__ bf16* WEGU() const { return (bf16*)(ws + WS_P + P_WEGU); }
    __device__ __forceinline__ bf16* WED() const { return (bf16*)(ws + WS_P + P_WED); }
    __device__ __forceinline__ bf16* XS() const { return (bf16*)(ws + WS_P + P_XS); }
    __device__ __forceinline__ bf16* ACT() const { return (bf16*)(ws + WS_P + P_ACT); }
    __device__ __forceinline__ unsigned* CTL() const { return (unsigned*)(ws + WS_CTL); }
    __device__ __forceinline__ unsigned* CNT(int l) const { return (unsigned*)(ws + WS_CTL) + CW_CNT + l * 64; }
    __device__ __forceinline__ int* TAB() const { return (int*)(lds + LDS_STAGE) + LDSW_TAB; }
};

template <class RowMap>
__device__ __forceinline__ void tconv_tile(const float* __restrict__ src, int ldsrc, int k0, int n0, bf16* __restrict__ dst, int ldd, int lane, RowMap rm) {
    float v[64];
    const float* s = src + (size_t)k0 * ldsrc + n0 + lane;
#pragma unroll
    for (int k = 0; k < 64; ++k) { v[k] = *s; s += ldsrc; asm volatile("" : "+v"(s)); }
    bf16* d = dst + (size_t)rm(n0 + lane) * ldd + k0;
#pragma unroll
    for (int j = 0; j < 8; ++j) { uint4 w; w.x = pk2(v[8 * j], v[8 * j + 1]); w.y = pk2(v[8 * j + 2], v[8 * j + 3]); w.z = pk2(v[8 * j + 4], v[8 * j + 5]); w.w = pk2(v[8 * j + 6], v[8 * j + 7]);
        *(uint4*)(d + 8 * j) = w; }
}
struct RmId { __device__ __forceinline__ int operator()(int n) const { return n; } };
struct RmGU { int base; __device__ __forceinline__ int operator()(int n) const { return base + (n >> 7) * 256 + (n & 127); } };

__device__ __forceinline__ void conv_mixer(const Ctx& C, int l) {
    for (int id = C.gw; id < 2048; id += C.nw) {
        if (id < 1536) { const int kt = id & 15, nt = id >> 4; tconv_tile(C.p->w_in + (size_t)l * DM * INW, INW, kt * 64, nt * 64, C.WIN_T(), DM, C.lane, RmId()); }
        else if (id < 1664) { const int j = id - 1536, kt = j & 7, nt = j >> 3; tconv_tile(C.p->w_na_o + (size_t)l * 512 * DM, DM, kt * 64, nt * 64, C.WNA_T(), 512, C.lane, RmId()); }
        else if (id < 1792) { const int j = id - 1664, kt = j & 7, nt = j >> 3; tconv_tile(C.p->w_hg_o + (size_t)l * 512 * DM, DM, kt * 64, nt * 64, C.WHG_T(), 512, C.lane, RmId()); }
        else { const int j = id - 1792, kt = j & 15, nt = j >> 4; tconv_tile(C.p->w_out + (size_t)l * DM * DM, DM, kt * 64, nt * 64, C.WOUT_T(), DM, C.lane, RmId()); }
    }
}
__device__ __forceinline__ void conv_experts(const Ctx& C, int l) {
    for (int id = C.gw; id < 6144; id += C.nw) {
        const int e = id / 384, j = id % 384;
        if (j < 128) { const int kt = j & 15, nt = j >> 4; tconv_tile(C.p->w_gate + ((size_t)l * 16 + e) * DM * 512, 512, kt * 64, nt * 64, C.WEGU(), DM, C.lane, RmGU{e * 1024}); }
        else if (j < 256) { const int jj = j - 128, kt = jj & 15, nt = jj >> 4; tconv_tile(C.p->w_up + ((size_t)l * 16 + e) * DM * 512, 512, kt * 64, nt * 64, C.WEGU(), DM, C.lane, RmGU{e * 1024 + 128}); }
        else { const int jj = j - 256, kt = jj & 7, nt = jj >> 3; tconv_tile(C.p->w_down + ((size_t)l * 16 + e) * 512 * DM, DM, kt * 64, nt * 64, C.WED() + (size_t)e * 1024 * 512, 512, C.lane, RmId()); }
    }
}

__device__ __forceinline__ void p0_prologue(const Ctx& C) {
    for (int u = C.bid; u < 24; u += C.G) {
        float* sl = (float*)C.lds;
        for (int i = C.tid; i < 9 * 1024; i += 512) { const int r = i >> 10, k = i & 1023; const float v = (r < 8) ? C.p->c[r * 1024 + k] : C.p->c_ctx[k]; sl[i] = v / (1.f + expf(-v)); }
        __syncthreads();
        const int l = u / 12, n = (u % 12) * 512 + C.tid;
        const float* w = C.p->w_ada + (size_t)l * DM * INW + n;
        float acc[9];
#pragma unroll
        for (int r = 0; r < 9; ++r) acc[r] = 0.f;
#pragma unroll 8
        for (int k = 0; k < 1024; ++k) { const float wv = w[(size_t)k * INW];
#pragma unroll
            for (int r = 0; r < 9; ++r) acc[r] += sl[r * 1024 + k] * wv; }
        const float bb = C.p->b_ada[l * INW + n];
#pragma unroll
        for (int r = 0; r < 9; ++r) C.MOD()[(size_t)(l * 9 + r) * INW + n] = acc[r] + bb;
        __syncthreads();
    }
    const int gt = C.bid * 512 + C.tid, nthr = C.G * 512;
    for (int i = gt; i < 4096 * 32; i += nthr) { const int t = i >> 5, pr = i & 31; const float pos = (float)((pr < 16) ? (t >> 6) : (t & 63)); const int j = pr & 15;
        const float inv = powf(10000.f, -(float)(2 * j) / 32.f); const float ang = pos * inv; C.ROPE()[i] = make_float2(cosf(ang), sinf(ang)); }
    for (int i = gt; i < 1024; i += nthr) { const int dir = i >> 9, ch = i & 511; const float* raw = dir ? C.p->lowb : C.p->lowf; const float r0 = raw[ch], r1 = raw[512 + ch];
        const float p1 = 1.f / (1.f + expf(r0 - r1)); C.LB()[(0 * 2 + dir) * 512 + ch] = 0.f; C.LB()[(1 * 2 + dir) * 512 + ch] = p1; }
    conv_mixer(C, 0);
}

__device__ __forceinline__ void load_row(const float* xr, int lane, float (&v)[16]) {
#pragma unroll
    for (int j = 0; j < 4; ++j) { const float4 t = *(const float4*)(xr + j * 256 + lane * 4); v[4 * j] = t.x; v[4 * j + 1] = t.y; v[4 * j + 2] = t.z; v[4 * j + 3] = t.w; }
}
__device__ __forceinline__ float row_rinv(const float (&v)[16]) {
    float ss = 0.f;
#pragma unroll
    for (int i = 0; i < 16; ++i) ss += v[i] * v[i];
    ss = wave_sum(ss);
    return rsqrtf(ss * (1.f / 1024.f) + EPS);
}
__device__ __forceinline__ void norm_mod(const float (&v)[16], float rinv, const float* gam, const float* sc, const float* sh, int lane, float (&h)[16]) {
#pragma unroll
    for (int j = 0; j < 4; ++j) { const int c = j * 256 + lane * 4; const float4 g = *(const float4*)(gam + c), s = *(const float4*)(sc + c), b = *(const float4*)(sh + c);
        h[4 * j] = v[4 * j] * rinv * g.x * (1.f + s.x) + b.x; h[4 * j + 1] = v[4 * j + 1] * rinv * g.y * (1.f + s.y) + b.y;
        h[4 * j + 2] = v[4 * j + 2] * rinv * g.z * (1.f + s.z) + b.z; h[4 * j + 3] = v[4 * j + 3] * rinv * g.w * (1.f + s.w) + b.w; }
}
__device__ __forceinline__ void store_row_bf16(bf16* hr, int lane, const float (&h)[16]) {
#pragma unroll
    for (int j = 0; j < 4; ++j) { uint2 w; w.x = pk2(h[4 * j], h[4 * j + 1]); w.y = pk2(h[4 * j + 2], h[4 * j + 3]); *(uint2*)(hr + j * 256 + lane * 4) = w; }
}
__device__ __forceinline__ int modrow_of(int r) { return r < TL ? (r >> 12) : 8; }

__device__ __forceinline__ void p1_norm1(const Ctx& C, int l, const float* xl, const float* xc) {
    for (int r = C.gw; r < TA; r += C.nw) {
        const float* xr = r < TL ? xl + (size_t)r * DM : xc + (size_t)(r - TL) * DM;
        float v[16], h[16]; load_row(xr, C.lane, v);
        const float rinv = row_rinv(v);
        const float* mod = C.MOD() + (size_t)(l * 9 + modrow_of(r)) * INW;
        norm_mod(v, rinv, C.p->norm1_g + l * DM, mod + 1024, mod, C.lane, h);
        store_row_bf16(C.H() + (size_t)r * DM, C.lane, h);
    }
}

struct EpiInProj {
    static constexpr bool PERM = true, AFTER_DRAIN = false;
    bf16* P; const float2* rope; const float* lbl;
    __device__ __forceinline__ void operator()(const f32x4 (&acc)[2][2][4][2], const pg8::Unit& u, int wr, int wc, int fr, int fq) const {
        const int grp = u.pn >> 1; bf16* base = P + (size_t)grp * GSTRIDE;
        const int colb = (u.pn & 1) * 256 + wc * 32 + 8 * fq;
        const bool do_rope = (grp < 2) && (u.pm < TL / 256);
#pragma unroll
        for (int ai = 0; ai < 2; ++ai)
#pragma unroll
            for (int m = 0; m < 4; ++m) { const int row = u.pm * 256 + ai * 128 + wr * 64 + m * 16 + fr;
#pragma unroll
                for (int bj = 0; bj < 2; ++bj) { const int col = colb + bj * 128; f32x4 v0 = acc[ai][bj][m][0], v1 = acc[ai][bj][m][1];
                    if (do_rope) { const float4* rp = (const float4*)(rope + (size_t)(row & 4095) * 32 + ((col & 63) >> 1)); const float4 c01 = rp[0], c23 = rp[1];
                        const f32x4 a = v0, b = v1;
                        v0[0] = a[0] * c01.x - a[1] * c01.y; v0[1] = a[0] * c01.y + a[1] * c01.x; v0[2] = a[2] * c01.z - a[3] * c01.w; v0[3] = a[2] * c01.w + a[3] * c01.z;
                        v1[0] = b[0] * c23.x - b[1] * c23.y; v1[1] = b[0] * c23.y + b[1] * c23.x; v1[2] = b[2] * c23.z - b[3] * c23.w; v1[3] = b[2] * c23.w + b[3] * c23.z; }
                    if (grp == 3) {
#pragma unroll
                        for (int i = 0; i < 4; ++i) { v0[i] = silu(v0[i]); v1[i] = silu(v1[i]); }
                    } else if (grp == 4 || grp == 5) {
                        const float* lp = lbl + (grp - 4) * 512 + col; const f32x4 l0 = *(const f32x4*)lp, l1 = *(const f32x4*)(lp + 4);
#pragma unroll
                        for (int i = 0; i < 4; ++i) { v0[i] = fmaxf(l0[i] + (1.f - l0[i]) * sigm(v0[i]), 1e-30f); v1[i] = fmaxf(l1[i] + (1.f - l1[i]) * sigm(v1[i]), 1e-30f); }
                    }
                    if (grp == 2) {
                        const int hh = col >> 6, d0 = col & 63; const bool lat = row < TL;
                        const int bb = lat ? (row >> 12) : ((row - TL) >> 8), tt = lat ? (row & 4095) : ((row - TL) & 255);
                        bf16* vp = lat ? base + ((size_t)((bb * 8 + hh) * 64 + d0) << 12) + tt : base + (size_t)TL * GW + ((size_t)((bb * 8 + hh) * 64 + d0) << 8) + tt;
                        const size_t st = lat ? 4096 : 256;
#pragma unroll
                        for (int i = 0; i < 4; ++i) { vp[(size_t)i * st] = (bf16)f2bf(v0[i]); vp[(size_t)(4 + i) * st] = (bf16)f2bf(v1[i]); }
                    } else {
                    u32x4 w; w.x = pg8::cvt_pk_bf16(v0[0], v0[1]); w.y = pg8::cvt_pk_bf16(v0[2], v0[3]); w.z = pg8::cvt_pk_bf16(v1[0], v1[1]); w.w = pg8::cvt_pk_bf16(v1[2], v1[3]);
                    *(u32x4*)(base + (size_t)row * GW + col) = w; } } }
    }
};
template <int PASS> struct EpiMerge {
    static constexpr bool PERM = true, AFTER_DRAIN = false;
    bf16* M; const bf16* G;
    __device__ __forceinline__ void operator()(const f32x4 (&acc)[2][2][4][2], const pg8::Unit& u, int wr, int wc, int fr, int fq) const {
        const bf16* gb = G + (size_t)(u.pn >> 1) * GSTRIDE; const int gcol = (u.pn & 1) * 256 + wc * 32 + 8 * fq, mcol = u.pn * 256 + wc * 32 + 8 * fq;
#pragma unroll
        for (int ai = 0; ai < 2; ++ai)
#pragma unroll
            for (int m = 0; m < 4; ++m) { const int row = u.pm * 256 + ai * 128 + wr * 64 + m * 16 + fr;
#pragma unroll
                for (int bj = 0; bj < 2; ++bj) { const uint4 gw = *(const uint4*)(gb + (size_t)row * GW + gcol + bj * 128); float g[8]; unpack8(gw, g);
                    bf16* mp = M + (size_t)row * DM + mcol + bj * 128; const f32x4 v0 = acc[ai][bj][m][0], v1 = acc[ai][bj][m][1];
                    float o[8];
#pragma unroll
                    for (int i = 0; i < 4; ++i) { o[i] = sigm(g[i]) * v0[i]; o[4 + i] = sigm(g[4 + i]) * v1[i]; }
                    if (PASS == 1) { const uint4 mw = *(const uint4*)mp; float pm_[8]; unpack8(mw, pm_);
#pragma unroll
                        for (int i = 0; i < 8; ++i) o[i] += pm_[i]; }
                    u32x4 w; w.x = pg8::cvt_pk_bf16(o[0], o[1]); w.y = pg8::cvt_pk_bf16(o[2], o[3]); w.z = pg8::cvt_pk_bf16(o[4], o[5]); w.w = pg8::cvt_pk_bf16(o[6], o[7]);
                    *(u32x4*)mp = w; } }
    }
};
struct EpiOut {
    static constexpr bool PERM = false, AFTER_DRAIN = false;
    const float* xl_src; float* xl_dst; const float* xc_src; float* xc_dst; const float* mod;
    __device__ __forceinline__ void operator()(const f32x4 (&acc)[2][2][4][2], const pg8::Unit& u, int wr, int wc, int fr, int fq) const {
        const bool lat = u.pm < TL / 256; const int mr = lat ? (u.pm >> 4) : 8;
        const float* gate = mod + (size_t)mr * INW + 2048; const int col0 = u.pn * 256 + wc * 32 + 4 * fq;
        const float* src = lat ? xl_src : xc_src - (size_t)TL * DM; float* dst = lat ? xl_dst : xc_dst - (size_t)TL * DM;
        f32x4 gv[2][2];
#pragma unroll
        for (int bj = 0; bj < 2; ++bj)
#pragma unroll
            for (int n = 0; n < 2; ++n) gv[bj][n] = *(const f32x4*)(gate + col0 + bj * 128 + n * 16);
#pragma unroll
        for (int ai = 0; ai < 2; ++ai)
#pragma unroll
            for (int m = 0; m < 4; ++m) { const size_t off = (size_t)(u.pm * 256 + ai * 128 + wr * 64 + m * 16 + fr) * DM + col0;
#pragma unroll
                for (int bj = 0; bj < 2; ++bj)
#pragma unroll
                    for (int n = 0; n < 2; ++n) { const f32x4 xo = *(const f32x4*)(src + off + bj * 128 + n * 16); *(f32x4*)(dst + off + bj * 128 + n * 16) = xo + gv[bj][n] * acc[ai][bj][m][n]; } }
    }
};
struct EpiGateUp {
    static constexpr bool PERM = true, AFTER_DRAIN = false;
    bf16* A;
    __device__ __forceinline__ void operator()(const f32x4 (&acc)[2][2][4][2], const pg8::Unit& u, int wr, int wc, int fr, int fq) const {
        const int col = (u.pn & 3) * 128 + wc * 32 + 8 * fq;
#pragma unroll
        for (int ai = 0; ai < 2; ++ai)
#pragma unroll
            for (int m = 0; m < 4; ++m) { const int row = u.pm * 256 + ai * 128 + wr * 64 + m * 16 + fr; float o[8];
#pragma unroll
                for (int i = 0; i < 4; ++i) { o[i] = silu(acc[ai][0][m][0][i]) * acc[ai][1][m][0][i]; o[4 + i] = silu(acc[ai][0][m][1][i]) * acc[ai][1][m][1][i]; }
                u32x4 w; w.x = pg8::cvt_pk_bf16(o[0], o[1]); w.y = pg8::cvt_pk_bf16(o[2], o[3]); w.z = pg8::cvt_pk_bf16(o[4], o[5]); w.w = pg8::cvt_pk_bf16(o[6], o[7]);
                *(u32x4*)(A + (size_t)row * 512 + col) = w; }
    }
};
struct EpiDown {
    static constexpr bool PERM = true, AFTER_DRAIN = false;
    bf16* Y;
    __device__ __forceinline__ void operator()(const f32x4 (&acc)[2][2][4][2], const pg8::Unit& u, int wr, int wc, int fr, int fq) const {
        const int col = (u.pn & 3) * 256 + wc * 32 + 8 * fq;
#pragma unroll
        for (int ai = 0; ai < 2; ++ai)
#pragma unroll
            for (int m = 0; m < 4; ++m) { const int row = u.pm * 256 + ai * 128 + wr * 64 + m * 16 + fr;
#pragma unroll
                for (int bj = 0; bj < 2; ++bj) { const f32x4 v0 = acc[ai][bj][m][0], v1 = acc[ai][bj][m][1];
                    u32x4 w; w.x = pg8::cvt_pk_bf16(v0[0], v0[1]); w.y = pg8::cvt_pk_bf16(v0[2], v0[3]); w.z = pg8::cvt_pk_bf16(v1[0], v1[1]); w.w = pg8::cvt_pk_bf16(v1[2], v1[3]);
                    *(u32x4*)(Y + (size_t)row * DM + col + bj * 128) = w; } }
    }
};
struct MoeOrder {
    const int* tab; int G, c;
    __device__ __forceinline__ bool next(int i, pg8::Unit& u) const {
        const int L = i * G + c, MT = tab[16]; if (L >= MT * 4) return false;
        const int mt = L >> 2; int e = 0;
#pragma unroll
        for (int j = 1; j < 16; ++j) e += (mt >= tab[j]) ? 1 : 0;
        u.pm = mt; u.pn = e * 4 + (L & 3); return true;
    }
    __device__ __forceinline__ void a_ready(const pg8::Unit&) const {}
    __device__ __forceinline__ void done(const pg8::Unit&) const {}
};
__device__ __forceinline__ void moe_table(const Ctx& C, int l) {
    __syncthreads();
    if (C.tid == 0) { int acc = 0; const unsigned* cnt = C.CNT(l);
        for (int e = 0; e < 16; ++e) { C.TAB()[e] = acc; acc += (int)((__hip_atomic_load(cnt + e, __ATOMIC_RELAXED, __HIP_MEMORY_SCOPE_AGENT) + 255u) >> 8); }
        C.TAB()[16] = acc; }
    __syncthreads();
}

__device__ __forceinline__ void p3_attn_naive(const Ctx& C, int l) {
    float* pl = (float*)C.lds + C.wave * 768; int* kl = (int*)(pl + 384);
    const bf16* Q = C.GRP(0); const bf16* K = C.GRP(1); const bf16* V = C.GRP(2); bf16* O = C.GRP(0);
    const int nq = (l == 0 ? TA : TL) * 8;
    for (int wq = C.gw; wq < nq; wq += C.nw) {
        const int r = wq >> 3, h = wq & 7; const bool lat = r < TL;
        const int b = lat ? (r >> 12) : ((r - TL) >> 8);
        float q[64];
        { const uint4* qp = (const uint4*)(Q + (size_t)r * GW + h * 64);
#pragma unroll
          for (int j = 0; j < 8; ++j) { float t[8]; unpack8(qp[j], t);
#pragma unroll
              for (int i = 0; i < 8; ++i) q[8 * j + i] = t[i]; } }
        const int t = r & 4095, gr = t >> 6, gc = t & 63;
        const int rs = min(max(gr - 4, 0), 56), cs = min(max(gc - 8, 0), 48);
        float s[6]; int krow[6];
#pragma unroll
        for (int i = 0; i < 6; ++i) {
            float bias = 0.f; bool valid = true;
            if (i < 2) { const int j = C.lane + 64 * i, kr = rs + (j >> 4), kc = cs + (j & 15); krow[i] = b * 4096 + kr * 64 + kc; valid = lat;
                if (lat) bias = C.p->rel_bias[((size_t)(l * 8 + h) * 15 + (kr - gr + 7)) * 31 + (kc - gc + 15)]; if (!lat) krow[i] = TL + b * 256; }
            else krow[i] = TL + b * 256 + C.lane + 64 * (i - 2);
            const uint4* kp = (const uint4*)(K + (size_t)krow[i] * GW + h * 64); float d = 0.f;
#pragma unroll
            for (int j = 0; j < 8; ++j) { float tk[8]; unpack8(kp[j], tk);
#pragma unroll
                for (int ii = 0; ii < 8; ++ii) d += q[8 * j + ii] * tk[ii]; }
            s[i] = valid ? d * 0.125f + bias : -1e30f;
        }
        float mx = s[0];
#pragma unroll
        for (int i = 1; i < 6; ++i) mx = fmaxf(mx, s[i]);
        mx = wave_max(mx);
        float sum = 0.f;
#pragma unroll
        for (int i = 0; i < 6; ++i) { s[i] = (s[i] > -1e29f) ? __expf(s[i] - mx) : 0.f; sum += s[i]; }
        sum = wave_sum(sum); const float inv = 1.f / sum;
#pragma unroll
        for (int i = 0; i < 6; ++i) { pl[C.lane + 64 * i] = s[i] * inv; kl[C.lane + 64 * i] = krow[i]; }
        float acc = 0.f;
        for (int j = lat ? 0 : 128; j < 384; ++j) acc += pl[j] * bf2f(V[(size_t)kl[j] * GW + h * 64 + C.lane]);
        O[(size_t)r * GW + h * 64 + C.lane] = (bf16)f2bf(acc);
    }
}


typedef pg8::bf16x8 bf16x8;
typedef unsigned u32x2 __attribute__((ext_vector_type(2)));
__device__ __forceinline__ bf16x8 ld16(const bf16* p) { return *(const bf16x8*)p; }
__device__ __forceinline__ bf16x8 ld8x2(const bf16* p0, const bf16* p1) { const u32x2 a = *(const u32x2*)p0, b = *(const u32x2*)p1; u32x4 w; w.x = a.x; w.y = a.y; w.z = b.x; w.w = b.y; return __builtin_bit_cast(bf16x8, w); }
__device__ __forceinline__ bf16x8 pack8(const f32x4 a, const f32x4 b) { u32x4 w; w.x = pg8::cvt_pk_bf16(a[0], a[1]); w.y = pg8::cvt_pk_bf16(a[2], a[3]); w.z = pg8::cvt_pk_bf16(b[0], b[1]); w.w = pg8::cvt_pk_bf16(b[2], b[3]); return __builtin_bit_cast(bf16x8, w); }
#define MFMA16(a, b, c) __builtin_amdgcn_mfma_f32_16x16x32_bf16(a, b, c, 0, 0, 0)

__device__ __forceinline__ void p3_attn(const Ctx& C, int l) {
    float* relb = (float*)(C.lds + 98304);
    __syncthreads();
    for (int i = C.tid; i < 8 * 15 * 32; i += 512) { const int dc = i & 31, hd = i >> 5; relb[i] = (dc < 31) ? C.p->rel_bias[(size_t)l * 8 * 15 * 31 + hd * 31 + dc] : 0.f; }
    __syncthreads();
    const bf16* Qb = C.GRP(0); const bf16* Kb = C.GRP(1); const bf16* VT = C.GRP(2); const bf16* VTc = C.GRP(2) + (size_t)TL * GW; bf16* Ob = C.GRP(0);
    const int lq = C.lane & 15, g = C.lane >> 4;
    const int nlat = 16384, nu = nlat + (l == 0 ? 1024 : 0);
    for (int u = C.gw; u < nu; u += C.nw) {
        const bool lat = u < nlat;
        int b, h, gr = 0, gc0 = 0, qrow0;
        if (lat) { const int ct = u & 3; h = (u >> 2) & 7; gr = (u >> 5) & 63; b = u >> 11; gc0 = ct * 16; qrow0 = b * 4096 + gr * 64 + gc0; }
        else { const int v = u - nlat, qt = v & 15; h = (v >> 4) & 7; b = v >> 7; qrow0 = TL + b * 256 + qt * 16; }
        const int rs = min(max(gr - 4, 0), 56), u0 = min(max(gc0 - 8, 0), 32);
        const bf16* qp = Qb + (size_t)(qrow0 + lq) * GW + h * 64 + 8 * g;
        const bf16x8 q0 = ld16(qp), q1 = ld16(qp + 32);
        f32x4 s[32];
        const f32x4 z4 = {0.f, 0.f, 0.f, 0.f};
        if (lat) {
            const int gcq = gc0 + lq, csq = min(max(gcq - 8, 0), 48);
#pragma unroll
            for (int wt = 0; wt < 16; ++wt) { const int wrow = wt >> 1, half = wt & 1;
                const bf16* kp = Kb + (size_t)(b * 4096 + (rs + wrow) * 64 + u0 + 16 * half + lq) * GW + h * 64 + 8 * g;
                f32x4 a = MFMA16(ld16(kp), q0, z4); a = MFMA16(ld16(kp + 32), q1, a);
                const float* brow = relb + (h * 15 + (rs + wrow - gr + 7)) * 32;
#pragma unroll
                for (int r = 0; r < 4; ++r) { const int kc = u0 + 16 * half + 4 * g + r; const bool valid = (kc >= csq) && (kc < csq + 16); const int dc = min(max(kc - gcq + 15, 0), 30);
                    a[r] = valid ? a[r] * 0.125f + brow[dc] : -1e30f; }
                s[wt] = a; }
        } else {
#pragma unroll
            for (int wt = 0; wt < 16; ++wt) s[wt] = (f32x4){-1e30f, -1e30f, -1e30f, -1e30f};
        }
#pragma unroll
        for (int ctile = 0; ctile < 16; ++ctile) {
            const bf16* kp = Kb + (size_t)(TL + b * 256 + ctile * 16 + lq) * GW + h * 64 + 8 * g;
            f32x4 a = MFMA16(ld16(kp), q0, z4); a = MFMA16(ld16(kp + 32), q1, a);
            s[16 + ctile] = a * 0.125f; }
        float mx = -1e30f;
#pragma unroll
        for (int i = 0; i < 32; ++i) mx = fmaxf(fmaxf(fmaxf(mx, s[i][0]), fmaxf(s[i][1], s[i][2])), s[i][3]);
        mx = fmaxf(mx, __shfl_xor(mx, 16)); mx = fmaxf(mx, __shfl_xor(mx, 32));
        float sum = 0.f;
#pragma unroll
        for (int i = 0; i < 32; ++i) {
#pragma unroll
            for (int r = 0; r < 4; ++r) { const float e = __expf(s[i][r] - mx); s[i][r] = e; sum += e; } }
        sum += __shfl_xor(sum, 16); sum += __shfl_xor(sum, 32);
        const float inv = 1.f / sum;
        f32x4 o[4] = {z4, z4, z4, z4};
        if (lat) {
#pragma unroll
            for (int wrow = 0; wrow < 8; ++wrow) { const bf16x8 pb = pack8(s[2 * wrow], s[2 * wrow + 1]);
                const bf16* vp = VT + ((size_t)((b * 8 + h) * 64 + lq) << 12) + (rs + wrow) * 64 + u0 + 4 * g;
#pragma unroll
                for (int dt = 0; dt < 4; ++dt) o[dt] = MFMA16(ld8x2(vp + ((size_t)dt << 16), vp + ((size_t)dt << 16) + 16), pb, o[dt]); }
        }
#pragma unroll
        for (int cb = 0; cb < 8; ++cb) { const bf16x8 pb = pack8(s[16 + 2 * cb], s[16 + 2 * cb + 1]);
            const bf16* vp = VTc + ((size_t)((b * 8 + h) * 64 + lq) << 8) + cb * 32 + 4 * g;
#pragma unroll
            for (int dt = 0; dt < 4; ++dt) o[dt] = MFMA16(ld8x2(vp + (dt << 12), vp + (dt << 12) + 16), pb, o[dt]); }
        bf16* op = Ob + (size_t)(qrow0 + lq) * GW + h * 64 + 4 * g;
#pragma unroll
        for (int dt = 0; dt < 4; ++dt) { u32x2 w; w.x = pg8::cvt_pk_bf16(o[dt][0] * inv, o[dt][1] * inv); w.y = pg8::cvt_pk_bf16(o[dt][2] * inv, o[dt][3] * inv); *(u32x2*)(op + 16 * dt) = w; }
    }
}


__device__ __forceinline__ int scan_row(int b, int dir, int s) { return dir == 0 ? (s < NCTX ? TL + b * NCTX + s : b * SEQ + (s - NCTX)) : (s < NCTX ? TL + b * NCTX + (NCTX - 1 - s) : b * SEQ + (SEQ - 1 - (s - NCTX))); }
constexpr int SC_QT = 0, SC_KT = 17408, SC_QS = 34816, SC_KST = 52224, SC_VT = 70656, SC_DV = 75264, SC_TOT = 75776;
__device__ __forceinline__ float ex2(float x) { return __builtin_amdgcn_exp2f(x); }
__device__ __forceinline__ void p3_scan(const Ctx& C, int l) {
    unsigned char* L = C.lds;
    const int k = C.tid & 127, tq = C.tid >> 7, lq = C.lane & 15, g = C.lane >> 4, tt = C.wave >> 1, vt = C.wave & 1;
    const bf16* HQ = C.GRP(3); const bf16* HI = C.GRP(6);
    for (int u = C.bid; u < 256; u += C.G) {
        const int dvq = u & 3, dir = (u >> 2) & 1, h = (u >> 3) & 3, b = u >> 5;
        const bf16* HF = C.GRP(dir ? 5 : 4); bf16* OUT = C.H() + (size_t)dir * GSTRIDE;
        const int sgn = dir ? -1 : 1;
        f32x4 S[8];
#pragma unroll
        for (int i = 0; i < 8; ++i) S[i] = (f32x4){0.f, 0.f, 0.f, 0.f};
        unsigned gv[16], qv[16]; u32x2 vraw;
        const int vs = C.tid >> 3, v4 = (C.tid & 7) * 4;
        { const int row0 = scan_row(b, dir, 0);
#pragma unroll
          for (int i = 0; i < 16; ++i) { const size_t ro = (size_t)(row0 + sgn * (16 * tq + i)) * GW + h * 128 + k; gv[i] = HF[ro]; qv[i] = HQ[ro]; }
          vraw = *(const u32x2*)(HI + (size_t)(row0 + sgn * vs) * GW + h * 128 + dvq * 32 + v4); }
        for (int c = 0; c < 68; ++c) {
            const int row0 = scan_row(b, dir, 64 * c);
            float cs[16]; float run = 0.f;
#pragma unroll
            for (int i = 0; i < 16; ++i) { run += __builtin_amdgcn_logf(bf2f(gv[i])); cs[i] = run; }
            ((float*)(L + SC_TOT))[tq * 128 + k] = run;
            __syncthreads();
            const float t0 = ((float*)(L + SC_TOT))[k], t1 = ((float*)(L + SC_TOT))[128 + k], t2 = ((float*)(L + SC_TOT))[256 + k], t3 = ((float*)(L + SC_TOT))[384 + k];
            const float beta = t0 + t1, last = beta + t2 + t3;
            const float off = (tq == 0) ? 0.f : (tq == 1) ? t0 : (tq == 2) ? beta : beta + t2;
            const float eb = ex2(fmaxf(beta, -120.f)), el = ex2(fmaxf(last - beta, -120.f));
            float ks_[16];
#pragma unroll
            for (int i = 0; i < 16; ++i) { const float d = off + cs[i] - beta; const float e1 = ex2(fminf(fmaxf(d, -120.f), 120.f)), r1 = ex2(fminf(fmaxf(-d, -120.f), 120.f));
                const float q = bf2f(qv[i]), kk = 1.f - bf2f(gv[i]); const float qt = q * e1, kt = kk * r1; const int t = 16 * tq + i;
                *(bf16*)(L + SC_QT + t * 272 + k * 2) = (bf16)f2bf(qt); *(bf16*)(L + SC_KT + t * 272 + k * 2) = (bf16)f2bf(kt); *(bf16*)(L + SC_QS + t * 272 + k * 2) = (bf16)f2bf(qt * eb); ks_[i] = kt * el; }
            { uint4 w0, w1; w0.x = pk2(ks_[0], ks_[1]); w0.y = pk2(ks_[2], ks_[3]); w0.z = pk2(ks_[4], ks_[5]); w0.w = pk2(ks_[6], ks_[7]); w1.x = pk2(ks_[8], ks_[9]); w1.y = pk2(ks_[10], ks_[11]); w1.z = pk2(ks_[12], ks_[13]); w1.w = pk2(ks_[14], ks_[15]);
              *(uint4*)(L + SC_KST + k * 144 + tq * 32) = w0; *(uint4*)(L + SC_KST + k * 144 + tq * 32 + 16) = w1; }
            if (tq == 0) ((float*)(L + SC_DV))[k] = ex2(fmaxf(last, -120.f));
            { *(bf16*)(L + SC_VT + (v4 + 0) * 144 + vs * 2) = (bf16)(vraw.x & 0xffffu); *(bf16*)(L + SC_VT + (v4 + 1) * 144 + vs * 2) = (bf16)(vraw.x >> 16);
              *(bf16*)(L + SC_VT + (v4 + 2) * 144 + vs * 2) = (bf16)(vraw.y & 0xffffu); *(bf16*)(L + SC_VT + (v4 + 3) * 144 + vs * 2) = (bf16)(vraw.y >> 16); }
            __syncthreads();
            if (c + 1 < 68) { const int nrow0 = scan_row(b, dir, 64 * (c + 1));
#pragma unroll
                for (int i = 0; i < 16; ++i) { const size_t ro = (size_t)(nrow0 + sgn * (16 * tq + i)) * GW + h * 128 + k; gv[i] = HF[ro]; qv[i] = HQ[ro]; }
                vraw = *(const u32x2*)(HI + (size_t)(nrow0 + sgn * vs) * GW + h * 128 + dvq * 32 + v4); }
            const f32x4 z4 = {0.f, 0.f, 0.f, 0.f};
            f32x4 o = z4;
            { const unsigned char* qb = L + SC_QT + (16 * tt + lq) * 272 + g * 16;
              bf16x8 qf[4];
#pragma unroll
              for (int ks = 0; ks < 4; ++ks) qf[ks] = *(const bf16x8*)(qb + ks * 64);
              const int tcol = 16 * tt + lq;
#pragma unroll
              for (int sp = 0; sp < 2; ++sp) if (sp <= (tt >> 1)) {
                  f32x4 X[2];
#pragma unroll
                  for (int hf = 0; hf < 2; ++hf) { const int st = 2 * sp + hf; const unsigned char* kb = L + SC_KT + (16 * st + lq) * 272 + g * 16; f32x4 a = z4;
#pragma unroll
                      for (int ks = 0; ks < 4; ++ks) a = MFMA16(*(const bf16x8*)(kb + ks * 64), qf[ks], a);
#pragma unroll
                      for (int r = 0; r < 4; ++r) a[r] = (16 * st + 4 * g + r <= tcol) ? a[r] : 0.f;
                      X[hf] = a; }
                  const unsigned char* vb = L + SC_VT + (16 * vt + lq) * 144 + (32 * sp + 4 * g) * 2;
                  o = MFMA16(pack8(X[0], X[1]), ld8x2((const bf16*)vb, (const bf16*)(vb + 32)), o); } }
            { const unsigned char* sb = L + SC_QS + (16 * tt + lq) * 272 + (4 * g) * 2;
#pragma unroll
              for (int kp = 0; kp < 4; ++kp) o = MFMA16(ld8x2((const bf16*)(sb + kp * 64), (const bf16*)(sb + kp * 64 + 32)), pack8(S[2 * kp], S[2 * kp + 1]), o); }
            { bf16* op = OUT + (size_t)(row0 + sgn * (16 * tt + 4 * g)) * GW + h * 128 + dvq * 32 + 16 * vt + lq;
#pragma unroll
              for (int r = 0; r < 4; ++r) op[(ptrdiff_t)(sgn * r) * GW] = (bf16)f2bf(o[r]); }
            { const unsigned char* vb = L + SC_VT + (16 * vt + lq) * 144 + g * 16; const bf16x8 vf0 = *(const bf16x8*)vb, vf1 = *(const bf16x8*)(vb + 64);
#pragma unroll
              for (int kt = 0; kt < 8; ++kt) { const f32x4 dsc = *(const f32x4*)(L + SC_DV + (16 * kt + 4 * g) * 4); const unsigned char* kb = L + SC_KST + (16 * kt + lq) * 144 + g * 16;
                  f32x4 a = S[kt] * dsc; a = MFMA16(*(const bf16x8*)kb, vf0, a); a = MFMA16(*(const bf16x8*)(kb + 64), vf1, a); S[kt] = a; } }
        }
        __syncthreads();
    }
}

__device__ __forceinline__ void p3_scan_naive(const Ctx& C, int l) {
    const bf16* HQ = C.GRP(3); const bf16* HI = C.GRP(6);
    for (int u = C.gw; u < 2048; u += C.nw) {
        const int dv4 = u & 31, dir = (u >> 5) & 1, h = (u >> 6) & 3, b = u >> 8;
        const bf16* HF = C.GRP(dir ? 5 : 4); bf16* OUT = C.H() + (size_t)dir * GSTRIDE;
        const float lb0 = C.LB()[(l * 2 + dir) * 512 + h * 128 + C.lane], lb1 = C.LB()[(l * 2 + dir) * 512 + h * 128 + 64 + C.lane];
        float S0[4] = {0.f, 0.f, 0.f, 0.f}, S1[4] = {0.f, 0.f, 0.f, 0.f};
        const int NS = NCTX + SEQ;
        int row = scan_row(b, dir, 0);
        unsigned q0 = HQ[(size_t)row * GW + h * 128 + C.lane], q1 = HQ[(size_t)row * GW + h * 128 + 64 + C.lane], f0 = HF[(size_t)row * GW + h * 128 + C.lane], f1 = HF[(size_t)row * GW + h * 128 + 64 + C.lane];
        uint2 vv = *(const uint2*)(HI + (size_t)row * GW + h * 128 + dv4 * 4);
        for (int s = 0; s < NS; ++s) {
            const int nrow = scan_row(b, dir, (s + 1 < NS) ? s + 1 : s);
            const unsigned nq0 = HQ[(size_t)nrow * GW + h * 128 + C.lane], nq1 = HQ[(size_t)nrow * GW + h * 128 + 64 + C.lane], nf0 = HF[(size_t)nrow * GW + h * 128 + C.lane], nf1 = HF[(size_t)nrow * GW + h * 128 + 64 + C.lane];
            const uint2 nvv = *(const uint2*)(HI + (size_t)nrow * GW + h * 128 + dv4 * 4);
            const float qa = silu(bf2f(q0)), qb = silu(bf2f(q1));
            const float fa = fminf(fmaxf(bf2f(f0), -30.f), 30.f), fb = fminf(fmaxf(bf2f(f1), -30.f), 30.f);
            const float ea = __expf(-fa), eb = __expf(-fb);
            const float sga = 1.f / (1.f + ea), sgb = 1.f / (1.f + eb);
            const float ga = fmaxf(lb0 + (1.f - lb0) * sga, 1e-30f), gb = fmaxf(lb1 + (1.f - lb1) * sgb, 1e-30f);
            const float ka = (1.f - lb0) * (ea * sga), kb = (1.f - lb1) * (eb * sgb);
            const float v[4] = {bflo(vv.x), bfhi(vv.x), bflo(vv.y), bfhi(vv.y)};
            float o[4];
#pragma unroll
            for (int j = 0; j < 4; ++j) { S0[j] = ga * S0[j] + ka * v[j]; S1[j] = gb * S1[j] + kb * v[j]; o[j] = wave_sum(qa * S0[j] + qb * S1[j]); }
            if (C.lane == 0) { uint2 w; w.x = pk2(o[0], o[1]); w.y = pk2(o[2], o[3]); *(uint2*)(OUT + (size_t)row * GW + h * 128 + dv4 * 4) = w; }
            row = nrow; q0 = nq0; q1 = nq1; f0 = nf0; f1 = nf1; vv = nvv;
        }
    }
}

__device__ __forceinline__ void p3c_headnorm(const Ctx& C, int l) {
    const int nrows = (l == 0) ? TA : TL;
    bf16* OF = C.H(); const bf16* OB = C.H() + GSTRIDE; const bf16* HG = C.GRP(7);
    const float* gain = C.p->hg_norm_g + l * 128;
    for (int r = C.gw; r < nrows; r += C.nw) {
        const size_t off = (size_t)r * GW + C.lane * 8;
        float a[8], b[8], g[8]; unpack8(*(const uint4*)(OF + off), a); unpack8(*(const uint4*)(OB + off), b); unpack8(*(const uint4*)(HG + off), g);
        float ss = 0.f;
#pragma unroll
        for (int i = 0; i < 8; ++i) { a[i] += b[i]; ss += a[i] * a[i]; }
        ss += __shfl_xor(ss, 1); ss += __shfl_xor(ss, 2); ss += __shfl_xor(ss, 4); ss += __shfl_xor(ss, 8);
        const float rinv = rsqrtf(ss * (1.f / 128.f) + EPS);
        const int cg = (C.lane & 15) * 8; float o[8];
#pragma unroll
        for (int i = 0; i < 8; ++i) o[i] = a[i] * rinv * gain[cg + i] * silu(g[i]);
        uint4 w; w.x = pk2(o[0], o[1]); w.y = pk2(o[2], o[3]); w.z = pk2(o[4], o[5]); w.w = pk2(o[6], o[7]);
        *(uint4*)(OF + off) = w;
    }
}

__device__ __forceinline__ void p5_norm2_router(const Ctx& C, int l) {
    float* wr = (float*)C.lds;
    for (int i = C.tid; i < 1024 * 16; i += 512) wr[(i & 15) * 1024 + (i >> 4)] = C.p->w_router[i];
    __syncthreads();
    const int nrows = (l == 0) ? TA : TL;
    float rb[16];
#pragma unroll
    for (int e = 0; e < 16; ++e) rb[e] = C.p->router_bias[e];
    for (int r = C.gw; r < nrows; r += C.nw) {
        const float* xr = r < TL ? C.p->out + (size_t)r * DM : C.CTXS() + (size_t)(r - TL) * DM;
        float v[16], h[16]; load_row(xr, C.lane, v);
        const float rinv = row_rinv(v);
        const float* mod = C.MOD() + (size_t)(l * 9 + modrow_of(r)) * INW;
        norm_mod(v, rinv, C.p->norm2_g + l * DM, mod + 4096, mod + 3072, C.lane, h);
        store_row_bf16(C.H() + (size_t)r * DM, C.lane, h);
        float lgv = 0.f;
#pragma unroll 1
        for (int e = 0; e < 16; ++e) { const float* we = wr + e * 1024 + C.lane * 4; float a = 0.f;
#pragma unroll
            for (int j = 0; j < 4; ++j) { const float4 ww = *(const float4*)(we + j * 256); a += h[4 * j] * ww.x + h[4 * j + 1] * ww.y + h[4 * j + 2] * ww.z + h[4 * j + 3] * ww.w; }
            a = wave_sum(a); lgv = (C.lane == e) ? a : lgv; }
        float lg[16];
#pragma unroll
        for (int e = 0; e < 16; ++e) lg[e] = __shfl(lgv, e);
        float bestg = -1e30f; int e0 = 0, e1 = 1; float s0 = 0.f, s1 = 0.f;
#pragma unroll
        for (int g = 0; g < 4; ++g) {
            float sc[4], gbv[4];
#pragma unroll
            for (int j = 0; j < 4; ++j) { sc[j] = 1.f / (1.f + expf(-lg[4 * g + j])); gbv[j] = sc[j] + rb[4 * g + j]; }
            int i0 = 0; float b0 = gbv[0], u0 = sc[0];
#pragma unroll
            for (int j = 1; j < 4; ++j) if (gbv[j] > b0) { b0 = gbv[j]; i0 = j; u0 = sc[j]; }
            int i1 = -1; float b1 = -1e30f, u1 = 0.f;
#pragma unroll
            for (int j = 0; j < 4; ++j) if (j != i0 && gbv[j] > b1) { b1 = gbv[j]; i1 = j; u1 = sc[j]; }
            const float gs = b0 + b1;
            if (gs > bestg) { bestg = gs; e0 = 4 * g + i0; e1 = 4 * g + i1; s0 = u0; s1 = u1; }
        }
        if (C.lane == 0) {
            const float den = s0 + s1; unsigned* cnt = C.CNT(l);
            const int r0 = (int)atomicAdd(cnt + e0, 1u), r1 = (int)atomicAdd(cnt + e1, 1u);
            C.TOKE()[2 * r] = e0; C.TOKE()[2 * r + 1] = e1; C.TOKW()[2 * r] = s0 / den; C.TOKW()[2 * r + 1] = s1 / den; C.TOKS()[2 * r] = r0; C.TOKS()[2 * r + 1] = r1;
        }
    }
    __syncthreads();
}

__device__ __forceinline__ void p6_permute(const Ctx& C, int l) {
    moe_table(C, l);
    const int nrows = (l == 0) ? TA : TL;
    for (int r = C.gw; r < nrows; r += C.nw) {
        const int e0 = C.TOKE()[2 * r], e1 = C.TOKE()[2 * r + 1];
        const int sl0 = C.TAB()[e0] * 256 + C.TOKS()[2 * r], sl1 = C.TAB()[e1] * 256 + C.TOKS()[2 * r + 1];
        const uint4* src = (const uint4*)(C.H() + (size_t)r * DM);
        const uint4 a = src[C.lane], b = src[64 + C.lane];
        uint4* d0 = (uint4*)(C.XS() + (size_t)sl0 * DM); uint4* d1 = (uint4*)(C.XS() + (size_t)sl1 * DM);
        d0[C.lane] = a; d0[64 + C.lane] = b; d1[C.lane] = a; d1[64 + C.lane] = b;
        if (C.lane == 0) { C.TOKS()[2 * r] = sl0; C.TOKS()[2 * r + 1] = sl1; }
    }
}

__device__ __forceinline__ void p9_combine(const Ctx& C, int l) {
    const int nrows = (l == 0) ? TA : TL; const bf16* YS = C.XS();
    for (int r = C.gw; r < nrows; r += C.nw) {
        float* xr = r < TL ? C.p->out + (size_t)r * DM : C.CTXS() + (size_t)(r - TL) * DM;
        float v[16]; load_row(xr, C.lane, v);
        const int s0 = C.TOKS()[2 * r], s1 = C.TOKS()[2 * r + 1]; const float w0 = C.TOKW()[2 * r], w1 = C.TOKW()[2 * r + 1];
        const float* mod = C.MOD() + (size_t)(l * 9 + modrow_of(r)) * INW;
#pragma unroll
        for (int j = 0; j < 4; ++j) { const int c = j * 256 + C.lane * 4; const uint2 a = *(const uint2*)(YS + (size_t)s0 * DM + c), b = *(const uint2*)(YS + (size_t)s1 * DM + c); const float4 g = *(const float4*)(mod + 5120 + c);
            v[4 * j] += g.x * (w0 * bflo(a.x) + w1 * bflo(b.x)); v[4 * j + 1] += g.y * (w0 * bfhi(a.x) + w1 * bfhi(b.x));
            v[4 * j + 2] += g.z * (w0 * bflo(a.y) + w1 * bflo(b.y)); v[4 * j + 3] += g.w * (w0 * bfhi(a.y) + w1 * bfhi(b.y)); }
        const float rinv = row_rinv(v);
        if (l == 0) {
#pragma unroll
            for (int j = 0; j < 4; ++j) *(float4*)(xr + j * 256 + C.lane * 4) = make_float4(v[4 * j], v[4 * j + 1], v[4 * j + 2], v[4 * j + 3]);
            float h[16]; const float* mod1 = C.MOD() + (size_t)(9 + modrow_of(r)) * INW;
            norm_mod(v, rinv, C.p->norm1_g + DM, mod1 + 1024, mod1, C.lane, h);
            store_row_bf16(C.H() + (size_t)r * DM, C.lane, h);
        } else {
#pragma unroll
            for (int j = 0; j < 4; ++j) { const int c = j * 256 + C.lane * 4; const float4 g = *(const float4*)(C.p->final_g + c);
                *(float4*)(xr + c) = make_float4(v[4 * j] * rinv * g.x, v[4 * j + 1] * rinv * g.y, v[4 * j + 2] * rinv * g.z, v[4 * j + 3] * rinv * g.w); }
        }
    }
}

#ifndef PHMASK
#define PHMASK 0xFFFFu
#endif
#define PHON(i) (((PHMASK) >> (i)) & 1u)
constexpr int NPH = 22;
__global__ void __launch_bounds__(512, 2) mk_fwd(Params p) {
    extern __shared__ __attribute__((aligned(16))) unsigned char lds_raw[];
    LAS unsigned char* ldsl = (LAS unsigned char*)lds_raw;
    if (threadIdx.x < 64) ((LAS unsigned*)(ldsl + LDS_STAGE))[threadIdx.x] = 0u;
    __syncthreads();
    XcdBarrier bar = xcd_barrier_post((unsigned*)(p.ws + WS_CTL) + CW_BAR + p.li * XCD_BAR_WORDS, (volatile LAS unsigned*)(ldsl + LDS_STAGE) + LDSW_BAR);
#define MKCTX() Ctx C; { unsigned long long kp_ = (unsigned long long)__builtin_amdgcn_kernarg_segment_ptr(); asm volatile("" : "+s"(kp_)); C.p.q = (ParamsK)kp_; } \
    C.ws = C.p->ws; C.lds = lds_raw; { int t_ = threadIdx.x, g_ = gridDim.x, b_ = blockIdx.x; asm volatile("" : "+v"(t_), "+s"(g_), "+s"(b_)); C.tid = t_; C.G = g_; C.bid = b_; } \
    C.lane = C.tid & 63; C.wave = __builtin_amdgcn_readfirstlane(C.tid >> 6); C.gw = C.bid * 8 + C.wave; C.nw = C.G * 8;
    const int lo = p.lo, hi = p.hi;
#define IN(k) (lo <= (k) && (k) < hi)
#define SEAM(k) do { if (IN((k) + 1)) xcd_barrier(bar); } while (0)

    if (PHON(0) && IN(0)) { MKCTX(); p0_prologue(C); SEAM(0); }
    if (PHON(1) && IN(1)) { MKCTX(); p1_norm1(C, 0, C.p->x, C.p->ctx); SEAM(1); }
    for (int l = 0; l < 2; ++l) {
        const int pb = 2 + 10 * l;
        const int mrows = (l == 0) ? TA : TL;
        if (PHON(2) && IN(pb + 0)) {
            MKCTX();
            pg8::Gemm g{C.H(), C.WIN_T(), TA, INW, DM}; pg8::StaticOrder S; S.init(TA, INW, C.G, C.bid);
            EpiInProj E{C.GRP(0), C.ROPE(), C.LB() + l * 1024};
            pg8::gemm_phase<EpiInProj, pg8::StaticOrder, true, true>(ldsl, g, S, E);
            SEAM(pb + 0);
        }
        if (PHON(3) && IN(pb + 1)) {
            MKCTX();
            p3_scan(C, l);
            p3_attn(C, l);
            SEAM(pb + 1);
        }
        if (PHON(4) && IN(pb + 2)) { MKCTX(); p3c_headnorm(C, l); SEAM(pb + 2); }
        if (PHON(5) && IN(pb + 3)) {
            MKCTX();
            pg8::StaticOrder S; S.init(mrows, DM, C.G, C.bid);
            { pg8::Gemm g{C.GRP(0), C.WNA_T(), mrows, DM, 512}; EpiMerge<0> E{C.MB(), C.GRP(8)}; pg8::gemm_phase<EpiMerge<0>, pg8::StaticOrder, true, true>(ldsl, g, S, E); }
            __syncthreads();
            { pg8::Gemm g{C.H(), C.WHG_T(), mrows, DM, 512}; EpiMerge<1> E{C.MB(), C.GRP(10)}; pg8::gemm_phase<EpiMerge<1>, pg8::StaticOrder, true, true>(ldsl, g, S, E); }
            SEAM(pb + 3);
        }
        if (PHON(6) && IN(pb + 4)) {
            MKCTX();
            pg8::StaticOrder S; S.init(mrows, DM, C.G, C.bid);
            pg8::Gemm g{C.MB(), C.WOUT_T(), mrows, DM, DM};
            EpiOut E{l == 0 ? C.p->x : (const float*)C.p->out, C.p->out, C.p->ctx, C.CTXS(), C.MOD() + (size_t)l * 9 * INW};
            pg8::gemm_phase<EpiOut, pg8::StaticOrder, true, true>(ldsl, g, S, E);
            conv_experts(C, l);
            SEAM(pb + 4);
        }
        if (PHON(7) && IN(pb + 5)) { MKCTX(); p5_norm2_router(C, l); SEAM(pb + 5); }
        if (PHON(8) && IN(pb + 6)) { MKCTX(); p6_permute(C, l); SEAM(pb + 6); }
        if (PHON(9) && IN(pb + 7)) {
            MKCTX();
            moe_table(C, l);
            MoeOrder S{C.TAB(), C.G, C.bid};
            pg8::Gemm g{C.XS(), C.WEGU(), SLOT_ROWS, 16384, DM}; EpiGateUp E{C.ACT()};
            pg8::gemm_phase<EpiGateUp, MoeOrder, true, true>(ldsl, g, S, E);
            SEAM(pb + 7);
        }
        if (PHON(10) && IN(pb + 8)) {
            MKCTX();
            moe_table(C, l);
            MoeOrder S{C.TAB(), C.G, C.bid};
            pg8::Gemm g{C.ACT(), C.WED(), SLOT_ROWS, 16384, 512}; EpiDown E{C.XS()};
            pg8::gemm_phase<EpiDown, MoeOrder, true, true>(ldsl, g, S, E);
            SEAM(pb + 8);
        }
        if (PHON(11) && IN(pb + 9)) { MKCTX(); p9_combine(C, l); if (l == 0) conv_mixer(C, 1); SEAM(pb + 9); }
    }
#undef IN
#undef SEAM
}

#ifndef MK_SPLIT
#define MK_SPLIT 0
#endif
extern "C" void kernel_launch(void* const* d_in, const int* in_sizes, int n_in, void* d_out, int out_size, void* d_ws, size_t ws_size, hipStream_t stream) {
    static int grid = 0;
    if (grid == 0) {
        if (n_in != 22 || ws_size < WS_END) { fprintf(stderr, "kernel_launch: unexpected n_in %d / ws_size %zu (need %zu)\n", n_in, ws_size, (size_t)WS_END); grid = -1; return; }
        int dev = 0, cus = 0, per_cu = 0;
        if (hipGetDevice(&dev) != hipSuccess || hipDeviceGetAttribute(&cus, hipDeviceAttributeMultiprocessorCount, dev) != hipSuccess) { grid = -1; return; }
        if (hipFuncSetAttribute((const void*)mk_fwd, hipFuncAttributeMaxDynamicSharedMemorySize, LDS_BYTES) != hipSuccess) { fprintf(stderr, "kernel_launch: hipFuncSetAttribute failed\n"); grid = -1; return; }
        if (hipOccupancyMaxActiveBlocksPerMultiprocessor(&per_cu, (const void*)mk_fwd, 512, LDS_BYTES) != hipSuccess || per_cu < 1) fprintf(stderr, "kernel_launch: occupancy query says %d\n", per_cu);
        (void)hipGetLastError();
        grid = cus;
    }
    if (grid < 0) return;
    if (hipMemsetAsync((char*)d_ws + WS_CTL, 0, CTL_BYTES, stream) != hipSuccess) return;
    Params p{};
    const float** pp = (const float**)&p;
    for (int i = 0; i < 22; ++i) pp[i] = (const float*)d_in[i];
    p.out = (float*)d_out; p.ws = (unsigned char*)d_ws; p.pad = 0;
#if MK_SPLIT
    for (int k = 0; k < NPH; ++k) { p.lo = k; p.hi = k + 1; p.li = k; hipLaunchKernelGGL(mk_fwd, dim3(grid), dim3(512), LDS_BYTES, stream, p); }
#else
    p.lo = 0; p.hi = NPH; p.li = 0;
    hipLaunchKernelGGL(mk_fwd, dim3(grid), dim3(512), LDS_BYTES, stream, p);
#endif
}
```

```cpp
#include <hip/hip_runtime.h>
#include <cstdio>
#include <cstdint>
namespace pg8 {
#define PG8_LAS __attribute__((address_space(3)))
typedef unsigned short bf16_t;
typedef short bf16x8 __attribute__((ext_vector_type(8)));
typedef float f32x4 __attribute__((ext_vector_type(4)));
typedef unsigned u32x4 __attribute__((ext_vector_type(4)));
constexpr int BM = 256, BK = 64, HALF = 128, HTB = HALF * BK * 2  , STAGE_BYTES = 8 * HTB, NXCD = 8, WGM = 8;

__host__ __device__ __forceinline__ int lds_byte(int r, int c) { const int st = (r >> 4) * 2 + (c >> 5), rr = r & 15, cc = c & 31, ob = rr * 64 + cc * 2; return st * 1024 + (ob ^ (((ob >> 9) & 1) << 5)); }
__host__ __device__ __forceinline__ void stage_rc(int b, int& R, int& C) { const int st = b / 1024, sb = b % 1024, swz = sb ^ (((sb >> 9) & 1) << 5); R = (st >> 1) * 16 + swz / 64; C = (st & 1) * 32 + (swz % 64) / 2; }
__host__ __device__ __forceinline__ int perm32(int rho) { const int n = rho >> 4, i = rho & 15; return 8 * (i >> 2) + 4 * n + (i & 3); }

struct Unit { int pm, pn; };
struct Gemm { const bf16_t* A; const bf16_t* Bt; int M, N, K; };

struct StaticOrder {
    int nM, nN, nwg, G, c;
    __host__ __device__ void init(int M, int N, int G_, int c_) { nM = M / BM; nN = N / BM; nwg = nM * nN; G = G_; c = c_; }
    __host__ __device__ bool next(int i, Unit& u) const {
        const long L = (long)i * G + c; if (L >= nwg) return false;
        int wgid = (int)L; { const int q = nwg / NXCD, r = nwg % NXCD, xcd = wgid % NXCD, off = wgid / NXCD; wgid = (xcd < r ? xcd * (q + 1) : r * (q + 1) + (xcd - r) * q) + off; }
        const int nig = WGM * nN, gid = wgid / nig, fm = gid * WGM, gsz = (nM - fm) < WGM ? (nM - fm) : WGM;
        u.pm = fm + ((wgid % nig) % gsz); u.pn = (wgid % nig) / gsz; return true;
    }
    __device__ __forceinline__ void a_ready(const Unit&) const {}
    __device__ __forceinline__ void done(const Unit&) const {}
};

__device__ __forceinline__ unsigned cvt_pk_bf16(float lo, float hi) { unsigned r; asm volatile("v_cvt_pk_bf16_f32 %0, %1, %2" : "=v"(r) : "v"(lo), "v"(hi)); return r; }
template <class Epi, class Sched, bool ALIGN_EPI = false, bool SP2 = false>
__device__ __forceinline__ void gemm_phase(PG8_LAS unsigned char* lds, const Gemm g, const Sched& S, const Epi& E) {
    int tid_ = threadIdx.x; asm volatile("" : "+v"(tid_));
    const int tid = tid_, wid = __builtin_amdgcn_readfirstlane(tid >> 6), lane = tid & 63, wr = wid >> 2, wc = wid & 3, fr = lane & 15, fq = lane >> 4;
    const int K = g.K, nt = K / BK;
    unsigned voffA[2], voffB[2];
#pragma unroll
    for (int i = 0; i < 2; ++i) { int R, C; stage_rc(tid * 16 + i * 8192, R, C); const int Rb = Epi::PERM ? ((R & ~31) + perm32(R & 31)) : R;
        voffA[i] = (unsigned)(R * K + C) * 2u; voffB[i] = (unsigned)(Rb * K + C) * 2u; }
    const size_t kstep = (size_t)(BK * 2);
    const size_t hstep = (size_t)HALF * K * 2;
    const size_t tstep = 2 * hstep;
    const unsigned ldsw = (unsigned)wid * 1024u;
    const int aoff = lds_byte(wr * 64 + fr, fq * 8), boff = lds_byte(wc * 32 + fr, fq * 8);
#define PG8_SA(b, h) (((b) * 2 + (h)) * HTB)
#define PG8_SB(b, h) ((4 + (b) * 2 + (h)) * HTB)
#define PG8_STAGE(bufoff, gbase, voff) do { _Pragma("unroll") for (int _i = 0; _i < 2; ++_i) \
        __builtin_amdgcn_global_load_lds((const unsigned*)((const char*)(gbase) + (voff)[_i]), (PG8_LAS unsigned*)(lds + (bufoff) + ldsw + _i * 8192), 16, 0, 0); } while (0)
#define PG8_LDA(dst, b, h) do { _Pragma("unroll") for (int m = 0; m < 4; ++m) _Pragma("unroll") for (int k = 0; k < 2; ++k) dst[m][k] = *(const PG8_LAS bf16x8*)(lds + PG8_SA(b, h) + aoff + m * 2048 + k * 1024); } while (0)
#define PG8_LDB(dst, b, h) do { _Pragma("unroll") for (int n = 0; n < 2; ++n) _Pragma("unroll") for (int k = 0; k < 2; ++k) dst[n][k] = *(const PG8_LAS bf16x8*)(lds + PG8_SB(b, h) + boff + n * 2048 + k * 1024); } while (0)
#define PG8_MMA(ai, bj, At, Bt) do { __builtin_amdgcn_s_setprio(1); _Pragma("unroll") for (int m = 0; m < 4; ++m) _Pragma("unroll") for (int n = 0; n < 2; ++n) _Pragma("unroll") for (int k = 0; k < 2; ++k) \
        acc[ai][bj][m][n] = __builtin_amdgcn_mfma_f32_16x16x32_bf16(Bt[n][k], At[m][k], acc[ai][bj][m][n], 0, 0, 0); __builtin_amdgcn_s_setprio(0); } while (0)
#define PG8_WAIT_V(n) asm volatile("s_waitcnt vmcnt(" #n ")" ::: "memory")
#define PG8_WAIT_L(n) asm volatile("s_waitcnt lgkmcnt(" #n ")" ::: "memory")
#define PG8_BAR __builtin_amdgcn_s_barrier()
#define PG8_SCHED __builtin_amdgcn_sched_barrier(0)
    Unit cur, nxt; int ui = 0;
    if (!S.next(0, cur)) return;
    f32x4 acc[2][2][4][2];
#pragma unroll
    for (int a = 0; a < 2; ++a)
#pragma unroll
        for (int b = 0; b < 2; ++b)
#pragma unroll
            for (int m = 0; m < 4; ++m)
#pragma unroll
                for (int n = 0; n < 2; ++n) acc[a][b][m][n] = (f32x4){0.f, 0.f, 0.f, 0.f};
    bf16x8 At[4][2], B0[2][2], B1[2][2];
    const char* cA = (const char*)g.A + (size_t)cur.pm * tstep; const char* cB = (const char*)g.Bt + (size_t)cur.pn * tstep;
    S.a_ready(cur);
    if constexpr (SP2) {
        PG8_STAGE(PG8_SB(0, 0), cB, voffB); PG8_STAGE(PG8_SB(0, 1), cB + hstep, voffB); PG8_STAGE(PG8_SA(0, 0), cA, voffA); PG8_STAGE(PG8_SA(0, 1), cA + hstep, voffA);
        if (wr == 1) PG8_BAR;
        PG8_WAIT_V(2); PG8_BAR;
        PG8_STAGE(PG8_SB(1, 0), cB + kstep, voffB); PG8_STAGE(PG8_SA(1, 0), cA + kstep, voffA); PG8_STAGE(PG8_SB(1, 1), cB + hstep + kstep, voffB);
        PG8_WAIT_V(6); PG8_BAR;
    } else {
        PG8_STAGE(PG8_SB(0, 0), cB, voffB); PG8_STAGE(PG8_SA(0, 0), cA, voffA); PG8_STAGE(PG8_SB(0, 1), cB + hstep, voffB); PG8_STAGE(PG8_SA(0, 1), cA + hstep, voffA);
        if (wr == 1) PG8_BAR;
        PG8_WAIT_V(4); PG8_BAR;
        PG8_STAGE(PG8_SB(1, 0), cB + kstep, voffB); PG8_STAGE(PG8_SA(1, 0), cA + kstep, voffA); PG8_STAGE(PG8_SB(1, 1), cB + hstep + kstep, voffB);
        PG8_WAIT_V(6); PG8_BAR;
    }
    for (;;) {
        const bool has_next = S.next(ui + 1, nxt);
        const char* nA = has_next ? (const char*)g.A + (size_t)nxt.pm * tstep : cA; const char* nB = has_next ? (const char*)g.Bt + (size_t)nxt.pn * tstep : cB;
        for (int t = 0; t < nt; t += 2) {
            const bool last = (t == nt - 2);
            const char* a1 = cA + (size_t)(t + 1) * kstep;
            const char* a2 = last ? nA : cA + (size_t)(t + 2) * kstep; const char* b2 = last ? nB : cB + (size_t)(t + 2) * kstep;
            const char* a3 = a2 + kstep; const char* b3 = b2 + kstep;
            if (last && has_next) S.a_ready(nxt);
            if constexpr (SP2) {
            PG8_LDB(B0, 0, 0); PG8_LDB(B1, 0, 1); PG8_SCHED; PG8_LDA(At, 0, 0); PG8_STAGE(PG8_SA(1, 1), a1 + hstep, voffA);
            PG8_WAIT_V(8); PG8_WAIT_L(0); PG8_BAR; PG8_MMA(0, 0, At, B0); PG8_MMA(0, 1, At, B1); PG8_BAR; PG8_SCHED;
            PG8_LDA(At, 0, 1); PG8_STAGE(PG8_SB(0, 0), b2, voffB); PG8_STAGE(PG8_SB(0, 1), b2 + hstep, voffB); PG8_STAGE(PG8_SA(0, 0), a2, voffA);
            PG8_WAIT_V(8); PG8_WAIT_L(0); PG8_BAR; PG8_MMA(1, 0, At, B0); PG8_MMA(1, 1, At, B1); PG8_BAR; PG8_SCHED;
            PG8_LDB(B0, 1, 0); PG8_LDB(B1, 1, 1); PG8_SCHED; PG8_LDA(At, 1, 0); PG8_STAGE(PG8_SA(0, 1), a2 + hstep, voffA);
            PG8_WAIT_V(8); PG8_WAIT_L(0); PG8_BAR; PG8_MMA(0, 0, At, B0); PG8_MMA(0, 1, At, B1); PG8_BAR; PG8_SCHED;
            PG8_LDA(At, 1, 1); PG8_STAGE(PG8_SB(1, 0), b3, voffB); PG8_STAGE(PG8_SB(1, 1), b3 + hstep, voffB); PG8_STAGE(PG8_SA(1, 0), a3, voffA);
            PG8_WAIT_V(8); PG8_WAIT_L(0); PG8_BAR; PG8_MMA(1, 0, At, B0); PG8_MMA(1, 1, At, B1); PG8_BAR; PG8_SCHED;
            } else {
            PG8_LDB(B0, 0, 0); PG8_SCHED; PG8_LDA(At, 0, 0); PG8_STAGE(PG8_SA(1, 1), a1 + hstep, voffA);
            PG8_WAIT_L(8); PG8_BAR; PG8_WAIT_L(0); PG8_MMA(0, 0, At, B0); PG8_BAR; PG8_SCHED;
            PG8_LDB(B1, 0, 1); PG8_STAGE(PG8_SB(0, 0), b2, voffB);
            PG8_BAR; PG8_WAIT_L(0); PG8_MMA(0, 1, At, B1); PG8_BAR;
            PG8_LDA(At, 0, 1); PG8_STAGE(PG8_SA(0, 0), a2, voffA);
            PG8_BAR; PG8_WAIT_L(0); PG8_MMA(1, 0, At, B0); PG8_BAR; PG8_SCHED;
            PG8_STAGE(PG8_SB(0, 1), b2 + hstep, voffB);
            PG8_WAIT_V(6); PG8_BAR; PG8_MMA(1, 1, At, B1); PG8_BAR;
            PG8_LDB(B0, 1, 0); PG8_SCHED; PG8_LDA(At, 1, 0); PG8_STAGE(PG8_SA(0, 1), a2 + hstep, voffA);
            PG8_WAIT_L(8); PG8_BAR; PG8_WAIT_L(0); PG8_MMA(0, 0, At, B0); PG8_BAR; PG8_SCHED;
            PG8_LDB(B1, 1, 1); PG8_STAGE(PG8_SB(1, 0), b3, voffB);
            PG8_BAR; PG8_WAIT_L(0); PG8_MMA(0, 1, At, B1); PG8_BAR;
            PG8_LDA(At, 1, 1); PG8_STAGE(PG8_SA(1, 0), a3, voffA);
            PG8_BAR; PG8_WAIT_L(0); PG8_MMA(1, 0, At, B0); PG8_BAR; PG8_SCHED;
            PG8_STAGE(PG8_SB(1, 1), b3 + hstep, voffB);
            PG8_WAIT_V(6); PG8_BAR; PG8_MMA(1, 1, At, B1); PG8_BAR;
            }
        }
        if constexpr (ALIGN_EPI) { if (wr == 0) PG8_BAR; }
        if constexpr (!Epi::AFTER_DRAIN) { E(acc, cur, wr, wc, fr, fq); S.done(cur); }
        if (!has_next) break;
#pragma unroll
        for (int a = 0; a < 2; ++a)
#pragma unroll
            for (int b = 0; b < 2; ++b)
#pragma unroll
                for (int m = 0; m < 4; ++m)
#pragma unroll
                    for (int n = 0; n < 2; ++n) acc[a][b][m][n] = (f32x4){0.f, 0.f, 0.f, 0.f};
        cur = nxt; cA = nA; cB = nB; ++ui;
        if constexpr (ALIGN_EPI) { if (wr == 1) PG8_BAR; }
    }
    PG8_WAIT_V(0);
    if constexpr (!ALIGN_EPI) { if (wr == 0) PG8_BAR; }
    PG8_BAR;
    if constexpr (Epi::AFTER_DRAIN) { E.fused(acc, cur, wr, wc, fr, fq, lds, wid, lane); S.done(cur); }
#undef PG8_SA
#undef PG8_SB
#undef PG8_STAGE
#undef PG8_LDA
#undef PG8_LDB
#undef PG8_MMA
#undef PG8_WAIT_V
#undef PG8_WAIT_L
#undef PG8_BAR
#undef PG8_SCHED
}
}
#define XB_TMO      128
#define XB_XCNT(j)  (256  + 64 * (j))
#define XB_XSUB(j)  (1280 + 64 * (j))
#define XB_XGEN(j)  (2304 + 64 * (j))
#define XB_TOP      3328
#define XB_TOPGEN   3392
#define XCD_BAR_WORDS 3456
#define XB_SPIN_CAP (1u << 18)
#define LAS __attribute__((address_space(3)))

__device__ __forceinline__ unsigned xb_ld(unsigned* p)              { return __hip_atomic_load(p, __ATOMIC_RELAXED, __HIP_MEMORY_SCOPE_AGENT); }
__device__ __forceinline__ unsigned xb_add(unsigned* p, unsigned v) { return __hip_atomic_fetch_add(p, v, __ATOMIC_RELAXED, __HIP_MEMORY_SCOPE_AGENT); }
__device__ __forceinline__ unsigned xb_xcc_id() { return (unsigned)__builtin_amdgcn_s_getreg((3 << 11) | 20) & 0xFu; }
#define XB_SPIN(cond, bar) do { unsigned _sp = 0; while (cond) { __builtin_amdgcn_s_sleep(1); \
    if ((++_sp & 255u) == 0u) { if (xb_ld(&(bar)[XB_TMO])) break; if (_sp > XB_SPIN_CAP) { atomicAdd(&(bar)[XB_TMO], 1u); break; } } } } while (0)

struct XcdBarrier {
    unsigned* bar; unsigned x;
    volatile LAS unsigned* st;
};

__device__ __forceinline__ XcdBarrier xcd_barrier_post(unsigned* bar, volatile LAS unsigned* st) {
    XcdBarrier b; b.bar = bar; b.x = xb_xcc_id(); b.st = st;
    if (threadIdx.x == 0) (void)xb_add(&bar[XB_XCNT(b.x)], 1u);
    return b;
}
__device__ __forceinline__ void xcd_barrier_complete(unsigned* bar, unsigned x, unsigned& nloc, unsigned& nx) {
    const unsigned G = gridDim.x * gridDim.y * gridDim.z;
    unsigned sum, cnt, mine, sp = 0u;
    for (;;) {
        sum = 0u; cnt = 0u; mine = 0u;
#pragma unroll
        for (unsigned j = 0; j < 16; ++j) { const unsigned c = xb_ld(&bar[XB_XCNT(j)]); sum += c; cnt += (c > 0u) ? 1u : 0u; mine = (j == x) ? c : mine; }
        if (sum == G) break;
        __builtin_amdgcn_s_sleep(1);
        if ((++sp & 255u) == 0u) { if (xb_ld(&bar[XB_TMO])) break; if (sp > XB_SPIN_CAP) { atomicAdd(&bar[XB_TMO], 1u); break; } }
    }
    nloc = mine > 0u ? mine : 1u; nx = cnt > 0u ? cnt : 1u;
}

__device__ __forceinline__ void xcd_barrier(const XcdBarrier& b) {
    asm volatile("s_waitcnt vmcnt(0)" ::: "memory");
    __syncthreads();
    if (threadIdx.x == 0) {
        unsigned* bar = b.bar;
        __builtin_amdgcn_s_waitcnt(0);
        unsigned nloc = b.st[0], nx = b.st[1];
        if (nloc == 0u) { xcd_barrier_complete(bar, b.x, nloc, nx); b.st[0] = nloc; b.st[1] = nx; }
        const unsigned old = xb_add(&bar[XB_XSUB(b.x)], 1u);
        const unsigned gen = old / nloc;
        if (old + 1u == (gen + 1u) * nloc) {
            __builtin_amdgcn_fence(__ATOMIC_RELEASE, "agent");
            asm volatile("s_waitcnt vmcnt(0)" ::: "memory");
            const unsigned og = xb_add(&bar[XB_TOP], 1u);
            const unsigned tg = og / nx;
            if (og + 1u == (tg + 1u) * nx) xb_add(&bar[XB_TOPGEN], 1u);
            else XB_SPIN(xb_ld(&bar[XB_TOPGEN]) == tg, bar);
            __builtin_amdgcn_fence(__ATOMIC_ACQUIRE, "agent");
            xb_add(&bar[XB_XGEN(b.x)], 1u);
            asm volatile("s_waitcnt vmcnt(0)" ::: "memory");
        } else {
            XB_SPIN(xb_ld(&bar[XB_XGEN(b.x)]) == gen, bar);
            __builtin_amdgcn_fence(__ATOMIC_ACQUIRE, "agent");
            asm volatile("s_waitcnt vmcnt(0)" ::: "memory");
        }
    }
    __syncthreads();
}


typedef unsigned short bf16;
typedef pg8::f32x4 f32x4;
typedef pg8::u32x4 u32x4;
constexpr int NB = 8, SEQ = 4096, DM = 1024, NCTX = 256;
constexpr int TL = NB * SEQ, TC = NB * NCTX, TA = TL + TC;
constexpr int INW = 6144, GW = 512, NGRP = 12;
constexpr size_t GSTRIDE = (size_t)TA * GW;
constexpr float EPS = 1e-6f;
constexpr int SLOT_ROWS = 73728;

constexpr size_t MiB = (size_t)1 << 20;
constexpr size_t WS_CTL = 0, CTL_BYTES = 1 * MiB;
constexpr size_t WS_MOD = 1 * MiB;
constexpr size_t WS_LB = 1 * MiB + 512 * 1024;
constexpr size_t WS_ROPE = 2 * MiB;
constexpr size_t WS_TOK = 3 * MiB;
constexpr size_t WS_CTXS = 4 * MiB;
constexpr size_t WS_WB = 12 * MiB;
constexpr size_t WS_H = 28 * MiB;
constexpr size_t WS_P = 96 * MiB;
constexpr size_t P_M = 34 * MiB, P_WEGU = 102 * MiB, P_WED = 134 * MiB, P_XS = 150 * MiB, P_ACT = 294 * MiB;
constexpr size_t WS_END = 504 * MiB;
constexpr int CW_BAR = 4096, CW_CNT = 131072;

constexpr int LDS_STAGE = 131072, LDS_BYTES = 147456;
constexpr int LDSW_BAR = 0, LDSW_TAB = 16;

struct Params {
    const float* x; const float* c; const float* ctx; const float* c_ctx; const float* w_ada; const float* b_ada; const float* norm1_g; const float* w_in;
    const float* rel_bias; const float* lowf; const float* lowb; const float* hg_norm_g; const float* w_na_o; const float* w_hg_o; const float* w_out; const float* norm2_g;
    const float* w_router; const float* router_bias; const float* w_gate; const float* w_up; const float* w_down; const float* final_g;
    float* out; unsigned char* ws; int lo, hi, li, pad;
};

__device__ __forceinline__ float bf2f(unsigned b) { return __uint_as_float(b << 16); }
__device__ __forceinline__ float bflo(unsigned w) { return __uint_as_float(w << 16); }
__device__ __forceinline__ float bfhi(unsigned w) { return __uint_as_float(w & 0xffff0000u); }
__device__ __forceinline__ unsigned f2bf(float f) { unsigned u = __float_as_uint(f); u += 0x7FFFu + ((u >> 16) & 1u); return u >> 16; }
__device__ __forceinline__ unsigned pk2(float lo, float hi) { return f2bf(lo) | (f2bf(hi) << 16); }
__device__ __forceinline__ float sigm(float x) { return 1.f / (1.f + __expf(-x)); }
__device__ __forceinline__ float silu(float x) { return x / (1.f + __expf(-x)); }
__device__ __forceinline__ float wave_sum(float v) {
#pragma unroll
    for (int o = 32; o >= 1; o >>= 1) v += __shfl_xor(v, o);
    return v; }
__device__ __forceinline__ float wave_max(float v) {
#pragma unroll
    for (int o = 32; o >= 1; o >>= 1) v = fmaxf(v, __shfl_xor(v, o));
    return v; }
__device__ __forceinline__ void unpack8(const uint4 w, float (&f)[8]) {
    f[0] = bflo(w.x); f[1] = bfhi(w.x); f[2] = bflo(w.y); f[3] = bfhi(w.y); f[4] = bflo(w.z); f[5] = bfhi(w.z); f[6] = bflo(w.w); f[7] = bfhi(w.w); }

typedef const __attribute__((address_space(4))) Params* ParamsK;
struct PView { ParamsK q; __device__ __forceinline__ const __attribute__((address_space(4))) Params* operator->() const { return q; } };
struct Ctx {
    PView p; unsigned char* ws; unsigned char* lds; int tid, lane, wave, G, bid, gw, nw;
    __device__ __forceinline__ float* MOD() const { return (float*)(ws + WS_MOD); }
    __device__ __forceinline__ float* LB() const { return (float*)(ws + WS_LB); }
    __device__ __forceinline__ float2* ROPE() const { return (float2*)(ws + WS_ROPE); }
    __device__ __forceinline__ int* TOKE() const { return (int*)(ws + WS_TOK); }
    __device__ __forceinline__ float* TOKW() const { return (float*)(ws + WS_TOK) + 2 * TA; }
    __device__ __forceinline__ int* TOKS() const { return (int*)(ws + WS_TOK) + 4 * TA; }
    __device__ __forceinline__ float* CTXS() const { return (float*)(ws + WS_CTXS); }
    __device__ __forceinline__ bf16* WIN_T() const { return (bf16*)(ws + WS_WB); }
    __device__ __forceinline__ bf16* WNA_T() const { return (bf16*)(ws + WS_WB + 12 * MiB); }
    __device__ __forceinline__ bf16* WHG_T() const { return (bf16*)(ws + WS_WB + 13 * MiB); }
    __device__ __forceinline__ bf16* WOUT_T() const { return (bf16*)(ws + WS_WB + 14 * MiB); }
    __device__ __forceinline__ bf16* H() const { return (bf16*)(ws + WS_H); }
    __device__ __forceinline__ bf16* GRP(int g) const { return (bf16*)(ws + WS_P) + (size_t)g * GSTRIDE; }
    __device__ __forceinline__ bf16* MB() const { return (bf16*)(ws + WS_P + P_M); }
    __device__ __forceinline__ bf16* WEGU() const { return (bf16*)(ws + WS_P + P_WEGU); }
    __device__ __forceinline__ bf16* WED() const { return (bf16*)(ws + WS_P + P_WED); }
    __device__ __forceinline__ bf16* XS() const { return (bf16*)(ws + WS_P + P_XS); }
    __device__ __forceinline__ bf16* ACT() const { return (bf16*)(ws + WS_P + P_ACT); }
    __device__ __forceinline__ unsigned* CTL() const { return (unsigned*)(ws + WS_CTL); }
    __device__ __forceinline__ unsigned* CNT(int l) const { return (unsigned*)(ws + WS_CTL) + CW_CNT + l * 64; }
    __device__ __forceinline__ int* TAB() const { return (int*)(lds + LDS_STAGE) + LDSW_TAB; }
};

template <class RowMap>
__device__ __forceinline__ void tconv_tile(const float* __restrict__ src, int ldsrc, int k0, int n0, bf16* __restrict__ dst, int ldd, int lane, RowMap rm) {
    float v[64];
    const float* s = src + (size_t)k0 * ldsrc + n0 + lane;
#pragma unroll
    for (int k = 0; k < 64; ++k) { v[k] = *s; s += ldsrc; asm volatile("" : "+v"(s)); }
    bf16* d = dst + (size_t)rm(n0 + lane) * ldd + k0;
#pragma unroll
    for (int j = 0; j < 8; ++j) { uint4 w; w.x = pk2(v[8 * j], v[8 * j + 1]); w.y = pk2(v[8 * j + 2], v[8 * j + 3]); w.z = pk2(v[8 * j + 4], v[8 * j + 5]); w.w = pk2(v[8 * j + 6], v[8 * j + 7]);
        *(uint4*)(d + 8 * j) = w; }
}
struct RmId { __device__ __forceinline__ int operator()(int n) const { return n; } };
struct RmGU { int base; __device__ __forceinline__ int operator()(int n) const { return base + (n >> 7) * 256 + (n & 127); } };

__device__ __forceinline__ void conv_mixer(const Ctx& C, int l) {
    for (int id = C.gw; id < 2048; id += C.nw) {
        if (id < 1536) { const int kt = id & 15, nt = id >> 4; tconv_tile(C.p->w_in + (size_t)l * DM * INW, INW, kt * 64, nt * 64, C.WIN_T(), DM, C.lane, RmId()); }
        else if (id < 1664) { const int j = id - 1536, kt = j & 7, nt = j >> 3; tconv_tile(C.p->w_na_o + (size_t)l * 512 * DM, DM, kt * 64, nt * 64, C.WNA_T(), 512, C.lane, RmId()); }
        else if (id < 1792) { const int j = id - 1664, kt = j & 7, nt = j >> 3; tconv_tile(C.p->w_hg_o + (size_t)l * 512 * DM, DM, kt * 64, nt * 64, C.WHG_T(), 512, C.lane, RmId()); }
        else { const int j = id - 1792, kt = j & 15, nt = j >> 4; tconv_tile(C.p->w_out + (size_t)l * DM * DM, DM, kt * 64, nt * 64, C.WOUT_T(), DM, C.lane, RmId()); }
    }
}
__device__ __forceinline__ void conv_experts(const Ctx& C, int l) {
    for (int id = C.gw; id < 6144; id += C.nw) {
        const int e = id / 384, j = id % 384;
        if (j < 128) { const int kt = j & 15, nt = j >> 4; tconv_tile(C.p->w_gate + ((size_t)l * 16 + e) * DM * 512, 512, kt * 64, nt * 64, C.WEGU(), DM, C.lane, RmGU{e * 1024}); }
        else if (j < 256) { const int jj = j - 128, kt = jj & 15, nt = jj >> 4; tconv_tile(C.p->w_up + ((size_t)l * 16 + e) * DM * 512, 512, kt * 64, nt * 64, C.WEGU(), DM, C.lane, RmGU{e * 1024 + 128}); }
        else { const int jj = j - 256, kt = jj & 7, nt = jj >> 3; tconv_tile(C.p->w_down + ((size_t)l * 16 + e) * 512 * DM, DM, kt * 64, nt * 64, C.WED() + (size_t)e * 1024 * 512, 512, C.lane, RmId()); }
    }
}

__device__ __forceinline__ void p0_prologue(const Ctx& C) {
    for (int u = C.bid; u < 24; u += C.G) {
        float* sl = (float*)C.lds;
        for (int i = C.tid; i < 9 * 1024; i += 512) { const int r = i >> 10, k = i & 1023; const float v = (r < 8) ? C.p->c[r * 1024 + k] : C.p->c_ctx[k]; sl[i] = v / (1.f + expf(-v)); }
        __syncthreads();
        const int l = u / 12, n = (u % 12) * 512 + C.tid;
        const float* w = C.p->w_ada + (size_t)l * DM * INW + n;
        float acc[9];
#pragma unroll
        for (int r = 0; r < 9; ++r) acc[r] = 0.f;
#pragma unroll 8
        for (int k = 0; k < 1024; ++k) { const float wv = w[(size_t)k * INW];
#pragma unroll
            for (int r = 0; r < 9; ++r) acc[r] += sl[r * 1024 + k] * wv; }
        const float bb = C.p->b_ada[l * INW + n];
#pragma unroll
        for (int r = 0; r < 9; ++r) C.MOD()[(size_t)(l * 9 + r) * INW + n] = acc[r] + bb;
        __syncthreads();
    }
    const int gt = C.bid * 512 + C.tid, nthr = C.G * 512;
    for (int i = gt; i < 4096 * 32; i += nthr) { const int t = i >> 5, pr = i & 31; const float pos = (float)((pr < 16) ? (t >> 6) : (t & 63)); const int j = pr & 15;
        const float inv = powf(10000.f, -(float)(2 * j) / 32.f); const float ang = pos * inv; C.ROPE()[i] = make_float2(cosf(ang), sinf(ang)); }
    for (int i = gt; i < 1024; i += nthr) { const int dir = i >> 9, ch = i & 511; const float* raw = dir ? C.p->lowb : C.p->lowf; const float r0 = raw[ch], r1 = raw[512 + ch];
        const float p1 = 1.f / (1.f + expf(r0 - r1)); C.LB()[(0 * 2 + dir) * 512 + ch] = 0.f; C.LB()[(1 * 2 + dir) * 512 + ch] = p1; }
    conv_mixer(C, 0);
}

__device__ __forceinline__ void load_row(const float* xr, int lane, float (&v)[16]) {
#pragma unroll
    for (int j = 0; j < 4; ++j) { const float4 t = *(const float4*)(xr + j * 256 + lane * 4); v[4 * j] = t.x; v[4 * j + 1] = t.y; v[4 * j + 2] = t.z; v[4 * j + 3] = t.w; }
}
__device__ __forceinline__ float row_rinv(const float (&v)[16]) {
    float ss = 0.f;
#pragma unroll
    for (int i = 0; i < 16; ++i) ss += v[i] * v[i];
    ss = wave_sum(ss);
    return rsqrtf(ss * (1.f / 1024.f) + EPS);
}
__device__ __forceinline__ void norm_mod(const float (&v)[16], float rinv, const float* gam, const float* sc, const float* sh, int lane, float (&h)[16]) {
#pragma unroll
    for (int j = 0; j < 4; ++j) { const int c = j * 256 + lane * 4; const float4 g = *(const float4*)(gam + c), s = *(const float4*)(sc + c), b = *(const float4*)(sh + c);
        h[4 * j] = v[4 * j] * rinv * g.x * (1.f + s.x) + b.x; h[4 * j + 1] = v[4 * j + 1] * rinv * g.y * (1.f + s.y) + b.y;
        h[4 * j + 2] = v[4 * j + 2] * rinv * g.z * (1.f + s.z) + b.z; h[4 * j + 3] = v[4 * j + 3] * rinv * g.w * (1.f + s.w) + b.w; }
}
__device__ __forceinline__ void store_row_bf16(bf16* hr, int lane, const float (&h)[16]) {
#pragma unroll
    for (int j = 0; j < 4; ++j) { uint2 w; w.x = pk2(h[4 * j], h[4 * j + 1]); w.y = pk2(h[4 * j + 2], h[4 * j + 3]); *(uint2*)(hr + j * 256 + lane * 4) = w; }
}
__device__ __forceinline__ int modrow_of(int r) { return r < TL ? (r >> 12) : 8; }

__device__ __forceinline__ void p1_norm1(const Ctx& C, int l, const float* xl, const float* xc) {
    for (int r = C.gw; r < TA; r += C.nw) {
        const float* xr = r < TL ? xl + (size_t)r * DM : xc + (size_t)(r - TL) * DM;
        float v[16], h[16]; load_row(xr, C.lane, v);
        const float rinv = row_rinv(v);
        const float* mod = C.MOD() + (size_t)(l * 9 + modrow_of(r)) * INW;
        norm_mod(v, rinv, C.p->norm1_g + l * DM, mod + 1024, mod, C.lane, h);
        store_row_bf16(C.H() + (size_t)r * DM, C.lane, h);
    }
}

struct EpiInProj {
    static constexpr bool PERM = true, AFTER_DRAIN = false;
    bf16* P; const float2* rope; const float* lbl;
    __device__ __forceinline__ void operator()(const f32x4 (&acc)[2][2][4][2], const pg8::Unit& u, int wr, int wc, int fr, int fq) const {
        const int grp = u.pn >> 1; bf16* base = P + (size_t)grp * GSTRIDE;
        const int colb = (u.pn & 1) * 256 + wc * 32 + 8 * fq;
        const bool do_rope = (grp < 2) && (u.pm < TL / 256);
#pragma unroll
        for (int ai = 0; ai < 2; ++ai)
#pragma unroll
            for (int m = 0; m < 4; ++m) { const int row = u.pm * 256 + ai * 128 + wr * 64 + m * 16 + fr;
#pragma unroll
                for (int bj = 0; bj < 2; ++bj) { const int col = colb + bj * 128; f32x4 v0 = acc[ai][bj][m][0], v1 = acc[ai][bj][m][1];
                    if (do_rope) { const float4* rp = (const float4*)(rope + (size_t)(row & 4095) * 32 + ((col & 63) >> 1)); const float4 c01 = rp[0], c23 = rp[1];
                        const f32x4 a = v0, b = v1;
                        v0[0] = a[0] * c01.x - a[1] * c01.y; v0[1] = a[0] * c01.y + a[1] * c01.x; v0[2] = a[2] * c01.z - a[3] * c01.w; v0[3] = a[2] * c01.w + a[3] * c01.z;
                        v1[0] = b[0] * c23.x - b[1] * c23.y; v1[1] = b[0] * c23.y + b[1] * c23.x; v1[2] = b[2] * c23.z - b[3] * c23.w; v1[3] = b[2] * c23.w + b[3] * c23.z; }
                    if (grp == 3) {
#pragma unroll
                        for (int i = 0; i < 4; ++i) { v0[i] = silu(v0[i]); v1[i] = silu(v1[i]); }
                    } else if (grp == 4 || grp == 5) {
                        const float* lp = lbl + (grp - 4) * 512 + col; const f32x4 l0 = *(const f32x4*)lp, l1 = *(const f32x4*)(lp + 4);
#pragma unroll
                        for (int i = 0; i < 4; ++i) { v0[i] = fmaxf(l0[i] + (1.f - l0[i]) * sigm(v0[i]), 1e-30f); v1[i] = fmaxf(l1[i] + (1.f - l1[i]) * sigm(v1[i]), 1e-30f); }
                    }
                    if (grp == 2) {
                        const int hh = col >> 6, d0 = col & 63; const bool lat = row < TL;
                        const int bb = lat ? (row >> 12) : ((row - TL) >> 8), tt = lat ? (row & 4095) : ((row - TL) & 255);
                        bf16* vp = lat ? base + ((size_t)((bb * 8 + hh) * 64 + d0) << 12) + tt : base + (size_t)TL * GW + ((size_t)((bb * 8 + hh) * 64 + d0) << 8) + tt;
                        const size_t st = lat ? 4096 : 256;
#pragma unroll
                        for (int i = 0; i < 4; ++i) { vp[(size_t)i * st] = (bf16)f2bf(v0[i]); vp[(size_t)(4 + i) * st] = (bf16)f2bf(v1[i]); }
                    } else {
                    u32x4 w; w.x = pg8::cvt_pk_bf16(v0[0], v0[1]); w.y = pg8::cvt_pk_bf16(v0[2], v0[3]); w.z = pg8::cvt_pk_bf16(v1[0], v1[1]); w.w = pg8::cvt_pk_bf16(v1[2], v1[3]);
                    *(u32x4*)(base + (size_t)row * GW + col) = w; } } }
    }
};
template <int PASS> struct EpiMerge {
    static constexpr bool PERM = true, AFTER_DRAIN = false;
    bf16* M; const bf16* G;
    __device__ __forceinline__ void operator()(const f32x4 (&acc)[2][2][4][2], const pg8::Unit& u, int wr, int wc, int fr, int fq) const {
        const bf16* gb = G + (size_t)(u.pn >> 1) * GSTRIDE; const int gcol = (u.pn & 1) * 256 + wc * 32 + 8 * fq, mcol = u.pn * 256 + wc * 32 + 8 * fq;
#pragma unroll
        for (int ai = 0; ai < 2; ++ai)
#pragma unroll
            for (int m = 0; m < 4; ++m) { const int row = u.pm * 256 + ai * 128 + wr * 64 + m * 16 + fr;
#pragma unroll
                for (int bj = 0; bj < 2; ++bj) { const uint4 gw = *(const uint4*)(gb + (size_t)row * GW + gcol + bj * 128); float g[8]; unpack8(gw, g);
                    bf16* mp = M + (size_t)row * DM + mcol + bj * 128; const f32x4 v0 = acc[ai][bj][m][0], v1 = acc[ai][bj][m][1];
                    float o[8];
#pragma unroll
                    for (int i = 0; i < 4; ++i) { o[i] = sigm(g[i]) * v0[i]; o[4 + i] = sigm(g[4 + i]) * v1[i]; }
                    if (PASS == 1) { const uint4 mw = *(const uint4*)mp; float pm_[8]; unpack8(mw, pm_);
#pragma unroll
                        for (int i = 0; i < 8; ++i) o[i] += pm_[i]; }
                    u32x4 w; w.x = pg8::cvt_pk_bf16(o[0], o[1]); w.y = pg8::cvt_pk_bf16(o[2], o[3]); w.z = pg8::cvt_pk_bf16(o[4], o[5]); w.w = pg8::cvt_pk_bf16(o[6], o[7]);
                    *(u32x4*)mp = w; } }
    }
};
struct EpiOut {
    static constexpr bool PERM = false, AFTER_DRAIN = false;
    const float* xl_src; float* xl_dst; const float* xc_src; float* xc_dst; const float* mod;
    __device__ __forceinline__ void operator()(const f32x4 (&acc)[2][2][4][2], const pg8::Unit& u, int wr, int wc, int fr, int fq) const {
        const bool lat = u.pm < TL / 256; const int mr = lat ? (u.pm >> 4) : 8;
        const float* gate = mod + (size_t)mr * INW + 2048; const int col0 = u.pn * 256 + wc * 32 + 4 * fq;
        const float* src = lat ? xl_src : xc_src - (size_t)TL * DM; float* dst = lat ? xl_dst : xc_dst - (size_t)TL * DM;
        f32x4 gv[2][2];
#pragma unroll
        for (int bj = 0; bj < 2; ++bj)
#pragma unroll
            for (int n = 0; n < 2; ++n) gv[bj][n] = *(const f32x4*)(gate + col0 + bj * 128 + n * 16);
#pragma unroll
        for (int ai = 0; ai < 2; ++ai)
#pragma unroll
            for (int m = 0; m < 4; ++m) { const size_t off = (size_t)(u.pm * 256 + ai * 128 + wr * 64 + m * 16 + fr) * DM + col0;
#pragma unroll
                for (int bj = 0; bj < 2; ++bj)
#pragma unroll
                    for (int n = 0; n < 2; ++n) { const f32x4 xo = *(const f32x4*)(src + off + bj * 128 + n * 16); *(f32x4*)(dst + off + bj * 128 + n * 16) = xo + gv[bj][n] * acc[ai][bj][m][n]; } }
    }
};
struct EpiGateUp {
    static constexpr bool PERM = true, AFTER_DRAIN = false;
    bf16* A;
    __device__ __forceinline__ void operator()(const f32x4 (&acc)[2][2][4][2], const pg8::Unit& u, int wr, int wc, int fr, int fq) const {
        const int col = (u.pn & 3) * 128 + wc * 32 + 8 * fq;
#pragma unroll
        for (int ai = 0; ai < 2; ++ai)
#pragma unroll
            for (int m = 0; m < 4; ++m) { const int row = u.pm * 256 + ai * 128 + wr * 64 + m * 16 + fr; float o[8];
#pragma unroll
                for (int i = 0; i < 4; ++i) { o[i] = silu(acc[ai][0][m][0][i]) * acc[ai][1][m][0][i]; o[4 + i] = silu(acc[ai][0][m][1][i]) * acc[ai][1][m][1][i]; }
                u32x4 w; w.x = pg8::cvt_pk_bf16(o[0], o[1]); w.y = pg8::cvt_pk_bf16(o[2], o[3]); w.z = pg8::cvt_pk_bf16(o[4], o[5]); w.w = pg8::cvt_pk_bf16(o[6], o[7]);
                *(u32x4*)(A + (size_t)row * 512 + col) = w; }
    }
};
struct EpiDown {
    static constexpr bool PERM = true, AFTER_DRAIN = false;
    bf16* Y;
    __device__ __forceinline__ void operator()(const f32x4 (&acc)[2][2][4][2], const pg8::Unit& u, int wr, int wc, int fr, int fq) const {
        const int col = (u.pn & 3) * 256 + wc * 32 + 8 * fq;
#pragma unroll
        for (int ai = 0; ai < 2; ++ai)
#pragma unroll
            for (int m = 0; m < 4; ++m) { const int row = u.pm * 256 + ai * 128 + wr * 64 + m * 16 + fr;
#pragma unroll
                for (int bj = 0; bj < 2; ++bj) { const f32x4 v0 = acc[ai][bj][m][0], v1 = acc[ai][bj][m][1];
                    u32x4 w; w.x = pg8::cvt_pk_bf16(v0[0], v0[1]); w.y = pg8::cvt_pk_bf16(v0[2], v0[3]); w.z = pg8::cvt_pk_bf16(v1[0], v1[1]); w.w = pg8::cvt_pk_bf16(v1[2], v1[3]);
                    *(u32x4*)(Y + (size_t)row * DM + col + bj * 128) = w; } }
    }
};
struct MoeOrder {
    const int* tab; int G, c;
    __device__ __forceinline__ bool next(int i, pg8::Unit& u) const {
        const int L = i * G + c, MT = tab[16]; if (L >= MT * 4) return false;
        const int mt = L >> 2; int e = 0;
#pragma unroll
        for (int j = 1; j < 16; ++j) e += (mt >= tab[j]) ? 1 : 0;
        u.pm = mt; u.pn = e * 4 + (L & 3); return true;
    }
    __device__ __forceinline__ void a_ready(const pg8::Unit&) const {}
    __device__ __forceinline__ void done(const pg8::Unit&) const {}
};
__device__ __forceinline__ void moe_table(const Ctx& C, int l) {
    __syncthreads();
    if (C.tid == 0) { int acc = 0; const unsigned* cnt = C.CNT(l);
        for (int e = 0; e < 16; ++e) { C.TAB()[e] = acc; acc += (int)((__hip_atomic_load(cnt + e, __ATOMIC_RELAXED, __HIP_MEMORY_SCOPE_AGENT) + 255u) >> 8); }
        C.TAB()[16] = acc; }
    __syncthreads();
}

__device__ __forceinline__ void p3_attn_naive(const Ctx& C, int l) {
    float* pl = (float*)C.lds + C.wave * 768; int* kl = (int*)(pl + 384);
    const bf16* Q = C.GRP(0); const bf16* K = C.GRP(1); const bf16* V = C.GRP(2); bf16* O = C.GRP(0);
    const int nq = (l == 0 ? TA : TL) * 8;
    for (int wq = C.gw; wq < nq; wq += C.nw) {
        const int r = wq >> 3, h = wq & 7; const bool lat = r < TL;
        const int b = lat ? (r >> 12) : ((r - TL) >> 8);
        float q[64];
        { const uint4* qp = (const uint4*)(Q + (size_t)r * GW + h * 64);
#pragma unroll
          for (int j = 0; j < 8; ++j) { float t[8]; unpack8(qp[j], t);
#pragma unroll
              for (int i = 0; i < 8; ++i) q[8 * j + i] = t[i]; } }
        const int t = r & 4095, gr = t >> 6, gc = t & 63;
        const int rs = min(max(gr - 4, 0), 56), cs = min(max(gc - 8, 0), 48);
        float s[6]; int krow[6];
#pragma unroll
        for (int i = 0; i < 6; ++i) {
            float bias = 0.f; bool valid = true;
            if (i < 2) { const int j = C.lane + 64 * i, kr = rs + (j >> 4), kc = cs + (j & 15); krow[i] = b * 4096 + kr * 64 + kc; valid = lat;
                if (lat) bias = C.p->rel_bias[((size_t)(l * 8 + h) * 15 + (kr - gr + 7)) * 31 + (kc - gc + 15)]; if (!lat) krow[i] = TL + b * 256; }
            else krow[i] = TL + b * 256 + C.lane + 64 * (i - 2);
            const uint4* kp = (const uint4*)(K + (size_t)krow[i] * GW + h * 64); float d = 0.f;
#pragma unroll
            for (int j = 0; j < 8; ++j) { float tk[8]; unpack8(kp[j], tk);
#pragma unroll
                for (int ii = 0; ii < 8; ++ii) d += q[8 * j + ii] * tk[ii]; }
            s[i] = valid ? d * 0.125f + bias : -1e30f;
        }
        float mx = s[0];
#pragma unroll
        for (int i = 1; i < 6; ++i) mx = fmaxf(mx, s[i]);
        mx = wave_max(mx);
        float sum = 0.f;
#pragma unroll
        for (int i = 0; i < 6; ++i) { s[i] = (s[i] > -1e29f) ? __expf(s[i] - mx) : 0.f; sum += s[i]; }
        sum = wave_sum(sum); const float inv = 1.f / sum;
#pragma unroll
        for (int i = 0; i < 6; ++i) { pl[C.lane + 64 * i] = s[i] * inv; kl[C.lane + 64 * i] = krow[i]; }
        float acc = 0.f;
        for (int j = lat ? 0 : 128; j < 384; ++j) acc += pl[j] * bf2f(V[(size_t)kl[j] * GW + h * 64 + C.lane]);
        O[(size_t)r * GW + h * 64 + C.lane] = (bf16)f2bf(acc);
    }
}


typedef pg8::bf16x8 bf16x8;
typedef unsigned u32x2 __attribute__((ext_vector_type(2)));
__device__ __forceinline__ bf16x8 ld16(const bf16* p) { return *(const bf16x8*)p; }
__device__ __forceinline__ bf16x8 ld8x2(const bf16* p0, const bf16* p1) { const u32x2 a = *(const u32x2*)p0, b = *(const u32x2*)p1; u32x4 w; w.x = a.x; w.y = a.y; w.z = b.x; w.w = b.y; return __builtin_bit_cast(bf16x8, w); }
__device__ __forceinline__ bf16x8 pack8(const f32x4 a, const f32x4 b) { u32x4 w; w.x = pg8::cvt_pk_bf16(a[0], a[1]); w.y = pg8::cvt_pk_bf16(a[2], a[3]); w.z = pg8::cvt_pk_bf16(b[0], b[1]); w.w = pg8::cvt_pk_bf16(b[2], b[3]); return __builtin_bit_cast(bf16x8, w); }
#define MFMA16(a, b, c) __builtin_amdgcn_mfma_f32_16x16x32_bf16(a, b, c, 0, 0, 0)

__device__ __forceinline__ void p3_attn(const Ctx& C, int l, bool dry = false) {
    float* relb = (float*)(C.lds + 98304);
    __syncthreads();
    for (int i = C.tid; i < 8 * 15 * 32; i += 512) { const int dc = i & 31, hd = i >> 5; relb[i] = (dc < 31) ? C.p->rel_bias[(size_t)l * 8 * 15 * 31 + hd * 31 + dc] : 0.f; }
    __syncthreads();
    const bf16* Qb = C.GRP(0); const bf16* Kb = C.GRP(1); const bf16* VT = C.GRP(2); const bf16* VTc = C.GRP(2) + (size_t)TL * GW; bf16* Ob = C.GRP(0);
    const int lq = C.lane & 15, g = C.lane >> 4;
    const int nlat = 16384, nu = nlat + (l == 0 ? 1024 : 0);
    for (int u = C.gw; u < nu; u += C.nw) {
        const bool lat = u < nlat;
        int b, h, gr = 0, gc0 = 0, qrow0;
        if (lat) { const int ct = u & 3; h = (u >> 2) & 7; gr = (u >> 5) & 63; b = u >> 11; gc0 = ct * 16; qrow0 = b * 4096 + gr * 64 + gc0; }
        else { const int v = u - nlat, qt = v & 15; h = (v >> 4) & 7; b = v >> 7; qrow0 = TL + b * 256 + qt * 16; }
        const int rs = min(max(gr - 4, 0), 56), u0 = min(max(gc0 - 8, 0), 32);
        const bf16* qp = Qb + (size_t)(qrow0 + lq) * GW + h * 64 + 8 * g;
        const bf16x8 q0 = ld16(qp), q1 = ld16(qp + 32);
        f32x4 s[32];
        const f32x4 z4 = {0.f, 0.f, 0.f, 0.f};
        if (lat) {
            const int gcq = gc0 + lq, csq = min(max(gcq - 8, 0), 48);
#pragma unroll
            for (int wt = 0; wt < 16; ++wt) { const int wrow = wt >> 1, half = wt & 1;
                const bf16* kp = Kb + (size_t)(b * 4096 + (rs + wrow) * 64 + u0 + 16 * half + lq) * GW + h * 64 + 8 * g;
                f32x4 a = MFMA16(ld16(kp), q0, z4); a = MFMA16(ld16(kp + 32), q1, a);
                const float* brow = relb + (h * 15 + (rs + wrow - gr + 7)) * 32;
#pragma unroll
                for (int r = 0; r < 4; ++r) { const int kc = u0 + 16 * half + 4 * g + r; const bool valid = (kc >= csq) && (kc < csq + 16); const int dc = min(max(kc - gcq + 15, 0), 30);
                    a[r] = valid ? a[r] * 0.125f + brow[dc] : -1e30f; }
                s[wt] = a; }
        } else {
#pragma unroll
            for (int wt = 0; wt < 16; ++wt) s[wt] = (f32x4){-1e30f, -1e30f, -1e30f, -1e30f};
        }
#pragma unroll
        for (int ctile = 0; ctile < 16; ++ctile) {
            const bf16* kp = Kb + (size_t)(TL + b * 256 + ctile * 16 + lq) * GW + h * 64 + 8 * g;
            f32x4 a = MFMA16(ld16(kp), q0, z4); a = MFMA16(ld16(kp + 32), q1, a);
            s[16 + ctile] = a * 0.125f; }
        float mx = -1e30f;
#pragma unroll
        for (int i = 0; i < 32; ++i) mx = fmaxf(fmaxf(fmaxf(mx, s[i][0]), fmaxf(s[i][1], s[i][2])), s[i][3]);
        mx = fmaxf(mx, __shfl_xor(mx, 16)); mx = fmaxf(mx, __shfl_xor(mx, 32));
        float sum = 0.f;
#pragma unroll
        for (int i = 0; i < 32; ++i) {
#pragma unroll
            for (int r = 0; r < 4; ++r) { const float e = __expf(s[i][r] - mx); s[i][r] = e; sum += e; } }
        sum += __shfl_xor(sum, 16); sum += __shfl_xor(sum, 32);
        const float inv = 1.f / sum;
        f32x4 o[4] = {z4, z4, z4, z4};
        if (lat) {
#pragma unroll
            for (int wrow = 0; wrow < 8; ++wrow) { const bf16x8 pb = pack8(s[2 * wrow], s[2 * wrow + 1]);
                const bf16* vp = VT + ((size_t)((b * 8 + h) * 64 + lq) << 12) + (rs + wrow) * 64 + u0 + 4 * g;
#pragma unroll
                for (int dt = 0; dt < 4; ++dt) o[dt] = MFMA16(ld8x2(vp + ((size_t)dt << 16), vp + ((size_t)dt << 16) + 16), pb, o[dt]); }
        }
#pragma unroll
        for (int cb = 0; cb < 8; ++cb) { const bf16x8 pb = pack8(s[16 + 2 * cb], s[16 + 2 * cb + 1]);
            const bf16* vp = VTc + ((size_t)((b * 8 + h) * 64 + lq) << 8) + cb * 32 + 4 * g;
#pragma unroll
            for (int dt = 0; dt < 4; ++dt) o[dt] = MFMA16(ld8x2(vp + (dt << 12), vp + (dt << 12) + 16), pb, o[dt]); }
        bf16* op = Ob + (size_t)(qrow0 + lq) * GW + h * 64 + 4 * g;
#pragma unroll
        for (int dt = 0; dt < 4; ++dt) { u32x2 w; w.x = pg8::cvt_pk_bf16(o[dt][0] * inv, o[dt][1] * inv); w.y = pg8::cvt_pk_bf16(o[dt][2] * inv, o[dt][3] * inv); if (!dry) *(u32x2*)(op + 16 * dt) = w; }
    }
}


__device__ __forceinline__ int scan_row(int b, int dir, int s) { return dir == 0 ? (s < NCTX ? TL + b * NCTX + s : b * SEQ + (s - NCTX)) : (s < NCTX ? TL + b * NCTX + (NCTX - 1 - s) : b * SEQ + (SEQ - 1 - (s - NCTX))); }
constexpr int SC_QT = 0, SC_KT = 17408, SC_QS = 34816, SC_KST = 52224, SC_VT = 70656, SC_DV = 75264, SC_TOT = 75776;
__device__ __forceinline__ float ex2(float x) { return __builtin_amdgcn_exp2f(x); }
__device__ __forceinline__ void p3_scan(const Ctx& C, int l) {
    unsigned char* L = C.lds;
    const int k = C.tid & 127, tq = C.tid >> 7, lq = C.lane & 15, g = C.lane >> 4, tt = C.wave >> 1, vt = C.wave & 1;
    const bf16* HQ = C.GRP(3); const bf16* HI = C.GRP(6);
    for (int u = C.bid; u < 256; u += C.G) {
        const int dvq = u & 3, dir = (u >> 2) & 1, h = (u >> 3) & 3, b = u >> 5;
        const bf16* HF = C.GRP(dir ? 5 : 4); bf16* OUT = C.H() + (size_t)dir * GSTRIDE;
        const int sgn = dir ? -1 : 1;
        f32x4 S[8];
#pragma unroll
        for (int i = 0; i < 8; ++i) S[i] = (f32x4){0.f, 0.f, 0.f, 0.f};
        unsigned gv[16], qv[16]; u32x2 vraw;
        const int vs = C.tid >> 3, v4 = (C.tid & 7) * 4;
        { const int row0 = scan_row(b, dir, 0);
#pragma unroll
          for (int i = 0; i < 16; ++i) { const size_t ro = (size_t)(row0 + sgn * (16 * tq + i)) * GW + h * 128 + k; gv[i] = HF[ro]; qv[i] = HQ[ro]; }
          vraw = *(const u32x2*)(HI + (size_t)(row0 + sgn * vs) * GW + h * 128 + dvq * 32 + v4); }
        for (int c = 0; c < 68; ++c) {
            const int row0 = scan_row(b, dir, 64 * c);
            float cs[16]; float run = 0.f;
#pragma unroll
            for (int i = 0; i < 16; ++i) { run += __builtin_amdgcn_logf(bf2f(gv[i])); cs[i] = run; }
            ((float*)(L + SC_TOT))[tq * 128 + k] = run;
            __syncthreads();
            const float t0 = ((float*)(L + SC_TOT))[k], t1 = ((float*)(L + SC_TOT))[128 + k], t2 = ((float*)(L + SC_TOT))[256 + k], t3 = ((float*)(L + SC_TOT))[384 + k];
            const float beta = t0 + t1, last = beta + t2 + t3;
            const float off = (tq == 0) ? 0.f : (tq == 1) ? t0 : (tq == 2) ? beta : beta + t2;
            const float eb = ex2(fmaxf(beta, -120.f)), el = ex2(fmaxf(last - beta, -120.f));
            float ks_[16];
#pragma unroll
            for (int i = 0; i < 16; ++i) { const float d = off + cs[i] - beta; const float e1 = ex2(fminf(fmaxf(d, -120.f), 120.f)), r1 = ex2(fminf(fmaxf(-d, -120.f), 120.f));
                const float q = bf2f(qv[i]), kk = 1.f - bf2f(gv[i]); const float qt = q * e1, kt = kk * r1; const int t = 16 * tq + i;
                *(bf16*)(L + SC_QT + t * 272 + k * 2) = (bf16)f2bf(qt); *(bf16*)(L + SC_KT + t * 272 + k * 2) = (bf16)f2bf(kt); *(bf16*)(L + SC_QS + t * 272 + k * 2) = (bf16)f2bf(qt * eb); ks_[i] = kt * el; }
            { uint4 w0, w1; w0.x = pk2(ks_[0], ks_[1]); w0.y = pk2(ks_[2], ks_[3]); w0.z = pk2(ks_[4], ks_[5]); w0.w = pk2(ks_[6], ks_[7]); w1.x = pk2(ks_[8], ks_[9]); w1.y = pk2(ks_[10], ks_[11]); w1.z = pk2(ks_[12], ks_[13]); w1.w = pk2(ks_[14], ks_[15]);
              *(uint4*)(L + SC_KST + k * 144 + tq * 32) = w0; *(uint4*)(L + SC_KST + k * 144 + tq * 32 + 16) = w1; }
            if (tq == 0) ((float*)(L + SC_DV))[k] = ex2(fmaxf(last, -120.f));
            { *(bf16*)(L + SC_VT + (v4 + 0) * 144 + vs * 2) = (bf16)(vraw.x & 0xffffu); *(bf16*)(L + SC_VT + (v4 + 1) * 144 + vs * 2) = (bf16)(vraw.x >> 16);
              *(bf16*)(L + SC_VT + (v4 + 2) * 144 + vs * 2) = (bf16)(vraw.y & 0xffffu); *(bf16*)(L + SC_VT + (v4 + 3) * 144 + vs * 2) = (bf16)(vraw.y >> 16); }
            __syncthreads();
            if (c + 1 < 68) { const int nrow0 = scan_row(b, dir, 64 * (c + 1));
#pragma unroll
                for (int i = 0; i < 16; ++i) { const size_t ro = (size_t)(nrow0 + sgn * (16 * tq + i)) * GW + h * 128 + k; gv[i] = HF[ro]; qv[i] = HQ[ro]; }
                vraw = *(const u32x2*)(HI + (size_t)(nrow0 + sgn * vs) * GW + h * 128 + dvq * 32 + v4); }
            const f32x4 z4 = {0.f, 0.f, 0.f, 0.f};
            f32x4 o = z4;
            { const unsigned char* qb = L + SC_QT + (16 * tt + lq) * 272 + g * 16;
              bf16x8 qf[4];
#pragma unroll
              for (int ks = 0; ks < 4; ++ks) qf[ks] = *(const bf16x8*)(qb + ks * 64);
              const int tcol = 16 * tt + lq;
#pragma unroll
              for (int sp = 0; sp < 2; ++sp) if (sp <= (tt >> 1)) {
                  f32x4 X[2];
#pragma unroll
                  for (int hf = 0; hf < 2; ++hf) { const int st = 2 * sp + hf; const unsigned char* kb = L + SC_KT + (16 * st + lq) * 272 + g * 16; f32x4 a = z4;
#pragma unroll
                      for (int ks = 0; ks < 4; ++ks) a = MFMA16(*(const bf16x8*)(kb + ks * 64), qf[ks], a);
#pragma unroll
                      for (int r = 0; r < 4; ++r) a[r] = (16 * st + 4 * g + r <= tcol) ? a[r] : 0.f;
                      X[hf] = a; }
                  const unsigned char* vb = L + SC_VT + (16 * vt + lq) * 144 + (32 * sp + 4 * g) * 2;
                  o = MFMA16(pack8(X[0], X[1]), ld8x2((const bf16*)vb, (const bf16*)(vb + 32)), o); } }
            { const unsigned char* sb = L + SC_QS + (16 * tt + lq) * 272 + (4 * g) * 2;
#pragma unroll
              for (int kp = 0; kp < 4; ++kp) o = MFMA16(ld8x2((const bf16*)(sb + kp * 64), (const bf16*)(sb + kp * 64 + 32)), pack8(S[2 * kp], S[2 * kp + 1]), o); }
            { bf16* op = OUT + (size_t)(row0 + sgn * (16 * tt + 4 * g)) * GW + h * 128 + dvq * 32 + 16 * vt + lq;
#pragma unroll
              for (int r = 0; r < 4; ++r) op[(ptrdiff_t)(sgn * r) * GW] = (bf16)f2bf(o[r]); }
            { const unsigned char* vb = L + SC_VT + (16 * vt + lq) * 144 + g * 16; const bf16x8 vf0 = *(const bf16x8*)vb, vf1 = *(const bf16x8*)(vb + 64);
#pragma unroll
              for (int kt = 0; kt < 8; ++kt) { const f32x4 dsc = *(const f32x4*)(L + SC_DV + (16 * kt + 4 * g) * 4); const unsigned char* kb = L + SC_KST + (16 * kt + lq) * 144 + g * 16;
                  f32x4 a = S[kt] * dsc; a = MFMA16(*(const bf16x8*)kb, vf0, a); a = MFMA16(*(const bf16x8*)(kb + 64), vf1, a); S[kt] = a; } }
        }
        __syncthreads();
    }
}

__device__ __forceinline__ void p3_scan_naive(const Ctx& C, int l) {
    const bf16* HQ = C.GRP(3); const bf16* HI = C.GRP(6);
    for (int u = C.gw; u < 2048; u += C.nw) {
        const int dv4 = u & 31, dir = (u >> 5) & 1, h = (u >> 6) & 3, b = u >> 8;
        const bf16* HF = C.GRP(dir ? 5 : 4); bf16* OUT = C.H() + (size_t)dir * GSTRIDE;
        const float lb0 = C.LB()[(l * 2 + dir) * 512 + h * 128 + C.lane], lb1 = C.LB()[(l * 2 + dir) * 512 + h * 128 + 64 + C.lane];
        float S0[4] = {0.f, 0.f, 0.f, 0.f}, S1[4] = {0.f, 0.f, 0.f, 0.f};
        const int NS = NCTX + SEQ;
        int row = scan_row(b, dir, 0);
        unsigned q0 = HQ[(size_t)row * GW + h * 128 + C.lane], q1 = HQ[(size_t)row * GW + h * 128 + 64 + C.lane], f0 = HF[(size_t)row * GW + h * 128 + C.lane], f1 = HF[(size_t)row * GW + h * 128 + 64 + C.lane];
        uint2 vv = *(const uint2*)(HI + (size_t)row * GW + h * 128 + dv4 * 4);
        for (int s = 0; s < NS; ++s) {
            const int nrow = scan_row(b, dir, (s + 1 < NS) ? s + 1 : s);
            const unsigned nq0 = HQ[(size_t)nrow * GW + h * 128 + C.lane], nq1 = HQ[(size_t)nrow * GW + h * 128 + 64 + C.lane], nf0 = HF[(size_t)nrow * GW + h * 128 + C.lane], nf1 = HF[(size_t)nrow * GW + h * 128 + 64 + C.lane];
            const uint2 nvv = *(const uint2*)(HI + (size_t)nrow * GW + h * 128 + dv4 * 4);
            const float qa = silu(bf2f(q0)), qb = silu(bf2f(q1));
            const float fa = fminf(fmaxf(bf2f(f0), -30.f), 30.f), fb = fminf(fmaxf(bf2f(f1), -30.f), 30.f);
            const float ea = __expf(-fa), eb = __expf(-fb);
            const float sga = 1.f / (1.f + ea), sgb = 1.f / (1.f + eb);
            const float ga = fmaxf(lb0 + (1.f - lb0) * sga, 1e-30f), gb = fmaxf(lb1 + (1.f - lb1) * sgb, 1e-30f);
            const float ka = (1.f - lb0) * (ea * sga), kb = (1.f - lb1) * (eb * sgb);
            const float v[4] = {bflo(vv.x), bfhi(vv.x), bflo(vv.y), bfhi(vv.y)};
            float o[4];
#pragma unroll
            for (int j = 0; j < 4; ++j) { S0[j] = ga * S0[j] + ka * v[j]; S1[j] = gb * S1[j] + kb * v[j]; o[j] = wave_sum(qa * S0[j] + qb * S1[j]); }
            if (C.lane == 0) { uint2 w; w.x = pk2(o[0], o[1]); w.y = pk2(o[2], o[3]); *(uint2*)(OUT + (size_t)row * GW + h * 128 + dv4 * 4) = w; }
            row = nrow; q0 = nq0; q1 = nq1; f0 = nf0; f1 = nf1; vv = nvv;
        }
    }
}

__device__ __forceinline__ void p3c_headnorm(const Ctx& C, int l) {
    const int nrows = (l == 0) ? TA : TL;
    bf16* OF = C.H(); const bf16* OB = C.H() + GSTRIDE; const bf16* HG = C.GRP(7);
    const float* gain = C.p->hg_norm_g + l * 128;
    for (int r = C.gw; r < nrows; r += C.nw) {
        const size_t off = (size_t)r * GW + C.lane * 8;
        float a[8], b[8], g[8]; unpack8(*(const uint4*)(OF + off), a); unpack8(*(const uint4*)(OB + off), b); unpack8(*(const uint4*)(HG + off), g);
        float ss = 0.f;
#pragma unroll
        for (int i = 0; i < 8; ++i) { a[i] += b[i]; ss += a[i] * a[i]; }
        ss += __shfl_xor(ss, 1); ss += __shfl_xor(ss, 2); ss += __shfl_xor(ss, 4); ss += __shfl_xor(ss, 8);
        const float rinv = rsqrtf(ss * (1.f / 128.f) + EPS);
        const int cg = (C.lane & 15) * 8; float o[8];
#pragma unroll
        for (int i = 0; i < 8; ++i) o[i] = a[i] * rinv * gain[cg + i] * silu(g[i]);
        uint4 w; w.x = pk2(o[0], o[1]); w.y = pk2(o[2], o[3]); w.z = pk2(o[4], o[5]); w.w = pk2(o[6], o[7]);
        *(uint4*)(OF + off) = w;
    }
}

__device__ __forceinline__ int e_of(const Ctx& C, int i) { return C.TOKE()[i]; }
__device__ __forceinline__ void p5_norm2_router(const Ctx& C, int l) {
    float* wr = (float*)C.lds;
    unsigned* lcnt = (unsigned*)(C.lds + 65536);
    for (int i = C.tid; i < 1024 * 16; i += 512) wr[(i & 15) * 1024 + (i >> 4)] = C.p->w_router[i];
    if (C.tid < 32) lcnt[C.tid] = 0u;
    __syncthreads();
    const int nrows = (l == 0) ? TA : TL;
    float rb[16];
#pragma unroll
    for (int e = 0; e < 16; ++e) rb[e] = C.p->router_bias[e];
    for (int r = C.gw; r < nrows; r += C.nw) {
        const float* xr = r < TL ? C.p->out + (size_t)r * DM : C.CTXS() + (size_t)(r - TL) * DM;
        float v[16], h[16]; load_row(xr, C.lane, v);
        const float rinv = row_rinv(v);
        const float* mod = C.MOD() + (size_t)(l * 9 + modrow_of(r)) * INW;
        norm_mod(v, rinv, C.p->norm2_g + l * DM, mod + 4096, mod + 3072, C.lane, h);
        store_row_bf16(C.H() + (size_t)r * DM, C.lane, h);
        float lgv = 0.f;
#pragma unroll 1
        for (int e = 0; e < 16; ++e) { const float* we = wr + e * 1024 + C.lane * 4; float a = 0.f;
#pragma unroll
            for (int j = 0; j < 4; ++j) { const float4 ww = *(const float4*)(we + j * 256); a += h[4 * j] * ww.x + h[4 * j + 1] * ww.y + h[4 * j + 2] * ww.z + h[4 * j + 3] * ww.w; }
            a = wave_sum(a); lgv = (C.lane == e) ? a : lgv; }
        float lg[16];
#pragma unroll
        for (int e = 0; e < 16; ++e) lg[e] = __shfl(lgv, e);
        float bestg = -1e30f; int e0 = 0, e1 = 1; float s0 = 0.f, s1 = 0.f;
#pragma unroll
        for (int g = 0; g < 4; ++g) {
            float sc[4], gbv[4];
#pragma unroll
            for (int j = 0; j < 4; ++j) { sc[j] = 1.f / (1.f + expf(-lg[4 * g + j])); gbv[j] = sc[j] + rb[4 * g + j]; }
            int i0 = 0; float b0 = gbv[0], u0 = sc[0];
#pragma unroll
            for (int j = 1; j < 4; ++j) if (gbv[j] > b0) { b0 = gbv[j]; i0 = j; u0 = sc[j]; }
            int i1 = -1; float b1 = -1e30f, u1 = 0.f;
#pragma unroll
            for (int j = 0; j < 4; ++j) if (j != i0 && gbv[j] > b1) { b1 = gbv[j]; i1 = j; u1 = sc[j]; }
            const float gs = b0 + b1;
            if (gs > bestg) { bestg = gs; e0 = 4 * g + i0; e1 = 4 * g + i1; s0 = u0; s1 = u1; }
        }
        if (C.lane == 0) {
            const float den = s0 + s1;
            const int r0 = (int)atomicAdd(lcnt + e0, 1u), r1 = (int)atomicAdd(lcnt + e1, 1u);
            C.TOKE()[2 * r] = e0; C.TOKE()[2 * r + 1] = e1; C.TOKW()[2 * r] = s0 / den; C.TOKW()[2 * r + 1] = s1 / den; C.TOKS()[2 * r] = r0; C.TOKS()[2 * r + 1] = r1;
        }
    }
    __syncthreads();
    if (C.tid < 16) lcnt[16 + C.tid] = atomicAdd(C.CNT(l) + C.tid, lcnt[C.tid]);
    __syncthreads();
    if (C.lane == 0) for (int r = C.gw; r < nrows; r += C.nw) { C.TOKS()[2 * r] += (int)lcnt[16 + e_of(C, 2 * r)]; C.TOKS()[2 * r + 1] += (int)lcnt[16 + e_of(C, 2 * r + 1)]; }
    __syncthreads();
}

__device__ __forceinline__ void p6_permute(const Ctx& C, int l) {
    moe_table(C, l);
    const int nrows = (l == 0) ? TA : TL;
    for (int r = C.gw; r < nrows; r += C.nw) {
        const int e0 = C.TOKE()[2 * r], e1 = C.TOKE()[2 * r + 1];
        const int sl0 = C.TAB()[e0] * 256 + C.TOKS()[2 * r], sl1 = C.TAB()[e1] * 256 + C.TOKS()[2 * r + 1];
        const uint4* src = (const uint4*)(C.H() + (size_t)r * DM);
        const uint4 a = src[C.lane], b = src[64 + C.lane];
        uint4* d0 = (uint4*)(C.XS() + (size_t)sl0 * DM); uint4* d1 = (uint4*)(C.XS() + (size_t)sl1 * DM);
        d0[C.lane] = a; d0[64 + C.lane] = b; d1[C.lane] = a; d1[64 + C.lane] = b;
        if (C.lane == 0) { C.TOKS()[2 * r] = sl0; C.TOKS()[2 * r + 1] = sl1; }
    }
}

__device__ __forceinline__ void p9_combine(const Ctx& C, int l) {
    const int nrows = (l == 0) ? TA : TL; const bf16* YS = C.XS();
    for (int r = C.gw; r < nrows; r += C.nw) {
        float* xr = r < TL ? C.p->out + (size_t)r * DM : C.CTXS() + (size_t)(r - TL) * DM;
        float v[16]; load_row(xr, C.lane, v);
        const int s0 = C.TOKS()[2 * r], s1 = C.TOKS()[2 * r + 1]; const float w0 = C.TOKW()[2 * r], w1 = C.TOKW()[2 * r + 1];
        const float* mod = C.MOD() + (size_t)(l * 9 + modrow_of(r)) * INW;
#pragma unroll
        for (int j = 0; j < 4; ++j) { const int c = j * 256 + C.lane * 4; const uint2 a = *(const uint2*)(YS + (size_t)s0 * DM + c), b = *(const uint2*)(YS + (size_t)s1 * DM + c); const float4 g = *(const float4*)(mod + 5120 + c);
            v[4 * j] += g.x * (w0 * bflo(a.x) + w1 * bflo(b.x)); v[4 * j + 1] += g.y * (w0 * bfhi(a.x) + w1 * bfhi(b.x));
            v[4 * j + 2] += g.z * (w0 * bflo(a.y) + w1 * bflo(b.y)); v[4 * j + 3] += g.w * (w0 * bfhi(a.y) + w1 * bfhi(b.y)); }
        const float rinv = row_rinv(v);
        if (l == 0) {
#pragma unroll
            for (int j = 0; j < 4; ++j) *(float4*)(xr + j * 256 + C.lane * 4) = make_float4(v[4 * j], v[4 * j + 1], v[4 * j + 2], v[4 * j + 3]);
            float h[16]; const float* mod1 = C.MOD() + (size_t)(9 + modrow_of(r)) * INW;
            norm_mod(v, rinv, C.p->norm1_g + DM, mod1 + 1024, mod1, C.lane, h);
            store_row_bf16(C.H() + (size_t)r * DM, C.lane, h);
        } else {
#pragma unroll
            for (int j = 0; j < 4; ++j) { const int c = j * 256 + C.lane * 4; const float4 g = *(const float4*)(C.p->final_g + c);
                *(float4*)(xr + c) = make_float4(v[4 * j] * rinv * g.x, v[4 * j + 1] * rinv * g.y, v[4 * j + 2] * rinv * g.z, v[4 * j + 3] * rinv * g.w); }
        }
    }
}

#ifndef PHMASK
#define PHMASK 0xFFFFu
#endif
#define PHON(i) (((PHMASK) >> (i)) & 1u)
constexpr int NPH = 22;
__global__ void __launch_bounds__(512, 2) mk_fwd(Params p) {
    extern __shared__ __attribute__((aligned(16))) unsigned char lds_raw[];
    LAS unsigned char* ldsl = (LAS unsigned char*)lds_raw;
    if (threadIdx.x < 64) ((LAS unsigned*)(ldsl + LDS_STAGE))[threadIdx.x] = 0u;
    __syncthreads();
    XcdBarrier bar = xcd_barrier_post((unsigned*)(p.ws + WS_CTL) + CW_BAR + p.li * XCD_BAR_WORDS, (volatile LAS unsigned*)(ldsl + LDS_STAGE) + LDSW_BAR);
#define MKCTX() Ctx C; { unsigned long long kp_ = (unsigned long long)__builtin_amdgcn_kernarg_segment_ptr(); asm volatile("" : "+s"(kp_)); C.p.q = (ParamsK)kp_; } \
    C.ws = C.p->ws; C.lds = lds_raw; { int t_ = threadIdx.x, g_ = gridDim.x, b_ = blockIdx.x; asm volatile("" : "+v"(t_), "+s"(g_), "+s"(b_)); C.tid = t_; C.G = g_; C.bid = b_; } \
    C.lane = C.tid & 63; C.wave = __builtin_amdgcn_readfirstlane(C.tid >> 6); C.gw = C.bid * 8 + C.wave; C.nw = C.G * 8;
    const int lo = p.lo, hi = p.hi;
#define IN(k) (lo <= (k) && (k) < hi)
#ifdef PROBE_BAR
#define SEAM(k) do { if (IN((k) + 1)) { xcd_barrier(bar); xcd_barrier(bar); xcd_barrier(bar); } } while (0)
#else
#define SEAM(k) do { if (IN((k) + 1)) xcd_barrier(bar); } while (0)
#endif

    if (PHON(0) && IN(0)) { MKCTX(); p0_prologue(C);
#ifdef PROBE_P0
        __syncthreads(); p0_prologue(C);
#endif
        SEAM(0); }
    if (PHON(1) && IN(1)) { MKCTX(); p1_norm1(C, 0, C.p->x, C.p->ctx); SEAM(1); }
    for (int l = 0; l < 2; ++l) {
        const int pb = 2 + 10 * l;
        const int mrows = (l == 0) ? TA : TL;
        if (PHON(2) && IN(pb + 0)) {
            MKCTX();
            pg8::Gemm g{C.H(), C.WIN_T(), TA, INW, DM}; pg8::StaticOrder S; S.init(TA, INW, C.G, C.bid);
            EpiInProj E{C.GRP(0), C.ROPE(), C.LB() + l * 1024};
            pg8::gemm_phase<EpiInProj, pg8::StaticOrder, true, true>(ldsl, g, S, E);
#ifdef PROBE_P2
            __syncthreads(); pg8::gemm_phase<EpiInProj, pg8::StaticOrder, true, true>(ldsl, g, S, E);
#endif
            SEAM(pb + 0);
        }
        if (PHON(3) && IN(pb + 1)) {
            MKCTX();
            p3_scan(C, l);
#ifdef PROBE_SCAN2
            p3_scan(C, l);
#endif
#ifdef PROBE_ATTN2
            p3_attn(C, l, C.p->pad == 0);
#endif
            p3_attn(C, l);
            SEAM(pb + 1);
        }
        if (PHON(4) && IN(pb + 2)) { MKCTX(); p3c_headnorm(C, l); SEAM(pb + 2); }
        if (PHON(5) && IN(pb + 3)) {
            MKCTX();
            pg8::StaticOrder S; S.init(mrows, DM, C.G, C.bid);
            { pg8::Gemm g{C.GRP(0), C.WNA_T(), mrows, DM, 512}; EpiMerge<0> E{C.MB(), C.GRP(8)}; pg8::gemm_phase<EpiMerge<0>, pg8::StaticOrder, true, true>(ldsl, g, S, E); }
            __syncthreads();
            { pg8::Gemm g{C.H(), C.WHG_T(), mrows, DM, 512}; EpiMerge<1> E{C.MB(), C.GRP(10)}; pg8::gemm_phase<EpiMerge<1>, pg8::StaticOrder, true, true>(ldsl, g, S, E); }
            SEAM(pb + 3);
        }
        if (PHON(6) && IN(pb + 4)) {
            MKCTX();
            pg8::StaticOrder S; S.init(mrows, DM, C.G, C.bid);
            pg8::Gemm g{C.MB(), C.WOUT_T(), mrows, DM, DM};
            EpiOut E{l == 0 ? C.p->x : (const float*)C.p->out, C.p->out, C.p->ctx, C.CTXS(), C.MOD() + (size_t)l * 9 * INW};
            pg8::gemm_phase<EpiOut, pg8::StaticOrder, true, true>(ldsl, g, S, E);
            conv_experts(C, l);
#ifdef PROBE_CE
            conv_experts(C, l);
#endif
            SEAM(pb + 4);
        }
        if (PHON(7) && IN(pb + 5)) { MKCTX(); p5_norm2_router(C, l); SEAM(pb + 5); }
        if (PHON(8) && IN(pb + 6)) { MKCTX(); p6_permute(C, l); SEAM(pb + 6); }
        if (PHON(9) && IN(pb + 7)) {
            MKCTX();
            moe_table(C, l);
            MoeOrder S{C.TAB(), C.G, C.bid};
            pg8::Gemm g{C.XS(), C.WEGU(), SLOT_ROWS, 16384, DM}; EpiGateUp E{C.ACT()};
            pg8::gemm_phase<EpiGateUp, MoeOrder, true, true>(ldsl, g, S, E);
#ifdef PROBE_P7
            __syncthreads(); pg8::gemm_phase<EpiGateUp, MoeOrder, true, true>(ldsl, g, S, E);
#endif
            SEAM(pb + 7);
        }
        if (PHON(10) && IN(pb + 8)) {
            MKCTX();
            moe_table(C, l);
            MoeOrder S{C.TAB(), C.G, C.bid};
            pg8::Gemm g{C.ACT(), C.WED(), SLOT_ROWS, 16384, 512}; EpiDown E{C.XS()};
            pg8::gemm_phase<EpiDown, MoeOrder, true, true>(ldsl, g, S, E);
#ifdef PROBE_P8
            __syncthreads(); pg8::gemm_phase<EpiDown, MoeOrder, true, true>(ldsl, g, S, E);
#endif
            SEAM(pb + 8);
        }
        if (PHON(11) && IN(pb + 9)) { MKCTX(); p9_combine(C, l); if (l == 0) conv_mixer(C, 1); SEAM(pb + 9); }
    }
#undef IN
#undef SEAM
}

#ifndef MK_SPLIT
#define MK_SPLIT 0
#endif
extern "C" void kernel_launch(void* const* d_in, const int* in_sizes, int n_in, void* d_out, int out_size, void* d_ws, size_t ws_size, hipStream_t stream) {
    static int grid = 0;
    if (grid == 0) {
        if (n_in != 22 || ws_size < WS_END) { fprintf(stderr, "kernel_launch: unexpected n_in %d / ws_size %zu (need %zu)\n", n_in, ws_size, (size_t)WS_END); grid = -1; return; }
        int dev = 0, cus = 0, per_cu = 0;
        if (hipGetDevice(&dev) != hipSuccess || hipDeviceGetAttribute(&cus, hipDeviceAttributeMultiprocessorCount, dev) != hipSuccess) { grid = -1; return; }
        if (hipFuncSetAttribute((const void*)mk_fwd, hipFuncAttributeMaxDynamicSharedMemorySize, LDS_BYTES) != hipSuccess) { fprintf(stderr, "kernel_launch: hipFuncSetAttribute failed\n"); grid = -1; return; }
        if (hipOccupancyMaxActiveBlocksPerMultiprocessor(&per_cu, (const void*)mk_fwd, 512, LDS_BYTES) != hipSuccess || per_cu < 1) fprintf(stderr, "kernel_launch: occupancy query says %d\n", per_cu);
        (void)hipGetLastError();
        grid = cus;
    }
    if (grid < 0) return;
    if (hipMemsetAsync((char*)d_ws + WS_CTL, 0, CTL_BYTES, stream) != hipSuccess) return;
    Params p{};
    const float** pp = (const float**)&p;
    for (int i = 0; i < 22; ++i) pp[i] = (const float*)d_in[i];
    p.out = (float*)d_out; p.ws = (unsigned char*)d_ws; p.pad = 0;
#if MK_SPLIT
    for (int k = 0; k < NPH; ++k) { p.lo = k; p.hi = k + 1; p.li = k; hipLaunchKernelGGL(mk_fwd, dim3(grid), dim3(512), LDS_BYTES, stream, p); }
#else
    p.lo = 0; p.hi = NPH; p.li = 0;
    hipLaunchKernelGGL(mk_fwd, dim3(grid), dim3(512), LDS_BYTES, stream, p);
#endif
}
```

```cpp
#include <hip/hip_runtime.h>
#include <cstdio>
#include <cstdint>
namespace pg8 {
#define PG8_LAS __attribute__((address_space(3)))
typedef unsigned short bf16_t;
typedef short bf16x8 __attribute__((ext_vector_type(8)));
typedef float f32x4 __attribute__((ext_vector_type(4)));
typedef unsigned u32x4 __attribute__((ext_vector_type(4)));
constexpr int BM = 256, BK = 64, HALF = 128, HTB = HALF * BK * 2  , STAGE_BYTES = 8 * HTB, NXCD = 8, WGM = 8;

__host__ __device__ __forceinline__ int lds_byte(int r, int c) { const int st = (r >> 4) * 2 + (c >> 5), rr = r & 15, cc = c & 31, ob = rr * 64 + cc * 2; return st * 1024 + (ob ^ (((ob >> 9) & 1) << 5)); }
__host__ __device__ __forceinline__ void stage_rc(int b, int& R, int& C) { const int st = b / 1024, sb = b % 1024, swz = sb ^ (((sb >> 9) & 1) << 5); R = (st >> 1) * 16 + swz / 64; C = (st & 1) * 32 + (swz % 64) / 2; }
__host__ __device__ __forceinline__ int perm32(int rho) { const int n = rho >> 4, i = rho & 15; return 8 * (i >> 2) + 4 * n + (i & 3); }

struct Unit { int pm, pn; };
struct Gemm { const bf16_t* A; const bf16_t* Bt; int M, N, K; };

struct StaticOrder {
    int nM, nN, nwg, G, c;
    __host__ __device__ void init(int M, int N, int G_, int c_) { nM = M / BM; nN = N / BM; nwg = nM * nN; G = G_; c = c_; }
    __host__ __device__ bool next(int i, Unit& u) const {
        const long L = (long)i * G + c; if (L >= nwg) return false;
        int wgid = (int)L; { const int q = nwg / NXCD, r = nwg % NXCD, xcd = wgid % NXCD, off = wgid / NXCD; wgid = (xcd < r ? xcd * (q + 1) : r * (q + 1) + (xcd - r) * q) + off; }
        const int nig = WGM * nN, gid = wgid / nig, fm = gid * WGM, gsz = (nM - fm) < WGM ? (nM - fm) : WGM;
        u.pm = fm + ((wgid % nig) % gsz); u.pn = (wgid % nig) / gsz; return true;
    }
    __device__ __forceinline__ void a_ready(const Unit&) const {}
    __device__ __forceinline__ void done(const Unit&) const {}
};

__device__ __forceinline__ unsigned cvt_pk_bf16(float lo, float hi) { unsigned r; asm volatile("v_cvt_pk_bf16_f32 %0, %1, %2" : "=v"(r) : "v"(lo), "v"(hi)); return r; }
template <class Epi, class Sched, bool ALIGN_EPI = false, bool SP2 = false>
__device__ __forceinline__ void gemm_phase(PG8_LAS unsigned char* lds, const Gemm g, const Sched& S, const Epi& E) {
    int tid_ = threadIdx.x; asm volatile("" : "+v"(tid_));
    const int tid = tid_, wid = __builtin_amdgcn_readfirstlane(tid >> 6), lane = tid & 63, wr = wid >> 2, wc = wid & 3, fr = lane & 15, fq = lane >> 4;
    const int K = g.K, nt = K / BK;
    unsigned voffA[2], voffB[2];
#pragma unroll
    for (int i = 0; i < 2; ++i) { int R, C; stage_rc(tid * 16 + i * 8192, R, C); const int Rb = Epi::PERM ? ((R & ~31) + perm32(R & 31)) : R;
        voffA[i] = (unsigned)(R * K + C) * 2u; voffB[i] = (unsigned)(Rb * K + C) * 2u; }
    const size_t kstep = (size_t)(BK * 2);
    const size_t hstep = (size_t)HALF * K * 2;
    const size_t tstep = 2 * hstep;
    const unsigned ldsw = (unsigned)wid * 1024u;
    const int aoff = lds_byte(wr * 64 + fr, fq * 8), boff = lds_byte(wc * 32 + fr, fq * 8);
#define PG8_SA(b, h) (((b) * 2 + (h)) * HTB)
#define PG8_SB(b, h) ((4 + (b) * 2 + (h)) * HTB)
#define PG8_STAGE(bufoff, gbase, voff) do { _Pragma("unroll") for (int _i = 0; _i < 2; ++_i) \
        __builtin_amdgcn_global_load_lds((const unsigned*)((const char*)(gbase) + (voff)[_i]), (PG8_LAS unsigned*)(lds + (bufoff) + ldsw + _i * 8192), 16, 0, 0); } while (0)
#define PG8_LDA(dst, b, h) do { _Pragma("unroll") for (int m = 0; m < 4; ++m) _Pragma("unroll") for (int k = 0; k < 2; ++k) dst[m][k] = *(const PG8_LAS bf16x8*)(lds + PG8_SA(b, h) + aoff + m * 2048 + k * 1024); } while (0)
#define PG8_LDB(dst, b, h) do { _Pragma("unroll") for (int n = 0; n < 2; ++n) _Pragma("unroll") for (int k = 0; k < 2; ++k) dst[n][k] = *(const PG8_LAS bf16x8*)(lds + PG8_SB(b, h) + boff + n * 2048 + k * 1024); } while (0)
#define PG8_MMA(ai, bj, At, Bt) do { __builtin_amdgcn_s_setprio(1); _Pragma("unroll") for (int m = 0; m < 4; ++m) _Pragma("unroll") for (int n = 0; n < 2; ++n) _Pragma("unroll") for (int k = 0; k < 2; ++k) \
        acc[ai][bj][m][n] = __builtin_amdgcn_mfma_f32_16x16x32_bf16(Bt[n][k], At[m][k], acc[ai][bj][m][n], 0, 0, 0); __builtin_amdgcn_s_setprio(0); } while (0)
#define PG8_WAIT_V(n) asm volatile("s_waitcnt vmcnt(" #n ")" ::: "memory")
#define PG8_WAIT_L(n) asm volatile("s_waitcnt lgkmcnt(" #n ")" ::: "memory")
#define PG8_BAR __builtin_amdgcn_s_barrier()
#define PG8_SCHED __builtin_amdgcn_sched_barrier(0)
    Unit cur, nxt; int ui = 0;
    if (!S.next(0, cur)) return;
    f32x4 acc[2][2][4][2];
#pragma unroll
    for (int a = 0; a < 2; ++a)
#pragma unroll
        for (int b = 0; b < 2; ++b)
#pragma unroll
            for (int m = 0; m < 4; ++m)
#pragma unroll
                for (int n = 0; n < 2; ++n) acc[a][b][m][n] = (f32x4){0.f, 0.f, 0.f, 0.f};
    bf16x8 At[4][2], B0[2][2], B1[2][2];
    const char* cA = (const char*)g.A + (size_t)cur.pm * tstep; const char* cB = (const char*)g.Bt + (size_t)cur.pn * tstep;
    S.a_ready(cur);
    if constexpr (SP2) {
        PG8_STAGE(PG8_SB(0, 0), cB, voffB); PG8_STAGE(PG8_SB(0, 1), cB + hstep, voffB); PG8_STAGE(PG8_SA(0, 0), cA, voffA); PG8_STAGE(PG8_SA(0, 1), cA + hstep, voffA);
        if (wr == 1) PG8_BAR;
        PG8_WAIT_V(2); PG8_BAR;
        PG8_STAGE(PG8_SB(1, 0), cB + kstep, voffB); PG8_STAGE(PG8_SA(1, 0), cA + kstep, voffA); PG8_STAGE(PG8_SB(1, 1), cB + hstep + kstep, voffB);
        PG8_WAIT_V(6); PG8_BAR;
    } else {
        PG8_STAGE(PG8_SB(0, 0), cB, voffB); PG8_STAGE(PG8_SA(0, 0), cA, voffA); PG8_STAGE(PG8_SB(0, 1), cB + hstep, voffB); PG8_STAGE(PG8_SA(0, 1), cA + hstep, voffA);
        if (wr == 1) PG8_BAR;
        PG8_WAIT_V(4); PG8_BAR;
        PG8_STAGE(PG8_SB(1, 0), cB + kstep, voffB); PG8_STAGE(PG8_SA(1, 0), cA + kstep, voffA); PG8_STAGE(PG8_SB(1, 1), cB + hstep + kstep, voffB);
        PG8_WAIT_V(6); PG8_BAR;
    }
    for (;;) {
        const bool has_next = S.next(ui + 1, nxt);
        const char* nA = has_next ? (const char*)g.A + (size_t)nxt.pm * tstep : cA; const char* nB = has_next ? (const char*)g.Bt + (size_t)nxt.pn * tstep : cB;
        for (int t = 0; t < nt; t += 2) {
            const bool last = (t == nt - 2);
            const char* a1 = cA + (size_t)(t + 1) * kstep;
            const char* a2 = last ? nA : cA + (size_t)(t + 2) * kstep; const char* b2 = last ? nB : cB + (size_t)(t + 2) * kstep;
            const char* a3 = a2 + kstep; const char* b3 = b2 + kstep;
            if (last && has_next) S.a_ready(nxt);
            if constexpr (SP2) {
            PG8_LDB(B0, 0, 0); PG8_LDB(B1, 0, 1); PG8_SCHED; PG8_LDA(At, 0, 0); PG8_STAGE(PG8_SA(1, 1), a1 + hstep, voffA);
            PG8_WAIT_V(8); PG8_WAIT_L(0); PG8_BAR; PG8_MMA(0, 0, At, B0); PG8_MMA(0, 1, At, B1); PG8_BAR; PG8_SCHED;
            PG8_LDA(At, 0, 1); PG8_STAGE(PG8_SB(0, 0), b2, voffB); PG8_STAGE(PG8_SB(0, 1), b2 + hstep, voffB); PG8_STAGE(PG8_SA(0, 0), a2, voffA);
            PG8_WAIT_V(8); PG8_WAIT_L(0); PG8_BAR; PG8_MMA(1, 0, At, B0); PG8_MMA(1, 1, At, B1); PG8_BAR; PG8_SCHED;
            PG8_LDB(B0, 1, 0); PG8_LDB(B1, 1, 1); PG8_SCHED; PG8_LDA(At, 1, 0); PG8_STAGE(PG8_SA(0, 1), a2 + hstep, voffA);
            PG8_WAIT_V(8); PG8_WAIT_L(0); PG8_BAR; PG8_MMA(0, 0, At, B0); PG8_MMA(0, 1, At, B1); PG8_BAR; PG8_SCHED;
            PG8_LDA(At, 1, 1); PG8_STAGE(PG8_SB(1, 0), b3, voffB); PG8_STAGE(PG8_SB(1, 1), b3 + hstep, voffB); PG8_STAGE(PG8_SA(1, 0), a3, voffA);
            PG8_WAIT_V(8); PG8_WAIT_L(0); PG8_BAR; PG8_MMA(1, 0, At, B0); PG8_MMA(1, 1, At, B1); PG8_BAR; PG8_SCHED;
            } else {
            PG8_LDB(B0, 0, 0); PG8_SCHED; PG8_LDA(At, 0, 0); PG8_STAGE(PG8_SA(1, 1), a1 + hstep, voffA);
            PG8_WAIT_L(8); PG8_BAR; PG8_WAIT_L(0); PG8_MMA(0, 0, At, B0); PG8_BAR; PG8_SCHED;
            PG8_LDB(B1, 0, 1); PG8_STAGE(PG8_SB(0, 0), b2, voffB);
            PG8_BAR; PG8_WAIT_L(0); PG8_MMA(0, 1, At, B1); PG8_BAR;
            PG8_LDA(At, 0, 1); PG8_STAGE(PG8_SA(0, 0), a2, voffA);
            PG8_BAR; PG8_WAIT_L(0); PG8_MMA(1, 0, At, B0); PG8_BAR; PG8_SCHED;
            PG8_STAGE(PG8_SB(0, 1), b2 + hstep, voffB);
            PG8_WAIT_V(6); PG8_BAR; PG8_MMA(1, 1, At, B1); PG8_BAR;
            PG8_LDB(B0, 1, 0); PG8_SCHED; PG8_LDA(At, 1, 0); PG8_STAGE(PG8_SA(0, 1), a2 + hstep, voffA);
            PG8_WAIT_L(8); PG8_BAR; PG8_WAIT_L(0); PG8_MMA(0, 0, At, B0); PG8_BAR; PG8_SCHED;
            PG8_LDB(B1, 1, 1); PG8_STAGE(PG8_SB(1, 0), b3, voffB);
            PG8_BAR; PG8_WAIT_L(0); PG8_MMA(0, 1, At, B1); PG8_BAR;
            PG8_LDA(At, 1, 1); PG8_STAGE(PG8_SA(1, 0), a3, voffA);
            PG8_BAR; PG8_WAIT_L(0); PG8_MMA(1, 0, At, B0); PG8_BAR; PG8_SCHED;
            PG8_STAGE(PG8_SB(1, 1), b3 + hstep, voffB);
            PG8_WAIT_V(6); PG8_BAR; PG8_MMA(1, 1, At, B1); PG8_BAR;
            }
        }
        if constexpr (ALIGN_EPI) { if (wr == 0) PG8_BAR; }
        if constexpr (!Epi::AFTER_DRAIN) { E(acc, cur, wr, wc, fr, fq); S.done(cur); }
        if (!has_next) break;
#pragma unroll
        for (int a = 0; a < 2; ++a)
#pragma unroll
            for (int b = 0; b < 2; ++b)
#pragma unroll
                for (int m = 0; m < 4; ++m)
#pragma unroll
                    for (int n = 0; n < 2; ++n) acc[a][b][m][n] = (f32x4){0.f, 0.f, 0.f, 0.f};
        cur = nxt; cA = nA; cB = nB; ++ui;
        if constexpr (ALIGN_EPI) { if (wr == 1) PG8_BAR; }
    }
    PG8_WAIT_V(0);
    if constexpr (!ALIGN_EPI) { if (wr == 0) PG8_BAR; }
    PG8_BAR;
    if constexpr (Epi::AFTER_DRAIN) { E.fused(acc, cur, wr, wc, fr, fq, lds, wid, lane); S.done(cur); }
#undef PG8_SA
#undef PG8_SB
#undef PG8_STAGE
#undef PG8_LDA
#undef PG8_LDB
#undef PG8_MMA
#undef PG8_WAIT_V
#undef PG8_WAIT_L
#undef PG8_BAR
#undef PG8_SCHED
}
}
#define XB_TMO      128
#define XB_XCNT(j)  (256  + 64 * (j))
#define XB_XSUB(j)  (1280 + 64 * (j))
#define XB_XGEN(j)  (2304 + 64 * (j))
#define XB_TOP      3328
#define XB_TOPGEN   3392
#define XCD_BAR_WORDS 3456
#define XB_SPIN_CAP (1u << 18)
#define LAS __attribute__((address_space(3)))

__device__ __forceinline__ unsigned xb_ld(unsigned* p)              { return __hip_atomic_load(p, __ATOMIC_RELAXED, __HIP_MEMORY_SCOPE_AGENT); }
__device__ __forceinline__ unsigned xb_add(unsigned* p, unsigned v) { return __hip_atomic_fetch_add(p, v, __ATOMIC_RELAXED, __HIP_MEMORY_SCOPE_AGENT); }
__device__ __forceinline__ unsigned xb_xcc_id() { return (unsigned)__builtin_amdgcn_s_getreg((3 << 11) | 20) & 0xFu; }
#define XB_SPIN(cond, bar) do { unsigned _sp = 0; while (cond) { __builtin_amdgcn_s_sleep(1); \
    if ((++_sp & 255u) == 0u) { if (xb_ld(&(bar)[XB_TMO])) break; if (_sp > XB_SPIN_CAP) { atomicAdd(&(bar)[XB_TMO], 1u); break; } } } } while (0)

struct XcdBarrier {
    unsigned* bar; unsigned x;
    volatile LAS unsigned* st;
};

__device__ __forceinline__ XcdBarrier xcd_barrier_post(unsigned* bar, volatile LAS unsigned* st) {
    XcdBarrier b; b.bar = bar; b.x = xb_xcc_id(); b.st = st;
    if (threadIdx.x == 0) (void)xb_add(&bar[XB_XCNT(b.x)], 1u);
    return b;
}
__device__ __forceinline__ void xcd_barrier_complete(unsigned* bar, unsigned x, unsigned& nloc, unsigned& nx) {
    const unsigned G = gridDim.x * gridDim.y * gridDim.z;
    unsigned sum, cnt, mine, sp = 0u;
    for (;;) {
        sum = 0u; cnt = 0u; mine = 0u;
#pragma unroll
        for (unsigned j = 0; j < 16; ++j) { const unsigned c = xb_ld(&bar[XB_XCNT(j)]); sum += c; cnt += (c > 0u) ? 1u : 0u; mine = (j == x) ? c : mine; }
        if (sum == G) break;
        __builtin_amdgcn_s_sleep(1);
        if ((++sp & 255u) == 0u) { if (xb_ld(&bar[XB_TMO])) break; if (sp > XB_SPIN_CAP) { atomicAdd(&bar[XB_TMO], 1u); break; } }
    }
    nloc = mine > 0u ? mine : 1u; nx = cnt > 0u ? cnt : 1u;
}

__device__ __forceinline__ void xcd_barrier(const XcdBarrier& b) {
    asm volatile("s_waitcnt vmcnt(0)" ::: "memory");
    __syncthreads();
    if (threadIdx.x == 0) {
        unsigned* bar = b.bar;
        __builtin_amdgcn_s_waitcnt(0);
        unsigned nloc = b.st[0], nx = b.st[1];
        if (nloc == 0u) { xcd_barrier_complete(bar, b.x, nloc, nx); b.st[0] = nloc; b.st[1] = nx; }
        const unsigned old = xb_add(&bar[XB_XSUB(b.x)], 1u);
        const unsigned gen = old / nloc;
        if (old + 1u == (gen + 1u) * nloc) {
            __builtin_amdgcn_fence(__ATOMIC_RELEASE, "agent");
            asm volatile("s_waitcnt vmcnt(0)" ::: "memory");
            const unsigned og = xb_add(&bar[XB_TOP], 1u);
            const unsigned tg = og / nx;
            if (og + 1u == (tg + 1u) * nx) xb_add(&bar[XB_TOPGEN], 1u);
            else XB_SPIN(xb_ld(&bar[XB_TOPGEN]) == tg, bar);
            __builtin_amdgcn_fence(__ATOMIC_ACQUIRE, "agent");
            xb_add(&bar[XB_XGEN(b.x)], 1u);
            asm volatile("s_waitcnt vmcnt(0)" ::: "memory");
        } else {
            XB_SPIN(xb_ld(&bar[XB_XGEN(b.x)]) == gen, bar);
            __builtin_amdgcn_fence(__ATOMIC_ACQUIRE, "agent");
            asm volatile("s_waitcnt vmcnt(0)" ::: "memory");
        }
    }
    __syncthreads();
}


typedef unsigned short bf16;
typedef pg8::f32x4 f32x4;
typedef pg8::u32x4 u32x4;
constexpr int NB = 8, SEQ = 4096, DM = 1024, NCTX = 256;
constexpr int TL = NB * SEQ, TC = NB * NCTX, TA = TL + TC;
constexpr int INW = 6144, GW = 512, NGRP = 12;
constexpr size_t GSTRIDE = (size_t)TA * GW;
constexpr float EPS = 1e-6f;
constexpr int SLOT_ROWS = 73728;

constexpr size_t MiB = (size_t)1 << 20;
constexpr size_t WS_CTL = 0, CTL_BYTES = 1 * MiB;
constexpr size_t WS_MOD = 1 * MiB;
constexpr size_t WS_LB = 1 * MiB + 512 * 1024;
constexpr size_t WS_ROPE = 2 * MiB;
constexpr size_t WS_TOK = 3 * MiB;
constexpr size_t WS_CTXS = 4 * MiB;
constexpr size_t WS_WB = 12 * MiB;
constexpr size_t WS_H = 28 * MiB;
constexpr size_t WS_P = 96 * MiB;
constexpr size_t P_M = 34 * MiB, P_WEGU = 102 * MiB, P_WED = 134 * MiB, P_XS = 150 * MiB, P_ACT = 294 * MiB;
constexpr size_t WS_END = 504 * MiB;
constexpr int CW_BAR = 4096, CW_CNT = 131072;

constexpr int LDS_STAGE = 163328, LDS_BYTES = 163840;
constexpr int LDSW_BAR = 0, LDSW_TAB = 16;

struct Params {
    const float* x; const float* c; const float* ctx; const float* c_ctx; const float* w_ada; const float* b_ada; const float* norm1_g; const float* w_in;
    const float* rel_bias; const float* lowf; const float* lowb; const float* hg_norm_g; const float* w_na_o; const float* w_hg_o; const float* w_out; const float* norm2_g;
    const float* w_router; const float* router_bias; const float* w_gate; const float* w_up; const float* w_down; const float* final_g;
    float* out; unsigned char* ws; int lo, hi, li, pad;
};

__device__ __forceinline__ float bf2f(unsigned b) { return __uint_as_float(b << 16); }
__device__ __forceinline__ float bflo(unsigned w) { return __uint_as_float(w << 16); }
__device__ __forceinline__ float bfhi(unsigned w) { return __uint_as_float(w & 0xffff0000u); }
__device__ __forceinline__ unsigned f2bf(float f) { unsigned u = __float_as_uint(f); u += 0x7FFFu + ((u >> 16) & 1u); return u >> 16; }
__device__ __forceinline__ unsigned pk2(float lo, float hi) { return f2bf(lo) | (f2bf(hi) << 16); }
__device__ __forceinline__ float sigm(float x) { return 1.f / (1.f + __expf(-x)); }
__device__ __forceinline__ float silu(float x) { return x / (1.f + __expf(-x)); }
__device__ __forceinline__ float wave_sum(float v) {
#pragma unroll
    for (int o = 32; o >= 1; o >>= 1) v += __shfl_xor(v, o);
    return v; }
__device__ __forceinline__ float wave_max(float v) {
#pragma unroll
    for (int o = 32; o >= 1; o >>= 1) v = fmaxf(v, __shfl_xor(v, o));
    return v; }
__device__ __forceinline__ void unpack8(const uint4 w, float (&f)[8]) {
    f[0] = bflo(w.x); f[1] = bfhi(w.x); f[2] = bflo(w.y); f[3] = bfhi(w.y); f[4] = bflo(w.z); f[5] = bfhi(w.z); f[6] = bflo(w.w); f[7] = bfhi(w.w); }

typedef const __attribute__((address_space(4))) Params* ParamsK;
struct PView { ParamsK q; __device__ __forceinline__ const __attribute__((address_space(4))) Params* operator->() const { return q; } };
struct Ctx {
    PView p; unsigned char* ws; unsigned char* lds; int tid, lane, wave, G, bid, gw, nw;
    __device__ __forceinline__ float* MOD() const { return (float*)(ws + WS_MOD); }
    __device__ __forceinline__ float* LB() const { return (float*)(ws + WS_LB); }
    __device__ __forceinline__ float2* ROPE() const { return (float2*)(ws + WS_ROPE); }
    __device__ __forceinline__ int* TOKE() const { return (int*)(ws + WS_TOK); }
    __device__ __forceinline__ float* TOKW() const { return (float*)(ws + WS_TOK) + 2 * TA; }
    __device__ __forceinline__ int* TOKS() const { return (int*)(ws + WS_TOK) + 4 * TA; }
    __device__ __forceinline__ float* CTXS() const { return (float*)(ws + WS_CTXS); }
    __device__ __forceinline__ bf16* WIN_T() const { return (bf16*)(ws + WS_WB); }
    __device__ __forceinline__ bf16* WNA_T() const { return (bf16*)(ws + WS_WB + 12 * MiB); }
    __device__ __forceinline__ bf16* WHG_T() const { return (bf16*)(ws + WS_WB + 13 * MiB); }
    __device__ __forceinline__ bf16* WOUT_T() const { return (bf16*)(ws + WS_WB + 14 * MiB); }
    __device__ __forceinline__ bf16* H() const { return (bf16*)(ws + WS_H); }
    __device__ __forceinline__ bf16* GRP(int g) const { return (bf16*)(ws + WS_P) + (size_t)g * GSTRIDE; }
    __device__ __forceinline__ bf16* MB() const { return (bf16*)(ws + WS_P + P_M); }
    __device__ __forceinline__ bf16* WEGU() const { return (bf16*)(ws + WS_P + P_WEGU); }
    __device__ __forceinline__ bf16* WED() const { return (bf16*)(ws + WS_P + P_WED); }
    __device__ __forceinline__ bf16* XS() const { return (bf16*)(ws + WS_P + P_XS); }
    __device__ __forceinline__ bf16* ACT() const { return (bf16*)(ws + WS_P + P_ACT); }
    __device__ __forceinline__ unsigned* CTL() const { return (unsigned*)(ws + WS_CTL); }
    __device__ __forceinline__ unsigned* CNT(int l) const { return (unsigned*)(ws + WS_CTL) + CW_CNT + l * 64; }
    __device__ __forceinline__ int* TAB() const { return (int*)(lds + LDS_STAGE) + LDSW_TAB; }
};

template <class RowMap>
__device__ __forceinline__ void tconv_tile(const float* __restrict__ src, int ldsrc, int k0, int n0, bf16* __restrict__ dst, int ldd, int lane, RowMap rm) {
    float v[64];
    const float* s = src + (size_t)k0 * ldsrc + n0 + lane;
#pragma unroll
    for (int k = 0; k < 64; ++k) { v[k] = *s; s += ldsrc; asm volatile("" : "+v"(s)); }
    bf16* d = dst + (size_t)rm(n0 + lane) * ldd + k0;
#pragma unroll
    for (int j = 0; j < 8; ++j) { uint4 w; w.x = pk2(v[8 * j], v[8 * j + 1]); w.y = pk2(v[8 * j + 2], v[8 * j + 3]); w.z = pk2(v[8 * j + 4], v[8 * j + 5]); w.w = pk2(v[8 * j + 6], v[8 * j + 7]);
        *(uint4*)(d + 8 * j) = w; }
}
struct RmId { __device__ __forceinline__ int operator()(int n) const { return n; } };
struct RmGU { int base; __device__ __forceinline__ int operator()(int n) const { return base + (n >> 7) * 256 + (n & 127); } };

__device__ __forceinline__ void conv_mixer(const Ctx& C, int l) {
    for (int id = C.gw; id < 2048; id += C.nw) {
        if (id < 1536) { const int kt = id & 15, nt = id >> 4; tconv_tile(C.p->w_in + (size_t)l * DM * INW, INW, kt * 64, nt * 64, C.WIN_T(), DM, C.lane, RmId()); }
        else if (id < 1664) { const int j = id - 1536, kt = j & 7, nt = j >> 3; tconv_tile(C.p->w_na_o + (size_t)l * 512 * DM, DM, kt * 64, nt * 64, C.WNA_T(), 512, C.lane, RmId()); }
        else if (id < 1792) { const int j = id - 1664, kt = j & 7, nt = j >> 3; tconv_tile(C.p->w_hg_o + (size_t)l * 512 * DM, DM, kt * 64, nt * 64, C.WHG_T(), 512, C.lane, RmId()); }
        else { const int j = id - 1792, kt = j & 15, nt = j >> 4; tconv_tile(C.p->w_out + (size_t)l * DM * DM, DM, kt * 64, nt * 64, C.WOUT_T(), DM, C.lane, RmId()); }
    }
}
__device__ __forceinline__ void conv_experts(const Ctx& C, int l) {
    for (int id = C.gw; id < 6144; id += C.nw) {
        const int e = id / 384, j = id % 384;
        if (j < 128) { const int kt = j & 15, nt = j >> 4; tconv_tile(C.p->w_gate + ((size_t)l * 16 + e) * DM * 512, 512, kt * 64, nt * 64, C.WEGU(), DM, C.lane, RmGU{e * 1024}); }
        else if (j < 256) { const int jj = j - 128, kt = jj & 15, nt = jj >> 4; tconv_tile(C.p->w_up + ((size_t)l * 16 + e) * DM * 512, 512, kt * 64, nt * 64, C.WEGU(), DM, C.lane, RmGU{e * 1024 + 128}); }
        else { const int jj = j - 256, kt = jj & 7, nt = jj >> 3; tconv_tile(C.p->w_down + ((size_t)l * 16 + e) * 512 * DM, DM, kt * 64, nt * 64, C.WED() + (size_t)e * 1024 * 512, 512, C.lane, RmId()); }
    }
}

__device__ __forceinline__ void p0_prologue(const Ctx& C) {
    for (int u = C.bid; u < 24; u += C.G) {
        float* sl = (float*)C.lds;
        for (int i = C.tid; i < 9 * 1024; i += 512) { const int r = i >> 10, k = i & 1023; const float v = (r < 8) ? C.p->c[r * 1024 + k] : C.p->c_ctx[k]; sl[i] = v / (1.f + expf(-v)); }
        __syncthreads();
        const int l = u / 12, n = (u % 12) * 512 + C.tid;
        const float* w = C.p->w_ada + (size_t)l * DM * INW + n;
        float acc[9];
#pragma unroll
        for (int r = 0; r < 9; ++r) acc[r] = 0.f;
#pragma unroll 8
        for (int k = 0; k < 1024; ++k) { const float wv = w[(size_t)k * INW];
#pragma unroll
            for (int r = 0; r < 9; ++r) acc[r] += sl[r * 1024 + k] * wv; }
        const float bb = C.p->b_ada[l * INW + n];
#pragma unroll
        for (int r = 0; r < 9; ++r) C.MOD()[(size_t)(l * 9 + r) * INW + n] = acc[r] + bb;
        __syncthreads();
    }
    const int gt = C.bid * 512 + C.tid, nthr = C.G * 512;
    for (int i = gt; i < 4096 * 32; i += nthr) { const int t = i >> 5, pr = i & 31; const float pos = (float)((pr < 16) ? (t >> 6) : (t & 63)); const int j = pr & 15;
        const float inv = powf(10000.f, -(float)(2 * j) / 32.f); const float ang = pos * inv; C.ROPE()[i] = make_float2(cosf(ang), sinf(ang)); }
    for (int i = gt; i < 1024; i += nthr) { const int dir = i >> 9, ch = i & 511; const float* raw = dir ? C.p->lowb : C.p->lowf; const float r0 = raw[ch], r1 = raw[512 + ch];
        const float p1 = 1.f / (1.f + expf(r0 - r1)); C.LB()[(0 * 2 + dir) * 512 + ch] = 0.f; C.LB()[(1 * 2 + dir) * 512 + ch] = p1; }
    conv_mixer(C, 0);
}

__device__ __forceinline__ void load_row(const float* xr, int lane, float (&v)[16]) {
#pragma unroll
    for (int j = 0; j < 4; ++j) { const float4 t = *(const float4*)(xr + j * 256 + lane * 4); v[4 * j] = t.x; v[4 * j + 1] = t.y; v[4 * j + 2] = t.z; v[4 * j + 3] = t.w; }
}
__device__ __forceinline__ float row_rinv(const float (&v)[16]) {
    float ss = 0.f;
#pragma unroll
    for (int i = 0; i < 16; ++i) ss += v[i] * v[i];
    ss = wave_sum(ss);
    return rsqrtf(ss * (1.f / 1024.f) + EPS);
}
__device__ __forceinline__ void norm_mod(const float (&v)[16], float rinv, const float* gam, const float* sc, const float* sh, int lane, float (&h)[16]) {
#pragma unroll
    for (int j = 0; j < 4; ++j) { const int c = j * 256 + lane * 4; const float4 g = *(const float4*)(gam + c), s = *(const float4*)(sc + c), b = *(const float4*)(sh + c);
        h[4 * j] = v[4 * j] * rinv * g.x * (1.f + s.x) + b.x; h[4 * j + 1] = v[4 * j + 1] * rinv * g.y * (1.f + s.y) + b.y;
        h[4 * j + 2] = v[4 * j + 2] * rinv * g.z * (1.f + s.z) + b.z; h[4 * j + 3] = v[4 * j + 3] * rinv * g.w * (1.f + s.w) + b.w; }
}
__device__ __forceinline__ void store_row_bf16(bf16* hr, int lane, const float (&h)[16]) {
#pragma unroll
    for (int j = 0; j < 4; ++j) { uint2 w; w.x = pk2(h[4 * j], h[4 * j + 1]); w.y = pk2(h[4 * j + 2], h[4 * j + 3]); *(uint2*)(hr + j * 256 + lane * 4) = w; }
}
__device__ __forceinline__ int modrow_of(int r) { return r < TL ? (r >> 12) : 8; }

__device__ __forceinline__ void p1_norm1(const Ctx& C, int l, const float* xl, const float* xc) {
    for (int r = C.gw; r < TA; r += C.nw) {
        const float* xr = r < TL ? xl + (size_t)r * DM : xc + (size_t)(r - TL) * DM;
        float v[16], h[16]; load_row(xr, C.lane, v);
        const float rinv = row_rinv(v);
        const float* mod = C.MOD() + (size_t)(l * 9 + modrow_of(r)) * INW;
        norm_mod(v, rinv, C.p->norm1_g + l * DM, mod + 1024, mod, C.lane, h);
        store_row_bf16(C.H() + (size_t)r * DM, C.lane, h);
    }
}

struct EpiInProj {
    static constexpr bool PERM = true, AFTER_DRAIN = false;
    bf16* P; const float2* rope; const float* lbl;
    __device__ __forceinline__ void operator()(const f32x4 (&acc)[2][2][4][2], const pg8::Unit& u, int wr, int wc, int fr, int fq) const {
        const int grp = u.pn >> 1; bf16* base = P + (size_t)grp * GSTRIDE;
        const int colb = (u.pn & 1) * 256 + wc * 32 + 8 * fq;
        const bool do_rope = (grp < 2) && (u.pm < TL / 256);
#pragma unroll
        for (int ai = 0; ai < 2; ++ai)
#pragma unroll
            for (int m = 0; m < 4; ++m) { const int row = u.pm * 256 + ai * 128 + wr * 64 + m * 16 + fr;
#pragma unroll
                for (int bj = 0; bj < 2; ++bj) { const int col = colb + bj * 128; f32x4 v0 = acc[ai][bj][m][0], v1 = acc[ai][bj][m][1];
                    if (do_rope) { const float4* rp = (const float4*)(rope + (size_t)(row & 4095) * 32 + ((col & 63) >> 1)); const float4 c01 = rp[0], c23 = rp[1];
                        const f32x4 a = v0, b = v1;
                        v0[0] = a[0] * c01.x - a[1] * c01.y; v0[1] = a[0] * c01.y + a[1] * c01.x; v0[2] = a[2] * c01.z - a[3] * c01.w; v0[3] = a[2] * c01.w + a[3] * c01.z;
                        v1[0] = b[0] * c23.x - b[1] * c23.y; v1[1] = b[0] * c23.y + b[1] * c23.x; v1[2] = b[2] * c23.z - b[3] * c23.w; v1[3] = b[2] * c23.w + b[3] * c23.z; }
                    if (grp == 3) {
#pragma unroll
                        for (int i = 0; i < 4; ++i) { v0[i] = silu(v0[i]); v1[i] = silu(v1[i]); }
                    } else if (grp == 4 || grp == 5) {
                        const float* lp = lbl + (grp - 4) * 512 + col; const f32x4 l0 = *(const f32x4*)lp, l1 = *(const f32x4*)(lp + 4);
#pragma unroll
                        for (int i = 0; i < 4; ++i) { v0[i] = fmaxf(l0[i] + (1.f - l0[i]) * sigm(v0[i]), 1e-30f); v1[i] = fmaxf(l1[i] + (1.f - l1[i]) * sigm(v1[i]), 1e-30f); }
                    }
                    if (grp == 2) {
                        const int hh = col >> 6, d0 = col & 63; const bool lat = row < TL;
                        const int bb = lat ? (row >> 12) : ((row - TL) >> 8), tt = lat ? (row & 4095) : ((row - TL) & 255);
                        bf16* vp = lat ? base + ((size_t)((bb * 8 + hh) * 64 + d0) << 12) + tt : base + (size_t)TL * GW + ((size_t)((bb * 8 + hh) * 64 + d0) << 8) + tt;
                        const size_t st = lat ? 4096 : 256;
#pragma unroll
                        for (int i = 0; i < 4; ++i) { vp[(size_t)i * st] = (bf16)f2bf(v0[i]); vp[(size_t)(4 + i) * st] = (bf16)f2bf(v1[i]); }
                    } else {
                    u32x4 w; w.x = pg8::cvt_pk_bf16(v0[0], v0[1]); w.y = pg8::cvt_pk_bf16(v0[2], v0[3]); w.z = pg8::cvt_pk_bf16(v1[0], v1[1]); w.w = pg8::cvt_pk_bf16(v1[2], v1[3]);
                    *(u32x4*)(base + (size_t)row * GW + col) = w; } } }
    }
};
template <int PASS> struct EpiMerge {
    static constexpr bool PERM = true, AFTER_DRAIN = false;
    bf16* M; const bf16* G;
    __device__ __forceinline__ void operator()(const f32x4 (&acc)[2][2][4][2], const pg8::Unit& u, int wr, int wc, int fr, int fq) const {
        const bf16* gb = G + (size_t)(u.pn >> 1) * GSTRIDE; const int gcol = (u.pn & 1) * 256 + wc * 32 + 8 * fq, mcol = u.pn * 256 + wc * 32 + 8 * fq;
#pragma unroll
        for (int ai = 0; ai < 2; ++ai)
#pragma unroll
            for (int m = 0; m < 4; ++m) { const int row = u.pm * 256 + ai * 128 + wr * 64 + m * 16 + fr;
#pragma unroll
                for (int bj = 0; bj < 2; ++bj) { const uint4 gw = *(const uint4*)(gb + (size_t)row * GW + gcol + bj * 128); float g[8]; unpack8(gw, g);
                    bf16* mp = M + (size_t)row * DM + mcol + bj * 128; const f32x4 v0 = acc[ai][bj][m][0], v1 = acc[ai][bj][m][1];
                    float o[8];
#pragma unroll
                    for (int i = 0; i < 4; ++i) { o[i] = sigm(g[i]) * v0[i]; o[4 + i] = sigm(g[4 + i]) * v1[i]; }
                    if (PASS == 1) { const uint4 mw = *(const uint4*)mp; float pm_[8]; unpack8(mw, pm_);
#pragma unroll
                        for (int i = 0; i < 8; ++i) o[i] += pm_[i]; }
                    u32x4 w; w.x = pg8::cvt_pk_bf16(o[0], o[1]); w.y = pg8::cvt_pk_bf16(o[2], o[3]); w.z = pg8::cvt_pk_bf16(o[4], o[5]); w.w = pg8::cvt_pk_bf16(o[6], o[7]);
                    *(u32x4*)mp = w; } }
    }
};
struct EpiOut {
    static constexpr bool PERM = false, AFTER_DRAIN = false;
    const float* xl_src; float* xl_dst; const float* xc_src; float* xc_dst; const float* mod;
    __device__ __forceinline__ void operator()(const f32x4 (&acc)[2][2][4][2], const pg8::Unit& u, int wr, int wc, int fr, int fq) const {
        const bool lat = u.pm < TL / 256; const int mr = lat ? (u.pm >> 4) : 8;
        const float* gate = mod + (size_t)mr * INW + 2048; const int col0 = u.pn * 256 + wc * 32 + 4 * fq;
        const float* src = lat ? xl_src : xc_src - (size_t)TL * DM; float* dst = lat ? xl_dst : xc_dst - (size_t)TL * DM;
        f32x4 gv[2][2];
#pragma unroll
        for (int bj = 0; bj < 2; ++bj)
#pragma unroll
            for (int n = 0; n < 2; ++n) gv[bj][n] = *(const f32x4*)(gate + col0 + bj * 128 + n * 16);
#pragma unroll
        for (int ai = 0; ai < 2; ++ai)
#pragma unroll
            for (int m = 0; m < 4; ++m) { const size_t off = (size_t)(u.pm * 256 + ai * 128 + wr * 64 + m * 16 + fr) * DM + col0;
#pragma unroll
                for (int bj = 0; bj < 2; ++bj)
#pragma unroll
                    for (int n = 0; n < 2; ++n) { const f32x4 xo = *(const f32x4*)(src + off + bj * 128 + n * 16); *(f32x4*)(dst + off + bj * 128 + n * 16) = xo + gv[bj][n] * acc[ai][bj][m][n]; } }
    }
};
struct EpiGateUp {
    static constexpr bool PERM = true, AFTER_DRAIN = false;
    bf16* A;
    __device__ __forceinline__ void operator()(const f32x4 (&acc)[2][2][4][2], const pg8::Unit& u, int wr, int wc, int fr, int fq) const {
        const int col = (u.pn & 3) * 128 + wc * 32 + 8 * fq;
#pragma unroll
        for (int ai = 0; ai < 2; ++ai)
#pragma unroll
            for (int m = 0; m < 4; ++m) { const int row = u.pm * 256 + ai * 128 + wr * 64 + m * 16 + fr; float o[8];
#pragma unroll
                for (int i = 0; i < 4; ++i) { o[i] = silu(acc[ai][0][m][0][i]) * acc[ai][1][m][0][i]; o[4 + i] = silu(acc[ai][0][m][1][i]) * acc[ai][1][m][1][i]; }
                u32x4 w; w.x = pg8::cvt_pk_bf16(o[0], o[1]); w.y = pg8::cvt_pk_bf16(o[2], o[3]); w.z = pg8::cvt_pk_bf16(o[4], o[5]); w.w = pg8::cvt_pk_bf16(o[6], o[7]);
                *(u32x4*)(A + (size_t)row * 512 + col) = w; }
    }
};
struct EpiDown {
    static constexpr bool PERM = true, AFTER_DRAIN = false;
    bf16* Y;
    __device__ __forceinline__ void operator()(const f32x4 (&acc)[2][2][4][2], const pg8::Unit& u, int wr, int wc, int fr, int fq) const {
        const int col = (u.pn & 3) * 256 + wc * 32 + 8 * fq;
#pragma unroll
        for (int ai = 0; ai < 2; ++ai)
#pragma unroll
            for (int m = 0; m < 4; ++m) { const int row = u.pm * 256 + ai * 128 + wr * 64 + m * 16 + fr;
#pragma unroll
                for (int bj = 0; bj < 2; ++bj) { const f32x4 v0 = acc[ai][bj][m][0], v1 = acc[ai][bj][m][1];
                    u32x4 w; w.x = pg8::cvt_pk_bf16(v0[0], v0[1]); w.y = pg8::cvt_pk_bf16(v0[2], v0[3]); w.z = pg8::cvt_pk_bf16(v1[0], v1[1]); w.w = pg8::cvt_pk_bf16(v1[2], v1[3]);
                    *(u32x4*)(Y + (size_t)row * DM + col + bj * 128) = w; } }
    }
};
struct MoeOrder {
    const int* tab; int G, c;
    __device__ __forceinline__ bool next(int i, pg8::Unit& u) const {
        const int L = i * G + c, MT = tab[16]; if (L >= MT * 4) return false;
        const int mt = L >> 2; int e = 0;
#pragma unroll
        for (int j = 1; j < 16; ++j) e += (mt >= tab[j]) ? 1 : 0;
        u.pm = mt; u.pn = e * 4 + (L & 3); return true;
    }
    __device__ __forceinline__ void a_ready(const pg8::Unit&) const {}
    __device__ __forceinline__ void done(const pg8::Unit&) const {}
};
__device__ __forceinline__ void moe_table(const Ctx& C, int l) {
    __syncthreads();
    if (C.tid == 0) { int acc = 0; const unsigned* cnt = C.CNT(l);
        for (int e = 0; e < 16; ++e) { C.TAB()[e] = acc; acc += (int)((__hip_atomic_load(cnt + e, __ATOMIC_RELAXED, __HIP_MEMORY_SCOPE_AGENT) + 255u) >> 8); }
        C.TAB()[16] = acc; }
    __syncthreads();
}

__device__ __forceinline__ void p3_attn_naive(const Ctx& C, int l) {
    float* pl = (float*)C.lds + C.wave * 768; int* kl = (int*)(pl + 384);
    const bf16* Q = C.GRP(0); const bf16* K = C.GRP(1); const bf16* V = C.GRP(2); bf16* O = C.GRP(0);
    const int nq = (l == 0 ? TA : TL) * 8;
    for (int wq = C.gw; wq < nq; wq += C.nw) {
        const int r = wq >> 3, h = wq & 7; const bool lat = r < TL;
        const int b = lat ? (r >> 12) : ((r - TL) >> 8);
        float q[64];
        { const uint4* qp = (const uint4*)(Q + (size_t)r * GW + h * 64);
#pragma unroll
          for (int j = 0; j < 8; ++j) { float t[8]; unpack8(qp[j], t);
#pragma unroll
              for (int i = 0; i < 8; ++i) q[8 * j + i] = t[i]; } }
        const int t = r & 4095, gr = t >> 6, gc = t & 63;
        const int rs = min(max(gr - 4, 0), 56), cs = min(max(gc - 8, 0), 48);
        float s[6]; int krow[6];
#pragma unroll
        for (int i = 0; i < 6; ++i) {
            float bias = 0.f; bool valid = true;
            if (i < 2) { const int j = C.lane + 64 * i, kr = rs + (j >> 4), kc = cs + (j & 15); krow[i] = b * 4096 + kr * 64 + kc; valid = lat;
                if (lat) bias = C.p->rel_bias[((size_t)(l * 8 + h) * 15 + (kr - gr + 7)) * 31 + (kc - gc + 15)]; if (!lat) krow[i] = TL + b * 256; }
            else krow[i] = TL + b * 256 + C.lane + 64 * (i - 2);
            const uint4* kp = (const uint4*)(K + (size_t)krow[i] * GW + h * 64); float d = 0.f;
#pragma unroll
            for (int j = 0; j < 8; ++j) { float tk[8]; unpack8(kp[j], tk);
#pragma unroll
                for (int ii = 0; ii < 8; ++ii) d += q[8 * j + ii] * tk[ii]; }
            s[i] = valid ? d * 0.125f + bias : -1e30f;
        }
        float mx = s[0];
#pragma unroll
        for (int i = 1; i < 6; ++i) mx = fmaxf(mx, s[i]);
        mx = wave_max(mx);
        float sum = 0.f;
#pragma unroll
        for (int i = 0; i < 6; ++i) { s[i] = (s[i] > -1e29f) ? __expf(s[i] - mx) : 0.f; sum += s[i]; }
        sum = wave_sum(sum); const float inv = 1.f / sum;
#pragma unroll
        for (int i = 0; i < 6; ++i) { pl[C.lane + 64 * i] = s[i] * inv; kl[C.lane + 64 * i] = krow[i]; }
        float acc = 0.f;
        for (int j = lat ? 0 : 128; j < 384; ++j) acc += pl[j] * bf2f(V[(size_t)kl[j] * GW + h * 64 + C.lane]);
        O[(size_t)r * GW + h * 64 + C.lane] = (bf16)f2bf(acc);
    }
}


typedef pg8::bf16x8 bf16x8;
typedef unsigned u32x2 __attribute__((ext_vector_type(2)));
__device__ __forceinline__ bf16x8 ld16(const bf16* p) { return *(const bf16x8*)p; }
__device__ __forceinline__ bf16x8 ld8x2(const bf16* p0, const bf16* p1) { const u32x2 a = *(const u32x2*)p0, b = *(const u32x2*)p1; u32x4 w; w.x = a.x; w.y = a.y; w.z = b.x; w.w = b.y; return __builtin_bit_cast(bf16x8, w); }
__device__ __forceinline__ bf16x8 pack8(const f32x4 a, const f32x4 b) { u32x4 w; w.x = pg8::cvt_pk_bf16(a[0], a[1]); w.y = pg8::cvt_pk_bf16(a[2], a[3]); w.z = pg8::cvt_pk_bf16(b[0], b[1]); w.w = pg8::cvt_pk_bf16(b[2], b[3]); return __builtin_bit_cast(bf16x8, w); }
#define MFMA16(a, b, c) __builtin_amdgcn_mfma_f32_16x16x32_bf16(a, b, c, 0, 0, 0)

__device__ __forceinline__ void p3_attn(const Ctx& C, int l, bool dry = false) {
    float* relb = (float*)(C.lds + 98304);
    __syncthreads();
    for (int i = C.tid; i < 8 * 15 * 32; i += 512) { const int dc = i & 31, hd = i >> 5; relb[i] = (dc < 31) ? C.p->rel_bias[(size_t)l * 8 * 15 * 31 + hd * 31 + dc] : 0.f; }
    __syncthreads();
    const bf16* Qb = C.GRP(0); const bf16* Kb = C.GRP(1); const bf16* VT = C.GRP(2); const bf16* VTc = C.GRP(2) + (size_t)TL * GW; bf16* Ob = C.GRP(0);
    const int lq = C.lane & 15, g = C.lane >> 4;
    const int nlat = 16384, nu = nlat + (l == 0 ? 1024 : 0);
    for (int u = C.gw; u < nu; u += C.nw) {
        const bool lat = u < nlat;
        int b, h, gr = 0, gc0 = 0, qrow0;
        if (lat) { const int ct = u & 3; h = (u >> 2) & 7; gr = (u >> 5) & 63; b = u >> 11; gc0 = ct * 16; qrow0 = b * 4096 + gr * 64 + gc0; }
        else { const int v = u - nlat, qt = v & 15; h = (v >> 4) & 7; b = v >> 7; qrow0 = TL + b * 256 + qt * 16; }
        const int rs = min(max(gr - 4, 0), 56), u0 = min(max(gc0 - 8, 0), 32);
        const bf16* qp = Qb + (size_t)(qrow0 + lq) * GW + h * 64 + 8 * g;
        const bf16x8 q0 = ld16(qp), q1 = ld16(qp + 32);
        f32x4 s[32];
        const f32x4 z4 = {0.f, 0.f, 0.f, 0.f};
        if (lat) {
            const int gcq = gc0 + lq, csq = min(max(gcq - 8, 0), 48);
#pragma unroll
            for (int wt = 0; wt < 16; ++wt) { const int wrow = wt >> 1, half = wt & 1;
                const bf16* kp = Kb + (size_t)(b * 4096 + (rs + wrow) * 64 + u0 + 16 * half + lq) * GW + h * 64 + 8 * g;
                f32x4 a = MFMA16(ld16(kp), q0, z4); a = MFMA16(ld16(kp + 32), q1, a);
                const float* brow = relb + (h * 15 + (rs + wrow - gr + 7)) * 32;
#pragma unroll
                for (int r = 0; r < 4; ++r) { const int kc = u0 + 16 * half + 4 * g + r; const bool valid = (kc >= csq) && (kc < csq + 16); const int dc = min(max(kc - gcq + 15, 0), 30);
                    a[r] = valid ? a[r] * 0.125f + brow[dc] : -1e30f; }
                s[wt] = a; }
        } else {
#pragma unroll
            for (int wt = 0; wt < 16; ++wt) s[wt] = (f32x4){-1e30f, -1e30f, -1e30f, -1e30f};
        }
#pragma unroll
        for (int ctile = 0; ctile < 16; ++ctile) {
            const bf16* kp = Kb + (size_t)(TL + b * 256 + ctile * 16 + lq) * GW + h * 64 + 8 * g;
            f32x4 a = MFMA16(ld16(kp), q0, z4); a = MFMA16(ld16(kp + 32), q1, a);
            s[16 + ctile] = a * 0.125f; }
        float mx = -1e30f;
#pragma unroll
        for (int i = 0; i < 32; ++i) mx = fmaxf(fmaxf(fmaxf(mx, s[i][0]), fmaxf(s[i][1], s[i][2])), s[i][3]);
        mx = fmaxf(mx, __shfl_xor(mx, 16)); mx = fmaxf(mx, __shfl_xor(mx, 32));
        float sum = 0.f;
#pragma unroll
        for (int i = 0; i < 32; ++i) {
#pragma unroll
            for (int r = 0; r < 4; ++r) { const float e = __expf(s[i][r] - mx); s[i][r] = e; sum += e; } }
        sum += __shfl_xor(sum, 16); sum += __shfl_xor(sum, 32);
        const float inv = 1.f / sum;
        f32x4 o[4] = {z4, z4, z4, z4};
        if (lat) {
#pragma unroll
            for (int wrow = 0; wrow < 8; ++wrow) { const bf16x8 pb = pack8(s[2 * wrow], s[2 * wrow + 1]);
                const bf16* vp = VT + ((size_t)((b * 8 + h) * 64 + lq) << 12) + (rs + wrow) * 64 + u0 + 4 * g;
#pragma unroll
                for (int dt = 0; dt < 4; ++dt) o[dt] = MFMA16(ld8x2(vp + ((size_t)dt << 16), vp + ((size_t)dt << 16) + 16), pb, o[dt]); }
        }
#pragma unroll
        for (int cb = 0; cb < 8; ++cb) { const bf16x8 pb = pack8(s[16 + 2 * cb], s[16 + 2 * cb + 1]);
            const bf16* vp = VTc + ((size_t)((b * 8 + h) * 64 + lq) << 8) + cb * 32 + 4 * g;
#pragma unroll
            for (int dt = 0; dt < 4; ++dt) o[dt] = MFMA16(ld8x2(vp + (dt << 12), vp + (dt << 12) + 16), pb, o[dt]); }
        bf16* op = Ob + (size_t)(qrow0 + lq) * GW + h * 64 + 4 * g;
#pragma unroll
        for (int dt = 0; dt < 4; ++dt) { u32x2 w; w.x = pg8::cvt_pk_bf16(o[dt][0] * inv, o[dt][1] * inv); w.y = pg8::cvt_pk_bf16(o[dt][2] * inv, o[dt][3] * inv); if (!dry) *(u32x2*)(op + 16 * dt) = w; }
    }
}


constexpr int AT_R1 = 0, AT_CK = 74752, AT_CV = 107520, AT_RB = 141312;
__device__ __forceinline__ int kswz(int key, int p) { return key * 128 + ((p ^ ((key >> 1) & 7)) << 4); }
__device__ __forceinline__ void p3_attn2(const Ctx& C, int l) {
    unsigned char* L = C.lds;
    const bf16* Qb = C.GRP(0); const bf16* Kb = C.GRP(1); const bf16* VT = C.GRP(2); const bf16* VTc = C.GRP(2) + (size_t)TL * GW; bf16* Ob = C.GRP(0);
    const int lq = C.lane & 15, g = C.lane >> 4;
    const int ngroups = 256 + (l == 0 ? 64 : 0);
    const f32x4 z4 = {0.f, 0.f, 0.f, 0.f};
    for (int gid = C.bid; gid < ngroups; gid += C.G) {
        const bool latg = gid < 256; const int bh = latg ? (gid >> 2) : (gid - 256); const int b = bh >> 3, h = bh & 7;
        __syncthreads();
#pragma unroll
        for (int it = 0; it < 4; ++it) { const int i = C.tid + it * 512, key = i >> 3, p = i & 7;
            *(uint4*)(L + AT_CK + kswz(key, p)) = *(const uint4*)(Kb + (size_t)(TL + b * 256 + key) * GW + h * 64 + p * 8);
            const int d = i >> 5, j = i & 31;
            *(uint4*)(L + AT_CV + d * 528 + j * 16) = *(const uint4*)(VTc + ((size_t)(bh * 64 + d) << 8) + j * 8); }
        if (C.tid < 480) { const int dr = C.tid >> 5, dc = C.tid & 31; ((float*)(L + AT_RB))[C.tid] = (dc < 31) ? C.p->rel_bias[((size_t)(l * 8 + h) * 15 + dr) * 31 + dc] : 0.f; }
        __syncthreads();
        const int nun = latg ? 8 : 2;
        for (int ui = 0; ui < nun; ++ui) {
            int gr = 0, gc0 = 0, qrow0, rsu = 0, nru = 1, rsw = 0;
            if (latg) { const int gr0 = ((gid & 3) * 8 + ui) * 2; gr = gr0 + (C.wave >> 2); gc0 = (C.wave & 3) * 16; qrow0 = b * 4096 + gr * 64 + gc0;
                rsu = min(max(gr0 - 4, 0), 56); nru = min(9, 64 - rsu); rsw = min(max(gr - 4, 0), 56); }
            else qrow0 = TL + b * 256 + (ui * 8 + C.wave) * 16;
            const int u0 = min(max(gc0 - 8, 0), 32);
            const bf16* qp = Qb + (size_t)(qrow0 + lq) * GW + h * 64 + 8 * g;
            const bf16x8 q0 = ld16(qp), q1 = ld16(qp + 32);
            uint4 kv[9]; const int limk = nru * 512;
            if (latg) {
#pragma unroll
                for (int it = 0; it < 9; ++it) { const int i = min(C.tid + it * 512, limk - 1); kv[it] = *(const uint4*)(Kb + (size_t)(b * 4096 + rsu * 64 + (i >> 3)) * GW + h * 64 + (i & 7) * 8); }
            } else {
#pragma unroll
                for (int it = 0; it < 9; ++it) kv[it] = make_uint4(0u, 0u, 0u, 0u);
            }
            f32x4 oc[4] = {z4, z4, z4, z4}; float mc, sc;
            { f32x4 s[16];
#pragma unroll
              for (int ct = 0; ct < 16; ++ct) { const int key = ct * 16 + lq;
                  f32x4 a = MFMA16(*(const bf16x8*)(L + AT_CK + kswz(key, g)), q0, z4); a = MFMA16(*(const bf16x8*)(L + AT_CK + kswz(key, 4 + g)), q1, a);
                  s[ct] = a * 0.125f; }
              float mx = -1e30f;
#pragma unroll
              for (int i = 0; i < 16; ++i) mx = fmaxf(fmaxf(fmaxf(mx, s[i][0]), fmaxf(s[i][1], s[i][2])), s[i][3]);
              mx = fmaxf(mx, __shfl_xor(mx, 16)); mx = fmaxf(mx, __shfl_xor(mx, 32));
              float sum = 0.f;
#pragma unroll
              for (int i = 0; i < 16; ++i) {
#pragma unroll
                  for (int r = 0; r < 4; ++r) { const float e = __expf(s[i][r] - mx); s[i][r] = e; sum += e; } }
              sum += __shfl_xor(sum, 16); sum += __shfl_xor(sum, 32);
              mc = mx; sc = sum;
#pragma unroll
              for (int cb = 0; cb < 8; ++cb) { const bf16x8 pb = pack8(s[2 * cb], s[2 * cb + 1]);
                  const unsigned char* vp = L + AT_CV + lq * 528 + (cb * 32 + 4 * g) * 2;
#pragma unroll
                  for (int dt = 0; dt < 4; ++dt) oc[dt] = MFMA16(ld8x2((const bf16*)(vp + dt * 16 * 528), (const bf16*)(vp + dt * 16 * 528 + 32)), pb, oc[dt]); } }
            float inv = 1.f / sc;
            if (latg) {
                __syncthreads();
#pragma unroll
                for (int it = 0; it < 9; ++it) { const int i = C.tid + it * 512; if (i < limk) *(uint4*)(L + AT_R1 + kswz(i >> 3, i & 7)) = kv[it]; }
                __syncthreads();
                const int gcq = gc0 + lq, csq = min(max(gcq - 8, 0), 48);
                const float* rb = (const float*)(L + AT_RB);
                f32x4 s[16];
#pragma unroll
                for (int wt = 0; wt < 16; ++wt) { const int wrow = wt >> 1, half = wt & 1;
                    const int key = (rsw - rsu + wrow) * 64 + u0 + 16 * half + lq;
                    f32x4 a = MFMA16(*(const bf16x8*)(L + AT_R1 + kswz(key, g)), q0, z4); a = MFMA16(*(const bf16x8*)(L + AT_R1 + kswz(key, 4 + g)), q1, a);
                    const float* brow = rb + (rsw + wrow - gr + 7) * 32;
#pragma unroll
                    for (int r = 0; r < 4; ++r) { const int kc = u0 + 16 * half + 4 * g + r; const bool valid = (kc >= csq) && (kc < csq + 16); const int dc = min(max(kc - gcq + 15, 0), 30);
                        a[r] = valid ? a[r] * 0.125f + brow[dc] : -1e30f; }
                    s[wt] = a; }
                __syncthreads();
                uint4 vv[9]; const int npr = nru * 8, limv = npr * 64;
#pragma unroll
                for (int it = 0; it < 9; ++it) { const int i = min(C.tid + it * 512, limv - 1); const int d = i / npr, j = i - d * npr; vv[it] = *(const uint4*)(VT + ((size_t)(bh * 64 + d) << 12) + rsu * 64 + j * 8); }
                float mx = -1e30f;
#pragma unroll
                for (int i = 0; i < 16; ++i) mx = fmaxf(fmaxf(fmaxf(mx, s[i][0]), fmaxf(s[i][1], s[i][2])), s[i][3]);
                mx = fmaxf(mx, __shfl_xor(mx, 16)); mx = fmaxf(mx, __shfl_xor(mx, 32));
                float sum = 0.f;
#pragma unroll
                for (int i = 0; i < 16; ++i) {
#pragma unroll
                    for (int r = 0; r < 4; ++r) { const float e = __expf(s[i][r] - mx); s[i][r] = e; sum += e; } }
                sum += __shfl_xor(sum, 16); sum += __shfl_xor(sum, 32);
#pragma unroll
                for (int it = 0; it < 9; ++it) { const int i = C.tid + it * 512; if (i < limv) { const int d = i / npr, j = i - d * npr; *(uint4*)(L + AT_R1 + d * 1168 + j * 16) = vv[it]; } }
                __syncthreads();
                f32x4 ow[4] = {z4, z4, z4, z4};
#pragma unroll
                for (int wrow = 0; wrow < 8; ++wrow) { const bf16x8 pb = pack8(s[2 * wrow], s[2 * wrow + 1]);
                    const unsigned char* vp = L + AT_R1 + lq * 1168 + ((rsw - rsu + wrow) * 64 + u0 + 4 * g) * 2;
#pragma unroll
                    for (int dt = 0; dt < 4; ++dt) ow[dt] = MFMA16(ld8x2((const bf16*)(vp + dt * 16 * 1168), (const bf16*)(vp + dt * 16 * 1168 + 32)), pb, ow[dt]); }
                const float m = fmaxf(mc, mx), fc = __expf(mc - m), fw = __expf(mx - m);
                inv = 1.f / (sc * fc + sum * fw);
#pragma unroll
                for (int dt = 0; dt < 4; ++dt) oc[dt] = oc[dt] * fc + ow[dt] * fw;
            }
            bf16* op = Ob + (size_t)(qrow0 + lq) * GW + h * 64 + 4 * g;
#pragma unroll
            for (int dt = 0; dt < 4; ++dt) { u32x2 w; w.x = pg8::cvt_pk_bf16(oc[dt][0] * inv, oc[dt][1] * inv); w.y = pg8::cvt_pk_bf16(oc[dt][2] * inv, oc[dt][3] * inv); *(u32x2*)(op + 16 * dt) = w; }
        }
    }
    __syncthreads();
}

__device__ __forceinline__ int scan_row(int b, int dir, int s) { return dir == 0 ? (s < NCTX ? TL + b * NCTX + s : b * SEQ + (s - NCTX)) : (s < NCTX ? TL + b * NCTX + (NCTX - 1 - s) : b * SEQ + (SEQ - 1 - (s - NCTX))); }
constexpr int SC_QT = 0, SC_KT = 17408, SC_QS = 34816, SC_KST = 52224, SC_VT = 70656, SC_DV = 75264, SC_TOT = 75776;
__device__ __forceinline__ float ex2(float x) { return __builtin_amdgcn_exp2f(x); }
__device__ __forceinline__ void p3_scan(const Ctx& C, int l) {
    unsigned char* L = C.lds;
    const int k = C.tid & 127, tq = C.tid >> 7, lq = C.lane & 15, g = C.lane >> 4, tt = C.wave >> 1, vt = C.wave & 1;
    const bf16* HQ = C.GRP(3); const bf16* HI = C.GRP(6);
    for (int u = C.bid; u < 256; u += C.G) {
        const int dvq = u & 3, dir = (u >> 2) & 1, h = (u >> 3) & 3, b = u >> 5;
        const bf16* HF = C.GRP(dir ? 5 : 4); bf16* OUT = C.H() + (size_t)dir * GSTRIDE;
        const int sgn = dir ? -1 : 1;
        f32x4 S[8];
#pragma unroll
        for (int i = 0; i < 8; ++i) S[i] = (f32x4){0.f, 0.f, 0.f, 0.f};
        unsigned gv[16], qv[16]; u32x2 vraw;
        const int vs = C.tid >> 3, v4 = (C.tid & 7) * 4;
        { const int row0 = scan_row(b, dir, 0);
#pragma unroll
          for (int i = 0; i < 16; ++i) { const size_t ro = (size_t)(row0 + sgn * (16 * tq + i)) * GW + h * 128 + k; gv[i] = HF[ro]; qv[i] = HQ[ro]; }
          vraw = *(const u32x2*)(HI + (size_t)(row0 + sgn * vs) * GW + h * 128 + dvq * 32 + v4); }
        for (int c = 0; c < 68; ++c) {
            const int row0 = scan_row(b, dir, 64 * c);
            float cs[16]; float run = 0.f;
#pragma unroll
            for (int i = 0; i < 16; ++i) { run += __builtin_amdgcn_logf(bf2f(gv[i])); cs[i] = run; }
            ((float*)(L + SC_TOT))[tq * 128 + k] = run;
            __syncthreads();
            const float t0 = ((float*)(L + SC_TOT))[k], t1 = ((float*)(L + SC_TOT))[128 + k], t2 = ((float*)(L + SC_TOT))[256 + k], t3 = ((float*)(L + SC_TOT))[384 + k];
            const float beta = t0 + t1, last = beta + t2 + t3;
            const float off = (tq == 0) ? 0.f : (tq == 1) ? t0 : (tq == 2) ? beta : beta + t2;
            const float eb = ex2(fmaxf(beta, -120.f)), el = ex2(fmaxf(last - beta, -120.f));
            float ks_[16];
#pragma unroll
            for (int i = 0; i < 16; ++i) { const float d = off + cs[i] - beta; const float e1 = ex2(fminf(fmaxf(d, -120.f), 120.f)), r1 = ex2(fminf(fmaxf(-d, -120.f), 120.f));
                const float q = bf2f(qv[i]), kk = 1.f - bf2f(gv[i]); const float qt = q * e1, kt = kk * r1; const int t = 16 * tq + i;
                *(bf16*)(L + SC_QT + t * 272 + k * 2) = (bf16)f2bf(qt); *(bf16*)(L + SC_KT + t * 272 + k * 2) = (bf16)f2bf(kt); *(bf16*)(L + SC_QS + t * 272 + k * 2) = (bf16)f2bf(qt * eb); ks_[i] = kt * el; }
            { uint4 w0, w1; w0.x = pk2(ks_[0], ks_[1]); w0.y = pk2(ks_[2], ks_[3]); w0.z = pk2(ks_[4], ks_[5]); w0.w = pk2(ks_[6], ks_[7]); w1.x = pk2(ks_[8], ks_[9]); w1.y = pk2(ks_[10], ks_[11]); w1.z = pk2(ks_[12], ks_[13]); w1.w = pk2(ks_[14], ks_[15]);
              *(uint4*)(L + SC_KST + k * 144 + tq * 32) = w0; *(uint4*)(L + SC_KST + k * 144 + tq * 32 + 16) = w1; }
            if (tq == 0) ((float*)(L + SC_DV))[k] = ex2(fmaxf(last, -120.f));
            { *(bf16*)(L + SC_VT + (v4 + 0) * 144 + vs * 2) = (bf16)(vraw.x & 0xffffu); *(bf16*)(L + SC_VT + (v4 + 1) * 144 + vs * 2) = (bf16)(vraw.x >> 16);
              *(bf16*)(L + SC_VT + (v4 + 2) * 144 + vs * 2) = (bf16)(vraw.y & 0xffffu); *(bf16*)(L + SC_VT + (v4 + 3) * 144 + vs * 2) = (bf16)(vraw.y >> 16); }
            __syncthreads();
            if (c + 1 < 68) { const int nrow0 = scan_row(b, dir, 64 * (c + 1));
#pragma unroll
                for (int i = 0; i < 16; ++i) { const size_t ro = (size_t)(nrow0 + sgn * (16 * tq + i)) * GW + h * 128 + k; gv[i] = HF[ro]; qv[i] = HQ[ro]; }
                vraw = *(const u32x2*)(HI + (size_t)(nrow0 + sgn * vs) * GW + h * 128 + dvq * 32 + v4); }
            const f32x4 z4 = {0.f, 0.f, 0.f, 0.f};
            f32x4 o = z4;
            { const unsigned char* qb = L + SC_QT + (16 * tt + lq) * 272 + g * 16;
              bf16x8 qf[4];
#pragma unroll
              for (int ks = 0; ks < 4; ++ks) qf[ks] = *(const bf16x8*)(qb + ks * 64);
              const int tcol = 16 * tt + lq;
#pragma unroll
              for (int sp = 0; sp < 2; ++sp) if (sp <= (tt >> 1)) {
                  f32x4 X[2];
#pragma unroll
                  for (int hf = 0; hf < 2; ++hf) { const int st = 2 * sp + hf; const unsigned char* kb = L + SC_KT + (16 * st + lq) * 272 + g * 16; f32x4 a = z4;
#pragma unroll
                      for (int ks = 0; ks < 4; ++ks) a = MFMA16(*(const bf16x8*)(kb + ks * 64), qf[ks], a);
#pragma unroll
                      for (int r = 0; r < 4; ++r) a[r] = (16 * st + 4 * g + r <= tcol) ? a[r] : 0.f;
                      X[hf] = a; }
                  const unsigned char* vb = L + SC_VT + (16 * vt + lq) * 144 + (32 * sp + 4 * g) * 2;
                  o = MFMA16(pack8(X[0], X[1]), ld8x2((const bf16*)vb, (const bf16*)(vb + 32)), o); } }
            { const unsigned char* sb = L + SC_QS + (16 * tt + lq) * 272 + (4 * g) * 2;
#pragma unroll
              for (int kp = 0; kp < 4; ++kp) o = MFMA16(ld8x2((const bf16*)(sb + kp * 64), (const bf16*)(sb + kp * 64 + 32)), pack8(S[2 * kp], S[2 * kp + 1]), o); }
            { bf16* op = OUT + (size_t)(row0 + sgn * (16 * tt + 4 * g)) * GW + h * 128 + dvq * 32 + 16 * vt + lq;
#pragma unroll
              for (int r = 0; r < 4; ++r) op[(ptrdiff_t)(sgn * r) * GW] = (bf16)f2bf(o[r]); }
            { const unsigned char* vb = L + SC_VT + (16 * vt + lq) * 144 + g * 16; const bf16x8 vf0 = *(const bf16x8*)vb, vf1 = *(const bf16x8*)(vb + 64);
#pragma unroll
              for (int kt = 0; kt < 8; ++kt) { const f32x4 dsc = *(const f32x4*)(L + SC_DV + (16 * kt + 4 * g) * 4); const unsigned char* kb = L + SC_KST + (16 * kt + lq) * 144 + g * 16;
                  f32x4 a = S[kt] * dsc; a = MFMA16(*(const bf16x8*)kb, vf0, a); a = MFMA16(*(const bf16x8*)(kb + 64), vf1, a); S[kt] = a; } }
        }
        __syncthreads();
    }
}

__device__ __forceinline__ void p3_scan_naive(const Ctx& C, int l) {
    const bf16* HQ = C.GRP(3); const bf16* HI = C.GRP(6);
    for (int u = C.gw; u < 2048; u += C.nw) {
        const int dv4 = u & 31, dir = (u >> 5) & 1, h = (u >> 6) & 3, b = u >> 8;
        const bf16* HF = C.GRP(dir ? 5 : 4); bf16* OUT = C.H() + (size_t)dir * GSTRIDE;
        const float lb0 = C.LB()[(l * 2 + dir) * 512 + h * 128 + C.lane], lb1 = C.LB()[(l * 2 + dir) * 512 + h * 128 + 64 + C.lane];
        float S0[4] = {0.f, 0.f, 0.f, 0.f}, S1[4] = {0.f, 0.f, 0.f, 0.f};
        const int NS = NCTX + SEQ;
        int row = scan_row(b, dir, 0);
        unsigned q0 = HQ[(size_t)row * GW + h * 128 + C.lane], q1 = HQ[(size_t)row * GW + h * 128 + 64 + C.lane], f0 = HF[(size_t)row * GW + h * 128 + C.lane], f1 = HF[(size_t)row * GW + h * 128 + 64 + C.lane];
        uint2 vv = *(const uint2*)(HI + (size_t)row * GW + h * 128 + dv4 * 4);
        for (int s = 0; s < NS; ++s) {
            const int nrow = scan_row(b, dir, (s + 1 < NS) ? s + 1 : s);
            const unsigned nq0 = HQ[(size_t)nrow * GW + h * 128 + C.lane], nq1 = HQ[(size_t)nrow * GW + h * 128 + 64 + C.lane], nf0 = HF[(size_t)nrow * GW + h * 128 + C.lane], nf1 = HF[(size_t)nrow * GW + h * 128 + 64 + C.lane];
            const uint2 nvv = *(const uint2*)(HI + (size_t)nrow * GW + h * 128 + dv4 * 4);
            const float qa = silu(bf2f(q0)), qb = silu(bf2f(q1));
            const float fa = fminf(fmaxf(bf2f(f0), -30.f), 30.f), fb = fminf(fmaxf(bf2f(f1), -30.f), 30.f);
            const float ea = __expf(-fa), eb = __expf(-fb);
            const float sga = 1.f / (1.f + ea), sgb = 1.f / (1.f + eb);
            const float ga = fmaxf(lb0 + (1.f - lb0) * sga, 1e-30f), gb = fmaxf(lb1 + (1.f - lb1) * sgb, 1e-30f);
            const float ka = (1.f - lb0) * (ea * sga), kb = (1.f - lb1) * (eb * sgb);
            const float v[4] = {bflo(vv.x), bfhi(vv.x), bflo(vv.y), bfhi(vv.y)};
            float o[4];
#pragma unroll
            for (int j = 0; j < 4; ++j) { S0[j] = ga * S0[j] + ka * v[j]; S1[j] = gb * S1[j] + kb * v[j]; o[j] = wave_sum(qa * S0[j] + qb * S1[j]); }
            if (C.lane == 0) { uint2 w; w.x = pk2(o[0], o[1]); w.y = pk2(o[2], o[3]); *(uint2*)(OUT + (size_t)row * GW + h * 128 + dv4 * 4) = w; }
            row = nrow; q0 = nq0; q1 = nq1; f0 = nf0; f1 = nf1; vv = nvv;
        }
    }
}

__device__ __forceinline__ void p3c_headnorm(const Ctx& C, int l) {
    const int nrows = (l == 0) ? TA : TL;
    bf16* OF = C.H(); const bf16* OB = C.H() + GSTRIDE; const bf16* HG = C.GRP(7);
    const float* gain = C.p->hg_norm_g + l * 128;
    for (int r = C.gw; r < nrows; r += C.nw) {
        const size_t off = (size_t)r * GW + C.lane * 8;
        float a[8], b[8], g[8]; unpack8(*(const uint4*)(OF + off), a); unpack8(*(const uint4*)(OB + off), b); unpack8(*(const uint4*)(HG + off), g);
        float ss = 0.f;
#pragma unroll
        for (int i = 0; i < 8; ++i) { a[i] += b[i]; ss += a[i] * a[i]; }
        ss += __shfl_xor(ss, 1); ss += __shfl_xor(ss, 2); ss += __shfl_xor(ss, 4); ss += __shfl_xor(ss, 8);
        const float rinv = rsqrtf(ss * (1.f / 128.f) + EPS);
        const int cg = (C.lane & 15) * 8; float o[8];
#pragma unroll
        for (int i = 0; i < 8; ++i) o[i] = a[i] * rinv * gain[cg + i] * silu(g[i]);
        uint4 w; w.x = pk2(o[0], o[1]); w.y = pk2(o[2], o[3]); w.z = pk2(o[4], o[5]); w.w = pk2(o[6], o[7]);
        *(uint4*)(OF + off) = w;
    }
}

__device__ __forceinline__ int e_of(const Ctx& C, int i) { return C.TOKE()[i]; }
__device__ __forceinline__ void p5_norm2_router(const Ctx& C, int l) {
    float* wr = (float*)C.lds;
    unsigned* lcnt = (unsigned*)(C.lds + 65536);
    for (int i = C.tid; i < 1024 * 16; i += 512) wr[(i & 15) * 1024 + (i >> 4)] = C.p->w_router[i];
    if (C.tid < 32) lcnt[C.tid] = 0u;
    __syncthreads();
    const int nrows = (l == 0) ? TA : TL;
    float rb[16];
#pragma unroll
    for (int e = 0; e < 16; ++e) rb[e] = C.p->router_bias[e];
    for (int r = C.gw; r < nrows; r += C.nw) {
        const float* xr = r < TL ? C.p->out + (size_t)r * DM : C.CTXS() + (size_t)(r - TL) * DM;
        float v[16], h[16]; load_row(xr, C.lane, v);
        const float rinv = row_rinv(v);
        const float* mod = C.MOD() + (size_t)(l * 9 + modrow_of(r)) * INW;
        norm_mod(v, rinv, C.p->norm2_g + l * DM, mod + 4096, mod + 3072, C.lane, h);
        store_row_bf16(C.H() + (size_t)r * DM, C.lane, h);
        float lgv = 0.f;
#pragma unroll 1
        for (int e = 0; e < 16; ++e) { const float* we = wr + e * 1024 + C.lane * 4; float a = 0.f;
#pragma unroll
            for (int j = 0; j < 4; ++j) { const float4 ww = *(const float4*)(we + j * 256); a += h[4 * j] * ww.x + h[4 * j + 1] * ww.y + h[4 * j + 2] * ww.z + h[4 * j + 3] * ww.w; }
            a = wave_sum(a); lgv = (C.lane == e) ? a : lgv; }
        float lg[16];
#pragma unroll
        for (int e = 0; e < 16; ++e) lg[e] = __shfl(lgv, e);
        float bestg = -1e30f; int e0 = 0, e1 = 1; float s0 = 0.f, s1 = 0.f;
#pragma unroll
        for (int g = 0; g < 4; ++g) {
            float sc[4], gbv[4];
#pragma unroll
            for (int j = 0; j < 4; ++j) { sc[j] = 1.f / (1.f + expf(-lg[4 * g + j])); gbv[j] = sc[j] + rb[4 * g + j]; }
            int i0 = 0; float b0 = gbv[0], u0 = sc[0];
#pragma unroll
            for (int j = 1; j < 4; ++j) if (gbv[j] > b0) { b0 = gbv[j]; i0 = j; u0 = sc[j]; }
            int i1 = -1; float b1 = -1e30f, u1 = 0.f;
#pragma unroll
            for (int j = 0; j < 4; ++j) if (j != i0 && gbv[j] > b1) { b1 = gbv[j]; i1 = j; u1 = sc[j]; }
            const float gs = b0 + b1;
            if (gs > bestg) { bestg = gs; e0 = 4 * g + i0; e1 = 4 * g + i1; s0 = u0; s1 = u1; }
        }
        if (C.lane == 0) {
            const float den = s0 + s1;
            const int r0 = (int)atomicAdd(lcnt + e0, 1u), r1 = (int)atomicAdd(lcnt + e1, 1u);
            C.TOKE()[2 * r] = e0; C.TOKE()[2 * r + 1] = e1; C.TOKW()[2 * r] = s0 / den; C.TOKW()[2 * r + 1] = s1 / den; C.TOKS()[2 * r] = r0; C.TOKS()[2 * r + 1] = r1;
        }
    }
    __syncthreads();
    if (C.tid < 16) lcnt[16 + C.tid] = atomicAdd(C.CNT(l) + C.tid, lcnt[C.tid]);
    __syncthreads();
    if (C.lane == 0) for (int r = C.gw; r < nrows; r += C.nw) { C.TOKS()[2 * r] += (int)lcnt[16 + e_of(C, 2 * r)]; C.TOKS()[2 * r + 1] += (int)lcnt[16 + e_of(C, 2 * r + 1)]; }
    __syncthreads();
}

__device__ __forceinline__ void p6_permute(const Ctx& C, int l) {
    moe_table(C, l);
    const int nrows = (l == 0) ? TA : TL;
    for (int r = C.gw; r < nrows; r += C.nw) {
        const int e0 = C.TOKE()[2 * r], e1 = C.TOKE()[2 * r + 1];
        const int sl0 = C.TAB()[e0] * 256 + C.TOKS()[2 * r], sl1 = C.TAB()[e1] * 256 + C.TOKS()[2 * r + 1];
        const uint4* src = (const uint4*)(C.H() + (size_t)r * DM);
        const uint4 a = src[C.lane], b = src[64 + C.lane];
        uint4* d0 = (uint4*)(C.XS() + (size_t)sl0 * DM); uint4* d1 = (uint4*)(C.XS() + (size_t)sl1 * DM);
        d0[C.lane] = a; d0[64 + C.lane] = b; d1[C.lane] = a; d1[64 + C.lane] = b;
        if (C.lane == 0) { C.TOKS()[2 * r] = sl0; C.TOKS()[2 * r + 1] = sl1; }
    }
}

__device__ __forceinline__ void p9_combine(const Ctx& C, int l) {
    const int nrows = (l == 0) ? TA : TL; const bf16* YS = C.XS();
    for (int r = C.gw; r < nrows; r += C.nw) {
        float* xr = r < TL ? C.p->out + (size_t)r * DM : C.CTXS() + (size_t)(r - TL) * DM;
        float v[16]; load_row(xr, C.lane, v);
        const int s0 = C.TOKS()[2 * r], s1 = C.TOKS()[2 * r + 1]; const float w0 = C.TOKW()[2 * r], w1 = C.TOKW()[2 * r + 1];
        const float* mod = C.MOD() + (size_t)(l * 9 + modrow_of(r)) * INW;
#pragma unroll
        for (int j = 0; j < 4; ++j) { const int c = j * 256 + C.lane * 4; const uint2 a = *(const uint2*)(YS + (size_t)s0 * DM + c), b = *(const uint2*)(YS + (size_t)s1 * DM + c); const float4 g = *(const float4*)(mod + 5120 + c);
            v[4 * j] += g.x * (w0 * bflo(a.x) + w1 * bflo(b.x)); v[4 * j + 1] += g.y * (w0 * bfhi(a.x) + w1 * bfhi(b.x));
            v[4 * j + 2] += g.z * (w0 * bflo(a.y) + w1 * bflo(b.y)); v[4 * j + 3] += g.w * (w0 * bfhi(a.y) + w1 * bfhi(b.y)); }
        const float rinv = row_rinv(v);
        if (l == 0) {
#pragma unroll
            for (int j = 0; j < 4; ++j) *(float4*)(xr + j * 256 + C.lane * 4) = make_float4(v[4 * j], v[4 * j + 1], v[4 * j + 2], v[4 * j + 3]);
            float h[16]; const float* mod1 = C.MOD() + (size_t)(9 + modrow_of(r)) * INW;
            norm_mod(v, rinv, C.p->norm1_g + DM, mod1 + 1024, mod1, C.lane, h);
            store_row_bf16(C.H() + (size_t)r * DM, C.lane, h);
        } else {
#pragma unroll
            for (int j = 0; j < 4; ++j) { const int c = j * 256 + C.lane * 4; const float4 g = *(const float4*)(C.p->final_g + c);
                *(float4*)(xr + c) = make_float4(v[4 * j] * rinv * g.x, v[4 * j + 1] * rinv * g.y, v[4 * j + 2] * rinv * g.z, v[4 * j + 3] * rinv * g.w); }
        }
    }
}

#ifndef PHMASK
#define PHMASK 0xFFFFu
#endif
#define PHON(i) (((PHMASK) >> (i)) & 1u)
constexpr int NPH = 22;
__global__ void __launch_bounds__(512, 2) mk_fwd(Params p) {
    extern __shared__ __attribute__((aligned(16))) unsigned char lds_raw[];
    LAS unsigned char* ldsl = (LAS unsigned char*)lds_raw;
    if (threadIdx.x < 64) ((LAS unsigned*)(ldsl + LDS_STAGE))[threadIdx.x] = 0u;
    __syncthreads();
    XcdBarrier bar = xcd_barrier_post((unsigned*)(p.ws + WS_CTL) + CW_BAR + p.li * XCD_BAR_WORDS, (volatile LAS unsigned*)(ldsl + LDS_STAGE) + LDSW_BAR);
#define MKCTX() Ctx C; { unsigned long long kp_ = (unsigned long long)__builtin_amdgcn_kernarg_segment_ptr(); asm volatile("" : "+s"(kp_)); C.p.q = (ParamsK)kp_; } \
    C.ws = C.p->ws; C.lds = lds_raw; { int t_ = threadIdx.x, g_ = gridDim.x, b_ = blockIdx.x; asm volatile("" : "+v"(t_), "+s"(g_), "+s"(b_)); C.tid = t_; C.G = g_; C.bid = b_; } \
    C.lane = C.tid & 63; C.wave = __builtin_amdgcn_readfirstlane(C.tid >> 6); C.gw = C.bid * 8 + C.wave; C.nw = C.G * 8;
    const int lo = p.lo, hi = p.hi;
#define IN(k) (lo <= (k) && (k) < hi)
#ifdef PROBE_BAR
#define SEAM(k) do { if (IN((k) + 1)) { xcd_barrier(bar); xcd_barrier(bar); xcd_barrier(bar); } } while (0)
#else
#define SEAM(k) do { if (IN((k) + 1)) xcd_barrier(bar); } while (0)
#endif

    if (PHON(0) && IN(0)) { MKCTX(); p0_prologue(C);
#ifdef PROBE_P0
        __syncthreads(); p0_prologue(C);
#endif
        SEAM(0); }
    if (PHON(1) && IN(1)) { MKCTX(); p1_norm1(C, 0, C.p->x, C.p->ctx); SEAM(1); }
    for (int l = 0; l < 2; ++l) {
        const int pb = 2 + 10 * l;
        const int mrows = (l == 0) ? TA : TL;
        if (PHON(2) && IN(pb + 0)) {
            MKCTX();
            pg8::Gemm g{C.H(), C.WIN_T(), TA, INW, DM}; pg8::StaticOrder S; S.init(TA, INW, C.G, C.bid);
            EpiInProj E{C.GRP(0), C.ROPE(), C.LB() + l * 1024};
            pg8::gemm_phase<EpiInProj, pg8::StaticOrder, true, true>(ldsl, g, S, E);
#ifdef PROBE_P2
            __syncthreads(); pg8::gemm_phase<EpiInProj, pg8::StaticOrder, true, true>(ldsl, g, S, E);
#endif
            SEAM(pb + 0);
        }
        if (PHON(3) && IN(pb + 1)) {
            MKCTX();
#ifndef NO_SCAN
            p3_scan(C, l);
#endif
#ifdef PROBE_SCAN2
            p3_scan(C, l);
#endif
#ifdef PROBE_ATTN2
            p3_attn(C, l, C.p->pad == 0);
#endif
#ifndef NO_ATTN
            p3_attn2(C, l);
#endif
            SEAM(pb + 1);
        }
        if (PHON(4) && IN(pb + 2)) { MKCTX(); p3c_headnorm(C, l); SEAM(pb + 2); }
        if (PHON(5) && IN(pb + 3)) {
            MKCTX();
            pg8::StaticOrder S; S.init(mrows, DM, C.G, C.bid);
            { pg8::Gemm g{C.GRP(0), C.WNA_T(), mrows, DM, 512}; EpiMerge<0> E{C.MB(), C.GRP(8)}; pg8::gemm_phase<EpiMerge<0>, pg8::StaticOrder, true, true>(ldsl, g, S, E); }
            __syncthreads();
            { pg8::Gemm g{C.H(), C.WHG_T(), mrows, DM, 512}; EpiMerge<1> E{C.MB(), C.GRP(10)}; pg8::gemm_phase<EpiMerge<1>, pg8::StaticOrder, true, true>(ldsl, g, S, E); }
            SEAM(pb + 3);
        }
        if (PHON(6) && IN(pb + 4)) {
            MKCTX();
            pg8::StaticOrder S; S.init(mrows, DM, C.G, C.bid);
            pg8::Gemm g{C.MB(), C.WOUT_T(), mrows, DM, DM};
            EpiOut E{l == 0 ? C.p->x : (const float*)C.p->out, C.p->out, C.p->ctx, C.CTXS(), C.MOD() + (size_t)l * 9 * INW};
            pg8::gemm_phase<EpiOut, pg8::StaticOrder, true, true>(ldsl, g, S, E);
            conv_experts(C, l);
#ifdef PROBE_CE
            conv_experts(C, l);
#endif
            SEAM(pb + 4);
        }
        if (PHON(7) && IN(pb + 5)) { MKCTX(); p5_norm2_router(C, l); SEAM(pb + 5); }
        if (PHON(8) && IN(pb + 6)) { MKCTX(); p6_permute(C, l); SEAM(pb + 6); }
        if (PHON(9) && IN(pb + 7)) {
            MKCTX();
            moe_table(C, l);
            MoeOrder S{C.TAB(), C.G, C.bid};
            pg8::Gemm g{C.XS(), C.WEGU(), SLOT_ROWS, 16384, DM}; EpiGateUp E{C.ACT()};
            pg8::gemm_phase<EpiGateUp, MoeOrder, true, true>(ldsl, g, S, E);
#ifdef PROBE_P7
            __syncthreads(); pg8::gemm_phase<EpiGateUp, MoeOrder, true, true>(ldsl, g, S, E);
#endif
            SEAM(pb + 7);
        }
        if (PHON(10) && IN(pb + 8)) {
            MKCTX();
            moe_table(C, l);
            MoeOrder S{C.TAB(), C.G, C.bid};
            pg8::Gemm g{C.ACT(), C.WED(), SLOT_ROWS, 16384, 512}; EpiDown E{C.XS()};
            pg8::gemm_phase<EpiDown, MoeOrder, true, true>(ldsl, g, S, E);
#ifdef PROBE_P8
            __syncthreads(); pg8::gemm_phase<EpiDown, MoeOrder, true, true>(ldsl, g, S, E);
#endif
            SEAM(pb + 8);
        }
        if (PHON(11) && IN(pb + 9)) { MKCTX(); p9_combine(C, l); if (l == 0) conv_mixer(C, 1); SEAM(pb + 9); }
    }
#undef IN
#undef SEAM
}

#ifndef MK_SPLIT
#define MK_SPLIT 0
#endif
extern "C" void kernel_launch(void* const* d_in, const int* in_sizes, int n_in, void* d_out, int out_size, void* d_ws, size_t ws_size, hipStream_t stream) {
    static int grid = 0;
    if (grid == 0) {
        if (n_in != 22 || ws_size < WS_END) { fprintf(stderr, "kernel_launch: unexpected n_in %d / ws_size %zu (need %zu)\n", n_in, ws_size, (size_t)WS_END); grid = -1; return; }
        int dev = 0, cus = 0, per_cu = 0;
        if (hipGetDevice(&dev) != hipSuccess || hipDeviceGetAttribute(&cus, hipDeviceAttributeMultiprocessorCount, dev) != hipSuccess) { grid = -1; return; }
        if (hipFuncSetAttribute((const void*)mk_fwd, hipFuncAttributeMaxDynamicSharedMemorySize, LDS_BYTES) != hipSuccess) { fprintf(stderr, "kernel_launch: hipFuncSetAttribute failed\n"); grid = -1; return; }
        if (hipOccupancyMaxActiveBlocksPerMultiprocessor(&per_cu, (const void*)mk_fwd, 512, LDS_BYTES) != hipSuccess || per_cu < 1) fprintf(stderr, "kernel_launch: occupancy query says %d\n", per_cu);
        (void)hipGetLastError();
        grid = cus;
    }
    if (grid < 0) return;
    if (hipMemsetAsync((char*)d_ws + WS_CTL, 0, CTL_BYTES, stream) != hipSuccess) return;
    Params p{};
    const float** pp = (const float**)&p;
    for (int i = 0; i < 22; ++i) pp[i] = (const float*)d_in[i];
    p.out = (float*)d_out; p.ws = (unsigned char*)d_ws; p.pad = 0;
#if MK_SPLIT
    for (int k = 0; k < NPH; ++k) { p.lo = k; p.hi = k + 1; p.li = k; hipLaunchKernelGGL(mk_fwd, dim3(grid), dim3(512), LDS_BYTES, stream, p); }
#else
    p.lo = 0; p.hi = NPH; p.li = 0;
    hipLaunchKernelGGL(mk_fwd, dim3(grid), dim3(512), LDS_BYTES, stream, p);
#endif
}
```

```cpp
#include <hip/hip_runtime.h>
#include <cstdio>
#include <cstdint>
namespace pg8 {
#define PG8_LAS __attribute__((address_space(3)))
typedef unsigned short bf16_t;
typedef short bf16x8 __attribute__((ext_vector_type(8)));
typedef float f32x4 __attribute__((ext_vector_type(4)));
typedef unsigned u32x4 __attribute__((ext_vector_type(4)));
constexpr int BM = 256, BK = 64, HALF = 128, HTB = HALF * BK * 2  , STAGE_BYTES = 8 * HTB, NXCD = 8, WGM = 8;

__host__ __device__ __forceinline__ int lds_byte(int r, int c) { const int st = (r >> 4) * 2 + (c >> 5), rr = r & 15, cc = c & 31, ob = rr * 64 + cc * 2; return st * 1024 + (ob ^ (((ob >> 9) & 1) << 5)); }
__host__ __device__ __forceinline__ void stage_rc(int b, int& R, int& C) { const int st = b / 1024, sb = b % 1024, swz = sb ^ (((sb >> 9) & 1) << 5); R = (st >> 1) * 16 + swz / 64; C = (st & 1) * 32 + (swz % 64) / 2; }
__host__ __device__ __forceinline__ int perm32(int rho) { const int n = rho >> 4, i = rho & 15; return 8 * (i >> 2) + 4 * n + (i & 3); }

struct Unit { int pm, pn; };
struct Gemm { const bf16_t* A; const bf16_t* Bt; int M, N, K; };

struct StaticOrder {
    int nM, nN, nwg, G, c;
    __host__ __device__ void init(int M, int N, int G_, int c_) { nM = M / BM; nN = N / BM; nwg = nM * nN; G = G_; c = c_; }
    __host__ __device__ bool next(int i, Unit& u) const {
        const long L = (long)i * G + c; if (L >= nwg) return false;
        int wgid = (int)L; { const int q = nwg / NXCD, r = nwg % NXCD, xcd = wgid % NXCD, off = wgid / NXCD; wgid = (xcd < r ? xcd * (q + 1) : r * (q + 1) + (xcd - r) * q) + off; }
        const int nig = WGM * nN, gid = wgid / nig, fm = gid * WGM, gsz = (nM - fm) < WGM ? (nM - fm) : WGM;
        u.pm = fm + ((wgid % nig) % gsz); u.pn = (wgid % nig) / gsz; return true;
    }
    __device__ __forceinline__ void a_ready(const Unit&) const {}
    __device__ __forceinline__ void done(const Unit&) const {}
};

typedef float f32x2_t __attribute__((ext_vector_type(2))); typedef __bf16 bf16x2_t __attribute__((ext_vector_type(2)));
__device__ __forceinline__ unsigned cvt_pk_bf16(float lo, float hi) { f32x2_t v = {lo, hi}; bf16x2_t b = __builtin_convertvector(v, bf16x2_t); return __builtin_bit_cast(unsigned, b); }
template <class Epi, class Sched, bool ALIGN_EPI = false, bool SP2 = false>
__device__ __forceinline__ void gemm_phase(PG8_LAS unsigned char* lds, const Gemm g, const Sched& S, const Epi& E, int tid_in) {
    int tid_ = tid_in; asm volatile("" : "+v"(tid_));
    const int tid = tid_, wid = __builtin_amdgcn_readfirstlane(tid >> 6), lane = tid & 63, wr = wid >> 2, wc = wid & 3, fr = lane & 15, fq = lane >> 4;
    const int K = g.K, nt = K / BK;
    unsigned voffA[2], voffB[2];
#pragma unroll
    for (int i = 0; i < 2; ++i) { int R, C; stage_rc(tid * 16 + i * 8192, R, C); const int Rb = Epi::PERM ? ((R & ~31) + perm32(R & 31)) : R;
        voffA[i] = (unsigned)(R * K + C) * 2u; voffB[i] = (unsigned)(Rb * K + C) * 2u; }
    const size_t kstep = (size_t)(BK * 2);
    const size_t hstep = (size_t)HALF * K * 2;
    const size_t tstep = 2 * hstep;
    const unsigned ldsw = (unsigned)wid * 1024u;
    const int aoff = lds_byte(wr * 64 + fr, fq * 8), boff = lds_byte(wc * 32 + fr, fq * 8);
#define PG8_SA(b, h) (((b) * 2 + (h)) * HTB)
#define PG8_SB(b, h) ((4 + (b) * 2 + (h)) * HTB)
#define PG8_STAGE(bufoff, gbase, voff) do { _Pragma("unroll") for (int _i = 0; _i < 2; ++_i) \
        __builtin_amdgcn_global_load_lds((const unsigned*)((const char*)(gbase) + (voff)[_i]), (PG8_LAS unsigned*)(lds + (bufoff) + ldsw + _i * 8192), 16, 0, 0); } while (0)
#define PG8_LDA(dst, b, h) do { _Pragma("unroll") for (int m = 0; m < 4; ++m) _Pragma("unroll") for (int k = 0; k < 2; ++k) dst[m][k] = *(const PG8_LAS bf16x8*)(lds + PG8_SA(b, h) + aoff + m * 2048 + k * 1024); } while (0)
#define PG8_LDB(dst, b, h) do { _Pragma("unroll") for (int n = 0; n < 2; ++n) _Pragma("unroll") for (int k = 0; k < 2; ++k) dst[n][k] = *(const PG8_LAS bf16x8*)(lds + PG8_SB(b, h) + boff + n * 2048 + k * 1024); } while (0)
#define PG8_MMA(ai, bj, At, Bt) do { __builtin_amdgcn_s_setprio(1); _Pragma("unroll") for (int m = 0; m < 4; ++m) _Pragma("unroll") for (int n = 0; n < 2; ++n) _Pragma("unroll") for (int k = 0; k < 2; ++k) \
        acc[ai][bj][m][n] = __builtin_amdgcn_mfma_f32_16x16x32_bf16(Bt[n][k], At[m][k], acc[ai][bj][m][n], 0, 0, 0); __builtin_amdgcn_s_setprio(0); } while (0)
#define PG8_WAIT_V(n) asm volatile("s_waitcnt vmcnt(" #n ")" ::: "memory")
#define PG8_WAIT_L(n) asm volatile("s_waitcnt lgkmcnt(" #n ")" ::: "memory")
#define PG8_BAR __builtin_amdgcn_s_barrier()
#define PG8_SCHED __builtin_amdgcn_sched_barrier(0)
    Unit cur, nxt; int ui = 0;
    if (!S.next(0, cur)) return;
    f32x4 acc[2][2][4][2];
#pragma unroll
    for (int a = 0; a < 2; ++a)
#pragma unroll
        for (int b = 0; b < 2; ++b)
#pragma unroll
            for (int m = 0; m < 4; ++m)
#pragma unroll
                for (int n = 0; n < 2; ++n) acc[a][b][m][n] = (f32x4){0.f, 0.f, 0.f, 0.f};
    bf16x8 At[4][2], B0[2][2], B1[2][2];
    const char* cA = (const char*)g.A + (size_t)cur.pm * tstep; const char* cB = (const char*)g.Bt + (size_t)cur.pn * tstep;
    S.a_ready(cur);
    if constexpr (SP2) {
        PG8_STAGE(PG8_SB(0, 0), cB, voffB); PG8_STAGE(PG8_SB(0, 1), cB + hstep, voffB); PG8_STAGE(PG8_SA(0, 0), cA, voffA); PG8_STAGE(PG8_SA(0, 1), cA + hstep, voffA);
        if (wr == 1) PG8_BAR;
        PG8_WAIT_V(2); PG8_BAR;
        PG8_STAGE(PG8_SB(1, 0), cB + kstep, voffB); PG8_STAGE(PG8_SA(1, 0), cA + kstep, voffA); PG8_STAGE(PG8_SB(1, 1), cB + hstep + kstep, voffB);
        PG8_WAIT_V(6); PG8_BAR;
    } else {
        PG8_STAGE(PG8_SB(0, 0), cB, voffB); PG8_STAGE(PG8_SA(0, 0), cA, voffA); PG8_STAGE(PG8_SB(0, 1), cB + hstep, voffB); PG8_STAGE(PG8_SA(0, 1), cA + hstep, voffA);
        if (wr == 1) PG8_BAR;
        PG8_WAIT_V(4); PG8_BAR;
        PG8_STAGE(PG8_SB(1, 0), cB + kstep, voffB); PG8_STAGE(PG8_SA(1, 0), cA + kstep, voffA); PG8_STAGE(PG8_SB(1, 1), cB + hstep + kstep, voffB);
        PG8_WAIT_V(6); PG8_BAR;
    }
    for (;;) {
        const bool has_next = S.next(ui + 1, nxt);
        const char* nA = has_next ? (const char*)g.A + (size_t)nxt.pm * tstep : cA; const char* nB = has_next ? (const char*)g.Bt + (size_t)nxt.pn * tstep : cB;
        for (int t = 0; t < nt; t += 2) {
            const bool last = (t == nt - 2);
            const char* a1 = cA + (size_t)(t + 1) * kstep;
            const char* a2 = last ? nA : cA + (size_t)(t + 2) * kstep; const char* b2 = last ? nB : cB + (size_t)(t + 2) * kstep;
            const char* a3 = a2 + kstep; const char* b3 = b2 + kstep;
            if (last && has_next) S.a_ready(nxt);
            if constexpr (SP2) {
            PG8_LDB(B0, 0, 0); PG8_LDB(B1, 0, 1); PG8_SCHED; PG8_LDA(At, 0, 0); PG8_STAGE(PG8_SA(1, 1), a1 + hstep, voffA);
            PG8_WAIT_V(8); PG8_WAIT_L(0); PG8_BAR; PG8_MMA(0, 0, At, B0); PG8_MMA(0, 1, At, B1); PG8_BAR; PG8_SCHED;
            PG8_LDA(At, 0, 1); PG8_STAGE(PG8_SB(0, 0), b2, voffB); PG8_STAGE(PG8_SB(0, 1), b2 + hstep, voffB); PG8_STAGE(PG8_SA(0, 0), a2, voffA);
            PG8_WAIT_V(8); PG8_WAIT_L(0); PG8_BAR; PG8_MMA(1, 0, At, B0); PG8_MMA(1, 1, At, B1); PG8_BAR; PG8_SCHED;
            PG8_LDB(B0, 1, 0); PG8_LDB(B1, 1, 1); PG8_SCHED; PG8_LDA(At, 1, 0); PG8_STAGE(PG8_SA(0, 1), a2 + hstep, voffA);
            PG8_WAIT_V(8); PG8_WAIT_L(0); PG8_BAR; PG8_MMA(0, 0, At, B0); PG8_MMA(0, 1, At, B1); PG8_BAR; PG8_SCHED;
            PG8_LDA(At, 1, 1); PG8_STAGE(PG8_SB(1, 0), b3, voffB); PG8_STAGE(PG8_SB(1, 1), b3 + hstep, voffB); PG8_STAGE(PG8_SA(1, 0), a3, voffA);
            PG8_WAIT_V(8); PG8_WAIT_L(0); PG8_BAR; PG8_MMA(1, 0, At, B0); PG8_MMA(1, 1, At, B1); PG8_BAR; PG8_SCHED;
            } else {
            PG8_LDB(B0, 0, 0); PG8_SCHED; PG8_LDA(At, 0, 0); PG8_STAGE(PG8_SA(1, 1), a1 + hstep, voffA);
            PG8_WAIT_L(8); PG8_BAR; PG8_WAIT_L(0); PG8_MMA(0, 0, At, B0); PG8_BAR; PG8_SCHED;
            PG8_LDB(B1, 0, 1); PG8_STAGE(PG8_SB(0, 0), b2, voffB);
            PG8_BAR; PG8_WAIT_L(0); PG8_MMA(0, 1, At, B1); PG8_BAR;
            PG8_LDA(At, 0, 1); PG8_STAGE(PG8_SA(0, 0), a2, voffA);
            PG8_BAR; PG8_WAIT_L(0); PG8_MMA(1, 0, At, B0); PG8_BAR; PG8_SCHED;
            PG8_STAGE(PG8_SB(0, 1), b2 + hstep, voffB);
            PG8_WAIT_V(6); PG8_BAR; PG8_MMA(1, 1, At, B1); PG8_BAR;
            PG8_LDB(B0, 1, 0); PG8_SCHED; PG8_LDA(At, 1, 0); PG8_STAGE(PG8_SA(0, 1), a2 + hstep, voffA);
            PG8_WAIT_L(8); PG8_BAR; PG8_WAIT_L(0); PG8_MMA(0, 0, At, B0); PG8_BAR; PG8_SCHED;
            PG8_LDB(B1, 1, 1); PG8_STAGE(PG8_SB(1, 0), b3, voffB);
            PG8_BAR; PG8_WAIT_L(0); PG8_MMA(0, 1, At, B1); PG8_BAR;
            PG8_LDA(At, 1, 1); PG8_STAGE(PG8_SA(1, 0), a3, voffA);
            PG8_BAR; PG8_WAIT_L(0); PG8_MMA(1, 0, At, B0); PG8_BAR; PG8_SCHED;
            PG8_STAGE(PG8_SB(1, 1), b3 + hstep, voffB);
            PG8_WAIT_V(6); PG8_BAR; PG8_MMA(1, 1, At, B1); PG8_BAR;
            }
        }
        if constexpr (ALIGN_EPI) { if (wr == 0) PG8_BAR; }
        if constexpr (!Epi::AFTER_DRAIN) { E(acc, cur, wr, wc, fr, fq); S.done(cur); }
        if (!has_next) break;
#pragma unroll
        for (int a = 0; a < 2; ++a)
#pragma unroll
            for (int b = 0; b < 2; ++b)
#pragma unroll
                for (int m = 0; m < 4; ++m)
#pragma unroll
                    for (int n = 0; n < 2; ++n) acc[a][b][m][n] = (f32x4){0.f, 0.f, 0.f, 0.f};
        cur = nxt; cA = nA; cB = nB; ++ui;
        if constexpr (ALIGN_EPI) { if (wr == 1) PG8_BAR; }
    }
    PG8_WAIT_V(0);
    if constexpr (!ALIGN_EPI) { if (wr == 0) PG8_BAR; }
    PG8_BAR;
    if constexpr (Epi::AFTER_DRAIN) { E.fused(acc, cur, wr, wc, fr, fq, lds, wid, lane); S.done(cur); }
#undef PG8_SA
#undef PG8_SB
#undef PG8_STAGE
#undef PG8_LDA
#undef PG8_LDB
#undef PG8_MMA
#undef PG8_WAIT_V
#undef PG8_WAIT_L
#undef PG8_BAR
#undef PG8_SCHED
}
}
#define XB_TMO      128
#define XB_XCNT(j)  (256  + 64 * (j))
#define XB_XSUB(j)  (1280 + 64 * (j))
#define XB_XGEN(j)  (2304 + 64 * (j))
#define XB_TOP      3328
#define XB_TOPGEN   3392
#define XCD_BAR_WORDS 3456
#define XB_SPIN_CAP (1u << 18)
#define LAS __attribute__((address_space(3)))

__device__ __forceinline__ unsigned xb_ld(unsigned* p)              { return __hip_atomic_load(p, __ATOMIC_RELAXED, __HIP_MEMORY_SCOPE_AGENT); }
__device__ __forceinline__ unsigned xb_add(unsigned* p, unsigned v) { return __hip_atomic_fetch_add(p, v, __ATOMIC_RELAXED, __HIP_MEMORY_SCOPE_AGENT); }
__device__ __forceinline__ unsigned xb_xcc_id() { return (unsigned)__builtin_amdgcn_s_getreg((3 << 11) | 20) & 0xFu; }
#define XB_SPIN(cond, bar) do { unsigned _sp = 0; while (cond) { __builtin_amdgcn_s_sleep(1); \
    if ((++_sp & 255u) == 0u) { if (xb_ld(&(bar)[XB_TMO])) break; if (_sp > XB_SPIN_CAP) { atomicAdd(&(bar)[XB_TMO], 1u); break; } } } } while (0)

struct XcdBarrier {
    unsigned* bar; unsigned x; unsigned lead;
    volatile LAS unsigned* st;
};

__device__ __forceinline__ bool xb_t0(unsigned lead) { unsigned z = 0u; asm volatile("" : "+s"(z)); return lead != 0u && __builtin_amdgcn_mbcnt_hi(~0u, __builtin_amdgcn_mbcnt_lo(~0u, z)) == 0u; }
__device__ __forceinline__ XcdBarrier xcd_barrier_post(unsigned* bar, volatile LAS unsigned* st, unsigned lead) {
    XcdBarrier b; b.bar = bar; b.x = xb_xcc_id(); b.st = st; b.lead = lead;
    if (xb_t0(lead)) (void)xb_add(&bar[XB_XCNT(b.x)], 1u);
    return b;
}
__device__ __forceinline__ void xcd_barrier_complete(unsigned* bar, unsigned x, unsigned& nloc, unsigned& nx) {
    const unsigned G = gridDim.x * gridDim.y * gridDim.z;
    unsigned sum, cnt, mine, sp = 0u;
    for (;;) {
        sum = 0u; cnt = 0u; mine = 0u;
#pragma unroll
        for (unsigned j = 0; j < 16; ++j) { const unsigned c = xb_ld(&bar[XB_XCNT(j)]); sum += c; cnt += (c > 0u) ? 1u : 0u; mine = (j == x) ? c : mine; }
        if (sum == G) break;
        __builtin_amdgcn_s_sleep(1);
        if ((++sp & 255u) == 0u) { if (xb_ld(&bar[XB_TMO])) break; if (sp > XB_SPIN_CAP) { atomicAdd(&bar[XB_TMO], 1u); break; } }
    }
    nloc = mine > 0u ? mine : 1u; nx = cnt > 0u ? cnt : 1u;
}

__device__ __forceinline__ void xcd_barrier(const XcdBarrier& b) {
    asm volatile("s_waitcnt vmcnt(0)" ::: "memory");
    __syncthreads();
    if (xb_t0(b.lead)) {
        unsigned* bar = b.bar;
        __builtin_amdgcn_s_waitcnt(0);
        unsigned nloc = b.st[0], nx = b.st[1];
        if (nloc == 0u) { xcd_barrier_complete(bar, b.x, nloc, nx); b.st[0] = nloc; b.st[1] = nx; }
        const unsigned old = xb_add(&bar[XB_XSUB(b.x)], 1u);
        const unsigned gen = old / nloc;
        if (old + 1u == (gen + 1u) * nloc) {
            __builtin_amdgcn_fence(__ATOMIC_RELEASE, "agent");
            asm volatile("s_waitcnt vmcnt(0)" ::: "memory");
            const unsigned og = xb_add(&bar[XB_TOP], 1u);
            const unsigned tg = og / nx;
            if (og + 1u == (tg + 1u) * nx) xb_add(&bar[XB_TOPGEN], 1u);
            else XB_SPIN(xb_ld(&bar[XB_TOPGEN]) == tg, bar);
            __builtin_amdgcn_fence(__ATOMIC_ACQUIRE, "agent");
            xb_add(&bar[XB_XGEN(b.x)], 1u);
            asm volatile("s_waitcnt vmcnt(0)" ::: "memory");
        } else {
            XB_SPIN(xb_ld(&bar[XB_XGEN(b.x)]) == gen, bar);
            __builtin_amdgcn_fence(__ATOMIC_ACQUIRE, "agent");
            asm volatile("s_waitcnt vmcnt(0)" ::: "memory");
        }
    }
    __syncthreads();
}


typedef unsigned short bf16;
typedef pg8::f32x4 f32x4;
typedef pg8::u32x4 u32x4;
constexpr int NB = 8, SEQ = 4096, DM = 1024, NCTX = 256;
constexpr int TL = NB * SEQ, TC = NB * NCTX, TA = TL + TC;
constexpr int INW = 6144, GW = 512, NGRP = 12;
constexpr size_t GSTRIDE = (size_t)TA * GW;
constexpr float EPS = 1e-6f;
constexpr int SLOT_ROWS = 73728;

constexpr size_t MiB = (size_t)1 << 20;
constexpr size_t WS_CTL = 0, CTL_BYTES = 1 * MiB;
constexpr size_t WS_MOD = 1 * MiB;
constexpr size_t WS_LB = 1 * MiB + 512 * 1024;
constexpr size_t WS_ROPE = 2 * MiB;
constexpr size_t WS_TOK = 3 * MiB;
constexpr size_t WS_CTXS = 4 * MiB;
constexpr size_t WS_WB = 12 * MiB;
constexpr size_t WS_H = 28 * MiB;
constexpr size_t WS_P = 96 * MiB;
constexpr size_t P_M = 34 * MiB, P_WEGU = 102 * MiB, P_WED = 134 * MiB, P_XS = 150 * MiB, P_ACT = 294 * MiB;
constexpr size_t WS_END = 504 * MiB;
constexpr int CW_BAR = 4096, CW_CNT = 131072;

constexpr int LDS_STAGE = 163328, LDS_BYTES = 163840;
constexpr int LDSW_BAR = 0, LDSW_TAB = 16;

struct Params {
    const float* x; const float* c; const float* ctx; const float* c_ctx; const float* w_ada; const float* b_ada; const float* norm1_g; const float* w_in;
    const float* rel_bias; const float* lowf; const float* lowb; const float* hg_norm_g; const float* w_na_o; const float* w_hg_o; const float* w_out; const float* norm2_g;
    const float* w_router; const float* router_bias; const float* w_gate; const float* w_up; const float* w_down; const float* final_g;
    float* out; unsigned char* ws; int lo, hi, li, pad;
};

__device__ __forceinline__ float bf2f(unsigned b) { return __uint_as_float(b << 16); }
__device__ __forceinline__ float bflo(unsigned w) { return __uint_as_float(w << 16); }
__device__ __forceinline__ float bfhi(unsigned w) { return __uint_as_float(w & 0xffff0000u); }
__device__ __forceinline__ unsigned f2bf(float f) { unsigned u = __float_as_uint(f); u += 0x7FFFu + ((u >> 16) & 1u); return u >> 16; }
__device__ __forceinline__ unsigned pk2(float lo, float hi) { return f2bf(lo) | (f2bf(hi) << 16); }
__device__ __forceinline__ float sigm(float x) { return 1.f / (1.f + __expf(-x)); }
__device__ __forceinline__ float silu(float x) { return x / (1.f + __expf(-x)); }
__device__ __forceinline__ float wave_sum(float v) {
#pragma unroll
    for (int o = 32; o >= 1; o >>= 1) v += __shfl_xor(v, o);
    return v; }
__device__ __forceinline__ float wave_max(float v) {
#pragma unroll
    for (int o = 32; o >= 1; o >>= 1) v = fmaxf(v, __shfl_xor(v, o));
    return v; }
__device__ __forceinline__ void unpack8(const uint4 w, float (&f)[8]) {
    f[0] = bflo(w.x); f[1] = bfhi(w.x); f[2] = bflo(w.y); f[3] = bfhi(w.y); f[4] = bflo(w.z); f[5] = bfhi(w.z); f[6] = bflo(w.w); f[7] = bfhi(w.w); }

typedef const __attribute__((address_space(4))) Params* ParamsK;
struct PView { ParamsK q; __device__ __forceinline__ const __attribute__((address_space(4))) Params* operator->() const { return q; } };
struct Ctx {
    PView p; unsigned char* ws; unsigned char* lds; int tid, lane, wave, G, bid, gw, nw;
    __device__ __forceinline__ float* MOD() const { return (float*)(ws + WS_MOD); }
    __device__ __forceinline__ float* LB() const { return (float*)(ws + WS_LB); }
    __device__ __forceinline__ float2* ROPE() const { return (float2*)(ws + WS_ROPE); }
    __device__ __forceinline__ int* TOKE() const { return (int*)(ws + WS_TOK); }
    __device__ __forceinline__ float* TOKW() const { return (float*)(ws + WS_TOK) + 2 * TA; }
    __device__ __forceinline__ int* TOKS() const { return (int*)(ws + WS_TOK) + 4 * TA; }
    __device__ __forceinline__ float* CTXS() const { return (float*)(ws + WS_CTXS); }
    __device__ __forceinline__ bf16* WIN_T() const { return (bf16*)(ws + WS_WB); }
    __device__ __forceinline__ bf16* WNA_T() const { return (bf16*)(ws + WS_WB + 12 * MiB); }
    __device__ __forceinline__ bf16* WHG_T() const { return (bf16*)(ws + WS_WB + 13 * MiB); }
    __device__ __forceinline__ bf16* WOUT_T() const { return (bf16*)(ws + WS_WB + 14 * MiB); }
    __device__ __forceinline__ bf16* H() const { return (bf16*)(ws + WS_H); }
    __device__ __forceinline__ bf16* GRP(int g) const { return (bf16*)(ws + WS_P) + (size_t)g * GSTRIDE; }
    __device__ __forceinline__ bf16* MB() const { return (bf16*)(ws + WS_P + P_M); }
    __device__ __forceinline__ bf16* WEGU() const { return (bf16*)(ws + WS_P + P_WEGU); }
    __device__ __forceinline__ bf16* WED() const { return (bf16*)(ws + WS_P + P_WED); }
    __device__ __forceinline__ bf16* XS() const { return (bf16*)(ws + WS_P + P_XS); }
    __device__ __forceinline__ bf16* ACT() const { return (bf16*)(ws + WS_P + P_ACT); }
    __device__ __forceinline__ unsigned* CTL() const { return (unsigned*)(ws + WS_CTL); }
    __device__ __forceinline__ unsigned* CNT(int l) const { return (unsigned*)(ws + WS_CTL) + CW_CNT + l * 64; }
    __device__ __forceinline__ int* TAB() const { return (int*)(lds + LDS_STAGE) + LDSW_TAB; }
};

template <class RowMap>
__device__ __forceinline__ void tconv_tile(const float* __restrict__ src, int ldsrc, int k0, int n0, bf16* __restrict__ dst, int ldd, int lane, RowMap rm) {
    float v[64];
    const float* s = src + (size_t)k0 * ldsrc + n0 + lane;
#pragma unroll
    for (int k = 0; k < 64; ++k) { v[k] = *s; s += ldsrc; asm volatile("" : "+v"(s)); }
    bf16* d = dst + (size_t)rm(n0 + lane) * ldd + k0;
#pragma unroll
    for (int j = 0; j < 8; ++j) { uint4 w; w.x = pk2(v[8 * j], v[8 * j + 1]); w.y = pk2(v[8 * j + 2], v[8 * j + 3]); w.z = pk2(v[8 * j + 4], v[8 * j + 5]); w.w = pk2(v[8 * j + 6], v[8 * j + 7]);
        *(uint4*)(d + 8 * j) = w; }
}
struct RmId { __device__ __forceinline__ int operator()(int n) const { return n; } };
struct RmGU { int base; __device__ __forceinline__ int operator()(int n) const { return base + (n >> 7) * 256 + (n & 127); } };

__device__ __forceinline__ void conv_mixer(const Ctx& C, int l) {
    for (int id = C.gw; id < 2048; id += C.nw) {
        if (id < 1536) { const int kt = id & 15, nt = id >> 4; tconv_tile(C.p->w_in + (size_t)l * DM * INW, INW, kt * 64, nt * 64, C.WIN_T(), DM, C.lane, RmId()); }
        else if (id < 1664) { const int j = id - 1536, kt = j & 7, nt = j >> 3; tconv_tile(C.p->w_na_o + (size_t)l * 512 * DM, DM, kt * 64, nt * 64, C.WNA_T(), 512, C.lane, RmId()); }
        else if (id < 1792) { const int j = id - 1664, kt = j & 7, nt = j >> 3; tconv_tile(C.p->w_hg_o + (size_t)l * 512 * DM, DM, kt * 64, nt * 64, C.WHG_T(), 512, C.lane, RmId()); }
        else { const int j = id - 1792, kt = j & 15, nt = j >> 4; tconv_tile(C.p->w_out + (size_t)l * DM * DM, DM, kt * 64, nt * 64, C.WOUT_T(), DM, C.lane, RmId()); }
    }
}
__device__ __forceinline__ void conv_experts(const Ctx& C, int l) {
    for (int id = C.gw; id < 6144; id += C.nw) {
        const int e = id / 384, j = id % 384;
        if (j < 128) { const int kt = j & 15, nt = j >> 4; tconv_tile(C.p->w_gate + ((size_t)l * 16 + e) * DM * 512, 512, kt * 64, nt * 64, C.WEGU(), DM, C.lane, RmGU{e * 1024}); }
        else if (j < 256) { const int jj = j - 128, kt = jj & 15, nt = jj >> 4; tconv_tile(C.p->w_up + ((size_t)l * 16 + e) * DM * 512, 512, kt * 64, nt * 64, C.WEGU(), DM, C.lane, RmGU{e * 1024 + 128}); }
        else { const int jj = j - 256, kt = jj & 7, nt = jj >> 3; tconv_tile(C.p->w_down + ((size_t)l * 16 + e) * 512 * DM, DM, kt * 64, nt * 64, C.WED() + (size_t)e * 1024 * 512, 512, C.lane, RmId()); }
    }
}

__device__ __forceinline__ void p0_prologue(const Ctx& C) {
    for (int u = C.bid; u < 24; u += C.G) {
        float* sl = (float*)C.lds;
        for (int i = C.tid; i < 9 * 1024; i += 512) { const int r = i >> 10, k = i & 1023; const float v = (r < 8) ? C.p->c[r * 1024 + k] : C.p->c_ctx[k]; sl[i] = v / (1.f + expf(-v)); }
        __syncthreads();
        const int l = u / 12, n = (u % 12) * 512 + C.tid;
        const float* w = C.p->w_ada + (size_t)l * DM * INW + n;
        float acc[9];
#pragma unroll
        for (int r = 0; r < 9; ++r) acc[r] = 0.f;
#pragma unroll 8
        for (int k = 0; k < 1024; ++k) { const float wv = w[(size_t)k * INW];
#pragma unroll
            for (int r = 0; r < 9; ++r) acc[r] += sl[r * 1024 + k] * wv; }
        const float bb = C.p->b_ada[l * INW + n];
#pragma unroll
        for (int r = 0; r < 9; ++r) C.MOD()[(size_t)(l * 9 + r) * INW + n] = acc[r] + bb;
        __syncthreads();
    }
    const int gt = C.bid * 512 + C.tid, nthr = C.G * 512;
    for (int i = gt; i < 4096 * 32; i += nthr) { const int t = i >> 5, pr = i & 31; const float pos = (float)((pr < 16) ? (t >> 6) : (t & 63)); const int j = pr & 15;
        const float inv = powf(10000.f, -(float)(2 * j) / 32.f); const float ang = pos * inv; C.ROPE()[i] = make_float2(cosf(ang), sinf(ang)); }
    for (int i = gt; i < 1024; i += nthr) { const int dir = i >> 9, ch = i & 511; const float* raw = dir ? C.p->lowb : C.p->lowf; const float r0 = raw[ch], r1 = raw[512 + ch];
        const float p1 = 1.f / (1.f + expf(r0 - r1)); C.LB()[(0 * 2 + dir) * 512 + ch] = 0.f; C.LB()[(1 * 2 + dir) * 512 + ch] = p1; }
    conv_mixer(C, 0);
}

__device__ __forceinline__ void load_row(const float* xr, int lane, float (&v)[16]) {
#pragma unroll
    for (int j = 0; j < 4; ++j) { const float4 t = *(const float4*)(xr + j * 256 + lane * 4); v[4 * j] = t.x; v[4 * j + 1] = t.y; v[4 * j + 2] = t.z; v[4 * j + 3] = t.w; }
}
__device__ __forceinline__ float row_rinv(const float (&v)[16]) {
    float ss = 0.f;
#pragma unroll
    for (int i = 0; i < 16; ++i) ss += v[i] * v[i];
    ss = wave_sum(ss);
    return rsqrtf(ss * (1.f / 1024.f) + EPS);
}
__device__ __forceinline__ void norm_mod(const float (&v)[16], float rinv, const float* gam, const float* sc, const float* sh, int lane, float (&h)[16]) {
#pragma unroll
    for (int j = 0; j < 4; ++j) { const int c = j * 256 + lane * 4; const float4 g = *(const float4*)(gam + c), s = *(const float4*)(sc + c), b = *(const float4*)(sh + c);
        h[4 * j] = v[4 * j] * rinv * g.x * (1.f + s.x) + b.x; h[4 * j + 1] = v[4 * j + 1] * rinv * g.y * (1.f + s.y) + b.y;
        h[4 * j + 2] = v[4 * j + 2] * rinv * g.z * (1.f + s.z) + b.z; h[4 * j + 3] = v[4 * j + 3] * rinv * g.w * (1.f + s.w) + b.w; }
}
__device__ __forceinline__ void store_row_bf16(bf16* hr, int lane, const float (&h)[16]) {
#pragma unroll
    for (int j = 0; j < 4; ++j) { uint2 w; w.x = pk2(h[4 * j], h[4 * j + 1]); w.y = pk2(h[4 * j + 2], h[4 * j + 3]); *(uint2*)(hr + j * 256 + lane * 4) = w; }
}
__device__ __forceinline__ int modrow_of(int r) { return r < TL ? (r >> 12) : 8; }

__device__ __forceinline__ void p1_norm1(const Ctx& C, int l, const float* xl, const float* xc) {
    float nv[16];
    if (C.gw < TA) load_row(C.gw < TL ? xl + (size_t)C.gw * DM : xc + (size_t)(C.gw - TL) * DM, C.lane, nv);
    for (int r = C.gw; r < TA; r += C.nw) {
        float v[16], h[16];
#pragma unroll
        for (int i = 0; i < 16; ++i) v[i] = nv[i];
        { const int rn = r + C.nw; if (rn < TA) load_row(rn < TL ? xl + (size_t)rn * DM : xc + (size_t)(rn - TL) * DM, C.lane, nv); }
        const float rinv = row_rinv(v);
        const float* mod = C.MOD() + (size_t)(l * 9 + modrow_of(r)) * INW;
        norm_mod(v, rinv, C.p->norm1_g + l * DM, mod + 1024, mod, C.lane, h);
        store_row_bf16(C.H() + (size_t)r * DM, C.lane, h);
    }
}

struct EpiInProj {
    static constexpr bool PERM = true, AFTER_DRAIN = false;
    bf16* P; const float2* rope; const float* lbl;
    __device__ __forceinline__ void operator()(const f32x4 (&acc)[2][2][4][2], const pg8::Unit& u, int wr, int wc, int fr, int fq) const {
        const int grp = u.pn >> 1; bf16* base = P + (size_t)grp * GSTRIDE;
        const int colb = (u.pn & 1) * 256 + wc * 32 + 8 * fq;
        const bool do_rope = (grp < 2) && (u.pm < TL / 256);
#pragma unroll
        for (int ai = 0; ai < 2; ++ai)
#pragma unroll
            for (int m = 0; m < 4; ++m) { const int row = u.pm * 256 + ai * 128 + wr * 64 + m * 16 + fr;
#pragma unroll
                for (int bj = 0; bj < 2; ++bj) { const int col = colb + bj * 128; f32x4 v0 = acc[ai][bj][m][0], v1 = acc[ai][bj][m][1];
                    if (do_rope) { const float4* rp = (const float4*)(rope + (size_t)(row & 4095) * 32 + ((col & 63) >> 1)); const float4 c01 = rp[0], c23 = rp[1];
                        const f32x4 a = v0, b = v1;
                        v0[0] = a[0] * c01.x - a[1] * c01.y; v0[1] = a[0] * c01.y + a[1] * c01.x; v0[2] = a[2] * c01.z - a[3] * c01.w; v0[3] = a[2] * c01.w + a[3] * c01.z;
                        v1[0] = b[0] * c23.x - b[1] * c23.y; v1[1] = b[0] * c23.y + b[1] * c23.x; v1[2] = b[2] * c23.z - b[3] * c23.w; v1[3] = b[2] * c23.w + b[3] * c23.z; }
                    if (grp == 3) {
#pragma unroll
                        for (int i = 0; i < 4; ++i) { v0[i] = silu(v0[i]); v1[i] = silu(v1[i]); }
                    } else if (grp == 4 || grp == 5) {
                        const float* lp = lbl + (grp - 4) * 512 + col; const f32x4 l0 = *(const f32x4*)lp, l1 = *(const f32x4*)(lp + 4);
#pragma unroll
                        for (int i = 0; i < 4; ++i) { v0[i] = __builtin_amdgcn_logf(fmaxf(l0[i] + (1.f - l0[i]) * sigm(v0[i]), 1e-30f)); v1[i] = __builtin_amdgcn_logf(fmaxf(l1[i] + (1.f - l1[i]) * sigm(v1[i]), 1e-30f)); }
                    }
                    {
                    u32x4 w; w.x = pg8::cvt_pk_bf16(v0[0], v0[1]); w.y = pg8::cvt_pk_bf16(v0[2], v0[3]); w.z = pg8::cvt_pk_bf16(v1[0], v1[1]); w.w = pg8::cvt_pk_bf16(v1[2], v1[3]);
                    *(u32x4*)(base + (size_t)row * GW + col) = w; } } }
    }
};
template <int PASS> struct EpiMerge {
    static constexpr bool PERM = true, AFTER_DRAIN = false;
    bf16* M; const bf16* G;
    __device__ __forceinline__ void operator()(const f32x4 (&acc)[2][2][4][2], const pg8::Unit& u, int wr, int wc, int fr, int fq) const {
        const bf16* gb = G + (size_t)(u.pn >> 1) * GSTRIDE; const int gcol = (u.pn & 1) * 256 + wc * 32 + 8 * fq, mcol = u.pn * 256 + wc * 32 + 8 * fq;
#pragma unroll
        for (int ai = 0; ai < 2; ++ai)
#pragma unroll
            for (int m = 0; m < 4; ++m) { const int row = u.pm * 256 + ai * 128 + wr * 64 + m * 16 + fr;
#pragma unroll
                for (int bj = 0; bj < 2; ++bj) { const uint4 gw = *(const uint4*)(gb + (size_t)row * GW + gcol + bj * 128); float g[8]; unpack8(gw, g);
                    bf16* mp = M + (size_t)row * DM + mcol + bj * 128; const f32x4 v0 = acc[ai][bj][m][0], v1 = acc[ai][bj][m][1];
                    float o[8];
#pragma unroll
                    for (int i = 0; i < 4; ++i) { o[i] = sigm(g[i]) * v0[i]; o[4 + i] = sigm(g[4 + i]) * v1[i]; }
                    if (PASS == 1) { const uint4 mw = *(const uint4*)mp; float pm_[8]; unpack8(mw, pm_);
#pragma unroll
                        for (int i = 0; i < 8; ++i) o[i] += pm_[i]; }
                    u32x4 w; w.x = pg8::cvt_pk_bf16(o[0], o[1]); w.y = pg8::cvt_pk_bf16(o[2], o[3]); w.z = pg8::cvt_pk_bf16(o[4], o[5]); w.w = pg8::cvt_pk_bf16(o[6], o[7]);
                    *(u32x4*)mp = w; } }
    }
};
struct EpiOut {
    static constexpr bool PERM = false, AFTER_DRAIN = false;
    const float* xl_src; float* xl_dst; const float* xc_src; float* xc_dst; const float* mod; int dry;
    __device__ __forceinline__ void operator()(const f32x4 (&acc)[2][2][4][2], const pg8::Unit& u, int wr, int wc, int fr, int fq) const {
        const bool lat = u.pm < TL / 256; const int mr = lat ? (u.pm >> 4) : 8;
        const float* gate = mod + (size_t)mr * INW + 2048; const int col0 = u.pn * 256 + wc * 32 + 4 * fq;
        const float* src = lat ? xl_src : xc_src - (size_t)TL * DM; float* dst = lat ? xl_dst : xc_dst - (size_t)TL * DM;
        f32x4 gv[2][2];
#pragma unroll
        for (int bj = 0; bj < 2; ++bj)
#pragma unroll
            for (int n = 0; n < 2; ++n) gv[bj][n] = *(const f32x4*)(gate + col0 + bj * 128 + n * 16);
#pragma unroll
        for (int ai = 0; ai < 2; ++ai)
#pragma unroll
            for (int m = 0; m < 4; ++m) { const size_t off = (size_t)(u.pm * 256 + ai * 128 + wr * 64 + m * 16 + fr) * DM + col0;
#pragma unroll
                for (int bj = 0; bj < 2; ++bj)
#pragma unroll
                    for (int n = 0; n < 2; ++n) { const f32x4 xo = *(const f32x4*)(src + off + bj * 128 + n * 16); if (!dry) *(f32x4*)(dst + off + bj * 128 + n * 16) = xo + gv[bj][n] * acc[ai][bj][m][n]; } }
    }
};
struct EpiGateUp {
    static constexpr bool PERM = true, AFTER_DRAIN = false;
    bf16* A;
    __device__ __forceinline__ void operator()(const f32x4 (&acc)[2][2][4][2], const pg8::Unit& u, int wr, int wc, int fr, int fq) const {
        const int col = (u.pn & 3) * 128 + wc * 32 + 8 * fq;
#pragma unroll
        for (int ai = 0; ai < 2; ++ai)
#pragma unroll
            for (int m = 0; m < 4; ++m) { const int row = u.pm * 256 + ai * 128 + wr * 64 + m * 16 + fr; float o[8];
#pragma unroll
                for (int i = 0; i < 4; ++i) { o[i] = silu(acc[ai][0][m][0][i]) * acc[ai][1][m][0][i]; o[4 + i] = silu(acc[ai][0][m][1][i]) * acc[ai][1][m][1][i]; }
                u32x4 w; w.x = pg8::cvt_pk_bf16(o[0], o[1]); w.y = pg8::cvt_pk_bf16(o[2], o[3]); w.z = pg8::cvt_pk_bf16(o[4], o[5]); w.w = pg8::cvt_pk_bf16(o[6], o[7]);
                *(u32x4*)(A + (size_t)row * 512 + col) = w; }
    }
};
struct EpiDown {
    static constexpr bool PERM = true, AFTER_DRAIN = false;
    bf16* Y;
    __device__ __forceinline__ void operator()(const f32x4 (&acc)[2][2][4][2], const pg8::Unit& u, int wr, int wc, int fr, int fq) const {
        const int col = (u.pn & 3) * 256 + wc * 32 + 8 * fq;
#pragma unroll
        for (int ai = 0; ai < 2; ++ai)
#pragma unroll
            for (int m = 0; m < 4; ++m) { const int row = u.pm * 256 + ai * 128 + wr * 64 + m * 16 + fr;
#pragma unroll
                for (int bj = 0; bj < 2; ++bj) { const f32x4 v0 = acc[ai][bj][m][0], v1 = acc[ai][bj][m][1];
                    u32x4 w; w.x = pg8::cvt_pk_bf16(v0[0], v0[1]); w.y = pg8::cvt_pk_bf16(v0[2], v0[3]); w.z = pg8::cvt_pk_bf16(v1[0], v1[1]); w.w = pg8::cvt_pk_bf16(v1[2], v1[3]);
                    *(u32x4*)(Y + (size_t)row * DM + col + bj * 128) = w; } }
    }
};
struct MoeOrder {
    const int* tab; int G, c;
    __device__ __forceinline__ bool next(int i, pg8::Unit& u) const {
        const int L = i * G + c, MT = tab[16]; if (L >= MT * 4) return false;
        const int mt = L >> 2; int e = 0;
#pragma unroll
        for (int j = 1; j < 16; ++j) e += (mt >= tab[j]) ? 1 : 0;
        u.pm = mt; u.pn = e * 4 + (L & 3); return true;
    }
    __device__ __forceinline__ void a_ready(const pg8::Unit&) const {}
    __device__ __forceinline__ void done(const pg8::Unit&) const {}
};
__device__ __forceinline__ void moe_table(const Ctx& C, int l) {
    __syncthreads();
    if (C.tid == 0) { int acc = 0; const unsigned* cnt = C.CNT(l);
        for (int e = 0; e < 16; ++e) { C.TAB()[e] = acc; acc += (int)((__hip_atomic_load(cnt + e, __ATOMIC_RELAXED, __HIP_MEMORY_SCOPE_AGENT) + 255u) >> 8); }
        C.TAB()[16] = acc; }
    __syncthreads();
}

__device__ __forceinline__ void p3_attn_naive(const Ctx& C, int l) {
    float* pl = (float*)C.lds + C.wave * 768; int* kl = (int*)(pl + 384);
    const bf16* Q = C.GRP(0); const bf16* K = C.GRP(1); const bf16* V = C.GRP(2); bf16* O = C.GRP(0);
    const int nq = (l == 0 ? TA : TL) * 8;
    for (int wq = C.gw; wq < nq; wq += C.nw) {
        const int r = wq >> 3, h = wq & 7; const bool lat = r < TL;
        const int b = lat ? (r >> 12) : ((r - TL) >> 8);
        float q[64];
        { const uint4* qp = (const uint4*)(Q + (size_t)r * GW + h * 64);
#pragma unroll
          for (int j = 0; j < 8; ++j) { float t[8]; unpack8(qp[j], t);
#pragma unroll
              for (int i = 0; i < 8; ++i) q[8 * j + i] = t[i]; } }
        const int t = r & 4095, gr = t >> 6, gc = t & 63;
        const int rs = min(max(gr - 4, 0), 56), cs = min(max(gc - 8, 0), 48);
        float s[6]; int krow[6];
#pragma unroll
        for (int i = 0; i < 6; ++i) {
            float bias = 0.f; bool valid = true;
            if (i < 2) { const int j = C.lane + 64 * i, kr = rs + (j >> 4), kc = cs + (j & 15); krow[i] = b * 4096 + kr * 64 + kc; valid = lat;
                if (lat) bias = C.p->rel_bias[((size_t)(l * 8 + h) * 15 + (kr - gr + 7)) * 31 + (kc - gc + 15)]; if (!lat) krow[i] = TL + b * 256; }
            else krow[i] = TL + b * 256 + C.lane + 64 * (i - 2);
            const uint4* kp = (const uint4*)(K + (size_t)krow[i] * GW + h * 64); float d = 0.f;
#pragma unroll
            for (int j = 0; j < 8; ++j) { float tk[8]; unpack8(kp[j], tk);
#pragma unroll
                for (int ii = 0; ii < 8; ++ii) d += q[8 * j + ii] * tk[ii]; }
            s[i] = valid ? d * 0.125f + bias : -1e30f;
        }
        float mx = s[0];
#pragma unroll
        for (int i = 1; i < 6; ++i) mx = fmaxf(mx, s[i]);
        mx = wave_max(mx);
        float sum = 0.f;
#pragma unroll
        for (int i = 0; i < 6; ++i) { s[i] = (s[i] > -1e29f) ? __expf(s[i] - mx) : 0.f; sum += s[i]; }
        sum = wave_sum(sum); const float inv = 1.f / sum;
#pragma unroll
        for (int i = 0; i < 6; ++i) { pl[C.lane + 64 * i] = s[i] * inv; kl[C.lane + 64 * i] = krow[i]; }
        float acc = 0.f;
        for (int j = lat ? 0 : 128; j < 384; ++j) acc += pl[j] * bf2f(V[(size_t)kl[j] * GW + h * 64 + C.lane]);
        O[(size_t)r * GW + h * 64 + C.lane] = (bf16)f2bf(acc);
    }
}


typedef pg8::bf16x8 bf16x8;
typedef unsigned u32x2 __attribute__((ext_vector_type(2)));
__device__ __forceinline__ bf16x8 ld16(const bf16* p) { return *(const bf16x8*)p; }
__device__ __forceinline__ bf16x8 ld8x2(const bf16* p0, const bf16* p1) { const u32x2 a = *(const u32x2*)p0, b = *(const u32x2*)p1; u32x4 w; w.x = a.x; w.y = a.y; w.z = b.x; w.w = b.y; return __builtin_bit_cast(bf16x8, w); }
__device__ __forceinline__ bf16x8 pack8(const f32x4 a, const f32x4 b) { u32x4 w; w.x = pg8::cvt_pk_bf16(a[0], a[1]); w.y = pg8::cvt_pk_bf16(a[2], a[3]); w.z = pg8::cvt_pk_bf16(b[0], b[1]); w.w = pg8::cvt_pk_bf16(b[2], b[3]); return __builtin_bit_cast(bf16x8, w); }
#define MFMA16(a, b, c) __builtin_amdgcn_mfma_f32_16x16x32_bf16(a, b, c, 0, 0, 0)

__device__ __forceinline__ void p3_attn(const Ctx& C, int l, bool dry = false) {
    float* relb = (float*)(C.lds + 98304);
    __syncthreads();
    for (int i = C.tid; i < 8 * 15 * 32; i += 512) { const int dc = i & 31, hd = i >> 5; relb[i] = (dc < 31) ? C.p->rel_bias[(size_t)l * 8 * 15 * 31 + hd * 31 + dc] : 0.f; }
    __syncthreads();
    const bf16* Qb = C.GRP(0); const bf16* Kb = C.GRP(1); const bf16* VT = C.GRP(2); const bf16* VTc = C.GRP(2) + (size_t)TL * GW; bf16* Ob = C.GRP(0);
    const int lq = C.lane & 15, g = C.lane >> 4;
    const int nlat = 16384, nu = nlat + (l == 0 ? 1024 : 0);
    for (int u = C.gw; u < nu; u += C.nw) {
        const bool lat = u < nlat;
        int b, h, gr = 0, gc0 = 0, qrow0;
        if (lat) { const int ct = u & 3; h = (u >> 2) & 7; gr = (u >> 5) & 63; b = u >> 11; gc0 = ct * 16; qrow0 = b * 4096 + gr * 64 + gc0; }
        else { const int v = u - nlat, qt = v & 15; h = (v >> 4) & 7; b = v >> 7; qrow0 = TL + b * 256 + qt * 16; }
        const int rs = min(max(gr - 4, 0), 56), u0 = min(max(gc0 - 8, 0), 32);
        const bf16* qp = Qb + (size_t)(qrow0 + lq) * GW + h * 64 + 8 * g;
        const bf16x8 q0 = ld16(qp), q1 = ld16(qp + 32);
        f32x4 s[32];
        const f32x4 z4 = {0.f, 0.f, 0.f, 0.f};
        if (lat) {
            const int gcq = gc0 + lq, csq = min(max(gcq - 8, 0), 48);
#pragma unroll
            for (int wt = 0; wt < 16; ++wt) { const int wrow = wt >> 1, half = wt & 1;
                const bf16* kp = Kb + (size_t)(b * 4096 + (rs + wrow) * 64 + u0 + 16 * half + lq) * GW + h * 64 + 8 * g;
                f32x4 a = MFMA16(ld16(kp), q0, z4); a = MFMA16(ld16(kp + 32), q1, a);
                const float* brow = relb + (h * 15 + (rs + wrow - gr + 7)) * 32;
#pragma unroll
                for (int r = 0; r < 4; ++r) { const int kc = u0 + 16 * half + 4 * g + r; const bool valid = (kc >= csq) && (kc < csq + 16); const int dc = min(max(kc - gcq + 15, 0), 30);
                    a[r] = valid ? a[r] * 0.125f + brow[dc] : -1e30f; }
                s[wt] = a; }
        } else {
#pragma unroll
            for (int wt = 0; wt < 16; ++wt) s[wt] = (f32x4){-1e30f, -1e30f, -1e30f, -1e30f};
        }
#pragma unroll
        for (int ctile = 0; ctile < 16; ++ctile) {
            const bf16* kp = Kb + (size_t)(TL + b * 256 + ctile * 16 + lq) * GW + h * 64 + 8 * g;
            f32x4 a = MFMA16(ld16(kp), q0, z4); a = MFMA16(ld16(kp + 32), q1, a);
            s[16 + ctile] = a * 0.125f; }
        float mx = -1e30f;
#pragma unroll
        for (int i = 0; i < 32; ++i) mx = fmaxf(fmaxf(fmaxf(mx, s[i][0]), fmaxf(s[i][1], s[i][2])), s[i][3]);
        mx = fmaxf(mx, __shfl_xor(mx, 16)); mx = fmaxf(mx, __shfl_xor(mx, 32));
        float sum = 0.f;
#pragma unroll
        for (int i = 0; i < 32; ++i) {
#pragma unroll
            for (int r = 0; r < 4; ++r) { const float e = __expf(s[i][r] - mx); s[i][r] = e; sum += e; } }
        sum += __shfl_xor(sum, 16); sum += __shfl_xor(sum, 32);
        const float inv = 1.f / sum;
        f32x4 o[4] = {z4, z4, z4, z4};
        if (lat) {
#pragma unroll
            for (int wrow = 0; wrow < 8; ++wrow) { const bf16x8 pb = pack8(s[2 * wrow], s[2 * wrow + 1]);
                const bf16* vp = VT + ((size_t)((b * 8 + h) * 64 + lq) << 12) + (rs + wrow) * 64 + u0 + 4 * g;
#pragma unroll
                for (int dt = 0; dt < 4; ++dt) o[dt] = MFMA16(ld8x2(vp + ((size_t)dt << 16), vp + ((size_t)dt << 16) + 16), pb, o[dt]); }
        }
#pragma unroll
        for (int cb = 0; cb < 8; ++cb) { const bf16x8 pb = pack8(s[16 + 2 * cb], s[16 + 2 * cb + 1]);
            const bf16* vp = VTc + ((size_t)((b * 8 + h) * 64 + lq) << 8) + cb * 32 + 4 * g;
#pragma unroll
            for (int dt = 0; dt < 4; ++dt) o[dt] = MFMA16(ld8x2(vp + (dt << 12), vp + (dt << 12) + 16), pb, o[dt]); }
        bf16* op = Ob + (size_t)(qrow0 + lq) * GW + h * 64 + 4 * g;
#pragma unroll
        for (int dt = 0; dt < 4; ++dt) { u32x2 w; w.x = pg8::cvt_pk_bf16(o[dt][0] * inv, o[dt][1] * inv); w.y = pg8::cvt_pk_bf16(o[dt][2] * inv, o[dt][3] * inv); if (!dry) *(u32x2*)(op + 16 * dt) = w; }
    }
}


#define SCHEDB_A() asm volatile("" ::: "memory")
constexpr int AT_R1 = 0, AT_CK = 74752, AT_CV = 107520, AT_RB = 141312;
__device__ __forceinline__ int kswz(int key, int p) { return key * 128 + ((p ^ ((key >> 1) & 7)) << 4); }
__device__ __forceinline__ void p3_attn2(const Ctx& C, int l) {
    unsigned char* L = C.lds;
    const bf16* Qb = C.GRP(0); const bf16* Kb = C.GRP(1); const bf16* Vb = C.GRP(2); bf16* Ob = C.GRP(0);
    const int lq = C.lane & 15, g = C.lane >> 4;
    const int ngroups = 256 + (l == 0 ? 64 : 0);
    const f32x4 z4 = {0.f, 0.f, 0.f, 0.f};
    unsigned* qctr = C.CTL() + CW_CNT + 1024 + l * 64;
    volatile int* qslot = (volatile int*)(C.lds + LDS_STAGE) + 40;
    for (int qit = 0;; ++qit) {
        __syncthreads();
#ifdef STATIC_Q
        if (C.tid == 0) { *qslot = C.bid + qit * C.G; }
#else
        if (C.tid == 0) *qslot = (int)atomicAdd(qctr, 1u);
#endif
        __syncthreads();
        const int gid = *qslot;
        if (gid >= ngroups) break;
        const bool latg = gid < 256; const int bh = latg ? (gid >> 2) : (gid - 256); const int b = bh >> 3, h = bh & 7;
#pragma unroll
        for (int it = 0; it < 4; ++it) { const int i = C.tid + it * 512, key = i >> 3, p = i & 7;
            *(uint4*)(L + AT_CK + kswz(key, p)) = *(const uint4*)(Kb + (size_t)(TL + b * 256 + key) * GW + h * 64 + p * 8);
            { const int ck = it * 64 + C.lane; const uint4 w = *(const uint4*)(Vb + (size_t)(TL + b * 256 + ck) * GW + h * 64 + C.wave * 8);
              unsigned char* dp = L + AT_CV + (C.wave * 8) * 528 + ck * 2;
              *(bf16*)(dp) = (bf16)(w.x & 0xffffu); *(bf16*)(dp + 528) = (bf16)(w.x >> 16); *(bf16*)(dp + 2 * 528) = (bf16)(w.y & 0xffffu); *(bf16*)(dp + 3 * 528) = (bf16)(w.y >> 16);
              *(bf16*)(dp + 4 * 528) = (bf16)(w.z & 0xffffu); *(bf16*)(dp + 5 * 528) = (bf16)(w.z >> 16); *(bf16*)(dp + 6 * 528) = (bf16)(w.w & 0xffffu); *(bf16*)(dp + 7 * 528) = (bf16)(w.w >> 16); } }
        if (C.tid < 480) { const int dr = C.tid >> 5, dc = C.tid & 31; ((float*)(L + AT_RB))[C.tid] = (dc < 31) ? C.p->rel_bias[((size_t)(l * 8 + h) * 15 + dr) * 31 + dc] : 0.f; }
        __syncthreads();
        const int nun = latg ? 8 : 2;
        for (int ui = 0; ui < nun; ++ui) {
            int gr = 0, gc0 = 0, qrow0, rsu = 0, nru = 1, rsw = 0;
            if (latg) { const int gr0 = ((gid & 3) * 8 + ui) * 2; gr = gr0 + (C.wave >> 2); gc0 = (C.wave & 3) * 16; qrow0 = b * 4096 + gr * 64 + gc0;
                rsu = min(max(gr0 - 4, 0), 56); nru = min(9, 64 - rsu); rsw = min(max(gr - 4, 0), 56); }
            else qrow0 = TL + b * 256 + (ui * 8 + C.wave) * 16;
            const int u0 = min(max(gc0 - 8, 0), 32);
            const bf16* qp = Qb + (size_t)(qrow0 + lq) * GW + h * 64 + 8 * g;
            const bf16x8 q0 = ld16(qp), q1 = ld16(qp + 32);
            const int limk = nru * 512;
#define REP9(M) M(0) M(1) M(2) M(3) M(4) M(5) M(6) M(7) M(8)
#define KLD(it) uint4 kv##it; { const int i = min(C.tid + it * 512, limk - 1); kv##it = *(const uint4*)(Kb + (size_t)(b * 4096 + rsu * 64 + (i >> 3)) * GW + h * 64 + (i & 7) * 8); }
            REP9(KLD)
#undef KLD
            SCHEDB_A();
            f32x4 oc[4] = {z4, z4, z4, z4}; float mc, sc;
            { f32x4 s[16];
#pragma unroll
              for (int ct = 0; ct < 16; ++ct) { const int key = ct * 16 + lq;
                  f32x4 a = MFMA16(*(const bf16x8*)(L + AT_CK + kswz(key, g)), q0, z4); a = MFMA16(*(const bf16x8*)(L + AT_CK + kswz(key, 4 + g)), q1, a);
                  s[ct] = a * 0.125f; }
              float mx = -1e30f;
#pragma unroll
              for (int i = 0; i < 16; ++i) mx = fmaxf(fmaxf(fmaxf(mx, s[i][0]), fmaxf(s[i][1], s[i][2])), s[i][3]);
              mx = fmaxf(mx, __shfl_xor(mx, 16)); mx = fmaxf(mx, __shfl_xor(mx, 32));
              float sum = 0.f;
#pragma unroll
              for (int i = 0; i < 16; ++i) {
#pragma unroll
                  for (int r = 0; r < 4; ++r) { const float e = __expf(s[i][r] - mx); s[i][r] = e; sum += e; } }
              sum += __shfl_xor(sum, 16); sum += __shfl_xor(sum, 32);
              mc = mx; sc = sum;
#pragma unroll
              for (int cb = 0; cb < 8; ++cb) { const bf16x8 pb = pack8(s[2 * cb], s[2 * cb + 1]);
                  const unsigned char* vp = L + AT_CV + lq * 528 + (cb * 32 + 4 * g) * 2;
#pragma unroll
                  for (int dt = 0; dt < 4; ++dt) oc[dt] = MFMA16(ld8x2((const bf16*)(vp + dt * 16 * 528), (const bf16*)(vp + dt * 16 * 528 + 32)), pb, oc[dt]); } }
            float inv = 1.f / sc;
            if (latg) {
                __syncthreads();
#define KST_(it) { const int i = C.tid + it * 512; if (i < limk) *(uint4*)(L + AT_R1 + kswz(i >> 3, i & 7)) = kv##it; }
                REP9(KST_)
#undef KST_
                __syncthreads();
                const int gcq = gc0 + lq, csq = min(max(gcq - 8, 0), 48);
                const float* rb = (const float*)(L + AT_RB);
                f32x4 s[16];
#pragma unroll
                for (int wt = 0; wt < 16; ++wt) { const int wrow = wt >> 1, half = wt & 1;
                    const int key = (rsw - rsu + wrow) * 64 + u0 + 16 * half + lq;
                    f32x4 a = MFMA16(*(const bf16x8*)(L + AT_R1 + kswz(key, g)), q0, z4); a = MFMA16(*(const bf16x8*)(L + AT_R1 + kswz(key, 4 + g)), q1, a);
                    const float* brow = rb + (rsw + wrow - gr + 7) * 32;
#pragma unroll
                    for (int r = 0; r < 4; ++r) { const int kc = u0 + 16 * half + 4 * g + r; const bool valid = (kc >= csq) && (kc < csq + 16); const int dc = min(max(kc - gcq + 15, 0), 30);
                        a[r] = valid ? a[r] * 0.125f + brow[dc] : -1e30f; }
                    s[wt] = a; }
                __syncthreads();
                const int nkeys = nru * 64;
#define VLD(it) uint4 vv##it; { const int vk = min(it * 64 + C.lane, nkeys - 1); vv##it = *(const uint4*)(Vb + (size_t)(b * 4096 + rsu * 64 + vk) * GW + h * 64 + C.wave * 8); }
                REP9(VLD)
#undef VLD
                SCHEDB_A();
                float mx = -1e30f;
#pragma unroll
                for (int i = 0; i < 16; ++i) mx = fmaxf(fmaxf(fmaxf(mx, s[i][0]), fmaxf(s[i][1], s[i][2])), s[i][3]);
                mx = fmaxf(mx, __shfl_xor(mx, 16)); mx = fmaxf(mx, __shfl_xor(mx, 32));
                float sum = 0.f;
#pragma unroll
                for (int i = 0; i < 16; ++i) {
#pragma unroll
                    for (int r = 0; r < 4; ++r) { const float e = __expf(s[i][r] - mx); s[i][r] = e; sum += e; } }
                sum += __shfl_xor(sum, 16); sum += __shfl_xor(sum, 32);
                SCHEDB_A();
#define VST_(it) { const int vk = it * 64 + C.lane; if (vk < nkeys) { unsigned char* dp = L + AT_R1 + (C.wave * 8) * 1168 + vk * 2; const uint4 w = vv##it; \
                    *(bf16*)(dp) = (bf16)(w.x & 0xffffu); *(bf16*)(dp + 1168) = (bf16)(w.x >> 16); *(bf16*)(dp + 2 * 1168) = (bf16)(w.y & 0xffffu); *(bf16*)(dp + 3 * 1168) = (bf16)(w.y >> 16); \
                    *(bf16*)(dp + 4 * 1168) = (bf16)(w.z & 0xffffu); *(bf16*)(dp + 5 * 1168) = (bf16)(w.z >> 16); *(bf16*)(dp + 6 * 1168) = (bf16)(w.w & 0xffffu); *(bf16*)(dp + 7 * 1168) = (bf16)(w.w >> 16); } }
                REP9(VST_)
#undef VST_
                __syncthreads();
                f32x4 ow[4] = {z4, z4, z4, z4};
#pragma unroll
                for (int wrow = 0; wrow < 8; ++wrow) { const bf16x8 pb = pack8(s[2 * wrow], s[2 * wrow + 1]);
                    const unsigned char* vp = L + AT_R1 + lq * 1168 + ((rsw - rsu + wrow) * 64 + u0 + 4 * g) * 2;
#pragma unroll
                    for (int dt = 0; dt < 4; ++dt) ow[dt] = MFMA16(ld8x2((const bf16*)(vp + dt * 16 * 1168), (const bf16*)(vp + dt * 16 * 1168 + 32)), pb, ow[dt]); }
                const float m = fmaxf(mc, mx), fc = __expf(mc - m), fw = __expf(mx - m);
                inv = 1.f / (sc * fc + sum * fw);
#pragma unroll
                for (int dt = 0; dt < 4; ++dt) oc[dt] = oc[dt] * fc + ow[dt] * fw;
            }
            bf16* op = Ob + (size_t)(qrow0 + lq) * GW + h * 64 + 4 * g;
#pragma unroll
            for (int dt = 0; dt < 4; ++dt) { u32x2 w; w.x = pg8::cvt_pk_bf16(oc[dt][0] * inv, oc[dt][1] * inv); w.y = pg8::cvt_pk_bf16(oc[dt][2] * inv, oc[dt][3] * inv); *(u32x2*)(op + 16 * dt) = w; }
        }
    }
    __syncthreads();
}


__device__ __forceinline__ float ex2(float x) { return __builtin_amdgcn_exp2f(x); }
__device__ __forceinline__ int scan_row(int b, int dir, int s) { return dir == 0 ? (s < NCTX ? TL + b * NCTX + s : b * SEQ + (s - NCTX)) : (s < NCTX ? TL + b * NCTX + (NCTX - 1 - s) : b * SEQ + (SEQ - 1 - (s - NCTX))); }
#define LBAR() do { asm volatile("s_waitcnt lgkmcnt(0)" ::: "memory"); __builtin_amdgcn_s_barrier(); asm volatile("" ::: "memory"); } while (0)
constexpr int S2_QT = 0, S2_KT = 17408, S2_QS = 34816, S2_KST = 52224, S2_VT = 70656, S2_DV = 89088, S2_TOT = 89600, S2_XP = 93696;
#define SCAN_CHUNK(CC_, GV_, QV_, VR0_, VR1_) do { \
            const int row0 = scan_row(b, dir, 64 * (CC_)); \
            float c0[8], c1[8]; float r0 = 0.f, r1 = 0.f; \
_Pragma("unroll") \
            for (int i = 0; i < 8; ++i) { r0 += bflo(GV_[i]); r1 += bfhi(GV_[i]); c0[i] = r0; c1[i] = r1; } \
            *(float2*)(L + S2_TOT + (seg * 128 + 2 * kp) * 4) = make_float2(r0, r1); \
            LBAR(); \
            float off0 = 0.f, off1 = 0.f, be0 = 0.f, be1 = 0.f, la0 = 0.f, la1 = 0.f; \
_Pragma("unroll") \
            for (int j = 0; j < 8; ++j) { const float2 t = *(const float2*)(L + S2_TOT + (j * 128 + 2 * kp) * 4); \
                if (j < seg) { off0 += t.x; off1 += t.y; } if (j < 4) { be0 += t.x; be1 += t.y; } la0 += t.x; la1 += t.y; } \
            off0 -= be0; off1 -= be1; \
            const float eb0 = ex2(fmaxf(be0, -120.f)), eb1 = ex2(fmaxf(be1, -120.f)), el0 = ex2(fmaxf(la0 - be0, -120.f)), el1 = ex2(fmaxf(la1 - be1, -120.f)); \
            float rp0 = ex2(fminf(fmaxf(-off0, -120.f), 120.f)), rp1 = ex2(fminf(fmaxf(-off1, -120.f), 120.f)); \
            float ks0[8], ks1[8]; \
_Pragma("unroll") \
            for (int i = 0; i < 8; ++i) { const float d0 = fminf(fmaxf(off0 + c0[i], -120.f), 120.f), d1 = fminf(fmaxf(off1 + c1[i], -120.f), 120.f); \
                const float e0 = ex2(d0), e1 = ex2(d1), rr0 = ex2(-d0), rr1 = ex2(-d1); \
                const float qt0 = bflo(QV_[i]) * e0, qt1 = bfhi(QV_[i]) * e1, kt0 = rr0 - rp0, kt1 = rr1 - rp1; rp0 = rr0; rp1 = rr1; \
                const int t = 8 * seg + i; \
                *(unsigned*)(L + S2_QT + t * 272 + 4 * kp) = pg8::cvt_pk_bf16(qt0, qt1); *(unsigned*)(L + S2_KT + t * 272 + 4 * kp) = pg8::cvt_pk_bf16(kt0, kt1); \
                *(unsigned*)(L + S2_QS + t * 272 + 4 * kp) = pg8::cvt_pk_bf16(qt0 * eb0, qt1 * eb1); ks0[i] = kt0 * el0; ks1[i] = kt1 * el1; } \
            { uint4 w0, w1; w0.x = pg8::cvt_pk_bf16(ks0[0], ks0[1]); w0.y = pg8::cvt_pk_bf16(ks0[2], ks0[3]); w0.z = pg8::cvt_pk_bf16(ks0[4], ks0[5]); w0.w = pg8::cvt_pk_bf16(ks0[6], ks0[7]); \
              w1.x = pg8::cvt_pk_bf16(ks1[0], ks1[1]); w1.y = pg8::cvt_pk_bf16(ks1[2], ks1[3]); w1.z = pg8::cvt_pk_bf16(ks1[4], ks1[5]); w1.w = pg8::cvt_pk_bf16(ks1[6], ks1[7]); \
              *(uint4*)(L + S2_KST + (2 * kp) * 144 + seg * 16) = w0; *(uint4*)(L + S2_KST + (2 * kp + 1) * 144 + seg * 16) = w1; } \
            if (seg == 0) *(float2*)(L + S2_DV + 8 * kp) = make_float2(ex2(fmaxf(la0, -120.f)), ex2(fmaxf(la1, -120.f))); \
            { const unsigned vw[8] = {VR0_.x, VR0_.y, VR0_.z, VR0_.w, VR1_.x, VR1_.y, VR1_.z, VR1_.w}; \
_Pragma("unroll") \
              for (int j = 0; j < 8; ++j) { *(bf16*)(L + S2_VT + (vg * 16 + 2 * j) * 144 + vs * 2) = (bf16)(vw[j] & 0xffffu); *(bf16*)(L + S2_VT + (vg * 16 + 2 * j + 1) * 144 + vs * 2) = (bf16)(vw[j] >> 16); } } \
            LBAR(); \
            if ((CC_) > 0) { \
_Pragma("unroll") \
                for (int tt = 0; tt < 4; ++tt) { bf16* op = OUT + (size_t)(prow0 + sgn * (16 * tt + 4 * g)) * GW + h * 128 + 16 * vt + lq; \
                    op[0] = (bf16)(ost[2 * tt] & 0xffffu); op[(ptrdiff_t)sgn * GW] = (bf16)(ost[2 * tt] >> 16); op[(ptrdiff_t)(2 * sgn) * GW] = (bf16)(ost[2 * tt + 1] & 0xffffu); op[(ptrdiff_t)(3 * sgn) * GW] = (bf16)(ost[2 * tt + 1] >> 16); } } \
            if ((CC_) + 2 < 68) { const int nrow0 = scan_row(b, dir, 64 * ((CC_) + 2)); \
_Pragma("unroll") \
                for (int i = 0; i < 8; ++i) { const size_t ro = (size_t)(nrow0 + sgn * (8 * seg + i)) * GW + h * 128 + 2 * kp; GV_[i] = *(const unsigned*)(HF + ro); QV_[i] = *(const unsigned*)(HQ + ro); } \
                const uint4* vp = (const uint4*)(HI + (size_t)(nrow0 + sgn * vs) * GW + h * 128 + vg * 16); VR0_ = vp[0]; VR1_ = vp[1]; } \
            __builtin_amdgcn_sched_barrier(0); \
            f32x4 o[4]; \
            { bf16x8 sp8[4]; \
_Pragma("unroll") \
              for (int kq = 0; kq < 4; ++kq) sp8[kq] = pack8(S[2 * kq], S[2 * kq + 1]); \
_Pragma("unroll") \
              for (int tt = 0; tt < 4; ++tt) { const unsigned char* sb = L + S2_QS + (16 * tt + lq) * 272 + (4 * g) * 2; f32x4 oo = z4; \
_Pragma("unroll") \
                  for (int kq = 0; kq < 4; ++kq) oo = MFMA16(ld8x2((const bf16*)(sb + kq * 64), (const bf16*)(sb + kq * 64 + 32)), sp8[kq], oo); \
                  o[tt] = oo; } } \
            if (C.wave < 6) { \
                const int xt = (C.wave < 2) ? C.wave : 2 + ((C.wave - 2) >> 1), xs = (C.wave < 2) ? 0 : ((C.wave - 2) & 1); \
                const unsigned char* qb = L + S2_QT + (16 * xt + lq) * 272 + g * 16; \
                bf16x8 qf[4]; \
_Pragma("unroll") \
                for (int ks = 0; ks < 4; ++ks) qf[ks] = *(const bf16x8*)(qb + ks * 64); \
                const int tcol = 16 * xt + lq; f32x4 X[2]; \
_Pragma("unroll") \
                for (int hf = 0; hf < 2; ++hf) { const int st = 2 * xs + hf; const unsigned char* kb = L + S2_KT + (16 * st + lq) * 272 + g * 16; f32x4 a = z4; \
_Pragma("unroll") \
                    for (int ks = 0; ks < 4; ++ks) a = MFMA16(*(const bf16x8*)(kb + ks * 64), qf[ks], a); \
_Pragma("unroll") \
                    for (int r = 0; r < 4; ++r) a[r] = (16 * st + 4 * g + r <= tcol) ? a[r] : 0.f; \
                    X[hf] = a; } \
                *(bf16x8*)(L + S2_XP + C.wave * 1024 + C.lane * 16) = pack8(X[0], X[1]); \
            } \
            LBAR(); \
            { const unsigned char* vb = L + S2_VT + (16 * vt + lq) * 144 + (4 * g) * 2; \
              const bf16x8 vq0 = ld8x2((const bf16*)vb, (const bf16*)(vb + 32)), vq1 = ld8x2((const bf16*)(vb + 64), (const bf16*)(vb + 96)); \
              const unsigned char* xp = L + S2_XP + C.lane * 16; \
              o[0] = MFMA16(*(const bf16x8*)(xp), vq0, o[0]); \
              o[1] = MFMA16(*(const bf16x8*)(xp + 1024), vq0, o[1]); \
              o[2] = MFMA16(*(const bf16x8*)(xp + 2048), vq0, o[2]); o[2] = MFMA16(*(const bf16x8*)(xp + 3072), vq1, o[2]); \
              o[3] = MFMA16(*(const bf16x8*)(xp + 4096), vq0, o[3]); o[3] = MFMA16(*(const bf16x8*)(xp + 5120), vq1, o[3]); } \
_Pragma("unroll") \
            for (int tt = 0; tt < 4; ++tt) { ost[2 * tt] = pg8::cvt_pk_bf16(o[tt][0], o[tt][1]); ost[2 * tt + 1] = pg8::cvt_pk_bf16(o[tt][2], o[tt][3]); } \
            prow0 = row0; \
            { const unsigned char* vb = L + S2_VT + (16 * vt + lq) * 144 + g * 16; const bf16x8 vf0 = *(const bf16x8*)vb, vf1 = *(const bf16x8*)(vb + 64); \
_Pragma("unroll") \
              for (int kt = 0; kt < 8; ++kt) { const f32x4 dsc = *(const f32x4*)(L + S2_DV + (16 * kt + 4 * g) * 4); const unsigned char* kb = L + S2_KST + (16 * kt + lq) * 144 + g * 16; \
                  f32x4 a = S[kt] * dsc; a = MFMA16(*(const bf16x8*)kb, vf0, a); a = MFMA16(*(const bf16x8*)(kb + 64), vf1, a); S[kt] = a; } } \
        } while (0)
__device__ __forceinline__ void p3_scan2(const Ctx& C, int l) {
    unsigned char* L = C.lds;
    const int kp = C.tid & 63, seg = C.tid >> 6, lq = C.lane & 15, g = C.lane >> 4, vt = C.wave;
    const bf16* HQ = C.GRP(3); const bf16* HI = C.GRP(6);
    const f32x4 z4 = {0.f, 0.f, 0.f, 0.f};
    for (int u = C.bid; u < 64; u += C.G) {
        const int dir = u & 1, h = (u >> 1) & 3, b = u >> 3;
        const bf16* HF = C.GRP(dir ? 5 : 4); bf16* OUT = C.H() + (size_t)dir * GSTRIDE;
        const int sgn = dir ? -1 : 1;
        f32x4 S[8];
#pragma unroll
        for (int i = 0; i < 8; ++i) S[i] = z4;
        unsigned gv[8], qv[8]; uint4 vr0, vr1;
        const int vs = C.tid >> 3, vg = C.tid & 7;
        { const int row0 = scan_row(b, dir, 0);
#pragma unroll
          for (int i = 0; i < 8; ++i) { const size_t ro = (size_t)(row0 + sgn * (8 * seg + i)) * GW + h * 128 + 2 * kp; gv[i] = *(const unsigned*)(HF + ro); qv[i] = *(const unsigned*)(HQ + ro); }
          const uint4* vp = (const uint4*)(HI + (size_t)(row0 + sgn * vs) * GW + h * 128 + vg * 16); vr0 = vp[0]; vr1 = vp[1]; }
        unsigned gvb[8], qvb[8]; uint4 vr0b, vr1b;
        { const int row0 = scan_row(b, dir, 64);
#pragma unroll
          for (int i = 0; i < 8; ++i) { const size_t ro = (size_t)(row0 + sgn * (8 * seg + i)) * GW + h * 128 + 2 * kp; gvb[i] = *(const unsigned*)(HF + ro); qvb[i] = *(const unsigned*)(HQ + ro); }
          const uint4* vp = (const uint4*)(HI + (size_t)(row0 + sgn * vs) * GW + h * 128 + vg * 16); vr0b = vp[0]; vr1b = vp[1]; }
        unsigned ost[8]; int prow0 = 0;
#pragma unroll
        for (int i = 0; i < 8; ++i) ost[i] = 0u;
        for (int c2 = 0; c2 < 68; c2 += 2) {
            SCAN_CHUNK(c2, gv, qv, vr0, vr1);
            SCAN_CHUNK(c2 + 1, gvb, qvb, vr0b, vr1b);
        }
#pragma unroll
        for (int tt = 0; tt < 4; ++tt) { bf16* op = OUT + (size_t)(prow0 + sgn * (16 * tt + 4 * g)) * GW + h * 128 + 16 * vt + lq;
            op[0] = (bf16)(ost[2 * tt] & 0xffffu); op[(ptrdiff_t)sgn * GW] = (bf16)(ost[2 * tt] >> 16); op[(ptrdiff_t)(2 * sgn) * GW] = (bf16)(ost[2 * tt + 1] & 0xffffu); op[(ptrdiff_t)(3 * sgn) * GW] = (bf16)(ost[2 * tt + 1] >> 16); }
        __syncthreads();
    }
}


__device__ __forceinline__ unsigned rot16(unsigned x) { return (x >> 16) | (x << 16); }
constexpr int S4_QT = 0, S4_KT = 17408, S4_KST = 34816, S4_VT = 53248, S4_DV = 71680, S4_EB = 72192, S4_BUF = 72704, S4_TOT = 145408, S4_XP = 149504;
__device__ __forceinline__ void p3_scan4(const Ctx& C, int l) {
    unsigned char* L = C.lds;
    const int kp = C.tid & 63, seg = C.tid >> 6, lq = C.lane & 15, g = C.lane >> 4, vt = C.wave;
    const bf16* HQ = C.GRP(3); const bf16* HIT = C.GRP(6);
    const f32x4 z4 = {0.f, 0.f, 0.f, 0.f};
    for (int u = C.bid; u < 64; u += C.G) {
        const int dir = u & 1, h = (u >> 1) & 3, b = u >> 3;
        const bf16* HF = C.GRP(dir ? 5 : 4); bf16* OUT = C.H() + (size_t)dir * GSTRIDE;
        const int sgn = dir ? -1 : 1;
        f32x4 S[8];
#pragma unroll
        for (int i = 0; i < 8; ++i) S[i] = z4;
        unsigned gva[8], qva[8], gvb[8], qvb[8]; uint4 vva[2], vvb[2];
        float c0[8], c1[8];
        unsigned ost[8]; int prow0 = 0;
#pragma unroll
        for (int i = 0; i < 8; ++i) ost[i] = 0u;
        f32x4 o[4];
#define S4_LOADS(CC_, GV_, QV_, VV_) do { const int cc_ = (CC_); const int row0_ = scan_row(b, dir, 64 * cc_); \
            _Pragma("unroll") for (int i = 0; i < 8; ++i) { const size_t ro = (size_t)(row0_ + sgn * (8 * seg + i)) * GW + h * 128 + 2 * kp; GV_[i] = *(const unsigned*)(HF + ro); QV_[i] = *(const unsigned*)(HQ + ro); } \
            _Pragma("unroll") for (int j = 0; j < 2; ++j) VV_[j] = *(const uint4*)(HIT + (size_t)(row0_ + sgn * C.lane) * GW + h * 128 + (2 * C.wave + j) * 8); } while (0)
#define S4_G1(GV_) do { float r0 = 0.f, r1 = 0.f; \
            _Pragma("unroll") for (int i = 0; i < 8; ++i) { r0 += bflo(GV_[i]); r1 += bfhi(GV_[i]); c0[i] = r0; c1[i] = r1; } \
            *(float2*)(L + S4_TOT + (seg * 128 + 2 * kp) * 4) = make_float2(r0, r1); } while (0)
#define S4_G2(BO_, QV_, VV_) do { unsigned char* B_ = L + (BO_); \
            float off0 = 0.f, off1 = 0.f, be0 = 0.f, be1 = 0.f, la0 = 0.f, la1 = 0.f; \
            _Pragma("unroll") for (int j = 0; j < 8; ++j) { const float2 t = *(const float2*)(L + S4_TOT + (j * 128 + 2 * kp) * 4); \
                if (j < seg) { off0 += t.x; off1 += t.y; } if (j < 4) { be0 += t.x; be1 += t.y; } la0 += t.x; la1 += t.y; } \
            off0 -= be0; off1 -= be1; \
            const float el0 = ex2(fmaxf(la0 - be0, -120.f)), el1 = ex2(fmaxf(la1 - be1, -120.f)); \
            float rp0 = ex2(fminf(fmaxf(-off0, -120.f), 120.f)), rp1 = ex2(fminf(fmaxf(-off1, -120.f), 120.f)); \
            float ks0[8], ks1[8]; \
            _Pragma("unroll") for (int i = 0; i < 8; ++i) { const float d0 = fminf(fmaxf(off0 + c0[i], -120.f), 120.f), d1 = fminf(fmaxf(off1 + c1[i], -120.f), 120.f); \
                const float e0 = ex2(d0), e1 = ex2(d1), rr0 = ex2(-d0), rr1 = ex2(-d1); \
                const float kt0 = rr0 - rp0, kt1 = rr1 - rp1; rp0 = rr0; rp1 = rr1; const int t = 8 * seg + i; \
                *(unsigned*)(B_ + S4_QT + t * 272 + 4 * kp) = pg8::cvt_pk_bf16(bflo(QV_[i]) * e0, bfhi(QV_[i]) * e1); *(unsigned*)(B_ + S4_KT + t * 272 + 4 * kp) = pg8::cvt_pk_bf16(kt0, kt1); \
                ks0[i] = kt0 * el0; ks1[i] = kt1 * el1; } \
            *(uint4*)(B_ + S4_KST + (2 * kp) * 144 + seg * 16) = make_uint4(pg8::cvt_pk_bf16(ks0[0], ks0[1]), pg8::cvt_pk_bf16(ks0[2], ks0[3]), pg8::cvt_pk_bf16(ks0[4], ks0[5]), pg8::cvt_pk_bf16(ks0[6], ks0[7])); \
            *(uint4*)(B_ + S4_KST + (2 * kp + 1) * 144 + seg * 16) = make_uint4(pg8::cvt_pk_bf16(ks1[0], ks1[1]), pg8::cvt_pk_bf16(ks1[2], ks1[3]), pg8::cvt_pk_bf16(ks1[4], ks1[5]), pg8::cvt_pk_bf16(ks1[6], ks1[7])); \
            if (seg == 0) { *(float2*)(B_ + S4_DV + 8 * kp) = make_float2(ex2(fmaxf(la0, -120.f)), ex2(fmaxf(la1, -120.f))); *(float2*)(B_ + S4_EB + 8 * kp) = make_float2(ex2(fmaxf(be0, -120.f)), ex2(fmaxf(be1, -120.f))); } \
            _Pragma("unroll") for (int j = 0; j < 2; ++j) { const uint4 w = VV_[j]; unsigned char* dp = B_ + S4_VT + ((2 * C.wave + j) * 8) * 144 + C.lane * 2; \
                *(bf16*)(dp) = (bf16)(w.x & 0xffffu); *(bf16*)(dp + 144) = (bf16)(w.x >> 16); *(bf16*)(dp + 288) = (bf16)(w.y & 0xffffu); *(bf16*)(dp + 432) = (bf16)(w.y >> 16); \
                *(bf16*)(dp + 576) = (bf16)(w.z & 0xffffu); *(bf16*)(dp + 720) = (bf16)(w.z >> 16); *(bf16*)(dp + 864) = (bf16)(w.w & 0xffffu); *(bf16*)(dp + 1008) = (bf16)(w.w >> 16); } } while (0)
#define S4_MA(BO_) do { const unsigned char* B_ = L + (BO_); \
            bf16x8 sp8[4]; \
            _Pragma("unroll") for (int kq = 0; kq < 4; ++kq) { const f32x4 ea = *(const f32x4*)(B_ + S4_EB + (32 * kq + 4 * g) * 4), eb = *(const f32x4*)(B_ + S4_EB + (32 * kq + 16 + 4 * g) * 4); sp8[kq] = pack8(S[2 * kq] * ea, S[2 * kq + 1] * eb); } \
            _Pragma("unroll") for (int tt = 0; tt < 4; ++tt) { const unsigned char* sb = B_ + S4_QT + (16 * tt + lq) * 272 + 8 * g; f32x4 oo = z4; \
                _Pragma("unroll") for (int kq = 0; kq < 4; ++kq) oo = MFMA16(ld8x2((const bf16*)(sb + kq * 64), (const bf16*)(sb + kq * 64 + 32)), sp8[kq], oo); \
                o[tt] = oo; } \
            if (C.wave < 6) { const int xt = (C.wave < 2) ? C.wave : 2 + ((C.wave - 2) >> 1), xs = (C.wave < 2) ? 0 : ((C.wave - 2) & 1); \
                const unsigned char* qb = B_ + S4_QT + (16 * xt + lq) * 272 + g * 16; bf16x8 qf[4]; \
                _Pragma("unroll") for (int ks = 0; ks < 4; ++ks) qf[ks] = *(const bf16x8*)(qb + ks * 64); \
                const int tcol = 16 * xt + lq; f32x4 X[2]; \
                _Pragma("unroll") for (int hf = 0; hf < 2; ++hf) { const int st = 2 * xs + hf; const unsigned char* kb = B_ + S4_KT + (16 * st + lq) * 272 + g * 16; f32x4 a = z4; \
                    _Pragma("unroll") for (int ks = 0; ks < 4; ++ks) a = MFMA16(*(const bf16x8*)(kb + ks * 64), qf[ks], a); \
                    _Pragma("unroll") for (int r = 0; r < 4; ++r) a[r] = (16 * st + 4 * g + r <= tcol) ? a[r] : 0.f; \
                    X[hf] = a; } \
                *(bf16x8*)(L + S4_XP + C.wave * 1024 + C.lane * 16) = pack8(X[0], X[1]); } } while (0)
#define S4_MB(BO_, ROW0_) do { const unsigned char* B_ = L + (BO_); \
            { const unsigned char* vb = B_ + S4_VT + (16 * vt + lq) * 144 + 8 * g; \
              const bf16x8 vq0 = ld8x2((const bf16*)vb, (const bf16*)(vb + 32)), vq1 = ld8x2((const bf16*)(vb + 64), (const bf16*)(vb + 96)); \
              const unsigned char* xp = L + S4_XP + C.lane * 16; \
              o[0] = MFMA16(*(const bf16x8*)(xp), vq0, o[0]); o[1] = MFMA16(*(const bf16x8*)(xp + 1024), vq0, o[1]); \
              o[2] = MFMA16(*(const bf16x8*)(xp + 2048), vq0, o[2]); o[2] = MFMA16(*(const bf16x8*)(xp + 3072), vq1, o[2]); \
              o[3] = MFMA16(*(const bf16x8*)(xp + 4096), vq0, o[3]); o[3] = MFMA16(*(const bf16x8*)(xp + 5120), vq1, o[3]); } \
            _Pragma("unroll") for (int tt = 0; tt < 4; ++tt) { ost[2 * tt] = pg8::cvt_pk_bf16(o[tt][0], o[tt][1]); ost[2 * tt + 1] = pg8::cvt_pk_bf16(o[tt][2], o[tt][3]); } \
            prow0 = (ROW0_); \
            { const unsigned char* vb = B_ + S4_VT + (16 * vt + lq) * 144 + g * 16; const bf16x8 vf0 = *(const bf16x8*)vb, vf1 = *(const bf16x8*)(vb + 64); \
              _Pragma("unroll") for (int kt = 0; kt < 8; ++kt) { const f32x4 dsc = *(const f32x4*)(B_ + S4_DV + (16 * kt + 4 * g) * 4); const unsigned char* kb = B_ + S4_KST + (16 * kt + lq) * 144 + g * 16; \
                  f32x4 a = S[kt] * dsc; a = MFMA16(*(const bf16x8*)kb, vf0, a); a = MFMA16(*(const bf16x8*)(kb + 64), vf1, a); S[kt] = a; } } } while (0)
#define S4_STORE() do { _Pragma("unroll") for (int tt = 0; tt < 4; ++tt) { bf16* op = OUT + (size_t)(prow0 + sgn * (16 * tt + 4 * g)) * GW + h * 128 + 16 * vt + lq; \
                op[0] = (bf16)(ost[2 * tt] & 0xffffu); op[(ptrdiff_t)sgn * GW] = (bf16)(ost[2 * tt] >> 16); op[(ptrdiff_t)(2 * sgn) * GW] = (bf16)(ost[2 * tt + 1] & 0xffffu); op[(ptrdiff_t)(3 * sgn) * GW] = (bf16)(ost[2 * tt + 1] >> 16); } } while (0)
#define S4_STEP(CC_, GV_, QV_, VV_) do { const int c_ = (CC_); \
            if (c_ + 1 < 68) S4_G1(GV_); \
            S4_MA((c_ & 1) * S4_BUF); \
            LBAR(); \
            if (c_ > 0) S4_STORE(); \
            if (c_ + 1 < 68) { S4_G2(((c_ + 1) & 1) * S4_BUF, QV_, VV_); if (c_ + 3 < 68) S4_LOADS(c_ + 3, GV_, QV_, VV_); } \
            __builtin_amdgcn_sched_barrier(0); \
            S4_MB((c_ & 1) * S4_BUF, scan_row(b, dir, 64 * c_)); \
            LBAR(); } while (0)
        S4_LOADS(0, gva, qva, vva); S4_LOADS(1, gvb, qvb, vvb);
        S4_G1(gva);
        LBAR();
        S4_G2(0, qva, vva); S4_LOADS(2, gva, qva, vva);
        LBAR();
        for (int c2 = 0; c2 < 68; c2 += 2) {
            S4_STEP(c2, gvb, qvb, vvb);
            S4_STEP(c2 + 1, gva, qva, vva);
        }
        S4_STORE();
#undef S4_LOADS
#undef S4_G1
#undef S4_G2
#undef S4_MA
#undef S4_MB
#undef S4_STORE
#undef S4_STEP
        __syncthreads();
    }
}

constexpr int SC_QT = 0, SC_KT = 17408, SC_QS = 34816, SC_KST = 52224, SC_VT = 70656, SC_DV = 75264, SC_TOT = 75776;
__device__ __forceinline__ void p3_scan(const Ctx& C, int l) {
    unsigned char* L = C.lds;
    const int k = C.tid & 127, tq = C.tid >> 7, lq = C.lane & 15, g = C.lane >> 4, tt = C.wave >> 1, vt = C.wave & 1;
    const bf16* HQ = C.GRP(3); const bf16* HI = C.GRP(6);
    for (int u = C.bid; u < 256; u += C.G) {
        const int dvq = u & 3, dir = (u >> 2) & 1, h = (u >> 3) & 3, b = u >> 5;
        const bf16* HF = C.GRP(dir ? 5 : 4); bf16* OUT = C.H() + (size_t)dir * GSTRIDE;
        const int sgn = dir ? -1 : 1;
        f32x4 S[8];
#pragma unroll
        for (int i = 0; i < 8; ++i) S[i] = (f32x4){0.f, 0.f, 0.f, 0.f};
        unsigned gv[16], qv[16]; u32x2 vraw;
        const int vs = C.tid >> 3, v4 = (C.tid & 7) * 4;
        { const int row0 = scan_row(b, dir, 0);
#pragma unroll
          for (int i = 0; i < 16; ++i) { const size_t ro = (size_t)(row0 + sgn * (16 * tq + i)) * GW + h * 128 + k; gv[i] = HF[ro]; qv[i] = HQ[ro]; }
          vraw = *(const u32x2*)(HI + (size_t)(row0 + sgn * vs) * GW + h * 128 + dvq * 32 + v4); }
        for (int c = 0; c < 68; ++c) {
            const int row0 = scan_row(b, dir, 64 * c);
            float cs[16]; float run = 0.f;
#pragma unroll
            for (int i = 0; i < 16; ++i) { run += bf2f(gv[i]); cs[i] = run; }
            ((float*)(L + SC_TOT))[tq * 128 + k] = run;
            __syncthreads();
            const float t0 = ((float*)(L + SC_TOT))[k], t1 = ((float*)(L + SC_TOT))[128 + k], t2 = ((float*)(L + SC_TOT))[256 + k], t3 = ((float*)(L + SC_TOT))[384 + k];
            const float beta = t0 + t1, last = beta + t2 + t3;
            const float off = (tq == 0) ? 0.f : (tq == 1) ? t0 : (tq == 2) ? beta : beta + t2;
            const float eb = ex2(fmaxf(beta, -120.f)), el = ex2(fmaxf(last - beta, -120.f));
            float ks_[16];
#pragma unroll
            for (int i = 0; i < 16; ++i) { const float d = off + cs[i] - beta; const float e1 = ex2(fminf(fmaxf(d, -120.f), 120.f)), r1 = ex2(fminf(fmaxf(-d, -120.f), 120.f));
                const float q = bf2f(qv[i]), kk = 1.f - ex2(bf2f(gv[i])); const float qt = q * e1, kt = kk * r1; const int t = 16 * tq + i;
                *(bf16*)(L + SC_QT + t * 272 + k * 2) = (bf16)f2bf(qt); *(bf16*)(L + SC_KT + t * 272 + k * 2) = (bf16)f2bf(kt); *(bf16*)(L + SC_QS + t * 272 + k * 2) = (bf16)f2bf(qt * eb); ks_[i] = kt * el; }
            { uint4 w0, w1; w0.x = pk2(ks_[0], ks_[1]); w0.y = pk2(ks_[2], ks_[3]); w0.z = pk2(ks_[4], ks_[5]); w0.w = pk2(ks_[6], ks_[7]); w1.x = pk2(ks_[8], ks_[9]); w1.y = pk2(ks_[10], ks_[11]); w1.z = pk2(ks_[12], ks_[13]); w1.w = pk2(ks_[14], ks_[15]);
              *(uint4*)(L + SC_KST + k * 144 + tq * 32) = w0; *(uint4*)(L + SC_KST + k * 144 + tq * 32 + 16) = w1; }
            if (tq == 0) ((float*)(L + SC_DV))[k] = ex2(fmaxf(last, -120.f));
            { *(bf16*)(L + SC_VT + (v4 + 0) * 144 + vs * 2) = (bf16)(vraw.x & 0xffffu); *(bf16*)(L + SC_VT + (v4 + 1) * 144 + vs * 2) = (bf16)(vraw.x >> 16);
              *(bf16*)(L + SC_VT + (v4 + 2) * 144 + vs * 2) = (bf16)(vraw.y & 0xffffu); *(bf16*)(L + SC_VT + (v4 + 3) * 144 + vs * 2) = (bf16)(vraw.y >> 16); }
            __syncthreads();
            if (c + 1 < 68) { const int nrow0 = scan_row(b, dir, 64 * (c + 1));
#pragma unroll
                for (int i = 0; i < 16; ++i) { const size_t ro = (size_t)(nrow0 + sgn * (16 * tq + i)) * GW + h * 128 + k; gv[i] = HF[ro]; qv[i] = HQ[ro]; }
                vraw = *(const u32x2*)(HI + (size_t)(nrow0 + sgn * vs) * GW + h * 128 + dvq * 32 + v4); }
            const f32x4 z4 = {0.f, 0.f, 0.f, 0.f};
            f32x4 o = z4;
            { const unsigned char* qb = L + SC_QT + (16 * tt + lq) * 272 + g * 16;
              bf16x8 qf[4];
#pragma unroll
              for (int ks = 0; ks < 4; ++ks) qf[ks] = *(const bf16x8*)(qb + ks * 64);
              const int tcol = 16 * tt + lq;
#pragma unroll
              for (int sp = 0; sp < 2; ++sp) if (sp <= (tt >> 1)) {
                  f32x4 X[2];
#pragma unroll
                  for (int hf = 0; hf < 2; ++hf) { const int st = 2 * sp + hf; const unsigned char* kb = L + SC_KT + (16 * st + lq) * 272 + g * 16; f32x4 a = z4;
#pragma unroll
                      for (int ks = 0; ks < 4; ++ks) a = MFMA16(*(const bf16x8*)(kb + ks * 64), qf[ks], a);
#pragma unroll
                      for (int r = 0; r < 4; ++r) a[r] = (16 * st + 4 * g + r <= tcol) ? a[r] : 0.f;
                      X[hf] = a; }
                  const unsigned char* vb = L + SC_VT + (16 * vt + lq) * 144 + (32 * sp + 4 * g) * 2;
                  o = MFMA16(pack8(X[0], X[1]), ld8x2((const bf16*)vb, (const bf16*)(vb + 32)), o); } }
            { const unsigned char* sb = L + SC_QS + (16 * tt + lq) * 272 + (4 * g) * 2;
#pragma unroll
              for (int kp = 0; kp < 4; ++kp) o = MFMA16(ld8x2((const bf16*)(sb + kp * 64), (const bf16*)(sb + kp * 64 + 32)), pack8(S[2 * kp], S[2 * kp + 1]), o); }
            { bf16* op = OUT + (size_t)(row0 + sgn * (16 * tt + 4 * g)) * GW + h * 128 + dvq * 32 + 16 * vt + lq;
#pragma unroll
              for (int r = 0; r < 4; ++r) op[(ptrdiff_t)(sgn * r) * GW] = (bf16)f2bf(o[r]); }
            { const unsigned char* vb = L + SC_VT + (16 * vt + lq) * 144 + g * 16; const bf16x8 vf0 = *(const bf16x8*)vb, vf1 = *(const bf16x8*)(vb + 64);
#pragma unroll
              for (int kt = 0; kt < 8; ++kt) { const f32x4 dsc = *(const f32x4*)(L + SC_DV + (16 * kt + 4 * g) * 4); const unsigned char* kb = L + SC_KST + (16 * kt + lq) * 144 + g * 16;
                  f32x4 a = S[kt] * dsc; a = MFMA16(*(const bf16x8*)kb, vf0, a); a = MFMA16(*(const bf16x8*)(kb + 64), vf1, a); S[kt] = a; } }
        }
        __syncthreads();
    }
}

__device__ __forceinline__ void p3_scan_naive(const Ctx& C, int l) {
    const bf16* HQ = C.GRP(3); const bf16* HI = C.GRP(6);
    for (int u = C.gw; u < 2048; u += C.nw) {
        const int dv4 = u & 31, dir = (u >> 5) & 1, h = (u >> 6) & 3, b = u >> 8;
        const bf16* HF = C.GRP(dir ? 5 : 4); bf16* OUT = C.H() + (size_t)dir * GSTRIDE;
        const float lb0 = C.LB()[(l * 2 + dir) * 512 + h * 128 + C.lane], lb1 = C.LB()[(l * 2 + dir) * 512 + h * 128 + 64 + C.lane];
        float S0[4] = {0.f, 0.f, 0.f, 0.f}, S1[4] = {0.f, 0.f, 0.f, 0.f};
        const int NS = NCTX + SEQ;
        int row = scan_row(b, dir, 0);
        unsigned q0 = HQ[(size_t)row * GW + h * 128 + C.lane], q1 = HQ[(size_t)row * GW + h * 128 + 64 + C.lane], f0 = HF[(size_t)row * GW + h * 128 + C.lane], f1 = HF[(size_t)row * GW + h * 128 + 64 + C.lane];
        uint2 vv = *(const uint2*)(HI + (size_t)row * GW + h * 128 + dv4 * 4);
        for (int s = 0; s < NS; ++s) {
            const int nrow = scan_row(b, dir, (s + 1 < NS) ? s + 1 : s);
            const unsigned nq0 = HQ[(size_t)nrow * GW + h * 128 + C.lane], nq1 = HQ[(size_t)nrow * GW + h * 128 + 64 + C.lane], nf0 = HF[(size_t)nrow * GW + h * 128 + C.lane], nf1 = HF[(size_t)nrow * GW + h * 128 + 64 + C.lane];
            const uint2 nvv = *(const uint2*)(HI + (size_t)nrow * GW + h * 128 + dv4 * 4);
            const float qa = silu(bf2f(q0)), qb = silu(bf2f(q1));
            const float fa = fminf(fmaxf(bf2f(f0), -30.f), 30.f), fb = fminf(fmaxf(bf2f(f1), -30.f), 30.f);
            const float ea = __expf(-fa), eb = __expf(-fb);
            const float sga = 1.f / (1.f + ea), sgb = 1.f / (1.f + eb);
            const float ga = fmaxf(lb0 + (1.f - lb0) * sga, 1e-30f), gb = fmaxf(lb1 + (1.f - lb1) * sgb, 1e-30f);
            const float ka = (1.f - lb0) * (ea * sga), kb = (1.f - lb1) * (eb * sgb);
            const float v[4] = {bflo(vv.x), bfhi(vv.x), bflo(vv.y), bfhi(vv.y)};
            float o[4];
#pragma unroll
            for (int j = 0; j < 4; ++j) { S0[j] = ga * S0[j] + ka * v[j]; S1[j] = gb * S1[j] + kb * v[j]; o[j] = wave_sum(qa * S0[j] + qb * S1[j]); }
            if (C.lane == 0) { uint2 w; w.x = pk2(o[0], o[1]); w.y = pk2(o[2], o[3]); *(uint2*)(OUT + (size_t)row * GW + h * 128 + dv4 * 4) = w; }
            row = nrow; q0 = nq0; q1 = nq1; f0 = nf0; f1 = nf1; vv = nvv;
        }
    }
}

__device__ __forceinline__ void p3c_headnorm(const Ctx& C, int l, bool dry = false) {
    const int nrows = (l == 0) ? TA : TL;
    bf16* OF = C.H(); const bf16* OB = C.H() + GSTRIDE; const bf16* HG = C.GRP(7);
    const float* gain = C.p->hg_norm_g + l * 128;
    uint4 na = make_uint4(0u, 0u, 0u, 0u), nb = na, ng = na;
    if (C.gw < nrows) { const size_t o0 = (size_t)C.gw * GW + C.lane * 8; na = *(const uint4*)(OF + o0); nb = *(const uint4*)(OB + o0); ng = *(const uint4*)(HG + o0); }
    for (int r = C.gw; r < nrows; r += C.nw) {
        const size_t off = (size_t)r * GW + C.lane * 8;
        float a[8], b[8], g[8]; unpack8(na, a); unpack8(nb, b); unpack8(ng, g);
        { const int rn = r + C.nw; if (rn < nrows) { const size_t o1 = (size_t)rn * GW + C.lane * 8; na = *(const uint4*)(OF + o1); nb = *(const uint4*)(OB + o1); ng = *(const uint4*)(HG + o1); } }
        float ss = 0.f;
#pragma unroll
        for (int i = 0; i < 8; ++i) { a[i] += b[i]; ss += a[i] * a[i]; }
        ss += __shfl_xor(ss, 1); ss += __shfl_xor(ss, 2); ss += __shfl_xor(ss, 4); ss += __shfl_xor(ss, 8);
        const float rinv = rsqrtf(ss * (1.f / 128.f) + EPS);
        const int cg = (C.lane & 15) * 8; float o[8];
#pragma unroll
        for (int i = 0; i < 8; ++i) o[i] = a[i] * rinv * gain[cg + i] * silu(g[i]);
        uint4 w; w.x = pk2(o[0], o[1]); w.y = pk2(o[2], o[3]); w.z = pk2(o[4], o[5]); w.w = pk2(o[6], o[7]);
        if (!dry) *(uint4*)(OF + off) = w;
    }
}

__device__ __forceinline__ int e_of(const Ctx& C, int i) { return C.TOKE()[i]; }
__device__ __forceinline__ void p5_norm2_router(const Ctx& C, int l, bool dry = false) {
    float* wr = (float*)C.lds;
    unsigned* lcnt = (unsigned*)(C.lds + 65536);
    for (int c = C.tid; c < 1024; c += 512) { const float4* src = (const float4*)(C.p->w_router + c * 16);
#pragma unroll
        for (int q = 0; q < 4; ++q) { const float4 w4 = src[q]; wr[(4 * q) * 1024 + c] = w4.x; wr[(4 * q + 1) * 1024 + c] = w4.y; wr[(4 * q + 2) * 1024 + c] = w4.z; wr[(4 * q + 3) * 1024 + c] = w4.w; } }
    if (C.tid < 32) lcnt[C.tid] = 0u;
    __syncthreads();
    const int nrows = (l == 0) ? TA : TL;
    float rb[16];
#pragma unroll
    for (int e = 0; e < 16; ++e) rb[e] = C.p->router_bias[e];
    float nv[16];
    if (C.gw < nrows) load_row(C.gw < TL ? C.p->out + (size_t)C.gw * DM : C.CTXS() + (size_t)(C.gw - TL) * DM, C.lane, nv);
    for (int r = C.gw; r < nrows; r += C.nw) {
        float v[16], h[16];
#pragma unroll
        for (int i = 0; i < 16; ++i) v[i] = nv[i];
        { const int rn = r + C.nw; if (rn < nrows) load_row(rn < TL ? C.p->out + (size_t)rn * DM : C.CTXS() + (size_t)(rn - TL) * DM, C.lane, nv); }
        const float rinv = row_rinv(v);
        const float* mod = C.MOD() + (size_t)(l * 9 + modrow_of(r)) * INW;
        norm_mod(v, rinv, C.p->norm2_g + l * DM, mod + 4096, mod + 3072, C.lane, h);
        if (!dry) store_row_bf16(C.H() + (size_t)r * DM, C.lane, h);
        float acc[16];
#pragma unroll
        for (int e = 0; e < 16; ++e) acc[e] = 0.f;
#pragma unroll
        for (int j = 0; j < 4; ++j)
#pragma unroll
            for (int e = 0; e < 16; ++e) { const float4 ww = *(const float4*)(wr + e * 1024 + j * 256 + C.lane * 4); acc[e] += h[4 * j] * ww.x + h[4 * j + 1] * ww.y + h[4 * j + 2] * ww.z + h[4 * j + 3] * ww.w; }
        float k8[8], k4[4], k2[2], k1;
        { const bool b5 = (C.lane & 32) != 0, b4 = (C.lane & 16) != 0, b3 = (C.lane & 8) != 0, b2 = (C.lane & 4) != 0;
#pragma unroll
          for (int i = 0; i < 8; ++i) { const float snd = b5 ? acc[i] : acc[i + 8], kp_ = b5 ? acc[i + 8] : acc[i]; k8[i] = kp_ + __shfl_xor(snd, 32); }
#pragma unroll
          for (int i = 0; i < 4; ++i) { const float snd = b4 ? k8[i] : k8[i + 4], kp_ = b4 ? k8[i + 4] : k8[i]; k4[i] = kp_ + __shfl_xor(snd, 16); }
#pragma unroll
          for (int i = 0; i < 2; ++i) { const float snd = b3 ? k4[i] : k4[i + 2], kp_ = b3 ? k4[i + 2] : k4[i]; k2[i] = kp_ + __shfl_xor(snd, 8); }
          { const float snd = b2 ? k2[0] : k2[1], kp_ = b2 ? k2[1] : k2[0]; k1 = kp_ + __shfl_xor(snd, 4); }
          k1 += __shfl_xor(k1, 2); k1 += __shfl_xor(k1, 1); }
        float lg[16];
#pragma unroll
        for (int e = 0; e < 16; ++e) lg[e] = __shfl(k1, 4 * e);
        float bestg = -1e30f; int e0 = 0, e1 = 1; float s0 = 0.f, s1 = 0.f;
#pragma unroll
        for (int g = 0; g < 4; ++g) {
            float sc[4], gbv[4];
#pragma unroll
            for (int j = 0; j < 4; ++j) { sc[j] = __builtin_amdgcn_rcpf(1.f + __expf(-lg[4 * g + j])); gbv[j] = sc[j] + rb[4 * g + j]; }
            int i0 = 0; float b0 = gbv[0], u0 = sc[0];
#pragma unroll
            for (int j = 1; j < 4; ++j) if (gbv[j] > b0) { b0 = gbv[j]; i0 = j; u0 = sc[j]; }
            int i1 = -1; float b1 = -1e30f, u1 = 0.f;
#pragma unroll
            for (int j = 0; j < 4; ++j) if (j != i0 && gbv[j] > b1) { b1 = gbv[j]; i1 = j; u1 = sc[j]; }
            const float gs = b0 + b1;
            if (gs > bestg) { bestg = gs; e0 = 4 * g + i0; e1 = 4 * g + i1; s0 = u0; s1 = u1; }
        }
        if (C.lane == 0 && !dry) {
            const float den = s0 + s1;
            const int r0 = (int)atomicAdd(lcnt + e0, 1u), r1 = (int)atomicAdd(lcnt + e1, 1u);
            C.TOKE()[2 * r] = e0; C.TOKE()[2 * r + 1] = e1; C.TOKW()[2 * r] = s0 / den; C.TOKW()[2 * r + 1] = s1 / den; C.TOKS()[2 * r] = r0; C.TOKS()[2 * r + 1] = r1;
        }
    }
    __syncthreads();
    if (C.tid < 16 && !dry) lcnt[16 + C.tid] = atomicAdd(C.CNT(l) + C.tid, lcnt[C.tid]);
    __syncthreads();
    if (C.lane == 0 && !dry) for (int r = C.gw; r < nrows; r += C.nw) { C.TOKS()[2 * r] += (int)lcnt[16 + e_of(C, 2 * r)]; C.TOKS()[2 * r + 1] += (int)lcnt[16 + e_of(C, 2 * r + 1)]; }
    __syncthreads();
}

__device__ __forceinline__ void p6_permute(const Ctx& C, int l, bool dry = false) {
    moe_table(C, l);
    const int nrows = (l == 0) ? TA : TL;
    uint4 na = make_uint4(0u, 0u, 0u, 0u), nb = na;
    if (C.gw < nrows) { const uint4* src = (const uint4*)(C.H() + (size_t)C.gw * DM); na = src[C.lane]; nb = src[64 + C.lane]; }
    for (int r = C.gw; r < nrows; r += C.nw) {
        const int e0 = C.TOKE()[2 * r], e1 = C.TOKE()[2 * r + 1];
        const int sl0 = C.TAB()[e0] * 256 + C.TOKS()[2 * r], sl1 = C.TAB()[e1] * 256 + C.TOKS()[2 * r + 1];
        const uint4 a = na, b = nb;
        { const int rn = r + C.nw; if (rn < nrows) { const uint4* src = (const uint4*)(C.H() + (size_t)rn * DM); na = src[C.lane]; nb = src[64 + C.lane]; } }
        uint4* d0 = (uint4*)(C.XS() + (size_t)sl0 * DM); uint4* d1 = (uint4*)(C.XS() + (size_t)sl1 * DM);
        if (!dry) { d0[C.lane] = a; d0[64 + C.lane] = b; d1[C.lane] = a; d1[64 + C.lane] = b; }
        if (C.lane == 0 && !dry) { C.TOKS()[2 * r] = sl0; C.TOKS()[2 * r + 1] = sl1; }
    }
}

__device__ __forceinline__ void p9_combine(const Ctx& C, int l, bool dry = false) {
    const int nrows = (l == 0) ? TA : TL; const bf16* YS = C.XS();
    float nv[16]; uint2 nya[4], nyb[4]; float nw0 = 0.f, nw1 = 0.f; int ns0 = 0, ns1 = 0;
#pragma unroll
    for (int j = 0; j < 4; ++j) { nya[j] = make_uint2(0u, 0u); nyb[j] = nya[j]; }
    if (C.gw < nrows) { const int r = C.gw; load_row(r < TL ? C.p->out + (size_t)r * DM : C.CTXS() + (size_t)(r - TL) * DM, C.lane, nv);
        const int s0 = C.TOKS()[2 * r], s1 = C.TOKS()[2 * r + 1]; nw0 = C.TOKW()[2 * r]; nw1 = C.TOKW()[2 * r + 1];
#pragma unroll
        for (int j = 0; j < 4; ++j) { const int c = j * 256 + C.lane * 4; nya[j] = *(const uint2*)(YS + (size_t)s0 * DM + c); nyb[j] = *(const uint2*)(YS + (size_t)s1 * DM + c); }
        if (r + C.nw < nrows) { ns0 = C.TOKS()[2 * (r + C.nw)]; ns1 = C.TOKS()[2 * (r + C.nw) + 1]; } }
    for (int r = C.gw; r < nrows; r += C.nw) {
        float* xr = r < TL ? C.p->out + (size_t)r * DM : C.CTXS() + (size_t)(r - TL) * DM;
        float v[16]; uint2 ya[4], yb[4]; const float w0 = nw0, w1 = nw1;
#pragma unroll
        for (int i = 0; i < 16; ++i) v[i] = nv[i];
#pragma unroll
        for (int j = 0; j < 4; ++j) { ya[j] = nya[j]; yb[j] = nyb[j]; }
        { const int rn = r + C.nw; if (rn < nrows) { load_row(rn < TL ? C.p->out + (size_t)rn * DM : C.CTXS() + (size_t)(rn - TL) * DM, C.lane, nv);
            nw0 = C.TOKW()[2 * rn]; nw1 = C.TOKW()[2 * rn + 1];
#pragma unroll
            for (int j = 0; j < 4; ++j) { const int c = j * 256 + C.lane * 4; nya[j] = *(const uint2*)(YS + (size_t)ns0 * DM + c); nyb[j] = *(const uint2*)(YS + (size_t)ns1 * DM + c); }
            const int rnn = rn + C.nw; if (rnn < nrows) { ns0 = C.TOKS()[2 * rnn]; ns1 = C.TOKS()[2 * rnn + 1]; } } }
        const float* mod = C.MOD() + (size_t)(l * 9 + modrow_of(r)) * INW;
#pragma unroll
        for (int j = 0; j < 4; ++j) { const int c = j * 256 + C.lane * 4; const uint2 a = ya[j], b = yb[j]; const float4 g = *(const float4*)(mod + 5120 + c);
            v[4 * j] += g.x * (w0 * bflo(a.x) + w1 * bflo(b.x)); v[4 * j + 1] += g.y * (w0 * bfhi(a.x) + w1 * bfhi(b.x));
            v[4 * j + 2] += g.z * (w0 * bflo(a.y) + w1 * bflo(b.y)); v[4 * j + 3] += g.w * (w0 * bfhi(a.y) + w1 * bfhi(b.y)); }
        const float rinv = row_rinv(v);
        if (l == 0) {
#pragma unroll
            for (int j = 0; j < 4; ++j) if (!dry) *(float4*)(xr + j * 256 + C.lane * 4) = make_float4(v[4 * j], v[4 * j + 1], v[4 * j + 2], v[4 * j + 3]);
            float h[16]; const float* mod1 = C.MOD() + (size_t)(9 + modrow_of(r)) * INW;
            norm_mod(v, rinv, C.p->norm1_g + DM, mod1 + 1024, mod1, C.lane, h);
            if (!dry) store_row_bf16(C.H() + (size_t)r * DM, C.lane, h);
        } else {
#pragma unroll
            for (int j = 0; j < 4; ++j) { const int c = j * 256 + C.lane * 4; const float4 g = *(const float4*)(C.p->final_g + c);
                if (!dry) *(float4*)(xr + c) = make_float4(v[4 * j] * rinv * g.x, v[4 * j + 1] * rinv * g.y, v[4 * j + 2] * rinv * g.z, v[4 * j + 3] * rinv * g.w); }
        }
    }
}

#ifndef PHMASK
#define PHMASK 0xFFFFu
#endif
#define PHON(i) (((PHMASK) >> (i)) & 1u)
constexpr int NPH = 22;
__global__ void __launch_bounds__(512, 2) mk_fwd(Params p) {
    extern __shared__ __attribute__((aligned(16))) unsigned char lds_raw[];
    LAS unsigned char* ldsl = (LAS unsigned char*)lds_raw;
    const int wv_ = __builtin_amdgcn_readfirstlane((int)threadIdx.x >> 6);
    if (threadIdx.x < 64) ((LAS unsigned*)(ldsl + LDS_STAGE))[threadIdx.x] = 0u;
    __syncthreads();
    XcdBarrier bar = xcd_barrier_post((unsigned*)(p.ws + WS_CTL) + CW_BAR + p.li * XCD_BAR_WORDS, (volatile LAS unsigned*)(ldsl + LDS_STAGE) + LDSW_BAR, wv_ == 0 ? 1u : 0u);
#define MKCTX() Ctx C; { unsigned long long kp_ = (unsigned long long)__builtin_amdgcn_kernarg_segment_ptr(); asm volatile("" : "+s"(kp_)); C.p.q = (ParamsK)kp_; } \
    C.ws = C.p->ws; C.lds = lds_raw; { unsigned z_ = 0u; asm volatile("" : "+s"(z_)); int t_ = wv_ * 64 + (int)__builtin_amdgcn_mbcnt_hi(~0u, __builtin_amdgcn_mbcnt_lo(~0u, z_)), g_ = gridDim.x, b_ = blockIdx.x; asm volatile("" : "+v"(t_), "+s"(g_), "+s"(b_)); C.tid = t_; C.G = g_; C.bid = b_; } \
    C.lane = C.tid & 63; C.wave = __builtin_amdgcn_readfirstlane(C.tid >> 6); C.gw = C.bid * 8 + C.wave; C.nw = C.G * 8;
    const int lo = p.lo, hi = p.hi;
#define IN(k) (lo <= (k) && (k) < hi)
#ifdef PROBE_BAR
#define SEAM(k) do { if (IN((k) + 1)) { xcd_barrier(bar); xcd_barrier(bar); xcd_barrier(bar); } } while (0)
#else
#define SEAM(k) do { if (IN((k) + 1)) xcd_barrier(bar); } while (0)
#endif

    if (PHON(0) && IN(0)) { MKCTX(); p0_prologue(C);
#ifdef PROBE_P0
        __syncthreads(); p0_prologue(C);
#endif
        SEAM(0); }
    if (PHON(1) && IN(1)) { MKCTX(); p1_norm1(C, 0, C.p->x, C.p->ctx);
#ifdef PROBE_P1
        for (int rep = 0; rep < 4 + C.p->pad; ++rep) p1_norm1(C, 0, C.p->x, C.p->ctx);
#endif
        SEAM(1); }
    for (int l = 0; l < 2; ++l) {
        const int pb = 2 + 10 * l;
        const int mrows = (l == 0) ? TA : TL;
        if (PHON(2) && IN(pb + 0)) {
            MKCTX();
            pg8::Gemm g{C.H(), C.WIN_T(), TA, INW, DM}; pg8::StaticOrder S; S.init(TA, INW, C.G, C.bid);
            EpiInProj E{C.GRP(0), C.ROPE(), C.LB() + l * 1024};
            pg8::gemm_phase<EpiInProj, pg8::StaticOrder, true, true>(ldsl, g, S, E, C.tid);
#ifdef PROBE_P2
            __syncthreads(); pg8::gemm_phase<EpiInProj, pg8::StaticOrder, true, true>(ldsl, g, S, E, C.tid);
#endif
            SEAM(pb + 0);
        }
        if (PHON(3) && IN(pb + 1)) {
            MKCTX();
#ifndef NO_SCAN
#ifdef PROBE_SCAN2
            for (int rep = 0; rep < 2 + C.p->pad; ++rep) p3_scan4(C, l);
#else
            p3_scan4(C, l);
#endif
#endif
#ifdef PROBE_ATTN2
            p3_attn(C, l, C.p->pad == 0);
#endif
#ifndef NO_ATTN
            p3_attn2(C, l);
#endif
            SEAM(pb + 1);
        }
        if (PHON(4) && IN(pb + 2)) { MKCTX();
#ifdef PROBE_P3C
            for (int rep = 0; rep < 4 + C.p->pad; ++rep) p3c_headnorm(C, l, C.p->pad == 0);
#endif
            p3c_headnorm(C, l); SEAM(pb + 2); }
        if (PHON(5) && IN(pb + 3)) {
            MKCTX();
            pg8::StaticOrder S; S.init(mrows, DM, C.G, C.bid);
            { pg8::Gemm g{C.GRP(0), C.WNA_T(), mrows, DM, 512}; EpiMerge<0> E{C.MB(), C.GRP(8)}; pg8::gemm_phase<EpiMerge<0>, pg8::StaticOrder, true, true>(ldsl, g, S, E, C.tid); }
#ifdef PROBE_P4A
            __syncthreads();
            { pg8::Gemm g{C.GRP(0), C.WNA_T(), mrows, DM, 512}; EpiMerge<0> E{C.MB(), C.GRP(8)}; pg8::gemm_phase<EpiMerge<0>, pg8::StaticOrder, true, true>(ldsl, g, S, E, C.tid); }
#endif
            __syncthreads();
            { pg8::Gemm g{C.H(), C.WHG_T(), mrows, DM, 512}; EpiMerge<1> E{C.MB(), C.GRP(10)}; pg8::gemm_phase<EpiMerge<1>, pg8::StaticOrder, true, true>(ldsl, g, S, E, C.tid); }
            SEAM(pb + 3);
        }
        if (PHON(6) && IN(pb + 4)) {
            MKCTX();
            pg8::StaticOrder S; S.init(mrows, DM, C.G, C.bid);
            pg8::Gemm g{C.MB(), C.WOUT_T(), mrows, DM, DM};
            EpiOut E{l == 0 ? C.p->x : (const float*)C.p->out, C.p->out, C.p->ctx, C.CTXS(), C.MOD() + (size_t)l * 9 * INW, 0};
#ifdef PROBE_P4B
            { EpiOut E2 = E; E2.dry = 1 - C.p->pad; pg8::gemm_phase<EpiOut, pg8::StaticOrder, true, true>(ldsl, g, S, E2, C.tid); __syncthreads(); }
#endif
            pg8::gemm_phase<EpiOut, pg8::StaticOrder, true, true>(ldsl, g, S, E, C.tid);
            conv_experts(C, l);
#ifdef PROBE_CE
            conv_experts(C, l);
#endif
            SEAM(pb + 4);
        }
        if (PHON(7) && IN(pb + 5)) { MKCTX();
#ifdef PROBE_P5
            for (int rep = 0; rep < 4 + C.p->pad; ++rep) p5_norm2_router(C, l, C.p->pad == 0);
#endif
            p5_norm2_router(C, l); SEAM(pb + 5); }
        if (PHON(8) && IN(pb + 6)) { MKCTX();
#ifdef PROBE_P6
            for (int rep = 0; rep < 4 + C.p->pad; ++rep) p6_permute(C, l, C.p->pad == 0);
#endif
            p6_permute(C, l); SEAM(pb + 6); }
        if (PHON(9) && IN(pb + 7)) {
            MKCTX();
            moe_table(C, l);
            MoeOrder S{C.TAB(), C.G, C.bid};
            pg8::Gemm g{C.XS(), C.WEGU(), SLOT_ROWS, 16384, DM}; EpiGateUp E{C.ACT()};
            pg8::gemm_phase<EpiGateUp, MoeOrder, true, true>(ldsl, g, S, E, C.tid);
#ifdef PROBE_P7
            __syncthreads(); pg8::gemm_phase<EpiGateUp, MoeOrder, true, true>(ldsl, g, S, E, C.tid);
#endif
            SEAM(pb + 7);
        }
        if (PHON(10) && IN(pb + 8)) {
            MKCTX();
            moe_table(C, l);
            MoeOrder S{C.TAB(), C.G, C.bid};
            pg8::Gemm g{C.ACT(), C.WED(), SLOT_ROWS, 16384, 512}; EpiDown E{C.XS()};
            pg8::gemm_phase<EpiDown, MoeOrder, true, true>(ldsl, g, S, E, C.tid);
#ifdef PROBE_P8
            __syncthreads(); pg8::gemm_phase<EpiDown, MoeOrder, true, true>(ldsl, g, S, E, C.tid);
#endif
            SEAM(pb + 8);
        }
        if (PHON(11) && IN(pb + 9)) { MKCTX();
#ifdef PROBE_P9
            for (int rep = 0; rep < 4 + C.p->pad; ++rep) p9_combine(C, l, C.p->pad == 0);
#endif
            p9_combine(C, l); if (l == 0) conv_mixer(C, 1); SEAM(pb + 9); }
    }
#undef IN
#undef SEAM
}

#ifndef MK_SPLIT
#define MK_SPLIT 0
#endif
extern "C" void kernel_launch(void* const* d_in, const int* in_sizes, int n_in, void* d_out, int out_size, void* d_ws, size_t ws_size, hipStream_t stream) {
    static int grid = 0;
    if (grid == 0) {
        if (n_in != 22 || ws_size < WS_END) { fprintf(stderr, "kernel_launch: unexpected n_in %d / ws_size %zu (need %zu)\n", n_in, ws_size, (size_t)WS_END); grid = -1; return; }
        int dev = 0, cus = 0, per_cu = 0;
        if (hipGetDevice(&dev) != hipSuccess || hipDeviceGetAttribute(&cus, hipDeviceAttributeMultiprocessorCount, dev) != hipSuccess) { grid = -1; return; }
        if (hipFuncSetAttribute((const void*)mk_fwd, hipFuncAttributeMaxDynamicSharedMemorySize, LDS_BYTES) != hipSuccess) { fprintf(stderr, "kernel_launch: hipFuncSetAttribute failed\n"); grid = -1; return; }
        if (hipOccupancyMaxActiveBlocksPerMultiprocessor(&per_cu, (const void*)mk_fwd, 512, LDS_BYTES) != hipSuccess || per_cu < 1) fprintf(stderr, "kernel_launch: occupancy query says %d\n", per_cu);
        (void)hipGetLastError();
        grid = cus;
    }
    if (grid < 0) return;
    if (hipMemsetAsync((char*)d_ws + WS_CTL, 0, CTL_BYTES, stream) != hipSuccess) return;
    Params p{};
    const float** pp = (const float**)&p;
    for (int i = 0; i < 22; ++i) pp[i] = (const float*)d_in[i];
    p.out = (float*)d_out; p.ws = (unsigned char*)d_ws; p.pad = 0;
#if MK_SPLIT
    for (int k = 0; k < NPH; ++k) { p.lo = k; p.hi = k + 1; p.li = k; hipLaunchKernelGGL(mk_fwd, dim3(grid), dim3(512), LDS_BYTES, stream, p); }
#else
    p.lo = 0; p.hi = NPH; p.li = 0;
    hipLaunchKernelGGL(mk_fwd, dim3(grid), dim3(512), LDS_BYTES, stream, p);
#endif
}
```

```cpp
#include <hip/hip_runtime.h>
#include <cstdio>
#include <cstdint>
namespace pg8 {
#define PG8_LAS __attribute__((address_space(3)))
typedef unsigned short bf16_t;
typedef short bf16x8 __attribute__((ext_vector_type(8)));
typedef float f32x4 __attribute__((ext_vector_type(4)));
typedef unsigned u32x4 __attribute__((ext_vector_type(4)));
constexpr int BM = 256, BK = 64, HALF = 128, HTB = HALF * BK * 2  , STAGE_BYTES = 8 * HTB, NXCD = 8, WGM = 8;

__host__ __device__ __forceinline__ int lds_byte(int r, int c) { const int st = (r >> 4) * 2 + (c >> 5), rr = r & 15, cc = c & 31, ob = rr * 64 + cc * 2; return st * 1024 + (ob ^ (((ob >> 9) & 1) << 5)); }
__host__ __device__ __forceinline__ void stage_rc(int b, int& R, int& C) { const int st = b / 1024, sb = b % 1024, swz = sb ^ (((sb >> 9) & 1) << 5); R = (st >> 1) * 16 + swz / 64; C = (st & 1) * 32 + (swz % 64) / 2; }
__host__ __device__ __forceinline__ int perm32(int rho) { const int n = rho >> 4, i = rho & 15; return 8 * (i >> 2) + 4 * n + (i & 3); }

struct Unit { int pm, pn; };
struct Gemm { const bf16_t* A; const bf16_t* Bt; int M, N, K; };

struct StaticOrder {
    static constexpr bool GATHER = false;
    int nM, nN, nwg, G, c;
    __host__ __device__ void init(int M, int N, int G_, int c_) { nM = M / BM; nN = N / BM; nwg = nM * nN; G = G_; c = c_; }
    __host__ __device__ bool next(int i, Unit& u) const {
        const long L = (long)i * G + c; if (L >= nwg) return false;
        int wgid = (int)L; { const int q = nwg / NXCD, r = nwg % NXCD, xcd = wgid % NXCD, off = wgid / NXCD; wgid = (xcd < r ? xcd * (q + 1) : r * (q + 1) + (xcd - r) * q) + off; }
        const int nig = WGM * nN, gid = wgid / nig, fm = gid * WGM, gsz = (nM - fm) < WGM ? (nM - fm) : WGM;
        u.pm = fm + ((wgid % nig) % gsz); u.pn = (wgid % nig) / gsz; return true;
    }
    __device__ __forceinline__ void a_ready(const Unit&) const {}
    __device__ __forceinline__ void done(const Unit&) const {}
};

typedef float f32x2_t __attribute__((ext_vector_type(2))); typedef __bf16 bf16x2_t __attribute__((ext_vector_type(2)));
__device__ __forceinline__ unsigned cvt_pk_bf16(float lo, float hi) { f32x2_t v = {lo, hi}; bf16x2_t b = __builtin_convertvector(v, bf16x2_t); return __builtin_bit_cast(unsigned, b); }
template <int NR> __device__ __forceinline__ void wait_vm_sel(int flag) { asm volatile("s_cmp_lg_u32 %0, 0\n\ts_cbranch_scc1 1f\n\ts_waitcnt vmcnt(8)\n\ts_branch 2f\n1:\n\ts_waitcnt vmcnt(%1)\n2:" :: "s"(flag), "n"(NR) : "memory", "scc"); }
template <class Epi, class Sched, bool ALIGN_EPI = false, bool SP2 = false>
__device__ __forceinline__ void gemm_phase(PG8_LAS unsigned char* lds, const Gemm g, const Sched& S, const Epi& E, int tid_in) {
    int tid_ = tid_in; asm volatile("" : "+v"(tid_));
    const int tid = tid_, wid = __builtin_amdgcn_readfirstlane(tid >> 6), lane = tid & 63, wr = wid >> 2, wc = wid & 3, fr = lane & 15, fq = lane >> 4;
    const int K = g.K, nt = K / BK;
    unsigned voffA[2], voffB[2];
#pragma unroll
    for (int i = 0; i < 2; ++i) { int R, C; stage_rc(tid * 16 + i * 8192, R, C); const int Rb = Epi::PERM ? ((R & ~31) + perm32(R & 31)) : R;
        voffA[i] = (unsigned)(R * K + C) * 2u; voffB[i] = (unsigned)(Rb * K + C) * 2u; }
    constexpr bool GATHER = Sched::GATHER;
    static_assert(!GATHER || SP2, "row gather is wired into the SP2 loop only");
    unsigned gA0[2] = {0u, 0u}, gA1[2] = {0u, 0u}, nG[4] = {0u, 0u, 0u, 0u}; int gR0 = 0; unsigned gC2 = 0u;
    if constexpr (GATHER) { int R, C; stage_rc(tid * 16, R, C); gR0 = R; gC2 = (unsigned)C * 2u; }
#define PG8_VA0 (GATHER ? gA0 : voffA)
#define PG8_VA1 (GATHER ? gA1 : voffA)
    const size_t kstep = (size_t)(BK * 2);
    const size_t hstep = (size_t)HALF * K * 2;
    const size_t hA = GATHER ? 0 : hstep;
    const size_t tstep = 2 * hstep;
    const unsigned ldsw = (unsigned)wid * 1024u;
    const int aoff = lds_byte(wr * 64 + fr, fq * 8), boff = lds_byte(wc * 32 + fr, fq * 8);
#define PG8_SA(b, h) (((b) * 2 + (h)) * HTB)
#define PG8_SB(b, h) ((4 + (b) * 2 + (h)) * HTB)
#define PG8_STAGE(bufoff, gbase, voff) do { _Pragma("unroll") for (int _i = 0; _i < 2; ++_i) \
        __builtin_amdgcn_global_load_lds((const unsigned*)((const char*)(gbase) + (voff)[_i]), (PG8_LAS unsigned*)(lds + (bufoff) + ldsw + _i * 8192), 16, 0, 0); } while (0)
#define PG8_LDA(dst, b, h) do { _Pragma("unroll") for (int m = 0; m < 4; ++m) _Pragma("unroll") for (int k = 0; k < 2; ++k) dst[m][k] = *(const PG8_LAS bf16x8*)(lds + PG8_SA(b, h) + aoff + m * 2048 + k * 1024); } while (0)
#define PG8_LDB(dst, b, h) do { _Pragma("unroll") for (int n = 0; n < 2; ++n) _Pragma("unroll") for (int k = 0; k < 2; ++k) dst[n][k] = *(const PG8_LAS bf16x8*)(lds + PG8_SB(b, h) + boff + n * 2048 + k * 1024); } while (0)
#define PG8_MMA(ai, bj, At, Bt) do { __builtin_amdgcn_s_setprio(1); _Pragma("unroll") for (int m = 0; m < 4; ++m) _Pragma("unroll") for (int n = 0; n < 2; ++n) _Pragma("unroll") for (int k = 0; k < 2; ++k) \
        acc[ai][bj][m][n] = __builtin_amdgcn_mfma_f32_16x16x32_bf16(Bt[n][k], At[m][k], acc[ai][bj][m][n], 0, 0, 0); __builtin_amdgcn_s_setprio(0); } while (0)
#define PG8_WAIT_V(n) asm volatile("s_waitcnt vmcnt(" #n ")" ::: "memory")
#define PG8_WAIT_L(n) asm volatile("s_waitcnt lgkmcnt(" #n ")" ::: "memory")
#define PG8_BAR __builtin_amdgcn_s_barrier()
#define PG8_SCHED __builtin_amdgcn_sched_barrier(0)
    Unit cur, nxt; int ui = 0; bool relax = false;
    if (!S.next(0, cur)) return;
    f32x4 acc[2][2][4][2];
#pragma unroll
    for (int a = 0; a < 2; ++a)
#pragma unroll
        for (int b = 0; b < 2; ++b)
#pragma unroll
            for (int m = 0; m < 4; ++m)
#pragma unroll
                for (int n = 0; n < 2; ++n) acc[a][b][m][n] = (f32x4){0.f, 0.f, 0.f, 0.f};
    bf16x8 At[4][2], B0[2][2], B1[2][2];
    const char* cA = (const char*)g.A + (GATHER ? (size_t)0 : (size_t)cur.pm * tstep); const char* cB = (const char*)g.Bt + (size_t)cur.pn * tstep;
    if constexpr (GATHER) { int ix[4]; S.gather4(cur, gR0, ix); const unsigned rb = (unsigned)K * 2u; gA0[0] = (unsigned)ix[0] * rb + gC2; gA0[1] = (unsigned)ix[1] * rb + gC2; gA1[0] = (unsigned)ix[2] * rb + gC2; gA1[1] = (unsigned)ix[3] * rb + gC2; }
    S.a_ready(cur);
    if constexpr (SP2) {
        PG8_STAGE(PG8_SB(0, 0), cB, voffB); PG8_STAGE(PG8_SB(0, 1), cB + hstep, voffB); PG8_STAGE(PG8_SA(0, 0), cA, PG8_VA0); PG8_STAGE(PG8_SA(0, 1), cA + hA, PG8_VA1);
        if (wr == 1) PG8_BAR;
        PG8_WAIT_V(2); PG8_BAR;
        PG8_STAGE(PG8_SB(1, 0), cB + kstep, voffB); PG8_STAGE(PG8_SA(1, 0), cA + kstep, PG8_VA0); PG8_STAGE(PG8_SB(1, 1), cB + hstep + kstep, voffB);
        PG8_WAIT_V(6); PG8_BAR;
    } else {
        PG8_STAGE(PG8_SB(0, 0), cB, voffB); PG8_STAGE(PG8_SA(0, 0), cA, voffA); PG8_STAGE(PG8_SB(0, 1), cB + hstep, voffB); PG8_STAGE(PG8_SA(0, 1), cA + hstep, voffA);
        if (wr == 1) PG8_BAR;
        PG8_WAIT_V(4); PG8_BAR;
        PG8_STAGE(PG8_SB(1, 0), cB + kstep, voffB); PG8_STAGE(PG8_SA(1, 0), cA + kstep, voffA); PG8_STAGE(PG8_SB(1, 1), cB + hstep + kstep, voffB);
        PG8_WAIT_V(6); PG8_BAR;
    }
    for (;;) {
        const bool has_next = S.next(ui + 1, nxt);
        const char* nA = has_next ? (const char*)g.A + (GATHER ? (size_t)0 : (size_t)nxt.pm * tstep) : cA; const char* nB = has_next ? (const char*)g.Bt + (size_t)nxt.pn * tstep : cB;
        if constexpr (GATHER) { if (has_next) { int ix[4]; S.gather4(nxt, gR0, ix); const unsigned rb = (unsigned)K * 2u; nG[0] = (unsigned)ix[0] * rb; nG[1] = (unsigned)ix[1] * rb; nG[2] = (unsigned)ix[2] * rb; nG[3] = (unsigned)ix[3] * rb; } }
        for (int t = 0; t < nt; t += 2) {
            const bool last = (t == nt - 2);
            const char* a1 = cA + (size_t)(t + 1) * kstep;
            const char* a2 = last ? nA : cA + (size_t)(t + 2) * kstep; const char* b2 = last ? nB : cB + (size_t)(t + 2) * kstep;
            const char* a3 = a2 + kstep; const char* b3 = b2 + kstep;
            if (last && has_next) S.a_ready(nxt);
            if constexpr (SP2) {
            PG8_LDB(B0, 0, 0); PG8_LDB(B1, 0, 1); PG8_SCHED; PG8_LDA(At, 0, 0);
            if constexpr (GATHER) { if (last && has_next) { gA0[0] = nG[0] + gC2; gA0[1] = nG[1] + gC2; } }
            PG8_STAGE(PG8_SA(1, 1), a1 + hA, PG8_VA1);
            if constexpr (GATHER) { if (last && has_next) { gA1[0] = nG[2] + gC2; gA1[1] = nG[3] + gC2; } }
            if constexpr (Epi::NST > 0) wait_vm_sel<8 + Epi::NST>(__builtin_amdgcn_readfirstlane((relax && t == 0) ? 1 : 0)); else PG8_WAIT_V(8);
            PG8_WAIT_L(0); PG8_BAR; PG8_MMA(0, 0, At, B0); PG8_MMA(0, 1, At, B1); PG8_BAR; PG8_SCHED;
            PG8_LDA(At, 0, 1); PG8_STAGE(PG8_SB(0, 0), b2, voffB); PG8_STAGE(PG8_SB(0, 1), b2 + hstep, voffB); PG8_STAGE(PG8_SA(0, 0), a2, PG8_VA0);
            if constexpr (Epi::NST > 0) wait_vm_sel<8 + Epi::NST>(__builtin_amdgcn_readfirstlane((relax && t == 0) ? 1 : 0)); else PG8_WAIT_V(8);
            PG8_WAIT_L(0); PG8_BAR; PG8_MMA(1, 0, At, B0); PG8_MMA(1, 1, At, B1); PG8_BAR; PG8_SCHED;
            PG8_LDB(B0, 1, 0); PG8_LDB(B1, 1, 1); PG8_SCHED; PG8_LDA(At, 1, 0); PG8_STAGE(PG8_SA(0, 1), a2 + hA, PG8_VA1);
            PG8_WAIT_V(8); PG8_WAIT_L(0); PG8_BAR; PG8_MMA(0, 0, At, B0); PG8_MMA(0, 1, At, B1); PG8_BAR; PG8_SCHED;
            PG8_LDA(At, 1, 1); PG8_STAGE(PG8_SB(1, 0), b3, voffB); PG8_STAGE(PG8_SB(1, 1), b3 + hstep, voffB); PG8_STAGE(PG8_SA(1, 0), a3, PG8_VA0);
            PG8_WAIT_V(8); PG8_WAIT_L(0); PG8_BAR; PG8_MMA(1, 0, At, B0); PG8_MMA(1, 1, At, B1); PG8_BAR; PG8_SCHED;
            } else {
            PG8_LDB(B0, 0, 0); PG8_SCHED; PG8_LDA(At, 0, 0); PG8_STAGE(PG8_SA(1, 1), a1 + hstep, voffA);
            PG8_WAIT_L(8); PG8_BAR; PG8_WAIT_L(0); PG8_MMA(0, 0, At, B0); PG8_BAR; PG8_SCHED;
            PG8_LDB(B1, 0, 1); PG8_STAGE(PG8_SB(0, 0), b2, voffB);
            PG8_BAR; PG8_WAIT_L(0); PG8_MMA(0, 1, At, B1); PG8_BAR;
            PG8_LDA(At, 0, 1); PG8_STAGE(PG8_SA(0, 0), a2, voffA);
            PG8_BAR; PG8_WAIT_L(0); PG8_MMA(1, 0, At, B0); PG8_BAR; PG8_SCHED;
            PG8_STAGE(PG8_SB(0, 1), b2 + hstep, voffB);
            PG8_WAIT_V(6); PG8_BAR; PG8_MMA(1, 1, At, B1); PG8_BAR;
            PG8_LDB(B0, 1, 0); PG8_SCHED; PG8_LDA(At, 1, 0); PG8_STAGE(PG8_SA(0, 1), a2 + hstep, voffA);
            PG8_WAIT_L(8); PG8_BAR; PG8_WAIT_L(0); PG8_MMA(0, 0, At, B0); PG8_BAR; PG8_SCHED;
            PG8_LDB(B1, 1, 1); PG8_STAGE(PG8_SB(1, 0), b3, voffB);
            PG8_BAR; PG8_WAIT_L(0); PG8_MMA(0, 1, At, B1); PG8_BAR;
            PG8_LDA(At, 1, 1); PG8_STAGE(PG8_SA(1, 0), a3, voffA);
            PG8_BAR; PG8_WAIT_L(0); PG8_MMA(1, 0, At, B0); PG8_BAR; PG8_SCHED;
            PG8_STAGE(PG8_SB(1, 1), b3 + hstep, voffB);
            PG8_WAIT_V(6); PG8_BAR; PG8_MMA(1, 1, At, B1); PG8_BAR;
            }
        }
        if constexpr (ALIGN_EPI) { if (wr == 0) PG8_BAR; }
        if constexpr (!Epi::AFTER_DRAIN) { E(acc, cur, wr, wc, fr, fq); S.done(cur); }
        if (!has_next) break;
#pragma unroll
        for (int a = 0; a < 2; ++a)
#pragma unroll
            for (int b = 0; b < 2; ++b)
#pragma unroll
                for (int m = 0; m < 4; ++m)
#pragma unroll
                    for (int n = 0; n < 2; ++n) acc[a][b][m][n] = (f32x4){0.f, 0.f, 0.f, 0.f};
        cur = nxt; cA = nA; cB = nB; ++ui; relax = true;
        if constexpr (ALIGN_EPI) { if (wr == 1) PG8_BAR; }
    }
    PG8_WAIT_V(0);
    if constexpr (!ALIGN_EPI) { if (wr == 0) PG8_BAR; }
    PG8_BAR;
    if constexpr (Epi::AFTER_DRAIN) { E.fused(acc, cur, wr, wc, fr, fq, lds, wid, lane); S.done(cur); }
#undef PG8_VA0
#undef PG8_VA1
#undef PG8_SA
#undef PG8_SB
#undef PG8_STAGE
#undef PG8_LDA
#undef PG8_LDB
#undef PG8_MMA
#undef PG8_WAIT_V
#undef PG8_WAIT_L
#undef PG8_BAR
#undef PG8_SCHED
}
}
#define XB_TMO      128
#define XB_XCNT(j)  (256  + 64 * (j))
#define XB_XSUB(j)  (1280 + 64 * (j))
#define XB_XGEN(j)  (2304 + 64 * (j))
#define XB_TOP      3328
#define XB_TOPGEN   3392
#define XCD_BAR_WORDS 3456
#define XB_SPIN_CAP (1u << 18)
#define LAS __attribute__((address_space(3)))

__device__ __forceinline__ unsigned xb_ld(unsigned* p)              { return __hip_atomic_load(p, __ATOMIC_RELAXED, __HIP_MEMORY_SCOPE_AGENT); }
__device__ __forceinline__ unsigned xb_add(unsigned* p, unsigned v) { return __hip_atomic_fetch_add(p, v, __ATOMIC_RELAXED, __HIP_MEMORY_SCOPE_AGENT); }
__device__ __forceinline__ unsigned xb_xcc_id() { return (unsigned)__builtin_amdgcn_s_getreg((3 << 11) | 20) & 0xFu; }
#define XB_SPIN(cond, bar) do { unsigned _sp = 0; while (cond) { __builtin_amdgcn_s_sleep(1); \
    if ((++_sp & 255u) == 0u) { if (xb_ld(&(bar)[XB_TMO])) break; if (_sp > XB_SPIN_CAP) { atomicAdd(&(bar)[XB_TMO], 1u); break; } } } } while (0)

struct XcdBarrier {
    unsigned* bar; unsigned x; unsigned lead;
    volatile LAS unsigned* st;
};

__device__ __forceinline__ bool xb_t0(unsigned lead) { unsigned z = 0u; asm volatile("" : "+s"(z)); return lead != 0u && __builtin_amdgcn_mbcnt_hi(~0u, __builtin_amdgcn_mbcnt_lo(~0u, z)) == 0u; }
__device__ __forceinline__ XcdBarrier xcd_barrier_post(unsigned* bar, volatile LAS unsigned* st, unsigned lead) {
    XcdBarrier b; b.bar = bar; b.x = xb_xcc_id(); b.st = st; b.lead = lead;
    if (xb_t0(lead)) (void)xb_add(&bar[XB_XCNT(b.x)], 1u);
    return b;
}
__device__ __forceinline__ void xcd_barrier_complete(unsigned* bar, unsigned x, unsigned& nloc, unsigned& nx) {
    const unsigned G = gridDim.x * gridDim.y * gridDim.z;
    unsigned sum, cnt, mine, sp = 0u;
    for (;;) {
        sum = 0u; cnt = 0u; mine = 0u;
#pragma unroll
        for (unsigned j = 0; j < 16; ++j) { const unsigned c = xb_ld(&bar[XB_XCNT(j)]); sum += c; cnt += (c > 0u) ? 1u : 0u; mine = (j == x) ? c : mine; }
        if (sum == G) break;
        __builtin_amdgcn_s_sleep(1);
        if ((++sp & 255u) == 0u) { if (xb_ld(&bar[XB_TMO])) break; if (sp > XB_SPIN_CAP) { atomicAdd(&bar[XB_TMO], 1u); break; } }
    }
    nloc = mine > 0u ? mine : 1u; nx = cnt > 0u ? cnt : 1u;
}

__device__ __forceinline__ void xcd_barrier(const XcdBarrier& b) {
    asm volatile("s_waitcnt vmcnt(0)" ::: "memory");
    __syncthreads();
    if (xb_t0(b.lead)) {
        unsigned* bar = b.bar;
        __builtin_amdgcn_s_waitcnt(0);
        unsigned nloc = b.st[0], nx = b.st[1];
        if (nloc == 0u) { xcd_barrier_complete(bar, b.x, nloc, nx); b.st[0] = nloc; b.st[1] = nx; }
        const unsigned old = xb_add(&bar[XB_XSUB(b.x)], 1u);
        const unsigned gen = old / nloc;
        if (old + 1u == (gen + 1u) * nloc) {
            __builtin_amdgcn_fence(__ATOMIC_RELEASE, "agent");
            asm volatile("s_waitcnt vmcnt(0)" ::: "memory");
            const unsigned og = xb_add(&bar[XB_TOP], 1u);
            const unsigned tg = og / nx;
            if (og + 1u == (tg + 1u) * nx) xb_add(&bar[XB_TOPGEN], 1u);
            else XB_SPIN(xb_ld(&bar[XB_TOPGEN]) == tg, bar);
            __builtin_amdgcn_fence(__ATOMIC_ACQUIRE, "agent");
            xb_add(&bar[XB_XGEN(b.x)], 1u);
            asm volatile("s_waitcnt vmcnt(0)" ::: "memory");
        } else {
            XB_SPIN(xb_ld(&bar[XB_XGEN(b.x)]) == gen, bar);
            __builtin_amdgcn_fence(__ATOMIC_ACQUIRE, "agent");
            asm volatile("s_waitcnt vmcnt(0)" ::: "memory");
        }
    }
    __syncthreads();
}


#ifdef USE_RELAX
#define RELAX_NST(n) (n)
#else
#define RELAX_NST(n) 0
#endif
typedef unsigned short bf16;
typedef pg8::f32x4 f32x4;
typedef pg8::u32x4 u32x4;
constexpr int NB = 8, SEQ = 4096, DM = 1024, NCTX = 256;
constexpr int TL = NB * SEQ, TC = NB * NCTX, TA = TL + TC;
constexpr int INW = 6144, GW = 512, NGRP = 12;
constexpr size_t GSTRIDE = (size_t)TA * GW;
constexpr float EPS = 1e-6f;
constexpr int SLOT_ROWS = 73728;

constexpr size_t MiB = (size_t)1 << 20;
constexpr size_t WS_CTL = 0, CTL_BYTES = 1 * MiB;
constexpr size_t WS_MOD = 1 * MiB;
constexpr size_t WS_LB = 1 * MiB + 512 * 1024;
constexpr size_t WS_ROPE = 2 * MiB;
constexpr size_t WS_TOK = 3 * MiB;
constexpr size_t WS_CTXS = 4 * MiB;
constexpr size_t WS_WB = 12 * MiB;
constexpr size_t WS_H = 28 * MiB;
constexpr size_t WS_P = 96 * MiB;
constexpr size_t P_M = 34 * MiB, P_WEGU = 102 * MiB, P_WED = 134 * MiB, P_XS = 150 * MiB, P_ACT = 294 * MiB;
constexpr size_t WS_S2T = 504 * MiB;
constexpr size_t WS_END = 507 * MiB;
constexpr int S2T_CAP = 36864;
constexpr int CW_BAR = 4096, CW_CNT = 131072;

constexpr int LDS_STAGE = 163328, LDS_BYTES = 163840;
constexpr int LDSW_BAR = 0, LDSW_TAB = 64;

struct Params {
    const float* x; const float* c; const float* ctx; const float* c_ctx; const float* w_ada; const float* b_ada; const float* norm1_g; const float* w_in;
    const float* rel_bias; const float* lowf; const float* lowb; const float* hg_norm_g; const float* w_na_o; const float* w_hg_o; const float* w_out; const float* norm2_g;
    const float* w_router; const float* router_bias; const float* w_gate; const float* w_up; const float* w_down; const float* final_g;
    float* out; unsigned char* ws; int lo, hi, li, pad;
};

__device__ __forceinline__ float bf2f(unsigned b) { return __uint_as_float(b << 16); }
__device__ __forceinline__ float bflo(unsigned w) { return __uint_as_float(w << 16); }
__device__ __forceinline__ float bfhi(unsigned w) { return __uint_as_float(w & 0xffff0000u); }
__device__ __forceinline__ unsigned f2bf(float f) { unsigned u = __float_as_uint(f); u += 0x7FFFu + ((u >> 16) & 1u); return u >> 16; }
__device__ __forceinline__ unsigned pk2(float lo, float hi) { return f2bf(lo) | (f2bf(hi) << 16); }
__device__ __forceinline__ float sigm(float x) { return __builtin_amdgcn_rcpf(1.f + __expf(-x)); }
__device__ __forceinline__ float silu(float x) { return x * __builtin_amdgcn_rcpf(1.f + __expf(-x)); }
__device__ __forceinline__ float wave_sum(float v) {
#pragma unroll
    for (int o = 32; o >= 1; o >>= 1) v += __shfl_xor(v, o);
    return v; }
__device__ __forceinline__ float wave_max(float v) {
#pragma unroll
    for (int o = 32; o >= 1; o >>= 1) v = fmaxf(v, __shfl_xor(v, o));
    return v; }
__device__ __forceinline__ void unpack8(const uint4 w, float (&f)[8]) {
    f[0] = bflo(w.x); f[1] = bfhi(w.x); f[2] = bflo(w.y); f[3] = bfhi(w.y); f[4] = bflo(w.z); f[5] = bfhi(w.z); f[6] = bflo(w.w); f[7] = bfhi(w.w); }

typedef const __attribute__((address_space(4))) Params* ParamsK;
struct PView { ParamsK q; __device__ __forceinline__ const __attribute__((address_space(4))) Params* operator->() const { return q; } };
struct Ctx {
    PView p; unsigned char* ws; unsigned char* lds; int tid, lane, wave, G, bid, gw, nw, rep;
    __device__ __forceinline__ float* MOD() const { return (float*)(ws + WS_MOD); }
    __device__ __forceinline__ float* LB() const { return (float*)(ws + WS_LB); }
    __device__ __forceinline__ float2* ROPE() const { return (float2*)(ws + WS_ROPE); }
    __device__ __forceinline__ int* TOKE() const { return (int*)(ws + WS_TOK); }
    __device__ __forceinline__ float* TOKW() const { return (float*)(ws + WS_TOK) + 2 * TA; }
    __device__ __forceinline__ int* TOKS() const { return (int*)(ws + WS_TOK) + 4 * TA; }
    __device__ __forceinline__ float* CTXS() const { return (float*)(ws + WS_CTXS); }
    __device__ __forceinline__ bf16* WIN_T() const { return (bf16*)(ws + WS_WB); }
    __device__ __forceinline__ bf16* WNA_T() const { return (bf16*)(ws + WS_WB + 12 * MiB); }
    __device__ __forceinline__ bf16* WHG_T() const { return (bf16*)(ws + WS_WB + 13 * MiB); }
    __device__ __forceinline__ bf16* WOUT_T() const { return (bf16*)(ws + WS_WB + 14 * MiB); }
    __device__ __forceinline__ bf16* H() const { return (bf16*)p->out; }
    __device__ __forceinline__ bf16* XB() const { return (bf16*)(ws + WS_H); }
    __device__ __forceinline__ bf16* GRP(int g) const { return (bf16*)(ws + WS_P) + (size_t)g * GSTRIDE; }
    __device__ __forceinline__ bf16* MB() const { return (bf16*)(ws + WS_P + P_M); }
    __device__ __forceinline__ bf16* WEGU(int l) const { return l == 0 ? (bf16*)(ws + WS_P + P_WEGU) : (bf16*)((unsigned char*)p->out + 68 * MiB); }
    __device__ __forceinline__ bf16* WED(int l) const { return l == 0 ? (bf16*)(ws + WS_P + P_WED) : (bf16*)((unsigned char*)p->out + 100 * MiB); }
    __device__ __forceinline__ bf16* XS() const { return (bf16*)(ws + WS_P + P_XS); }
    __device__ __forceinline__ bf16* ACT() const { return (bf16*)(ws + WS_P + P_ACT); }
    __device__ __forceinline__ int* S2T() const { return (int*)(ws + WS_S2T); }
    __device__ __forceinline__ unsigned* CTL() const { return (unsigned*)(ws + WS_CTL); }
    __device__ __forceinline__ unsigned* CNT(int l) const { return (unsigned*)(ws + WS_CTL) + CW_CNT + l * 64 + rep * 2048; }
    __device__ __forceinline__ int* TAB() const { return (int*)(lds + LDS_STAGE) + LDSW_TAB; }
};

template <class RowMap>
__device__ __forceinline__ void tconv_tile(const float* __restrict__ src, int ldsrc, int k0, int n0, bf16* __restrict__ dst, int ldd, int lane, RowMap rm) {
    float v[64];
    const float* s = src + (size_t)k0 * ldsrc + n0 + lane;
#pragma unroll
    for (int k = 0; k < 64; ++k) { v[k] = *s; s += ldsrc; asm volatile("" : "+v"(s)); }
    bf16* d = dst + (size_t)rm(n0 + lane) * ldd + k0;
#pragma unroll
    for (int j = 0; j < 8; ++j) { uint4 w; w.x = pk2(v[8 * j], v[8 * j + 1]); w.y = pk2(v[8 * j + 2], v[8 * j + 3]); w.z = pk2(v[8 * j + 4], v[8 * j + 5]); w.w = pk2(v[8 * j + 6], v[8 * j + 7]);
        *(uint4*)(d + 8 * j) = w; }
}
struct RmId { __device__ __forceinline__ int operator()(int n) const { return n; } };
struct RmGU { int base; __device__ __forceinline__ int operator()(int n) const { return base + (n >> 7) * 256 + (n & 127); } };

__device__ __forceinline__ void conv_mixer(const Ctx& C, int l, int fb = 0) {
    if (C.bid < fb) return;
    for (int id = (C.bid - fb) * 8 + C.wave; id < 2048; id += (C.G - fb) * 8) {
        if (id < 1536) { const int nt = id % 96, kt = id / 96; tconv_tile(C.p->w_in + (size_t)l * DM * INW, INW, kt * 64, nt * 64, C.WIN_T(), DM, C.lane, RmId()); }
        else if (id < 1664) { const int j = id - 1536, nt = j & 15, kt = j >> 4; tconv_tile(C.p->w_na_o + (size_t)l * 512 * DM, DM, kt * 64, nt * 64, C.WNA_T(), 512, C.lane, RmId()); }
        else if (id < 1792) { const int j = id - 1664, nt = j & 15, kt = j >> 4; tconv_tile(C.p->w_hg_o + (size_t)l * 512 * DM, DM, kt * 64, nt * 64, C.WHG_T(), 512, C.lane, RmId()); }
        else { const int j = id - 1792, nt = j & 15, kt = j >> 4; tconv_tile(C.p->w_out + (size_t)l * DM * DM, DM, kt * 64, nt * 64, C.WOUT_T(), DM, C.lane, RmId()); }
    }
}
__device__ __forceinline__ void conv_experts(const Ctx& C, int l, int fb) {
    if (C.bid < fb) return;
    for (int id = (C.bid - fb) * 8 + C.wave; id < 6144; id += (C.G - fb) * 8) {
        const int e = id / 384, j = id % 384;
        if (j < 128) { const int nt = j & 7, kt = j >> 3; tconv_tile(C.p->w_gate + ((size_t)l * 16 + e) * DM * 512, 512, kt * 64, nt * 64, C.WEGU(l), DM, C.lane, RmGU{e * 1024}); }
        else if (j < 256) { const int jj = j - 128, nt = jj & 7, kt = jj >> 3; tconv_tile(C.p->w_up + ((size_t)l * 16 + e) * DM * 512, 512, kt * 64, nt * 64, C.WEGU(l), DM, C.lane, RmGU{e * 1024 + 128}); }
        else { const int jj = j - 256, nt = jj & 15, kt = jj >> 4; tconv_tile(C.p->w_down + ((size_t)l * 16 + e) * 512 * DM, DM, kt * 64, nt * 64, C.WED(l) + (size_t)e * 1024 * 512, 512, C.lane, RmId()); }
    }
}

__device__ __forceinline__ void p0_prologue(const Ctx& C) {
    for (int u = C.bid; u < 192; u += C.G) {
        float* sl = (float*)C.lds;
        float* red = (float*)(C.lds + 36864);
        for (int i = C.tid; i < 9 * 1024; i += 512) { const int r = i >> 10, k = i & 1023; const float v = (r < 8) ? C.p->c[r * 1024 + k] : C.p->c_ctx[k]; sl[i] = v / (1.f + expf(-v)); }
        __syncthreads();
        const int l = u / 96, nb = (u % 96) * 64;
        const float* w = C.p->w_ada + (size_t)l * DM * INW + (size_t)(C.wave * 128) * INW + nb + C.lane;
        float acc[9];
#pragma unroll
        for (int r = 0; r < 9; ++r) acc[r] = 0.f;
#pragma unroll 4
        for (int k4 = 0; k4 < 32; ++k4) { const float w0 = w[(size_t)(4 * k4) * INW], w1 = w[(size_t)(4 * k4 + 1) * INW], w2 = w[(size_t)(4 * k4 + 2) * INW], w3 = w[(size_t)(4 * k4 + 3) * INW];
#pragma unroll
            for (int r = 0; r < 9; ++r) { const float4 sv = *(const float4*)(sl + r * 1024 + C.wave * 128 + 4 * k4); float a = acc[r]; a += sv.x * w0; a += sv.y * w1; a += sv.z * w2; a += sv.w * w3; acc[r] = a; } }
#pragma unroll
        for (int r = 0; r < 9; ++r) red[(C.wave * 9 + r) * 64 + C.lane] = acc[r];
        __syncthreads();
        for (int i = C.tid; i < 9 * 64; i += 512) { const int r = i >> 6, cc = i & 63; float a = 0.f;
#pragma unroll
            for (int ww = 0; ww < 8; ++ww) a += red[(ww * 9 + r) * 64 + cc];
            const int n = nb + cc; C.MOD()[(size_t)(l * 9 + r) * INW + n] = a + C.p->b_ada[l * INW + n]; }
        __syncthreads();
    }
    const int gt = C.bid * 512 + C.tid, nthr = C.G * 512;
    for (int i = gt; i < 4096 * 32; i += nthr) { const int t = i >> 5, pr = i & 31; const float pos = (float)((pr < 16) ? (t >> 6) : (t & 63)); const int j = pr & 15;
        const float inv = powf(10000.f, -(float)(2 * j) / 32.f); const float ang = pos * inv; C.ROPE()[i] = make_float2(cosf(ang), sinf(ang)); }
    for (int i = gt; i < 1024; i += nthr) { const int dir = i >> 9, ch = i & 511; const float* raw = dir ? C.p->lowb : C.p->lowf; const float r0 = raw[ch], r1 = raw[512 + ch];
        const float p1 = 1.f / (1.f + expf(r0 - r1)); C.LB()[(0 * 2 + dir) * 512 + ch] = 0.f; C.LB()[(1 * 2 + dir) * 512 + ch] = p1; }
    conv_mixer(C, 0, 0);
}

__device__ __forceinline__ void load_row(const float* xr, int lane, float (&v)[16]) {
#pragma unroll
    for (int j = 0; j < 4; ++j) { const float4 t = *(const float4*)(xr + j * 256 + lane * 4); v[4 * j] = t.x; v[4 * j + 1] = t.y; v[4 * j + 2] = t.z; v[4 * j + 3] = t.w; }
}
__device__ __forceinline__ void load_row_raw(const bf16* xr, int lane, uint2 (&t)[4]) {
#pragma unroll
    for (int j = 0; j < 4; ++j) t[j] = *(const uint2*)(xr + j * 256 + lane * 4);
}
__device__ __forceinline__ void unpack_row(const uint2 (&t)[4], float (&v)[16]) {
#pragma unroll
    for (int j = 0; j < 4; ++j) { v[4 * j] = bflo(t[j].x); v[4 * j + 1] = bfhi(t[j].x); v[4 * j + 2] = bflo(t[j].y); v[4 * j + 3] = bfhi(t[j].y); }
}
__device__ __forceinline__ float row_rinv(const float (&v)[16]) {
    float ss = 0.f;
#pragma unroll
    for (int i = 0; i < 16; ++i) ss += v[i] * v[i];
    ss = wave_sum(ss);
    return rsqrtf(ss * (1.f / 1024.f) + EPS);
}
__device__ __forceinline__ void norm_mod(const float (&v)[16], float rinv, const float* gam, const float* sc, const float* sh, int lane, float (&h)[16]) {
#pragma unroll
    for (int j = 0; j < 4; ++j) { const int c = j * 256 + lane * 4; const float4 g = *(const float4*)(gam + c), s = *(const float4*)(sc + c), b = *(const float4*)(sh + c);
        h[4 * j] = v[4 * j] * rinv * g.x * (1.f + s.x) + b.x; h[4 * j + 1] = v[4 * j + 1] * rinv * g.y * (1.f + s.y) + b.y;
        h[4 * j + 2] = v[4 * j + 2] * rinv * g.z * (1.f + s.z) + b.z; h[4 * j + 3] = v[4 * j + 3] * rinv * g.w * (1.f + s.w) + b.w; }
}
__device__ __forceinline__ void store_row_bf16(bf16* hr, int lane, const float (&h)[16]) {
#pragma unroll
    for (int j = 0; j < 4; ++j) { uint2 w; w.x = pk2(h[4 * j], h[4 * j + 1]); w.y = pk2(h[4 * j + 2], h[4 * j + 3]); *(uint2*)(hr + j * 256 + lane * 4) = w; }
}
__device__ __forceinline__ int modrow_of(int r) { return r < TL ? (r >> 12) : 8; }

__device__ __forceinline__ void p1_norm1(const Ctx& C, int l, const float* xl, const float* xc) {
    float na[16], nb[16];
#define P1_ROWP(r_) ((r_) < TL ? xl + (size_t)(r_) * DM : xc + (size_t)((r_) - TL) * DM)
#define P1_DO(v_, r_) do { const float rinv = row_rinv(v_); const float* mod = LM + modrow_of(r_) * 2048; float h[16]; \
        norm_mod(v_, rinv, LM + 9 * 2048, mod + 1024, mod, C.lane, h); store_row_bf16(C.H() + (size_t)(r_) * DM, C.lane, h); } while (0)
    if (C.gw < TA) load_row(P1_ROWP(C.gw), C.lane, na);
    if (C.gw + C.nw < TA) load_row(P1_ROWP(C.gw + C.nw), C.lane, nb);
    float* LM = (float*)C.lds;
    for (int i = C.tid; i < 9 * 512; i += 512) { const int rw = i >> 9, c4 = (i & 511) * 4; *(float4*)(LM + rw * 2048 + c4) = *(const float4*)(C.MOD() + (size_t)(l * 9 + rw) * INW + c4); }
    if (C.tid < 256) *(float4*)(LM + 9 * 2048 + C.tid * 4) = *(const float4*)(C.p->norm1_g + l * DM + C.tid * 4);
    __syncthreads();
    for (int r = C.gw; r < TA; r += 2 * C.nw) {
        float v[16];
#pragma unroll
        for (int i = 0; i < 16; ++i) v[i] = na[i];
        { const int rn = r + 2 * C.nw; if (rn < TA) load_row(P1_ROWP(rn), C.lane, na); }
        P1_DO(v, r);
        const int r2 = r + C.nw;
        if (r2 < TA) {
#pragma unroll
            for (int i = 0; i < 16; ++i) v[i] = nb[i];
            { const int rn = r2 + 2 * C.nw; if (rn < TA) load_row(P1_ROWP(rn), C.lane, nb); }
            P1_DO(v, r2);
        }
    }
#undef P1_ROWP
#undef P1_DO
}

struct EpiInProj {
    static constexpr bool PERM = true, AFTER_DRAIN = false; static constexpr int NST = RELAX_NST(16);
    bf16* P; const float2* rope; const float* lbl; int dry;
    template <int MODE> __device__ __forceinline__ void tile(const f32x4 (&acc)[2][2][4][2], bf16* base, int row0, int colb, const float* lp) const {
        f32x4 lb0[2], lb1[2];
        if (MODE == 3) {
#pragma unroll
            for (int bj = 0; bj < 2; ++bj) { lb0[bj] = *(const f32x4*)(lp + bj * 128); lb1[bj] = *(const f32x4*)(lp + bj * 128 + 4); } }
        float4 rc[2][4][2];
        if (MODE == 1) {
#pragma unroll
            for (int ai = 0; ai < 2; ++ai)
#pragma unroll
                for (int m = 0; m < 4; ++m) { const float4* rp = (const float4*)(rope + (size_t)((row0 + ai * 128 + m * 16) & 4095) * 32 + ((colb & 63) >> 1)); rc[ai][m][0] = rp[0]; rc[ai][m][1] = rp[1]; }
            asm volatile("" ::: "memory"); }
#pragma unroll
        for (int ai = 0; ai < 2; ++ai)
#pragma unroll
            for (int m = 0; m < 4; ++m) { const int row = row0 + ai * 128 + m * 16;
#pragma unroll
                for (int bj = 0; bj < 2; ++bj) { const int col = colb + bj * 128; f32x4 v0 = acc[ai][bj][m][0], v1 = acc[ai][bj][m][1];
                    if (MODE == 1) { const float4 c01 = rc[ai][m][0], c23 = rc[ai][m][1]; const f32x4 a = v0, b = v1;
                        v0[0] = a[0] * c01.x - a[1] * c01.y; v0[1] = a[0] * c01.y + a[1] * c01.x; v0[2] = a[2] * c01.z - a[3] * c01.w; v0[3] = a[2] * c01.w + a[3] * c01.z;
                        v1[0] = b[0] * c23.x - b[1] * c23.y; v1[1] = b[0] * c23.y + b[1] * c23.x; v1[2] = b[2] * c23.z - b[3] * c23.w; v1[3] = b[2] * c23.w + b[3] * c23.z; }
                    if (MODE == 2) {
#pragma unroll
                        for (int i = 0; i < 4; ++i) { v0[i] = v0[i] * __builtin_amdgcn_rcpf(1.f + __expf(-v0[i])); v1[i] = v1[i] * __builtin_amdgcn_rcpf(1.f + __expf(-v1[i])); } }
                    if (MODE == 3) {
#pragma unroll
                        for (int i = 0; i < 4; ++i) { v0[i] = fmaxf(lb0[bj][i] + (1.f - lb0[bj][i]) * __builtin_amdgcn_rcpf(1.f + __expf(-v0[i])), 1e-30f);
                                                      v1[i] = fmaxf(lb1[bj][i] + (1.f - lb1[bj][i]) * __builtin_amdgcn_rcpf(1.f + __expf(-v1[i])), 1e-30f); } }
                    u32x4 w; w.x = pg8::cvt_pk_bf16(v0[0], v0[1]); w.y = pg8::cvt_pk_bf16(v0[2], v0[3]); w.z = pg8::cvt_pk_bf16(v1[0], v1[1]); w.w = pg8::cvt_pk_bf16(v1[2], v1[3]);
                    if (!dry) *(u32x4*)(base + (size_t)row * GW + col) = w; } }
    }
    __device__ __forceinline__ void operator()(const f32x4 (&acc)[2][2][4][2], const pg8::Unit& u, int wr, int wc, int fr, int fq) const {
        const int grp = __builtin_amdgcn_readfirstlane(u.pn >> 1), pm = __builtin_amdgcn_readfirstlane(u.pm); bf16* base = P + (size_t)grp * GSTRIDE;
        const int colb = (u.pn & 1) * 256 + wc * 32 + 8 * fq, row0 = pm * 256 + wr * 64 + fr;
        if (grp < 2 && pm < TL / 256) tile<1>(acc, base, row0, colb, nullptr);
        else if (grp == 3) tile<2>(acc, base, row0, colb, nullptr);
        else if (grp == 4 || grp == 5) tile<3>(acc, base, row0, colb, lbl + (grp - 4) * 512 + colb);
        else tile<0>(acc, base, row0, colb, nullptr);
    }
};
template <int PASS> struct EpiMerge {
    static constexpr bool PERM = true, AFTER_DRAIN = false; static constexpr int NST = 0;
    bf16* M; const bf16* G;
    __device__ __forceinline__ void operator()(const f32x4 (&acc)[2][2][4][2], const pg8::Unit& u, int wr, int wc, int fr, int fq) const {
        const bf16* gb = G + (size_t)(u.pn >> 1) * GSTRIDE; const int gcol = (u.pn & 1) * 256 + wc * 32 + 8 * fq, mcol = u.pn * 256 + wc * 32 + 8 * fq;
        const int row0 = u.pm * 256 + wr * 64 + fr;
        uint4 gw[4][2], mw[4][2]; u32x4 res[4][2];
#pragma unroll
        for (int ai = 0; ai < 2; ++ai) {
#pragma unroll
            for (int m = 0; m < 4; ++m)
#pragma unroll
                for (int bj = 0; bj < 2; ++bj) { const int row = row0 + ai * 128 + m * 16; gw[m][bj] = *(const uint4*)(gb + (size_t)row * GW + gcol + bj * 128);
                    if (PASS == 1) mw[m][bj] = *(const uint4*)(M + (size_t)row * DM + mcol + bj * 128); }
            if (ai == 1) { asm volatile("" ::: "memory");
#pragma unroll
                for (int m = 0; m < 4; ++m)
#pragma unroll
                    for (int bj = 0; bj < 2; ++bj) *(u32x4*)(M + (size_t)(row0 + m * 16) * DM + mcol + bj * 128) = res[m][bj]; }
#pragma unroll
            for (int m = 0; m < 4; ++m)
#pragma unroll
                for (int bj = 0; bj < 2; ++bj) { float g[8]; unpack8(gw[m][bj], g);
                    const f32x4 v0 = acc[ai][bj][m][0], v1 = acc[ai][bj][m][1];
                    float o[8];
#pragma unroll
                    for (int i = 0; i < 4; ++i) { o[i] = sigm(g[i]) * v0[i]; o[4 + i] = sigm(g[4 + i]) * v1[i]; }
                    if (PASS == 1) { float pm_[8]; unpack8(mw[m][bj], pm_);
#pragma unroll
                        for (int i = 0; i < 8; ++i) o[i] += pm_[i]; }
                    u32x4 w; w.x = pg8::cvt_pk_bf16(o[0], o[1]); w.y = pg8::cvt_pk_bf16(o[2], o[3]); w.z = pg8::cvt_pk_bf16(o[4], o[5]); w.w = pg8::cvt_pk_bf16(o[6], o[7]);
                    if (ai == 0) res[m][bj] = w; else *(u32x4*)(M + (size_t)(row0 + 128 + m * 16) * DM + mcol + bj * 128) = w; }
        }
    }
};
template <bool SRC32> struct EpiOut {
    static constexpr bool PERM = true, AFTER_DRAIN = false; static constexpr int NST = 0;
    const float* xl_src; const float* xc_src; bf16* xs; const float* mod; int dry;
    __device__ __forceinline__ void operator()(const f32x4 (&acc)[2][2][4][2], const pg8::Unit& u, int wr, int wc, int fr, int fq) const {
        const bool lat = u.pm < TL / 256; const int mr = lat ? (u.pm >> 4) : 8;
        const int col0 = u.pn * 256 + wc * 32 + 8 * fq; const float* gate = mod + (size_t)mr * INW + 2048 + col0;
        const float* src = lat ? xl_src : xc_src - (size_t)TL * DM;
        f32x4 gv[2][2];
#pragma unroll
        for (int bj = 0; bj < 2; ++bj)
#pragma unroll
            for (int n = 0; n < 2; ++n) gv[bj][n] = *(const f32x4*)(gate + bj * 128 + n * 4);
        const size_t offb = (size_t)(u.pm * 256 + wr * 64 + fr) * DM + col0;
        f32x4 fa[4][2][2]; uint4 ba[4][2]; u32x4 res[4][2];
#pragma unroll
        for (int ai = 0; ai < 2; ++ai) {
#pragma unroll
            for (int m = 0; m < 4; ++m)
#pragma unroll
                for (int bj = 0; bj < 2; ++bj) { const size_t o = offb + (size_t)(ai * 128 + m * 16) * DM + bj * 128;
                    if (SRC32) { fa[m][bj][0] = *(const f32x4*)(src + o); fa[m][bj][1] = *(const f32x4*)(src + o + 4); } else ba[m][bj] = *(const uint4*)(xs + o); }
            if (ai == 1) { asm volatile("" ::: "memory");
#pragma unroll
                for (int m = 0; m < 4; ++m)
#pragma unroll
                    for (int bj = 0; bj < 2; ++bj) { if (!dry) *(u32x4*)(xs + offb + (size_t)(m * 16) * DM + bj * 128) = res[m][bj]; } }
#pragma unroll
            for (int m = 0; m < 4; ++m)
#pragma unroll
                for (int bj = 0; bj < 2; ++bj) { float x[8];
                    if (SRC32) {
#pragma unroll
                        for (int i = 0; i < 4; ++i) { x[i] = fa[m][bj][0][i]; x[4 + i] = fa[m][bj][1][i]; } }
                    else unpack8(ba[m][bj], x);
                    const f32x4 v0 = acc[ai][bj][m][0], v1 = acc[ai][bj][m][1];
#pragma unroll
                    for (int i = 0; i < 4; ++i) { x[i] += gv[bj][0][i] * v0[i]; x[4 + i] += gv[bj][1][i] * v1[i]; }
                    u32x4 w; w.x = pg8::cvt_pk_bf16(x[0], x[1]); w.y = pg8::cvt_pk_bf16(x[2], x[3]); w.z = pg8::cvt_pk_bf16(x[4], x[5]); w.w = pg8::cvt_pk_bf16(x[6], x[7]);
                    if (ai == 0) res[m][bj] = w; else if (!dry) *(u32x4*)(xs + offb + (size_t)(128 + m * 16) * DM + bj * 128) = w; }
        }
    }
};
struct EpiGateUp {
    static constexpr bool PERM = true, AFTER_DRAIN = false; static constexpr int NST = RELAX_NST(8);
    bf16* A;
    __device__ __forceinline__ void operator()(const f32x4 (&acc)[2][2][4][2], const pg8::Unit& u, int wr, int wc, int fr, int fq) const {
        const int col = (u.pn & 3) * 128 + wc * 32 + 8 * fq;
#pragma unroll
        for (int ai = 0; ai < 2; ++ai)
#pragma unroll
            for (int m = 0; m < 4; ++m) { const int row = u.pm * 256 + ai * 128 + wr * 64 + m * 16 + fr; float o[8];
#pragma unroll
                for (int i = 0; i < 4; ++i) { o[i] = silu(acc[ai][0][m][0][i]) * acc[ai][1][m][0][i]; o[4 + i] = silu(acc[ai][0][m][1][i]) * acc[ai][1][m][1][i]; }
                u32x4 w; w.x = pg8::cvt_pk_bf16(o[0], o[1]); w.y = pg8::cvt_pk_bf16(o[2], o[3]); w.z = pg8::cvt_pk_bf16(o[4], o[5]); w.w = pg8::cvt_pk_bf16(o[6], o[7]);
                *(u32x4*)(A + (size_t)row * 512 + col) = w; }
    }
};
struct EpiDown {
    static constexpr bool PERM = true, AFTER_DRAIN = false; static constexpr int NST = 0;
    bf16* Y; int dry;
    __device__ __forceinline__ void operator()(const f32x4 (&acc)[2][2][4][2], const pg8::Unit& u, int wr, int wc, int fr, int fq) const {
        const int col = (u.pn & 3) * 256 + wc * 32 + 8 * fq;
#pragma unroll
        for (int ai = 0; ai < 2; ++ai)
#pragma unroll
            for (int m = 0; m < 4; ++m) { const int row = u.pm * 256 + ai * 128 + wr * 64 + m * 16 + fr;
#pragma unroll
                for (int bj = 0; bj < 2; ++bj) { const f32x4 v0 = acc[ai][bj][m][0], v1 = acc[ai][bj][m][1];
                    u32x4 w; w.x = pg8::cvt_pk_bf16(v0[0], v0[1]); w.y = pg8::cvt_pk_bf16(v0[2], v0[3]); w.z = pg8::cvt_pk_bf16(v1[0], v1[1]); w.w = pg8::cvt_pk_bf16(v1[2], v1[3]);
                    if (!dry) *(u32x4*)(Y + (size_t)row * DM + col + bj * 128) = w; } }
    }
};
struct MoeOrder {
    static constexpr bool GATHER = false;
    const int* tab; int G, c;
    __device__ __forceinline__ bool next(int i, pg8::Unit& u) const {
        const int L = i * G + c, MT = tab[16]; if (L >= MT * 4) return false;
        const int mt = L >> 2; int e = 0;
#pragma unroll
        for (int j = 1; j < 16; ++j) e += (mt >= tab[j]) ? 1 : 0;
        u.pm = mt; u.pn = e * 4 + (L & 3); return true;
    }
    __device__ __forceinline__ void a_ready(const pg8::Unit&) const {}
    __device__ __forceinline__ void done(const pg8::Unit&) const {}
};
struct MoeOrderG {
    static constexpr bool GATHER = true;
    const int* tab; const int* s2t; int G, c;
    __device__ __forceinline__ bool next(int i, pg8::Unit& u) const {
        const int L = i * G + c, MT = tab[16]; if (L >= MT * 4) return false;
        const int mt = L >> 2; int e = 0;
#pragma unroll
        for (int j = 1; j < 16; ++j) e += (mt >= tab[j]) ? 1 : 0;
        u.pm = mt; u.pn = e * 4 + (L & 3); return true;
    }
    __device__ __forceinline__ void gather4(const pg8::Unit& u, int R0, int (&ix)[4]) const {
        const int e = u.pn >> 2, te = u.pm - tab[e], ce = tab[17 + e];
        const int4 v = *(const int4*)(s2t + (size_t)e * S2T_CAP + te * 256 + R0 * 4);
        const int g0 = te * 256 + R0;
        ix[0] = (g0 < ce) ? v.x : 0; ix[1] = (g0 + 64 < ce) ? v.y : 0; ix[2] = (g0 + 128 < ce) ? v.z : 0; ix[3] = (g0 + 192 < ce) ? v.w : 0;
    }
    __device__ __forceinline__ void a_ready(const pg8::Unit&) const {}
    __device__ __forceinline__ void done(const pg8::Unit&) const {}
};
__device__ __forceinline__ void moe_table(const Ctx& C, int l) {
    __syncthreads();
    if (C.wave == 0) { const unsigned* cnt = C.CNT(l);
        const unsigned ce = (C.lane < 16) ? __hip_atomic_load(cnt + C.lane, __ATOMIC_RELAXED, __HIP_MEMORY_SCOPE_AGENT) : 0u;
        const int t = (int)((ce + 255u) >> 8); int inc = t;
#pragma unroll
        for (int o = 1; o < 16; o <<= 1) { const int up = __shfl_up(inc, o); if (C.lane >= o) inc += up; }
        if (C.lane < 16) { C.TAB()[C.lane] = inc - t; C.TAB()[17 + C.lane] = (int)ce; }
        if (C.lane == 15) C.TAB()[16] = inc; }
    __syncthreads();
}

typedef pg8::bf16x8 bf16x8;
typedef unsigned u32x2 __attribute__((ext_vector_type(2)));
__device__ __forceinline__ bf16x8 ld16(const bf16* p) { return *(const bf16x8*)p; }
__device__ __forceinline__ bf16x8 ld8x2(const bf16* p0, const bf16* p1) { const u32x2 a = *(const u32x2*)p0, b = *(const u32x2*)p1; u32x4 w; w.x = a.x; w.y = a.y; w.z = b.x; w.w = b.y; return __builtin_bit_cast(bf16x8, w); }
__device__ __forceinline__ bf16x8 pack8(const f32x4 a, const f32x4 b) { u32x4 w; w.x = pg8::cvt_pk_bf16(a[0], a[1]); w.y = pg8::cvt_pk_bf16(a[2], a[3]); w.z = pg8::cvt_pk_bf16(b[0], b[1]); w.w = pg8::cvt_pk_bf16(b[2], b[3]); return __builtin_bit_cast(bf16x8, w); }
#define MFMA16(a, b, c) __builtin_amdgcn_mfma_f32_16x16x32_bf16(a, b, c, 0, 0, 0)

#define SCHEDB_A() asm volatile("" ::: "memory")
#define REP9(M) M(0) M(1) M(2) M(3) M(4) M(5) M(6) M(7) M(8)
constexpr int AT_R1 = 0, AT_CK = 73728, AT_CV = 106496, AT_RB = 139264;
__device__ __forceinline__ int kswz(int key, int p) { return key * 128 + ((p ^ ((key >> 1) & 7)) << 4); }
typedef short s16x4 __attribute__((ext_vector_type(4)));
__device__ __forceinline__ bf16x8 tr2(const unsigned char* p0, const unsigned char* p1) {
    const s16x4 a = __builtin_amdgcn_ds_read_tr16_b64_v4i16((LAS s16x4*)p0), b = __builtin_amdgcn_ds_read_tr16_b64_v4i16((LAS s16x4*)p1);
    return __builtin_shufflevector(a, b, 0, 1, 2, 3, 4, 5, 6, 7); }
__device__ __forceinline__ void p3_attn2(const Ctx& C, int l, bool dry = false) {
    unsigned char* L = C.lds; LAS unsigned char* Ll = (LAS unsigned char*)C.lds;
    const bf16* Qb = C.GRP(0); const bf16* Kb = C.GRP(1); const bf16* Vb = C.GRP(2); bf16* Ob = C.GRP(0);
    const int lq = C.lane & 15, g = C.lane >> 4;
    const int ngroups = 256 + (l == 0 ? 64 : 0);
    const f32x4 z4 = {0.f, 0.f, 0.f, 0.f};
    const float C1 = 0.125f * 1.4426950408889634f;
    unsigned* qctr = C.CTL() + CW_CNT + 1024 + l * 64 + (dry ? 32 : 0) + C.rep * 2048;
    volatile int* qslot = (volatile int*)(C.lds + LDS_STAGE) + 40;
    const int kl = C.lane >> 3, kpiece = (C.lane & 7) ^ ((4 * (C.wave & 1) + (kl >> 1)) & 7), vpiece = (C.lane & 7) ^ (((kl >> 1) & 3) << 1);
    const size_t kthr = (size_t)(C.wave * 8 + kl) * GW + kpiece * 8, vthr = (size_t)(C.wave * 8 + kl) * GW + vpiece * 8;
    const int tq = (C.lane >> 2) & 3, tp = C.lane & 3, txr = (2 * g + (tq >> 1)) & 3;
    int tro[4];
#pragma unroll
    for (int dt = 0; dt < 4; ++dt) tro[dt] = (4 * g + tq) * 128 + (((dt ^ txr) << 5) + 8 * tp);
    for (int qit = 0;; ++qit) {
        __syncthreads();
#ifdef STATIC_Q
        if (C.tid == 0) { *qslot = C.bid + qit * C.G; }
#else
        if (C.tid == 0) *qslot = (int)atomicAdd(qctr, 1u);
#endif
        __syncthreads();
        const int gid = *qslot;
        if (gid >= ngroups) break;
        const bool latg = gid < 256; const int bh = latg ? (gid >> 2) : (gid - 256); const int b = bh >> 3, h = bh & 7;
        { const bf16* ck0 = Kb + (size_t)(TL + b * 256) * GW + h * 64 + kthr; const bf16* cv0 = Vb + (size_t)(TL + b * 256) * GW + h * 64 + vthr;
#pragma unroll
          for (int it = 0; it < 4; ++it) {
              __builtin_amdgcn_global_load_lds((const unsigned*)(ck0 + (size_t)it * 64 * GW), (LAS unsigned*)(Ll + AT_CK + (it * 8 + C.wave) * 1024), 16, 0, 0);
              __builtin_amdgcn_global_load_lds((const unsigned*)(cv0 + (size_t)it * 64 * GW), (LAS unsigned*)(Ll + AT_CV + (it * 8 + C.wave) * 1024), 16, 0, 0); } }
        if (C.tid < 480) { const int dr = C.tid >> 5, dc = C.tid & 31; ((float*)(L + AT_RB))[C.tid] = (dc < 31) ? 1.4426950408889634f * C.p->rel_bias[((size_t)(l * 8 + h) * 15 + dr) * 31 + dc] : 0.f; }
        const int nun = latg ? 8 : 2;
        bf16x8 nq0, nq1;
        { const int qr = latg ? b * 4096 + ((gid & 3) * 16 + (C.wave >> 2)) * 64 + (C.wave & 3) * 16 : TL + b * 256 + C.wave * 16;
          const bf16* qp = Qb + (size_t)(qr + lq) * GW + h * 64 + 8 * g; nq0 = ld16(qp); nq1 = ld16(qp + 32); }
        for (int ui = 0; ui < nun; ++ui) {
            int gr = 0, gc0 = 0, qrow0, rsu = 0, nru = 1, rsw = 0;
            if (latg) { const int gr0 = ((gid & 3) * 8 + ui) * 2; gr = gr0 + (C.wave >> 2); gc0 = (C.wave & 3) * 16; qrow0 = b * 4096 + gr * 64 + gc0;
                rsu = min(max(gr0 - 4, 0), 56); nru = min(9, 64 - rsu); rsw = min(max(gr - 4, 0), 56); }
            else qrow0 = TL + b * 256 + (ui * 8 + C.wave) * 16;
            const int u0 = min(max(gc0 - 8, 0), 32);
            const bf16x8 q0 = nq0, q1 = nq1;
            asm volatile("s_waitcnt vmcnt(0)" ::: "memory");
            __syncthreads();
            if (latg) { const bf16* kb0 = Kb + (size_t)(b * 4096 + rsu * 64) * GW + h * 64 + kthr;
#pragma unroll
                for (int it = 0; it < 9; ++it) if (it < 8 || nru == 9)
                    __builtin_amdgcn_global_load_lds((const unsigned*)(kb0 + (size_t)it * 64 * GW), (LAS unsigned*)(Ll + AT_R1 + (it * 8 + C.wave) * 1024), 16, 0, 0); }
            if (ui + 1 < nun) { const int u1 = ui + 1;
                const int qr = latg ? b * 4096 + (((gid & 3) * 8 + u1) * 2 + (C.wave >> 2)) * 64 + (C.wave & 3) * 16 : TL + b * 256 + (u1 * 8 + C.wave) * 16;
                const bf16* qp = Qb + (size_t)(qr + lq) * GW + h * 64 + 8 * g; nq0 = ld16(qp); nq1 = ld16(qp + 32); }
            asm volatile("" ::: "memory");
            f32x4 oc[4] = {z4, z4, z4, z4}; float mc, sc;
            { f32x4 s[16];
              const unsigned char* ck0 = L + AT_CK + kswz(lq, g), *ck1 = L + AT_CK + kswz(lq, 4 + g);
#pragma unroll
              for (int ct = 0; ct < 16; ++ct) { f32x4 a = MFMA16(*(const bf16x8*)(ck0 + ct * 2048), q0, z4); a = MFMA16(*(const bf16x8*)(ck1 + ct * 2048), q1, a); s[ct] = a; }
              float mx = -1e30f;
#pragma unroll
              for (int i = 0; i < 16; ++i) mx = fmaxf(fmaxf(fmaxf(mx, s[i][0]), fmaxf(s[i][1], s[i][2])), s[i][3]);
              mx = fmaxf(mx, __shfl_xor(mx, 16)); mx = fmaxf(mx, __shfl_xor(mx, 32));
              mx *= C1;
              float sum = 0.f;
#pragma unroll
              for (int i = 0; i < 16; ++i) {
#pragma unroll
                  for (int r = 0; r < 4; ++r) { const float e = __builtin_amdgcn_exp2f(fmaf(s[i][r], C1, -mx)); s[i][r] = e; sum += e; } }
              sum += __shfl_xor(sum, 16); sum += __shfl_xor(sum, 32);
              mc = mx; sc = sum;
#pragma unroll
              for (int cb = 0; cb < 8; ++cb) { const bf16x8 pb = pack8(s[2 * cb], s[2 * cb + 1]);
                  const unsigned char* vp = L + AT_CV + cb * 4096;
#pragma unroll
                  for (int dt = 0; dt < 4; ++dt) oc[dt] = MFMA16(tr2(vp + tro[dt], vp + tro[dt] + 2048), pb, oc[dt]); } }
            float inv = 1.f / sc;
            if (latg) {
                asm volatile("s_waitcnt vmcnt(0)" ::: "memory");
                __syncthreads();
                const int gcq = gc0 + lq, csq = min(max(gcq - 8, 0), 48);
                bool val[8]; int bo[8];
#pragma unroll
                for (int hr = 0; hr < 8; ++hr) { const int kc = u0 + 16 * (hr >> 2) + 4 * g + (hr & 3); val[hr] = (kc >= csq) && (kc < csq + 16); bo[hr] = min(max(kc - gcq + 15, 0), 30) * 4; }
                const unsigned char* rb = L + AT_RB + (rsw - gr + 7) * 128;
                const int key0 = (rsw - rsu) * 64 + u0 + lq;
                const unsigned char* wk0 = L + AT_R1 + kswz(key0, g), *wk1 = L + AT_R1 + kswz(key0, 4 + g);
                f32x4 s[16];
#pragma unroll
                for (int wt = 0; wt < 16; ++wt) { const int wrow = wt >> 1, half = wt & 1;
                    f32x4 a = MFMA16(*(const bf16x8*)(wk0 + wrow * 8192 + half * 2048), q0, z4); a = MFMA16(*(const bf16x8*)(wk1 + wrow * 8192 + half * 2048), q1, a);
#pragma unroll
                    for (int r = 0; r < 4; ++r) a[r] = val[half * 4 + r] ? fmaf(a[r], C1, *(const float*)(rb + wrow * 128 + bo[half * 4 + r])) : -1e30f;
                    s[wt] = a; }
                __syncthreads();
                { const bf16* vb0 = Vb + (size_t)(b * 4096 + rsu * 64) * GW + h * 64 + vthr;
#pragma unroll
                  for (int it = 0; it < 9; ++it) if (it < 8 || nru == 9)
                      __builtin_amdgcn_global_load_lds((const unsigned*)(vb0 + (size_t)it * 64 * GW), (LAS unsigned*)(Ll + AT_R1 + (it * 8 + C.wave) * 1024), 16, 0, 0); }
                float mx = -1e30f;
#pragma unroll
                for (int i = 0; i < 16; ++i) mx = fmaxf(fmaxf(fmaxf(mx, s[i][0]), fmaxf(s[i][1], s[i][2])), s[i][3]);
                mx = fmaxf(mx, __shfl_xor(mx, 16)); mx = fmaxf(mx, __shfl_xor(mx, 32));
                float sum = 0.f;
#pragma unroll
                for (int i = 0; i < 16; ++i) {
#pragma unroll
                    for (int r = 0; r < 4; ++r) { const float e = __builtin_amdgcn_exp2f(s[i][r] - mx); s[i][r] = e; sum += e; } }
                sum += __shfl_xor(sum, 16); sum += __shfl_xor(sum, 32);
                asm volatile("s_waitcnt vmcnt(0)" ::: "memory");
                __syncthreads();
                f32x4 ow[4] = {z4, z4, z4, z4};
                const unsigned char* vpw = L + AT_R1 + ((rsw - rsu) * 64 + u0) * 128;
#pragma unroll
                for (int wrow = 0; wrow < 8; ++wrow) { const bf16x8 pb = pack8(s[2 * wrow], s[2 * wrow + 1]);
#pragma unroll
                    for (int dt = 0; dt < 4; ++dt) ow[dt] = MFMA16(tr2(vpw + wrow * 8192 + tro[dt], vpw + wrow * 8192 + tro[dt] + 2048), pb, ow[dt]); }
                const float m = fmaxf(mc, mx), fc = __builtin_amdgcn_exp2f(mc - m), fw = __builtin_amdgcn_exp2f(mx - m);
                inv = 1.f / (sc * fc + sum * fw);
#pragma unroll
                for (int dt = 0; dt < 4; ++dt) oc[dt] = oc[dt] * fc + ow[dt] * fw;
            }
            bf16* op = Ob + (size_t)(qrow0 + lq) * GW + h * 64 + 4 * g;
#pragma unroll
            for (int dt = 0; dt < 4; ++dt) { u32x2 w; w.x = pg8::cvt_pk_bf16(oc[dt][0] * inv, oc[dt][1] * inv); w.y = pg8::cvt_pk_bf16(oc[dt][2] * inv, oc[dt][3] * inv); if (!dry) *(u32x2*)(op + 16 * dt) = w; }
        }
    }
    __syncthreads();
}

#define LBAR() do { asm volatile("s_waitcnt lgkmcnt(0)" ::: "memory"); __builtin_amdgcn_s_barrier(); asm volatile("" ::: "memory"); } while (0)
__device__ __forceinline__ float ex2(float x) { return __builtin_amdgcn_exp2f(x); }
__device__ __forceinline__ int scan_row(int b, int dir, int s) { return dir == 0 ? (s < NCTX ? TL + b * NCTX + s : b * SEQ + (s - NCTX)) : (s < NCTX ? TL + b * NCTX + (NCTX - 1 - s) : b * SEQ + (SEQ - 1 - (s - NCTX))); }
__device__ __forceinline__ unsigned rot16(unsigned x) { return (x >> 16) | (x << 16); }
constexpr int S6_QT = 0, S6_KT = 17408, S6_QS = 34816, S6_DB = 52224, S6_KST = 0, S6_VT = 18432, S6_DV = 27648, S6_BUF = 28160, S6_TOT = 108544, S6_XP = 112640, S6_SPX = 118784;
__device__ __forceinline__ void p3_scan6(const Ctx& C, int l) {
    unsigned char* L = C.lds;
    const int kp = C.tid & 63, seg = C.tid >> 6, lq = C.lane & 15, g = C.lane >> 4, vt = C.wave & 3, th = C.wave >> 2;
    const bf16* HQ = C.GRP(3); const bf16* HIT = C.GRP(6);
    const f32x4 z4 = {0.f, 0.f, 0.f, 0.f};
    for (int u = C.bid; u < 128; u += C.G) {
        const int vh = u & 1, dir = (u >> 1) & 1, h = (u >> 2) & 3, b = u >> 4;
        const bf16* HF = C.GRP(dir ? 5 : 4); bf16* OUT = C.H() + (size_t)dir * GSTRIDE;
        const int sgn = dir ? -1 : 1;
        unsigned char* const spx = L + S6_SPX + C.tid * 16 + (C.wave << 10);
        f32x4 S[4];
        unsigned zz = 0u; asm volatile("" : "+v"(zz));
        const u32x4 zq = {zz, zz, zz, zz};
#pragma unroll
        for (int i = 0; i < 4; ++i) S[i] = __builtin_bit_cast(f32x4, zq);
        *(bf16x8*)(spx) = __builtin_bit_cast(bf16x8, zq); *(bf16x8*)(spx + 1024) = __builtin_bit_cast(bf16x8, zq);
        unsigned gva[8], qva[8], gvb[8], qvb[8]; uint4 vva[1], vvb[1];
        float c0[8], c1[8];
        unsigned ost[4]; int prow0 = 0;
#pragma unroll
        for (int i = 0; i < 4; ++i) ost[i] = 0u;
        f32x4 o[2];
#define S6_LOADS(CC_, GV_, QV_, VV_) do { const int cc_ = (CC_); const int row0_ = scan_row(b, dir, 64 * cc_); \
            _Pragma("unroll") for (int i = 0; i < 8; ++i) { const size_t ro = (size_t)(row0_ + sgn * (8 * C.wave + i)) * GW + h * 128; GV_[i] = *(const unsigned*)(HF + ro + 2 * kp); QV_[i] = *(const unsigned*)(HQ + ro + 2 * kp); } \
            VV_[0] = *(const uint4*)(HIT + (size_t)row0_ * GW + h * 128 + vh * 64 + C.wave * 8 + (ptrdiff_t)(sgn * C.lane) * GW); } while (0)
#define S6_G1(GV_) do { float r0 = 1.f, r1 = 1.f;        \
            _Pragma("unroll") for (int i = 0; i < 8; ++i) { r0 *= bflo(GV_[i]); r1 *= bfhi(GV_[i]); c0[i] = r0; c1[i] = r1; } \
            *(float2*)(L + S6_TOT + (seg * 128 + 2 * kp) * 4) = make_float2(r0, r1); } while (0)
#define S6_G2(BO_, QV_, VV_) do { unsigned char* B_ = L + S6_DB + (BO_); \
            float po0 = 1.f, po1 = 1.f, pb0 = 1.f, pb1 = 1.f, pl0 = 1.f, pl1 = 1.f; \
            float2 tt_[8]; \
            _Pragma("unroll") for (int j = 0; j < 8; ++j) tt_[j] = *(const float2*)(L + S6_TOT + (j * 128 + 2 * kp) * 4);        \
            __builtin_amdgcn_sched_barrier(0); \
            _Pragma("unroll") for (int j = 0; j < 8; ++j) { const float2 t = tt_[j]; \
                if (j < seg) { po0 *= t.x; po1 *= t.y; } if (j < 4) { pb0 *= t.x; pb1 *= t.y; } pl0 *= t.x; pl1 *= t.y; } \
            const float TINY = 7.8886e-31f;     \
            const float ib0 = __builtin_amdgcn_rcpf(fmaxf(pb0, TINY)), ib1 = __builtin_amdgcn_rcpf(fmaxf(pb1, TINY)); \
            const float s0_ = po0 * ib0, s1_ = po1 * ib1;              \
            const float el0 = pl0 * ib0, el1 = pl1 * ib1;                \
            float rp0 = __builtin_amdgcn_rcpf(fmaxf(s0_, TINY)), rp1 = __builtin_amdgcn_rcpf(fmaxf(s1_, TINY)); \
            float ks0[8], ks1[8]; \
            _Pragma("unroll") for (int i = 0; i < 8; ++i) { const float e0 = fmaxf(s0_ * c0[i], TINY), e1 = fmaxf(s1_ * c1[i], TINY); \
                const float rr0 = __builtin_amdgcn_rcpf(e0), rr1 = __builtin_amdgcn_rcpf(e1); \
                const float kt0 = rr0 - rp0, kt1 = rr1 - rp1; rp0 = rr0; rp1 = rr1; const int t = 8 * seg + i; \
                { const float qa = bflo(QV_[i]) * e0, qb = bfhi(QV_[i]) * e1; *(unsigned*)(L + S6_QT + t * 272 + 4 * kp) = pg8::cvt_pk_bf16(qa, qb); *(unsigned*)(L + S6_QS + t * 272 + 4 * kp) = pg8::cvt_pk_bf16(qa * pb0, qb * pb1); } \
                *(unsigned*)(L + S6_KT + t * 272 + 4 * kp) = pg8::cvt_pk_bf16(kt0, kt1); \
                ks0[i] = kt0 * el0; ks1[i] = kt1 * el1; } \
            *(uint4*)(B_ + S6_KST + (2 * kp) * 144 + seg * 16) = make_uint4(pg8::cvt_pk_bf16(ks0[0], ks0[1]), pg8::cvt_pk_bf16(ks0[2], ks0[3]), pg8::cvt_pk_bf16(ks0[4], ks0[5]), pg8::cvt_pk_bf16(ks0[6], ks0[7])); \
            *(uint4*)(B_ + S6_KST + (2 * kp + 1) * 144 + seg * 16) = make_uint4(pg8::cvt_pk_bf16(ks1[0], ks1[1]), pg8::cvt_pk_bf16(ks1[2], ks1[3]), pg8::cvt_pk_bf16(ks1[4], ks1[5]), pg8::cvt_pk_bf16(ks1[6], ks1[7])); \
            if (seg == 0) { *(float2*)(B_ + S6_DV + 8 * kp) = make_float2(pl0, pl1); } \
            { const uint4 w = VV_[0]; unsigned char* dp = B_ + S6_VT + (C.wave * 8) * 144 + C.lane * 2; \
                *(bf16*)(dp) = (bf16)(w.x & 0xffffu); *(bf16*)(dp + 144) = (bf16)(w.x >> 16); *(bf16*)(dp + 288) = (bf16)(w.y & 0xffffu); *(bf16*)(dp + 432) = (bf16)(w.y >> 16); \
                *(bf16*)(dp + 576) = (bf16)(w.z & 0xffffu); *(bf16*)(dp + 720) = (bf16)(w.z >> 16); *(bf16*)(dp + 864) = (bf16)(w.w & 0xffffu); *(bf16*)(dp + 1008) = (bf16)(w.w >> 16); } } while (0)
#define S6_MA(BO_) do { \
            const unsigned char* slo = L + S6_SPX + (vt << 11) + C.lane * 16; \
            const bf16x8 sp0 = *(const bf16x8*)(slo), sp1 = *(const bf16x8*)(slo + 1024), sp2 = *(const bf16x8*)(slo + 8192), sp3 = *(const bf16x8*)(slo + 9216);        \
            bf16x8 qa[2][4]; \
            _Pragma("unroll") for (int ti = 0; ti < 2; ++ti) _Pragma("unroll") for (int ks = 0; ks < 4; ++ks) { const unsigned char* sb = L + S6_QS + (16 * (2 * th + ti) + lq) * 272 + 8 * g + 64 * ks; qa[ti][ks] = ld8x2((const bf16*)(sb), (const bf16*)(sb + 32)); } \
            const int xt = (C.wave < 2) ? C.wave : 2 + ((C.wave - 2) >> 1), xs = (C.wave < 2) ? 0 : ((C.wave - 2) & 1); \
            __builtin_amdgcn_sched_barrier(0); \
            { f32x4 o0 = z4, o1 = z4; \
              o0 = MFMA16(qa[0][0], sp0, o0); o1 = MFMA16(qa[1][0], sp0, o1); o0 = MFMA16(qa[0][1], sp1, o0); o1 = MFMA16(qa[1][1], sp1, o1); \
              o0 = MFMA16(qa[0][2], sp2, o0); o1 = MFMA16(qa[1][2], sp2, o1); o0 = MFMA16(qa[0][3], sp3, o0); o1 = MFMA16(qa[1][3], sp3, o1); o[0] = o0; o[1] = o1; } \
            if (C.wave < 6) { const unsigned char* qb = L + S6_QT + (16 * xt + lq) * 272 + g * 16; bf16x8 qf[4], kf[2][4]; \
                _Pragma("unroll") for (int ks = 0; ks < 4; ++ks) qf[ks] = *(const bf16x8*)(qb + ks * 64); \
                _Pragma("unroll") for (int hf = 0; hf < 2; ++hf) { const unsigned char* kb = L + S6_KT + (16 * (2 * xs + hf) + lq) * 272 + g * 16; \
                    _Pragma("unroll") for (int ks = 0; ks < 4; ++ks) kf[hf][ks] = *(const bf16x8*)(kb + ks * 64); } \
                __builtin_amdgcn_sched_barrier(0); \
                const int tcol = 16 * xt + lq; f32x4 X0 = z4, X1 = z4; \
                _Pragma("unroll") for (int ks = 0; ks < 4; ++ks) { X0 = MFMA16(kf[0][ks], qf[ks], X0); X1 = MFMA16(kf[1][ks], qf[ks], X1); } \
                _Pragma("unroll") for (int r = 0; r < 4; ++r) { X0[r] = (16 * (2 * xs) + 4 * g + r <= tcol) ? X0[r] : 0.f; X1[r] = (16 * (2 * xs + 1) + 4 * g + r <= tcol) ? X1[r] : 0.f; } \
                *(bf16x8*)(L + S6_XP + C.wave * 1024 + C.lane * 16) = pack8(X0, X1); } } while (0)
#define S6_MB(BO_, ROW0_) do { const unsigned char* B_ = L + S6_DB + (BO_); \
            { const unsigned char* vb = B_ + S6_VT + (16 * vt + lq) * 144 + 8 * g; \
              const bf16x8 vq0 = ld8x2((const bf16*)vb, (const bf16*)(vb + 32)), vq1 = ld8x2((const bf16*)(vb + 64), (const bf16*)(vb + 96)); \
              const unsigned char* xp = L + S6_XP + C.lane * 16 + (th ? 2048 : 0); \
              const bf16x8 x0 = *(const bf16x8*)(xp), x1 = *(const bf16x8*)(xp + 1024); \
              const unsigned char* vb2 = B_ + S6_VT + (16 * vt + lq) * 144 + g * 16; const bf16x8 vf0 = *(const bf16x8*)vb2, vf1 = *(const bf16x8*)(vb2 + 64); \
              if (th == 0) { __builtin_amdgcn_sched_barrier(0); o[0] = MFMA16(x0, vq0, o[0]); o[1] = MFMA16(x1, vq0, o[1]); } \
              else { const bf16x8 x2 = *(const bf16x8*)(xp + 2048), x3 = *(const bf16x8*)(xp + 3072); __builtin_amdgcn_sched_barrier(0); \
                     o[0] = MFMA16(x0, vq0, o[0]); o[1] = MFMA16(x2, vq0, o[1]); o[0] = MFMA16(x1, vq1, o[0]); o[1] = MFMA16(x3, vq1, o[1]); } \
              f32x4 dsc[4]; bf16x8 ka[4], kb2[4]; \
              _Pragma("unroll") for (int i = 0; i < 4; ++i) { const int kt = 4 * th + i; dsc[i] = *(const f32x4*)(B_ + S6_DV + (16 * kt + 4 * g) * 4); const unsigned char* kb = B_ + S6_KST + (16 * kt + lq) * 144 + g * 16; \
                  ka[i] = *(const bf16x8*)kb; kb2[i] = *(const bf16x8*)(kb + 64); } \
              __builtin_amdgcn_sched_barrier(0); \
              _Pragma("unroll") for (int ti = 0; ti < 2; ++ti) { ost[2 * ti] = pg8::cvt_pk_bf16(o[ti][0], o[ti][1]); ost[2 * ti + 1] = pg8::cvt_pk_bf16(o[ti][2], o[ti][3]); } \
              prow0 = (ROW0_); \
              _Pragma("unroll") for (int i = 0; i < 4; ++i) S[i] = MFMA16(ka[i], vf0, S[i] * dsc[i]); \
              _Pragma("unroll") for (int i = 0; i < 4; ++i) S[i] = MFMA16(kb2[i], vf1, S[i]); \
              *(bf16x8*)(spx) = pack8(S[0], S[1]); *(bf16x8*)(spx + 1024) = pack8(S[2], S[3]); } } while (0)
#define S6_STORE() do { _Pragma("unroll") for (int ti = 0; ti < 2; ++ti) { bf16* op = OUT + (size_t)(prow0 + sgn * (16 * (2 * th + ti) + 4 * g)) * GW + h * 128 + vh * 64 + 16 * vt + lq; \
                op[0] = (bf16)(ost[2 * ti] & 0xffffu); op[(ptrdiff_t)sgn * GW] = (bf16)(ost[2 * ti] >> 16); op[(ptrdiff_t)(2 * sgn) * GW] = (bf16)(ost[2 * ti + 1] & 0xffffu); op[(ptrdiff_t)(3 * sgn) * GW] = (bf16)(ost[2 * ti + 1] >> 16); } } while (0)
#define S6_STEP(CC_, GV_, QV_, VV_) do { const int c_ = (CC_); \
            if (c_ + 1 < 68) S6_G1(GV_); \
            S6_MA((c_ & 1) * S6_BUF); \
            LBAR(); \
            if (c_ > 0) S6_STORE(); \
            if (c_ + 1 < 68) { S6_G2(((c_ + 1) & 1) * S6_BUF, QV_, VV_); if (c_ + 3 < 68) S6_LOADS(c_ + 3, GV_, QV_, VV_); } \
            __builtin_amdgcn_sched_barrier(0); \
            S6_MB((c_ & 1) * S6_BUF, scan_row(b, dir, 64 * c_)); \
            LBAR(); } while (0)
        S6_LOADS(0, gva, qva, vva); S6_LOADS(1, gvb, qvb, vvb);
        S6_G1(gva);
        LBAR();
        S6_G2(0, qva, vva); S6_LOADS(2, gva, qva, vva);
        LBAR();
        for (int c2 = 0; c2 < 68; c2 += 2) {
            S6_STEP(c2, gvb, qvb, vvb);
            S6_STEP(c2 + 1, gva, qva, vva);
        }
        S6_STORE();
#undef S6_LOADS
#undef S6_G1
#undef S6_G2
#undef S6_MA
#undef S6_MB
#undef S6_STORE
#undef S6_STEP
        __syncthreads();
    }
}

__device__ __forceinline__ void p3c_headnorm(const Ctx& C, int l, bool dry = false) {
    const int nrows = (l == 0) ? TA : TL;
    bf16* OF = C.H(); const bf16* OB = C.H() + GSTRIDE; const bf16* HG = C.GRP(7);
    float gn[8];
    { const float* gain = C.p->hg_norm_g + l * 128 + (C.lane & 15) * 8;
#pragma unroll
      for (int i = 0; i < 8; ++i) gn[i] = gain[i]; }
    const uint4 z = make_uint4(0u, 0u, 0u, 0u);
    uint4 a0 = z, b0 = z, g0 = z, a1 = z, b1 = z, g1 = z;
#define P3C_LD(A_, B_, G_, r_) do { const size_t o_ = (size_t)(r_) * GW + C.lane * 8; A_ = *(const uint4*)(OF + o_); B_ = *(const uint4*)(OB + o_); G_ = *(const uint4*)(HG + o_); } while (0)
#define P3C_DO(A_, B_, G_, r_) do { float a[8], b[8], g[8]; unpack8(A_, a); unpack8(B_, b); unpack8(G_, g); \
        { const int rn_ = (r_) + 2 * C.nw; if (rn_ < nrows) P3C_LD(A_, B_, G_, rn_); } \
        float ss = 0.f; \
        _Pragma("unroll") for (int i = 0; i < 8; ++i) { a[i] += b[i]; ss += a[i] * a[i]; } \
        ss += __shfl_xor(ss, 1); ss += __shfl_xor(ss, 2); ss += __shfl_xor(ss, 4); ss += __shfl_xor(ss, 8); \
        const float rinv = rsqrtf(ss * (1.f / 128.f) + EPS); float o[8]; \
        _Pragma("unroll") for (int i = 0; i < 8; ++i) o[i] = a[i] * rinv * gn[i] * silu(g[i]); \
        uint4 w; w.x = pk2(o[0], o[1]); w.y = pk2(o[2], o[3]); w.z = pk2(o[4], o[5]); w.w = pk2(o[6], o[7]); \
        if (!dry) *(uint4*)(OF + (size_t)(r_) * GW + C.lane * 8) = w; } while (0)
    if (C.gw < nrows) P3C_LD(a0, b0, g0, C.gw);
    if (C.gw + C.nw < nrows) P3C_LD(a1, b1, g1, C.gw + C.nw);
    for (int r = C.gw; r < nrows; r += 2 * C.nw) {
        P3C_DO(a0, b0, g0, r);
        const int r2 = r + C.nw;
        if (r2 < nrows) P3C_DO(a1, b1, g1, r2);
    }
#undef P3C_LD
#undef P3C_DO
}

__device__ __forceinline__ int e_of(const Ctx& C, int i) { return C.TOKE()[i]; }
__device__ __forceinline__ void p5_norm2_router(const Ctx& C, int l, bool dry = false) {
    const int nrows = (l == 0) ? TA : TL;
    uint2 nx[4];
#pragma unroll
    for (int j = 0; j < 4; ++j) nx[j] = make_uint2(0u, 0u);
    if (C.gw < nrows) load_row_raw(C.XB() + (size_t)C.gw * DM, C.lane, nx);
    float* wr = (float*)C.lds;
    unsigned* lcnt = (unsigned*)(C.lds + 65536);
    for (int c = C.tid; c < 1024; c += 512) { const float4* src = (const float4*)(C.p->w_router + c * 16);
#pragma unroll
        for (int q = 0; q < 4; ++q) { const float4 w4 = src[q]; wr[(4 * q) * 1024 + c] = w4.x; wr[(4 * q + 1) * 1024 + c] = w4.y; wr[(4 * q + 2) * 1024 + c] = w4.z; wr[(4 * q + 3) * 1024 + c] = w4.w; } }
    if (C.tid < 32) lcnt[C.tid] = 0u;
    __syncthreads();
    float rb[16];
#pragma unroll
    for (int e = 0; e < 16; ++e) rb[e] = C.p->router_bias[e];
    float* lgs = (float*)(C.lds + 66048) + C.wave * 576;
    float* LM = (float*)(C.lds + 84480);
    for (int i = C.tid; i < 9 * 512; i += 512) { const int rw = i >> 9, c4 = (i & 511) * 4; *(float4*)(LM + rw * 2048 + c4) = *(const float4*)(C.MOD() + (size_t)(l * 9 + rw) * INW + 3072 + c4); }
    if (C.tid < 256) *(float4*)(LM + 9 * 2048 + C.tid * 4) = *(const float4*)(C.p->norm2_g + l * DM + C.tid * 4);
    __syncthreads();
    int rslot = 0;
    for (int r = C.gw; r < nrows; r += C.nw) {
        float v[16], h[16];
        unpack_row(nx, v);
        { const int rn = r + C.nw; if (rn < nrows) load_row_raw(C.XB() + (size_t)rn * DM, C.lane, nx); }
        const float rinv = row_rinv(v);
        const float* mod = LM + modrow_of(r) * 2048;
        norm_mod(v, rinv, LM + 9 * 2048, mod + 1024, mod, C.lane, h);
        if (!dry) store_row_bf16(C.H() + (size_t)r * DM, C.lane, h);
        float acc[16];
#pragma unroll
        for (int e = 0; e < 16; ++e) acc[e] = 0.f;
#pragma unroll
        for (int j = 0; j < 4; ++j)
#pragma unroll
            for (int e = 0; e < 16; ++e) { const float4 ww = *(const float4*)(wr + e * 1024 + j * 256 + C.lane * 4); acc[e] += h[4 * j] * ww.x + h[4 * j + 1] * ww.y + h[4 * j + 2] * ww.z + h[4 * j + 3] * ww.w; }
        float k8[8], k4[4], k2[2], k1;
        { const bool b5 = (C.lane & 32) != 0, b4 = (C.lane & 16) != 0, b3 = (C.lane & 8) != 0, b2 = (C.lane & 4) != 0;
#pragma unroll
          for (int i = 0; i < 8; ++i) { const float snd = b5 ? acc[i] : acc[i + 8], kp_ = b5 ? acc[i + 8] : acc[i]; k8[i] = kp_ + __shfl_xor(snd, 32); }
#pragma unroll
          for (int i = 0; i < 4; ++i) { const float snd = b4 ? k8[i] : k8[i + 4], kp_ = b4 ? k8[i + 4] : k8[i]; k4[i] = kp_ + __shfl_xor(snd, 16); }
#pragma unroll
          for (int i = 0; i < 2; ++i) { const float snd = b3 ? k4[i] : k4[i + 2], kp_ = b3 ? k4[i + 2] : k4[i]; k2[i] = kp_ + __shfl_xor(snd, 8); }
          { const float snd = b2 ? k2[0] : k2[1], kp_ = b2 ? k2[1] : k2[0]; k1 = kp_ + __shfl_xor(snd, 4); }
          k1 += __shfl_xor(k1, 2); k1 += __shfl_xor(k1, 1); }
        if ((C.lane & 3) == 0) lgs[rslot * 16 + (C.lane >> 2)] = k1;
        ++rslot;
    }
    { const int r = C.gw + C.lane * C.nw;
      if (C.lane < rslot && r < nrows) {
        float lg[16];
#pragma unroll
        for (int q = 0; q < 4; ++q) { const float4 t = *(const float4*)(lgs + C.lane * 16 + 4 * q); lg[4 * q] = t.x; lg[4 * q + 1] = t.y; lg[4 * q + 2] = t.z; lg[4 * q + 3] = t.w; }
        float bestg = -1e30f; int e0 = 0, e1 = 1; float s0 = 0.f, s1 = 0.f;
#pragma unroll
        for (int g = 0; g < 4; ++g) {
            float sc[4], gbv[4];
#pragma unroll
            for (int j = 0; j < 4; ++j) { sc[j] = __builtin_amdgcn_rcpf(1.f + __expf(-lg[4 * g + j])); gbv[j] = sc[j] + rb[4 * g + j]; }
            int i0 = 0; float b0 = gbv[0], u0 = sc[0];
#pragma unroll
            for (int j = 1; j < 4; ++j) if (gbv[j] > b0) { b0 = gbv[j]; i0 = j; u0 = sc[j]; }
            int i1 = -1; float b1 = -1e30f, u1 = 0.f;
#pragma unroll
            for (int j = 0; j < 4; ++j) if (j != i0 && gbv[j] > b1) { b1 = gbv[j]; i1 = j; u1 = sc[j]; }
            const float gs = b0 + b1;
            if (gs > bestg) { bestg = gs; e0 = 4 * g + i0; e1 = 4 * g + i1; s0 = u0; s1 = u1; }
        }
        if (!dry) {
            const float den = s0 + s1;
            const int r0 = (int)atomicAdd(lcnt + e0, 1u), r1 = (int)atomicAdd(lcnt + e1, 1u);
            C.TOKE()[2 * r] = e0; C.TOKE()[2 * r + 1] = e1; C.TOKW()[2 * r] = s0 / den; C.TOKW()[2 * r + 1] = s1 / den; C.TOKS()[2 * r] = r0; C.TOKS()[2 * r + 1] = r1;
        }
      } }
    __syncthreads();
    if (C.tid < 16 && !dry) lcnt[16 + C.tid] = atomicAdd(C.CNT(l) + C.tid, lcnt[C.tid]);
    __syncthreads();
    { const int r = C.gw + C.lane * C.nw; if (!dry && C.lane < rslot && r < nrows) {
#pragma unroll
        for (int k = 0; k < 2; ++k) { const int e = e_of(C, 2 * r + k), gk = C.TOKS()[2 * r + k] + (int)lcnt[16 + e]; C.TOKS()[2 * r + k] = gk;
            C.S2T()[(size_t)e * S2T_CAP + (gk >> 8) * 256 + (gk & 63) * 4 + ((gk & 255) >> 6)] = r; } } }
    __syncthreads();
}

__device__ __forceinline__ int slot_of(const Ctx& C, int i) { return C.TAB()[C.TOKE()[i]] * 256 + C.TOKS()[i]; }
__device__ __forceinline__ void p9_combine(const Ctx& C, int l, bool dry = false) {
    moe_table(C, l);
    const int nrows = (l == 0) ? TA : TL; const bf16* YS = C.XS();
    uint2 nx[4], nya[4], nyb[4]; float nw0 = 0.f, nw1 = 0.f; int ns0 = 0, ns1 = 0;
#pragma unroll
    for (int j = 0; j < 4; ++j) { nya[j] = make_uint2(0u, 0u); nyb[j] = nya[j]; nx[j] = nya[j]; }
    if (C.gw < nrows) { const int r = C.gw; load_row_raw(C.XB() + (size_t)r * DM, C.lane, nx);
        const int s0 = slot_of(C, 2 * r), s1 = slot_of(C, 2 * r + 1); nw0 = C.TOKW()[2 * r]; nw1 = C.TOKW()[2 * r + 1];
#pragma unroll
        for (int j = 0; j < 4; ++j) { const int c = j * 256 + C.lane * 4; nya[j] = *(const uint2*)(YS + (size_t)s0 * DM + c); nyb[j] = *(const uint2*)(YS + (size_t)s1 * DM + c); }
        if (r + C.nw < nrows) { ns0 = slot_of(C, 2 * (r + C.nw)); ns1 = slot_of(C, 2 * (r + C.nw) + 1); } }
    float* LG = (float*)C.lds; float* LN = LG + 9 * 1024; float* LGAM = LN + (l == 0 ? 9 * 2048 : 0);
    for (int i = C.tid; i < 9 * 256; i += 512) { const int rw = i >> 8, c4 = (i & 255) * 4; *(float4*)(LG + rw * 1024 + c4) = *(const float4*)(C.MOD() + (size_t)(l * 9 + rw) * INW + 5120 + c4); }
    if (l == 0) for (int i = C.tid; i < 9 * 512; i += 512) { const int rw = i >> 9, c4 = (i & 511) * 4; *(float4*)(LN + rw * 2048 + c4) = *(const float4*)(C.MOD() + (size_t)(9 + rw) * INW + c4); }
    if (C.tid < 256) *(float4*)(LGAM + C.tid * 4) = *(const float4*)((l == 0 ? C.p->norm1_g + DM : C.p->final_g) + C.tid * 4);
    __syncthreads();
    for (int r = C.gw; r < nrows; r += C.nw) {
        float v[16]; uint2 ya[4], yb[4]; const float w0 = nw0, w1 = nw1;
        unpack_row(nx, v);
#pragma unroll
        for (int j = 0; j < 4; ++j) { ya[j] = nya[j]; yb[j] = nyb[j]; }
        { const int rn = r + C.nw; if (rn < nrows) { load_row_raw(C.XB() + (size_t)rn * DM, C.lane, nx);
            nw0 = C.TOKW()[2 * rn]; nw1 = C.TOKW()[2 * rn + 1];
#pragma unroll
            for (int j = 0; j < 4; ++j) { const int c = j * 256 + C.lane * 4; nya[j] = *(const uint2*)(YS + (size_t)ns0 * DM + c); nyb[j] = *(const uint2*)(YS + (size_t)ns1 * DM + c); }
            const int rnn = rn + C.nw; if (rnn < nrows) { ns0 = slot_of(C, 2 * rnn); ns1 = slot_of(C, 2 * rnn + 1); } } }
        const float* gate = LG + modrow_of(r) * 1024;
#pragma unroll
        for (int j = 0; j < 4; ++j) { const int c = j * 256 + C.lane * 4; const uint2 a = ya[j], b = yb[j]; const float4 g = *(const float4*)(gate + c);
            v[4 * j] += g.x * (w0 * bflo(a.x) + w1 * bflo(b.x)); v[4 * j + 1] += g.y * (w0 * bfhi(a.x) + w1 * bfhi(b.x));
            v[4 * j + 2] += g.z * (w0 * bflo(a.y) + w1 * bflo(b.y)); v[4 * j + 3] += g.w * (w0 * bfhi(a.y) + w1 * bfhi(b.y)); }
        const float rinv = row_rinv(v);
        if (l == 0) {
            if (!dry) store_row_bf16(C.XB() + (size_t)r * DM, C.lane, v);
            float h[16]; const float* mod1 = LN + modrow_of(r) * 2048;
            norm_mod(v, rinv, LGAM, mod1 + 1024, mod1, C.lane, h);
            if (!dry) store_row_bf16(C.H() + (size_t)r * DM, C.lane, h);
        } else {
#pragma unroll
            for (int j = 0; j < 4; ++j) { const int c = j * 256 + C.lane * 4; const float4 g = *(const float4*)(LGAM + c);
                if (!dry) *(float4*)(C.p->out + (size_t)r * DM + c) = make_float4(v[4 * j] * rinv * g.x, v[4 * j + 1] * rinv * g.y, v[4 * j + 2] * rinv * g.z, v[4 * j + 3] * rinv * g.w); }
        }
    }
}


__device__ __forceinline__ void stagger(int bid, unsigned ticks) {
    const unsigned long long t0 = __builtin_amdgcn_s_memrealtime(); const unsigned long long want = (unsigned long long)((unsigned)(bid >> 6) * ticks);
    while (__builtin_amdgcn_s_memrealtime() - t0 < want) __builtin_amdgcn_s_sleep(4);
}
#ifndef PHMASK
#define PHMASK 0xFFFFu
#endif
#define PHON(i) (((PHMASK) >> (i)) & 1u)
#ifndef SCANFN
#define SCANFN p3_scan6
#endif
#ifdef USE_VCU
#define MOE_VCU(C) (((C).G % 8 == 0) ? ((C).bid % 8) * ((C).G / 8) + (C).bid / 8 : (C).bid)
#else
#define MOE_VCU(C) ((C).bid)
#endif
#ifndef MOE_ALIGN
#define MOE_ALIGN true
#endif
#ifndef P2_ALIGN
#define P2_ALIGN false
#endif
#ifndef GEMM_ALIGN
#define GEMM_ALIGN true
#endif
#ifndef P2_SP2
#define P2_SP2 true
#endif
#ifndef STAGGER_P2
#define STAGGER_P2 0
#endif
constexpr int NPH = 20;
__global__ void __launch_bounds__(512, 2) mk_fwd(Params p) {
    extern __shared__ __attribute__((aligned(16))) unsigned char lds_raw[];
    LAS unsigned char* ldsl = (LAS unsigned char*)lds_raw;
    const int wv_ = __builtin_amdgcn_readfirstlane((int)threadIdx.x >> 6);
    if (threadIdx.x < 128) ((LAS unsigned*)(ldsl + LDS_STAGE))[threadIdx.x] = 0u;
    __syncthreads();
    XcdBarrier bar = xcd_barrier_post((unsigned*)(p.ws + WS_CTL) + CW_BAR + p.li * XCD_BAR_WORDS, (volatile LAS unsigned*)(ldsl + LDS_STAGE) + LDSW_BAR, wv_ == 0 ? 1u : 0u);
#define MKCTX() Ctx C; { unsigned long long kp_ = (unsigned long long)__builtin_amdgcn_kernarg_segment_ptr(); asm volatile("" : "+s"(kp_)); C.p.q = (ParamsK)kp_; } \
    C.ws = C.p->ws; C.lds = lds_raw; { unsigned z_ = 0u; asm volatile("" : "+s"(z_)); int t_ = wv_ * 64 + (int)__builtin_amdgcn_mbcnt_hi(~0u, __builtin_amdgcn_mbcnt_lo(~0u, z_)), g_ = gridDim.x, b_ = blockIdx.x; asm volatile("" : "+v"(t_), "+s"(g_), "+s"(b_)); C.tid = t_; C.G = g_; C.bid = b_; } \
    C.lane = C.tid & 63; C.wave = __builtin_amdgcn_readfirstlane(C.tid >> 6); C.gw = C.bid * 8 + C.wave; C.nw = C.G * 8; C.rep = rep_;
    const int lo = p.lo, hi = p.hi;
#define IN(k) (lo <= (k) && (k) < hi)
#ifdef PROBE_BAR
#define SEAM(k) do { if (IN((k) + 1)) { xcd_barrier(bar); xcd_barrier(bar); xcd_barrier(bar); } } while (0)
#else
#define SEAM(k) do { if (IN((k) + 1)) xcd_barrier(bar); } while (0)
#endif

#ifdef PROBE_FWD2
    for (int rep_ = 0; rep_ < 2 + p.pad; ++rep_) {
#else
    const int rep_ = 0; {
#endif
    if (PHON(0) && IN(0)) { MKCTX(); p0_prologue(C);
#ifdef PROBE_P0
        __syncthreads(); p0_prologue(C);
#endif
        SEAM(0); }
    if (PHON(1) && IN(1)) { MKCTX(); p1_norm1(C, 0, C.p->x, C.p->ctx);
#ifdef PROBE_P1
        for (int rep = 0; rep < 4 + C.p->pad; ++rep) p1_norm1(C, 0, C.p->x, C.p->ctx);
#endif
        SEAM(1); }
    for (int l = 0; l < 2; ++l) {
        const int pb = 2 + 9 * l;
        const int mrows = (l == 0) ? TA : TL;
        if (PHON(2) && IN(pb + 0)) {
            MKCTX();
            pg8::Gemm g{C.H(), C.WIN_T(), TA, INW, DM}; pg8::StaticOrder S; S.init(TA, INW, C.G, C.bid);
            EpiInProj E{C.GRP(0), C.ROPE(), C.LB() + l * 1024, 0};
#if STAGGER_P2 > 0
            stagger(C.bid, STAGGER_P2);
#endif
            pg8::gemm_phase<EpiInProj, pg8::StaticOrder, P2_ALIGN, P2_SP2>(ldsl, g, S, E, C.tid);
#ifdef PROBE_P2
            __syncthreads(); pg8::gemm_phase<EpiInProj, pg8::StaticOrder, P2_ALIGN, P2_SP2>(ldsl, g, S, E, C.tid);
#endif
#ifdef PROBE_P2DRY
            { __syncthreads(); EpiInProj E2 = E; E2.dry = 1 - C.p->pad; pg8::gemm_phase<EpiInProj, pg8::StaticOrder, P2_ALIGN, P2_SP2>(ldsl, g, S, E2, C.tid); }
#endif
            SEAM(pb + 0);
        }
        if (PHON(3) && IN(pb + 1)) {
            MKCTX();
#ifndef NO_SCAN
#ifdef PROBE_SCAN2
            for (int rep = 0; rep < 2 + C.p->pad; ++rep) SCANFN(C, l);
#else
            SCANFN(C, l);
#endif
#endif
#ifdef PROBE_ATTN2
            p3_attn(C, l, C.p->pad == 0);
#endif
#ifdef PROBE_ATTN3
            for (int rep = 0; rep < 2 + C.p->pad; ++rep) { p3_attn2(C, l, rep == 0); __syncthreads(); }
#else
#ifndef NO_ATTN
            p3_attn2(C, l);
#endif
#endif
            SEAM(pb + 1);
        }
        if (PHON(4) && IN(pb + 2)) { MKCTX();
#ifdef PROBE_P3C
            for (int rep = 0; rep < 4 + C.p->pad; ++rep) p3c_headnorm(C, l, C.p->pad == 0);
#endif
            p3c_headnorm(C, l); SEAM(pb + 2); }
        if (PHON(5) && IN(pb + 3)) {
            MKCTX();
            pg8::StaticOrder S; S.init(mrows, DM, C.G, C.bid);
            { pg8::Gemm g{C.GRP(0), C.WNA_T(), mrows, DM, 512}; EpiMerge<0> E{C.MB(), C.GRP(8)}; pg8::gemm_phase<EpiMerge<0>, pg8::StaticOrder, GEMM_ALIGN, true>(ldsl, g, S, E, C.tid); }
#ifdef PROBE_P4A
            __syncthreads();
            { pg8::Gemm g{C.GRP(0), C.WNA_T(), mrows, DM, 512}; EpiMerge<0> E{C.MB(), C.GRP(8)}; pg8::gemm_phase<EpiMerge<0>, pg8::StaticOrder, GEMM_ALIGN, true>(ldsl, g, S, E, C.tid); }
#endif
            __syncthreads();
            { pg8::Gemm g{C.H(), C.WHG_T(), mrows, DM, 512}; EpiMerge<1> E{C.MB(), C.GRP(10)}; pg8::gemm_phase<EpiMerge<1>, pg8::StaticOrder, GEMM_ALIGN, true>(ldsl, g, S, E, C.tid); }
            if (l == 0) conv_experts(C, 1, 32);
            SEAM(pb + 3);
        }
        if (PHON(6) && IN(pb + 4)) {
            MKCTX();
            pg8::StaticOrder S; S.init(mrows, DM, C.G, C.bid);
            pg8::Gemm g{C.MB(), C.WOUT_T(), mrows, DM, DM};
            if (l == 0) { EpiOut<true> E{C.p->x, C.p->ctx, C.XB(), C.MOD(), 0}; pg8::gemm_phase<EpiOut<true>, pg8::StaticOrder, GEMM_ALIGN, true>(ldsl, g, S, E, C.tid); }
            else { EpiOut<false> E{nullptr, nullptr, C.XB(), C.MOD() + (size_t)9 * INW, 0};
#ifdef PROBE_P4B
                { EpiOut<false> E2 = E; E2.dry = 1 - C.p->pad; pg8::gemm_phase<EpiOut<false>, pg8::StaticOrder, GEMM_ALIGN, true>(ldsl, g, S, E2, C.tid); __syncthreads(); }
#endif
                pg8::gemm_phase<EpiOut<false>, pg8::StaticOrder, GEMM_ALIGN, true>(ldsl, g, S, E, C.tid); }
            if (l == 0) conv_experts(C, 0, 32);
#ifdef PROBE_CONVX
            for (int rep = 0; rep < 1 + C.p->pad; ++rep) conv_experts(C, l, 0);
#endif
            SEAM(pb + 4);
        }
        if (PHON(7) && IN(pb + 5)) { MKCTX();
#ifdef PROBE_P5
            for (int rep = 0; rep < 4 + C.p->pad; ++rep) p5_norm2_router(C, l, C.p->pad == 0);
#endif
            p5_norm2_router(C, l); SEAM(pb + 5); }
        if (PHON(9) && IN(pb + 6)) {
            MKCTX();
            moe_table(C, l);
            MoeOrderG S{C.TAB(), C.S2T(), C.G, MOE_VCU(C)};
            pg8::Gemm g{C.H(), C.WEGU(l), TA, 16384, DM}; EpiGateUp E{C.ACT()};
            pg8::gemm_phase<EpiGateUp, MoeOrderG, MOE_ALIGN, true>(ldsl, g, S, E, C.tid);
#ifdef PROBE_P7
            __syncthreads(); pg8::gemm_phase<EpiGateUp, MoeOrderG, MOE_ALIGN, true>(ldsl, g, S, E, C.tid);
#endif
            SEAM(pb + 6);
        }
        if (PHON(10) && IN(pb + 7)) {
            MKCTX();
            moe_table(C, l);
            MoeOrder S{C.TAB(), C.G, MOE_VCU(C)};
            pg8::Gemm g{C.ACT(), C.WED(l), SLOT_ROWS, 16384, 512}; EpiDown E{C.XS(), 0};
#ifdef PROBE_P8DRY
            { EpiDown E2{C.XS(), 1 - C.p->pad}; pg8::gemm_phase<EpiDown, MoeOrder, MOE_ALIGN, true>(ldsl, g, S, E2, C.tid); __syncthreads(); }
#endif
            pg8::gemm_phase<EpiDown, MoeOrder, MOE_ALIGN, true>(ldsl, g, S, E, C.tid);
#ifdef PROBE_P8
            __syncthreads(); pg8::gemm_phase<EpiDown, MoeOrder, MOE_ALIGN, true>(ldsl, g, S, E, C.tid);
#endif
            SEAM(pb + 7);
        }
        if (PHON(11) && IN(pb + 8)) { MKCTX();
#ifdef PROBE_P9
            for (int rep = 0; rep < 4 + C.p->pad; ++rep) p9_combine(C, l, C.p->pad == 0);
#endif
            p9_combine(C, l); if (l == 0) conv_mixer(C, 1); SEAM(pb + 8); }
    }
#ifdef PROBE_FWD2
    if (rep_ == 0) xcd_barrier(bar);
#endif
    }
#undef IN
#undef SEAM
}

#ifndef MK_SPLIT
#define MK_SPLIT 0
#endif
extern "C" void kernel_launch(void* const* d_in, const int* in_sizes, int n_in, void* d_out, int out_size, void* d_ws, size_t ws_size, hipStream_t stream) {
    static int grid = 0;
    if (grid == 0) {
        if (n_in != 22 || ws_size < WS_END) { fprintf(stderr, "kernel_launch: unexpected n_in %d / ws_size %zu (need %zu)\n", n_in, ws_size, (size_t)WS_END); grid = -1; return; }
        int dev = 0, cus = 0, per_cu = 0;
        if (hipGetDevice(&dev) != hipSuccess || hipDeviceGetAttribute(&cus, hipDeviceAttributeMultiprocessorCount, dev) != hipSuccess) { grid = -1; return; }
        if (hipFuncSetAttribute((const void*)mk_fwd, hipFuncAttributeMaxDynamicSharedMemorySize, LDS_BYTES) != hipSuccess) { fprintf(stderr, "kernel_launch: hipFuncSetAttribute failed\n"); grid = -1; return; }
        if (hipOccupancyMaxActiveBlocksPerMultiprocessor(&per_cu, (const void*)mk_fwd, 512, LDS_BYTES) != hipSuccess || per_cu < 1) fprintf(stderr, "kernel_launch: occupancy query says %d\n", per_cu);
        (void)hipGetLastError();
        grid = cus;
    }
    if (grid < 0) return;
    if (hipMemsetAsync((char*)d_ws + WS_CTL, 0, CTL_BYTES, stream) != hipSuccess) return;
    Params p{};
    const float** pp = (const float**)&p;
    for (int i = 0; i < 22; ++i) pp[i] = (const float*)d_in[i];
    p.out = (float*)d_out; p.ws = (unsigned char*)d_ws; p.pad = 0;
#if MK_SPLIT
    for (int k = 0; k < NPH; ++k) { p.lo = k; p.hi = k + 1; p.li = k; hipLaunchKernelGGL(mk_fwd, dim3(grid), dim3(512), LDS_BYTES, stream, p); }
#else
    p.lo = 0; p.hi = NPH; p.li = 0;
    hipLaunchKernelGGL(mk_fwd, dim3(grid), dim3(512), LDS_BYTES, stream, p);
#endif
}
```

```cpp
#include <hip/hip_runtime.h>
#include <cstdio>
#include <cstdint>
namespace pg8 {
#define PG8_LAS __attribute__((address_space(3)))
typedef unsigned short bf16_t;
typedef short bf16x8 __attribute__((ext_vector_type(8)));
typedef float f32x4 __attribute__((ext_vector_type(4)));
typedef unsigned u32x4 __attribute__((ext_vector_type(4)));
constexpr int BM = 256, BK = 64, HALF = 128, HTB = HALF * BK * 2  , STAGE_BYTES = 8 * HTB, NXCD = 8, WGM = 8;

__host__ __device__ __forceinline__ int lds_byte(int r, int c) { const int st = (r >> 4) * 2 + (c >> 5), rr = r & 15, cc = c & 31, ob = rr * 64 + cc * 2; return st * 1024 + (ob ^ (((ob >> 9) & 1) << 5)); }
__host__ __device__ __forceinline__ void stage_rc(int b, int& R, int& C) { const int st = b / 1024, sb = b % 1024, swz = sb ^ (((sb >> 9) & 1) << 5); R = (st >> 1) * 16 + swz / 64; C = (st & 1) * 32 + (swz % 64) / 2; }
__host__ __device__ __forceinline__ int perm32(int rho) { const int n = rho >> 4, i = rho & 15; return 8 * (i >> 2) + 4 * n + (i & 3); }

struct Unit { int pm, pn; };
struct Gemm { const bf16_t* A; const bf16_t* Bt; int M, N, K; };

struct StaticOrder {
    static constexpr bool GATHER = false;
    int nM, nN, nwg, G, c;
    __host__ __device__ void init(int M, int N, int G_, int c_) { nM = M / BM; nN = N / BM; nwg = nM * nN; G = G_; c = c_; }
    __host__ __device__ bool next(int i, Unit& u) const {
        const long L = (long)i * G + c; if (L >= nwg) return false;
        int wgid = (int)L; { const int q = nwg / NXCD, r = nwg % NXCD, xcd = wgid % NXCD, off = wgid / NXCD; wgid = (xcd < r ? xcd * (q + 1) : r * (q + 1) + (xcd - r) * q) + off; }
        const int nig = WGM * nN, gid = wgid / nig, fm = gid * WGM, gsz = (nM - fm) < WGM ? (nM - fm) : WGM;
        u.pm = fm + ((wgid % nig) % gsz); u.pn = (wgid % nig) / gsz; return true;
    }
    __device__ __forceinline__ void a_ready(const Unit&) const {}
    __device__ __forceinline__ void done(const Unit&) const {}
};

typedef float f32x2_t __attribute__((ext_vector_type(2))); typedef __bf16 bf16x2_t __attribute__((ext_vector_type(2)));
__device__ __forceinline__ unsigned cvt_pk_bf16(float lo, float hi) { f32x2_t v = {lo, hi}; bf16x2_t b = __builtin_convertvector(v, bf16x2_t); return __builtin_bit_cast(unsigned, b); }
template <int NR> __device__ __forceinline__ void wait_vm_sel(int flag) { asm volatile("s_cmp_lg_u32 %0, 0\n\ts_cbranch_scc1 1f\n\ts_waitcnt vmcnt(8)\n\ts_branch 2f\n1:\n\ts_waitcnt vmcnt(%1)\n2:" :: "s"(flag), "n"(NR) : "memory", "scc"); }
template <class Epi, class Sched, bool ALIGN_EPI = false, bool SP2 = false>
__device__ __forceinline__ void gemm_phase(PG8_LAS unsigned char* lds, const Gemm g, const Sched& S, const Epi& E, int tid_in) {
    int tid_ = tid_in; asm volatile("" : "+v"(tid_));
    const int tid = tid_, wid = __builtin_amdgcn_readfirstlane(tid >> 6), lane = tid & 63, wr = wid >> 2, wc = wid & 3, fr = lane & 15, fq = lane >> 4;
    const int K = g.K, nt = K / BK;
    unsigned voffA[2], voffB[2];
#pragma unroll
    for (int i = 0; i < 2; ++i) { int R, C; stage_rc(tid * 16 + i * 8192, R, C); const int Rb = Epi::PERM ? ((R & ~31) + perm32(R & 31)) : R;
        voffA[i] = (unsigned)(R * K + C) * 2u; voffB[i] = (unsigned)(Rb * K + C) * 2u; }
    constexpr bool GATHER = Sched::GATHER;
    static_assert(!GATHER || SP2, "row gather is wired into the SP2 loop only");
    unsigned gA0[2] = {0u, 0u}, gA1[2] = {0u, 0u}, nG[4] = {0u, 0u, 0u, 0u}; int gR0 = 0; unsigned gC2 = 0u;
    if constexpr (GATHER) { int R, C; stage_rc(tid * 16, R, C); gR0 = R; gC2 = (unsigned)C * 2u; }
#define PG8_VA0 (GATHER ? gA0 : voffA)
#define PG8_VA1 (GATHER ? gA1 : voffA)
    const size_t kstep = (size_t)(BK * 2);
    const size_t hstep = (size_t)HALF * K * 2;
    const size_t hA = GATHER ? 0 : hstep;
    const size_t tstep = 2 * hstep;
    const unsigned ldsw = (unsigned)wid * 1024u;
    const int aoff = lds_byte(wr * 64 + fr, fq * 8), boff = lds_byte(wc * 32 + fr, fq * 8);
#define PG8_SA(b, h) (((b) * 2 + (h)) * HTB)
#define PG8_SB(b, h) ((4 + (b) * 2 + (h)) * HTB)
#define PG8_STAGE(bufoff, gbase, voff) do { _Pragma("unroll") for (int _i = 0; _i < 2; ++_i) \
        __builtin_amdgcn_global_load_lds((const unsigned*)((const char*)(gbase) + (voff)[_i]), (PG8_LAS unsigned*)(lds + (bufoff) + ldsw + _i * 8192), 16, 0, 0); } while (0)
#define PG8_LDA(dst, b, h) do { _Pragma("unroll") for (int m = 0; m < 4; ++m) _Pragma("unroll") for (int k = 0; k < 2; ++k) dst[m][k] = *(const PG8_LAS bf16x8*)(lds + PG8_SA(b, h) + aoff + m * 2048 + k * 1024); } while (0)
#define PG8_LDB(dst, b, h) do { _Pragma("unroll") for (int n = 0; n < 2; ++n) _Pragma("unroll") for (int k = 0; k < 2; ++k) dst[n][k] = *(const PG8_LAS bf16x8*)(lds + PG8_SB(b, h) + boff + n * 2048 + k * 1024); } while (0)
#define PG8_MMA(ai, bj, At, Bt) do { __builtin_amdgcn_s_setprio(1); _Pragma("unroll") for (int m = 0; m < 4; ++m) _Pragma("unroll") for (int n = 0; n < 2; ++n) _Pragma("unroll") for (int k = 0; k < 2; ++k) \
        acc[ai][bj][m][n] = __builtin_amdgcn_mfma_f32_16x16x32_bf16(Bt[n][k], At[m][k], acc[ai][bj][m][n], 0, 0, 0); __builtin_amdgcn_s_setprio(0); } while (0)
#define PG8_WAIT_V(n) asm volatile("s_waitcnt vmcnt(" #n ")" ::: "memory")
#define PG8_WAIT_L(n) asm volatile("s_waitcnt lgkmcnt(" #n ")" ::: "memory")
#define PG8_BAR __builtin_amdgcn_s_barrier()
#define PG8_SCHED __builtin_amdgcn_sched_barrier(0)
    Unit cur, nxt; int ui = 0; bool relax = false;
    if (!S.next(0, cur)) return;
    f32x4 acc[2][2][4][2];
#pragma unroll
    for (int a = 0; a < 2; ++a)
#pragma unroll
        for (int b = 0; b < 2; ++b)
#pragma unroll
            for (int m = 0; m < 4; ++m)
#pragma unroll
                for (int n = 0; n < 2; ++n) acc[a][b][m][n] = (f32x4){0.f, 0.f, 0.f, 0.f};
    bf16x8 At[4][2], B0[2][2], B1[2][2];
    const char* cA = (const char*)g.A + (GATHER ? (size_t)0 : (size_t)cur.pm * tstep); const char* cB = (const char*)g.Bt + (size_t)cur.pn * tstep;
    if constexpr (GATHER) { int ix[4]; S.gather4(cur, gR0, ix); const unsigned rb = (unsigned)K * 2u; gA0[0] = (unsigned)ix[0] * rb + gC2; gA0[1] = (unsigned)ix[1] * rb + gC2; gA1[0] = (unsigned)ix[2] * rb + gC2; gA1[1] = (unsigned)ix[3] * rb + gC2; }
    S.a_ready(cur);
    if constexpr (SP2) {
        PG8_STAGE(PG8_SB(0, 0), cB, voffB); PG8_STAGE(PG8_SB(0, 1), cB + hstep, voffB); PG8_STAGE(PG8_SA(0, 0), cA, PG8_VA0); PG8_STAGE(PG8_SA(0, 1), cA + hA, PG8_VA1);
        if (wr == 1) PG8_BAR;
        PG8_WAIT_V(2); PG8_BAR;
        PG8_STAGE(PG8_SB(1, 0), cB + kstep, voffB); PG8_STAGE(PG8_SA(1, 0), cA + kstep, PG8_VA0); PG8_STAGE(PG8_SB(1, 1), cB + hstep + kstep, voffB);
        PG8_WAIT_V(6); PG8_BAR;
    } else {
        PG8_STAGE(PG8_SB(0, 0), cB, voffB); PG8_STAGE(PG8_SA(0, 0), cA, voffA); PG8_STAGE(PG8_SB(0, 1), cB + hstep, voffB); PG8_STAGE(PG8_SA(0, 1), cA + hstep, voffA);
        if (wr == 1) PG8_BAR;
        PG8_WAIT_V(4); PG8_BAR;
        PG8_STAGE(PG8_SB(1, 0), cB + kstep, voffB); PG8_STAGE(PG8_SA(1, 0), cA + kstep, voffA); PG8_STAGE(PG8_SB(1, 1), cB + hstep + kstep, voffB);
        PG8_WAIT_V(6); PG8_BAR;
    }
    for (;;) {
        const bool has_next = S.next(ui + 1, nxt);
        const char* nA = has_next ? (const char*)g.A + (GATHER ? (size_t)0 : (size_t)nxt.pm * tstep) : cA; const char* nB = has_next ? (const char*)g.Bt + (size_t)nxt.pn * tstep : cB;
        if constexpr (GATHER) { if (has_next) { int ix[4]; S.gather4(nxt, gR0, ix); const unsigned rb = (unsigned)K * 2u; nG[0] = (unsigned)ix[0] * rb; nG[1] = (unsigned)ix[1] * rb; nG[2] = (unsigned)ix[2] * rb; nG[3] = (unsigned)ix[3] * rb; } }
        for (int t = 0; t < nt; t += 2) {
            const bool last = (t == nt - 2);
            const char* a1 = cA + (size_t)(t + 1) * kstep;
            const char* a2 = last ? nA : cA + (size_t)(t + 2) * kstep; const char* b2 = last ? nB : cB + (size_t)(t + 2) * kstep;
            const char* a3 = a2 + kstep; const char* b3 = b2 + kstep;
            if (last && has_next) S.a_ready(nxt);
            if constexpr (SP2) {
            PG8_LDB(B0, 0, 0); PG8_LDB(B1, 0, 1); PG8_SCHED; PG8_LDA(At, 0, 0);
            if constexpr (GATHER) { if (last && has_next) { gA0[0] = nG[0] + gC2; gA0[1] = nG[1] + gC2; } }
            PG8_STAGE(PG8_SA(1, 1), a1 + hA, PG8_VA1);
            if constexpr (GATHER) { if (last && has_next) { gA1[0] = nG[2] + gC2; gA1[1] = nG[3] + gC2; } }
            if constexpr (Epi::NST > 0) wait_vm_sel<8 + Epi::NST>(__builtin_amdgcn_readfirstlane((relax && t == 0) ? 1 : 0)); else PG8_WAIT_V(8);
            PG8_WAIT_L(0); PG8_BAR; PG8_MMA(0, 0, At, B0); PG8_MMA(0, 1, At, B1); PG8_BAR; PG8_SCHED;
            PG8_LDA(At, 0, 1); PG8_STAGE(PG8_SB(0, 0), b2, voffB); PG8_STAGE(PG8_SB(0, 1), b2 + hstep, voffB); PG8_STAGE(PG8_SA(0, 0), a2, PG8_VA0);
            if constexpr (Epi::NST > 0) wait_vm_sel<8 + Epi::NST>(__builtin_amdgcn_readfirstlane((relax && t == 0) ? 1 : 0)); else PG8_WAIT_V(8);
            PG8_WAIT_L(0); PG8_BAR; PG8_MMA(1, 0, At, B0); PG8_MMA(1, 1, At, B1); PG8_BAR; PG8_SCHED;
            PG8_LDB(B0, 1, 0); PG8_LDB(B1, 1, 1); PG8_SCHED; PG8_LDA(At, 1, 0); PG8_STAGE(PG8_SA(0, 1), a2 + hA, PG8_VA1);
            PG8_WAIT_V(8); PG8_WAIT_L(0); PG8_BAR; PG8_MMA(0, 0, At, B0); PG8_MMA(0, 1, At, B1); PG8_BAR; PG8_SCHED;
            PG8_LDA(At, 1, 1); PG8_STAGE(PG8_SB(1, 0), b3, voffB); PG8_STAGE(PG8_SB(1, 1), b3 + hstep, voffB); PG8_STAGE(PG8_SA(1, 0), a3, PG8_VA0);
            PG8_WAIT_V(8); PG8_WAIT_L(0); PG8_BAR; PG8_MMA(1, 0, At, B0); PG8_MMA(1, 1, At, B1); PG8_BAR; PG8_SCHED;
            } else {
            PG8_LDB(B0, 0, 0); PG8_SCHED; PG8_LDA(At, 0, 0); PG8_STAGE(PG8_SA(1, 1), a1 + hstep, voffA);
            PG8_WAIT_L(8); PG8_BAR; PG8_WAIT_L(0); PG8_MMA(0, 0, At, B0); PG8_BAR; PG8_SCHED;
            PG8_LDB(B1, 0, 1); PG8_STAGE(PG8_SB(0, 0), b2, voffB);
            PG8_BAR; PG8_WAIT_L(0); PG8_MMA(0, 1, At, B1); PG8_BAR;
            PG8_LDA(At, 0, 1); PG8_STAGE(PG8_SA(0, 0), a2, voffA);
            PG8_BAR; PG8_WAIT_L(0); PG8_MMA(1, 0, At, B0); PG8_BAR; PG8_SCHED;
            PG8_STAGE(PG8_SB(0, 1), b2 + hstep, voffB);
            PG8_WAIT_V(6); PG8_BAR; PG8_MMA(1, 1, At, B1); PG8_BAR;
            PG8_LDB(B0, 1, 0); PG8_SCHED; PG8_LDA(At, 1, 0); PG8_STAGE(PG8_SA(0, 1), a2 + hstep, voffA);
            PG8_WAIT_L(8); PG8_BAR; PG8_WAIT_L(0); PG8_MMA(0, 0, At, B0); PG8_BAR; PG8_SCHED;
            PG8_LDB(B1, 1, 1); PG8_STAGE(PG8_SB(1, 0), b3, voffB);
            PG8_BAR; PG8_WAIT_L(0); PG8_MMA(0, 1, At, B1); PG8_BAR;
            PG8_LDA(At, 1, 1); PG8_STAGE(PG8_SA(1, 0), a3, voffA);
            PG8_BAR; PG8_WAIT_L(0); PG8_MMA(1, 0, At, B0); PG8_BAR; PG8_SCHED;
            PG8_STAGE(PG8_SB(1, 1), b3 + hstep, voffB);
            PG8_WAIT_V(6); PG8_BAR; PG8_MMA(1, 1, At, B1); PG8_BAR;
            }
        }
        if constexpr (ALIGN_EPI) { if (wr == 0) PG8_BAR; }
        if constexpr (!Epi::AFTER_DRAIN) { E(acc, cur, wr, wc, fr, fq); S.done(cur); }
        if (!has_next) break;
#pragma unroll
        for (int a = 0; a < 2; ++a)
#pragma unroll
            for (int b = 0; b < 2; ++b)
#pragma unroll
                for (int m = 0; m < 4; ++m)
#pragma unroll
                    for (int n = 0; n < 2; ++n) acc[a][b][m][n] = (f32x4){0.f, 0.f, 0.f, 0.f};
        cur = nxt; cA = nA; cB = nB; ++ui; relax = true;
        if constexpr (ALIGN_EPI) { if (wr == 1) PG8_BAR; }
    }
    PG8_WAIT_V(0);
    if constexpr (!ALIGN_EPI) { if (wr == 0) PG8_BAR; }
    PG8_BAR;
    if constexpr (Epi::AFTER_DRAIN) { E.fused(acc, cur, wr, wc, fr, fq, lds, wid, lane); S.done(cur); }
#undef PG8_VA0
#undef PG8_VA1
#undef PG8_SA
#undef PG8_SB
#undef PG8_STAGE
#undef PG8_LDA
#undef PG8_LDB
#undef PG8_MMA
#undef PG8_WAIT_V
#undef PG8_WAIT_L
#undef PG8_BAR
#undef PG8_SCHED
}
}
#define XB_TMO      128
#define XB_XCNT(j)  (256  + 64 * (j))
#define XB_XSUB(j)  (1280 + 64 * (j))
#define XB_XGEN(j)  (2304 + 64 * (j))
#define XB_TOP      3328
#define XB_TOPGEN   3392
#define XCD_BAR_WORDS 3456
#define XB_SPIN_CAP (1u << 18)
#define LAS __attribute__((address_space(3)))

__device__ __forceinline__ unsigned xb_ld(unsigned* p)              { return __hip_atomic_load(p, __ATOMIC_RELAXED, __HIP_MEMORY_SCOPE_AGENT); }
__device__ __forceinline__ unsigned xb_add(unsigned* p, unsigned v) { return __hip_atomic_fetch_add(p, v, __ATOMIC_RELAXED, __HIP_MEMORY_SCOPE_AGENT); }
__device__ __forceinline__ unsigned xb_xcc_id() { return (unsigned)__builtin_amdgcn_s_getreg((3 << 11) | 20) & 0xFu; }
#define XB_SPIN(cond, bar) do { unsigned _sp = 0; while (cond) { __builtin_amdgcn_s_sleep(1); \
    if ((++_sp & 255u) == 0u) { if (xb_ld(&(bar)[XB_TMO])) break; if (_sp > XB_SPIN_CAP) { atomicAdd(&(bar)[XB_TMO], 1u); break; } } } } while (0)

struct XcdBarrier {
    unsigned* bar; unsigned x; unsigned lead;
    volatile LAS unsigned* st;
};

__device__ __forceinline__ bool xb_t0(unsigned lead) { unsigned z = 0u; asm volatile("" : "+s"(z)); return lead != 0u && __builtin_amdgcn_mbcnt_hi(~0u, __builtin_amdgcn_mbcnt_lo(~0u, z)) == 0u; }
__device__ __forceinline__ XcdBarrier xcd_barrier_post(unsigned* bar, volatile LAS unsigned* st, unsigned lead) {
    XcdBarrier b; b.bar = bar; b.x = xb_xcc_id(); b.st = st; b.lead = lead;
    if (xb_t0(lead)) (void)xb_add(&bar[XB_XCNT(b.x)], 1u);
    return b;
}
__device__ __forceinline__ void xcd_barrier_complete(unsigned* bar, unsigned x, unsigned& nloc, unsigned& nx) {
    const unsigned G = gridDim.x * gridDim.y * gridDim.z;
    unsigned sum, cnt, mine, sp = 0u;
    for (;;) {
        sum = 0u; cnt = 0u; mine = 0u;
#pragma unroll
        for (unsigned j = 0; j < 16; ++j) { const unsigned c = xb_ld(&bar[XB_XCNT(j)]); sum += c; cnt += (c > 0u) ? 1u : 0u; mine = (j == x) ? c : mine; }
        if (sum == G) break;
        __builtin_amdgcn_s_sleep(1);
        if ((++sp & 255u) == 0u) { if (xb_ld(&bar[XB_TMO])) break; if (sp > XB_SPIN_CAP) { atomicAdd(&bar[XB_TMO], 1u); break; } }
    }
    nloc = mine > 0u ? mine : 1u; nx = cnt > 0u ? cnt : 1u;
}

__device__ __forceinline__ void xcd_barrier(const XcdBarrier& b) {
    asm volatile("s_waitcnt vmcnt(0)" ::: "memory");
    __syncthreads();
    if (xb_t0(b.lead)) {
        unsigned* bar = b.bar;
        __builtin_amdgcn_s_waitcnt(0);
        unsigned nloc = b.st[0], nx = b.st[1];
        if (nloc == 0u) { xcd_barrier_complete(bar, b.x, nloc, nx); b.st[0] = nloc; b.st[1] = nx; }
        const unsigned old = xb_add(&bar[XB_XSUB(b.x)], 1u);
        const unsigned gen = old / nloc;
        if (old + 1u == (gen + 1u) * nloc) {
            __builtin_amdgcn_fence(__ATOMIC_RELEASE, "agent");
            asm volatile("s_waitcnt vmcnt(0)" ::: "memory");
            const unsigned og = xb_add(&bar[XB_TOP], 1u);
            const unsigned tg = og / nx;
            if (og + 1u == (tg + 1u) * nx) xb_add(&bar[XB_TOPGEN], 1u);
            else XB_SPIN(xb_ld(&bar[XB_TOPGEN]) == tg, bar);
            __builtin_amdgcn_fence(__ATOMIC_ACQUIRE, "agent");
            xb_add(&bar[XB_XGEN(b.x)], 1u);
            asm volatile("s_waitcnt vmcnt(0)" ::: "memory");
        } else {
            XB_SPIN(xb_ld(&bar[XB_XGEN(b.x)]) == gen, bar);
            __builtin_amdgcn_fence(__ATOMIC_ACQUIRE, "agent");
            asm volatile("s_waitcnt vmcnt(0)" ::: "memory");
        }
    }
    __syncthreads();
}


#ifdef USE_RELAX
#define RELAX_NST(n) (n)
#else
#define RELAX_NST(n) 0
#endif
typedef unsigned short bf16;
typedef pg8::f32x4 f32x4;
typedef pg8::u32x4 u32x4;
constexpr int NB = 8, SEQ = 4096, DM = 1024, NCTX = 256;
constexpr int TL = NB * SEQ, TC = NB * NCTX, TA = TL + TC;
constexpr int INW = 6144, GW = 512, NGRP = 12;
constexpr size_t GSTRIDE = (size_t)TA * GW;
constexpr float EPS = 1e-6f;
constexpr int SLOT_ROWS = 73728;

constexpr size_t MiB = (size_t)1 << 20;
constexpr size_t WS_CTL = 0, CTL_BYTES = 1 * MiB;
constexpr size_t WS_MOD = 1 * MiB;
constexpr size_t WS_LB = 1 * MiB + 512 * 1024;
constexpr size_t WS_ROPE = 2 * MiB;
constexpr size_t WS_TOK = 3 * MiB;
constexpr size_t WS_CTXS = 4 * MiB;
constexpr size_t WS_WB = 12 * MiB;
constexpr size_t WS_H = 28 * MiB;
constexpr size_t WS_P = 96 * MiB;
constexpr size_t P_M = 34 * MiB, P_WEGU = 102 * MiB, P_WED = 134 * MiB, P_XS = 150 * MiB, P_ACT = 294 * MiB;
constexpr size_t WS_S2T = 504 * MiB;
constexpr size_t WS_END = 507 * MiB;
constexpr int S2T_CAP = 36864;
constexpr int CW_BAR = 4096, CW_CNT = 131072;

constexpr int LDS_STAGE = 163328, LDS_BYTES = 163840;
constexpr int LDSW_BAR = 0, LDSW_TAB = 64;

struct Params {
    const float* x; const float* c; const float* ctx; const float* c_ctx; const float* w_ada; const float* b_ada; const float* norm1_g; const float* w_in;
    const float* rel_bias; const float* lowf; const float* lowb; const float* hg_norm_g; const float* w_na_o; const float* w_hg_o; const float* w_out; const float* norm2_g;
    const float* w_router; const float* router_bias; const float* w_gate; const float* w_up; const float* w_down; const float* final_g;
    float* out; unsigned char* ws; int lo, hi, li, pad;
};

__device__ __forceinline__ float bf2f(unsigned b) { return __uint_as_float(b << 16); }
__device__ __forceinline__ float bflo(unsigned w) { return __uint_as_float(w << 16); }
__device__ __forceinline__ float bfhi(unsigned w) { return __uint_as_float(w & 0xffff0000u); }
__device__ __forceinline__ unsigned f2bf(float f) { unsigned u = __float_as_uint(f); u += 0x7FFFu + ((u >> 16) & 1u); return u >> 16; }
__device__ __forceinline__ unsigned pk2(float lo, float hi) { return f2bf(lo) | (f2bf(hi) << 16); }
__device__ __forceinline__ float sigm(float x) { return __builtin_amdgcn_rcpf(1.f + __expf(-x)); }
__device__ __forceinline__ float silu(float x) { return x * __builtin_amdgcn_rcpf(1.f + __expf(-x)); }
__device__ __forceinline__ float wave_sum(float v) {
#pragma unroll
    for (int o = 32; o >= 1; o >>= 1) v += __shfl_xor(v, o);
    return v; }
__device__ __forceinline__ float wave_max(float v) {
#pragma unroll
    for (int o = 32; o >= 1; o >>= 1) v = fmaxf(v, __shfl_xor(v, o));
    return v; }
__device__ __forceinline__ void unpack8(const uint4 w, float (&f)[8]) {
    f[0] = bflo(w.x); f[1] = bfhi(w.x); f[2] = bflo(w.y); f[3] = bfhi(w.y); f[4] = bflo(w.z); f[5] = bfhi(w.z); f[6] = bflo(w.w); f[7] = bfhi(w.w); }

typedef const __attribute__((address_space(4))) Params* ParamsK;
struct PView { ParamsK q; __device__ __forceinline__ const __attribute__((address_space(4))) Params* operator->() const { return q; } };
struct Ctx {
    PView p; unsigned char* ws; unsigned char* lds; int tid, lane, wave, G, bid, gw, nw, rep;
    __device__ __forceinline__ float* MOD() const { return (float*)(ws + WS_MOD); }
    __device__ __forceinline__ float* LB() const { return (float*)(ws + WS_LB); }
    __device__ __forceinline__ float2* ROPE() const { return (float2*)(ws + WS_ROPE); }
    __device__ __forceinline__ int* TOKE() const { return (int*)(ws + WS_TOK); }
    __device__ __forceinline__ float* TOKW() const { return (float*)(ws + WS_TOK) + 2 * TA; }
    __device__ __forceinline__ int* TOKS() const { return (int*)(ws + WS_TOK) + 4 * TA; }
    __device__ __forceinline__ float* CTXS() const { return (float*)(ws + WS_CTXS); }
    __device__ __forceinline__ bf16* WIN_T() const { return (bf16*)(ws + WS_WB); }
    __device__ __forceinline__ bf16* WNA_T() const { return (bf16*)(ws + WS_WB + 12 * MiB); }
    __device__ __forceinline__ bf16* WHG_T() const { return (bf16*)(ws + WS_WB + 13 * MiB); }
    __device__ __forceinline__ bf16* WOUT_T() const { return (bf16*)(ws + WS_WB + 14 * MiB); }
    __device__ __forceinline__ bf16* H() const { return (bf16*)p->out; }
    __device__ __forceinline__ bf16* XB() const { return (bf16*)(ws + WS_H); }
    __device__ __forceinline__ bf16* GRP(int g) const { return (bf16*)(ws + WS_P) + (size_t)g * GSTRIDE; }
    __device__ __forceinline__ bf16* MB() const { return (bf16*)(ws + WS_P + P_M); }
    __device__ __forceinline__ bf16* WEGU(int l) const { return l == 0 ? (bf16*)(ws + WS_P + P_WEGU) : (bf16*)((unsigned char*)p->out + 68 * MiB); }
    __device__ __forceinline__ bf16* WED(int l) const { return l == 0 ? (bf16*)(ws + WS_P + P_WED) : (bf16*)((unsigned char*)p->out + 100 * MiB); }
    __device__ __forceinline__ bf16* XS() const { return (bf16*)(ws + WS_P + P_XS); }
    __device__ __forceinline__ bf16* ACT() const { return (bf16*)(ws + WS_P + P_ACT); }
    __device__ __forceinline__ int* S2T() const { return (int*)(ws + WS_S2T); }
    __device__ __forceinline__ unsigned* CTL() const { return (unsigned*)(ws + WS_CTL); }
    __device__ __forceinline__ unsigned* CNT(int l) const { return (unsigned*)(ws + WS_CTL) + CW_CNT + l * 64 + rep * 2048; }
    __device__ __forceinline__ int* TAB() const { return (int*)(lds + LDS_STAGE) + LDSW_TAB; }
};

template <class RowMap>
__device__ __forceinline__ void tconv_tile(const float* __restrict__ src, int ldsrc, int k0, int n0, bf16* __restrict__ dst, int ldd, int lane, RowMap rm) {
    float v[64];
    const float* s = src + (size_t)k0 * ldsrc + n0 + lane;
#pragma unroll
    for (int k = 0; k < 64; ++k) { v[k] = *s; s += ldsrc; asm volatile("" : "+v"(s)); }
    bf16* d = dst + (size_t)rm(n0 + lane) * ldd + k0;
#pragma unroll
    for (int j = 0; j < 8; ++j) { uint4 w; w.x = pk2(v[8 * j], v[8 * j + 1]); w.y = pk2(v[8 * j + 2], v[8 * j + 3]); w.z = pk2(v[8 * j + 4], v[8 * j + 5]); w.w = pk2(v[8 * j + 6], v[8 * j + 7]);
        *(uint4*)(d + 8 * j) = w; }
}
struct RmId { __device__ __forceinline__ int operator()(int n) const { return n; } };
struct RmGU { int base; __device__ __forceinline__ int operator()(int n) const { return base + (n >> 7) * 256 + (n & 127); } };

__device__ __forceinline__ void conv_mixer(const Ctx& C, int l, int fb = 0) {
    if (C.bid < fb) return;
    for (int id = (C.bid - fb) * 8 + C.wave; id < 2048; id += (C.G - fb) * 8) {
        if (id < 1536) { const int nt = id % 96, kt = id / 96; tconv_tile(C.p->w_in + (size_t)l * DM * INW, INW, kt * 64, nt * 64, C.WIN_T(), DM, C.lane, RmId()); }
        else if (id < 1664) { const int j = id - 1536, nt = j & 15, kt = j >> 4; tconv_tile(C.p->w_na_o + (size_t)l * 512 * DM, DM, kt * 64, nt * 64, C.WNA_T(), 512, C.lane, RmId()); }
        else if (id < 1792) { const int j = id - 1664, nt = j & 15, kt = j >> 4; tconv_tile(C.p->w_hg_o + (size_t)l * 512 * DM, DM, kt * 64, nt * 64, C.WHG_T(), 512, C.lane, RmId()); }
        else { const int j = id - 1792, nt = j & 15, kt = j >> 4; tconv_tile(C.p->w_out + (size_t)l * DM * DM, DM, kt * 64, nt * 64, C.WOUT_T(), DM, C.lane, RmId()); }
    }
}
__device__ __forceinline__ void conv_experts(const Ctx& C, int l, int fb) {
    if (C.bid < fb) return;
    for (int id = (C.bid - fb) * 8 + C.wave; id < 6144; id += (C.G - fb) * 8) {
        const int e = id / 384, j = id % 384;
        if (j < 128) { const int nt = j & 7, kt = j >> 3; tconv_tile(C.p->w_gate + ((size_t)l * 16 + e) * DM * 512, 512, kt * 64, nt * 64, C.WEGU(l), DM, C.lane, RmGU{e * 1024}); }
        else if (j < 256) { const int jj = j - 128, nt = jj & 7, kt = jj >> 3; tconv_tile(C.p->w_up + ((size_t)l * 16 + e) * DM * 512, 512, kt * 64, nt * 64, C.WEGU(l), DM, C.lane, RmGU{e * 1024 + 128}); }
        else { const int jj = j - 256, nt = jj & 15, kt = jj >> 4; tconv_tile(C.p->w_down + ((size_t)l * 16 + e) * 512 * DM, DM, kt * 64, nt * 64, C.WED(l) + (size_t)e * 1024 * 512, 512, C.lane, RmId()); }
    }
}

__device__ __forceinline__ void p0_prologue(const Ctx& C) {
    for (int u = C.bid; u < 192; u += C.G) {
        float* sl = (float*)C.lds;
        float* red = (float*)(C.lds + 36864);
        for (int i = C.tid; i < 9 * 1024; i += 512) { const int r = i >> 10, k = i & 1023; const float v = (r < 8) ? C.p->c[r * 1024 + k] : C.p->c_ctx[k]; sl[i] = v / (1.f + expf(-v)); }
        __syncthreads();
        const int l = u / 96, nb = (u % 96) * 64;
        const float* w = C.p->w_ada + (size_t)l * DM * INW + (size_t)(C.wave * 128) * INW + nb + C.lane;
        float acc[9];
#pragma unroll
        for (int r = 0; r < 9; ++r) acc[r] = 0.f;
#pragma unroll 4
        for (int k4 = 0; k4 < 32; ++k4) { const float w0 = w[(size_t)(4 * k4) * INW], w1 = w[(size_t)(4 * k4 + 1) * INW], w2 = w[(size_t)(4 * k4 + 2) * INW], w3 = w[(size_t)(4 * k4 + 3) * INW];
#pragma unroll
            for (int r = 0; r < 9; ++r) { const float4 sv = *(const float4*)(sl + r * 1024 + C.wave * 128 + 4 * k4); float a = acc[r]; a += sv.x * w0; a += sv.y * w1; a += sv.z * w2; a += sv.w * w3; acc[r] = a; } }
#pragma unroll
        for (int r = 0; r < 9; ++r) red[(C.wave * 9 + r) * 64 + C.lane] = acc[r];
        __syncthreads();
        for (int i = C.tid; i < 9 * 64; i += 512) { const int r = i >> 6, cc = i & 63; float a = 0.f;
#pragma unroll
            for (int ww = 0; ww < 8; ++ww) a += red[(ww * 9 + r) * 64 + cc];
            const int n = nb + cc; C.MOD()[(size_t)(l * 9 + r) * INW + n] = a + C.p->b_ada[l * INW + n]; }
        __syncthreads();
    }
    const int gt = C.bid * 512 + C.tid, nthr = C.G * 512;
    for (int i = gt; i < 4096 * 32; i += nthr) { const int t = i >> 5, pr = i & 31; const float pos = (float)((pr < 16) ? (t >> 6) : (t & 63)); const int j = pr & 15;
        const float inv = powf(10000.f, -(float)(2 * j) / 32.f); const float ang = pos * inv; C.ROPE()[i] = make_float2(cosf(ang), sinf(ang)); }
    for (int i = gt; i < 1024; i += nthr) { const int dir = i >> 9, ch = i & 511; const float* raw = dir ? C.p->lowb : C.p->lowf; const float r0 = raw[ch], r1 = raw[512 + ch];
        const float p1 = 1.f / (1.f + expf(r0 - r1)); C.LB()[(0 * 2 + dir) * 512 + ch] = 0.f; C.LB()[(1 * 2 + dir) * 512 + ch] = p1; }
    conv_mixer(C, 0, 0);
}

__device__ __forceinline__ void load_row(const float* xr, int lane, float (&v)[16]) {
#pragma unroll
    for (int j = 0; j < 4; ++j) { const float4 t = *(const float4*)(xr + j * 256 + lane * 4); v[4 * j] = t.x; v[4 * j + 1] = t.y; v[4 * j + 2] = t.z; v[4 * j + 3] = t.w; }
}
__device__ __forceinline__ void load_row_raw(const bf16* xr, int lane, uint2 (&t)[4]) {
#pragma unroll
    for (int j = 0; j < 4; ++j) t[j] = *(const uint2*)(xr + j * 256 + lane * 4);
}
__device__ __forceinline__ void unpack_row(const uint2 (&t)[4], float (&v)[16]) {
#pragma unroll
    for (int j = 0; j < 4; ++j) { v[4 * j] = bflo(t[j].x); v[4 * j + 1] = bfhi(t[j].x); v[4 * j + 2] = bflo(t[j].y); v[4 * j + 3] = bfhi(t[j].y); }
}
__device__ __forceinline__ float row_rinv(const float (&v)[16]) {
    float ss = 0.f;
#pragma unroll
    for (int i = 0; i < 16; ++i) ss += v[i] * v[i];
    ss = wave_sum(ss);
    return rsqrtf(ss * (1.f / 1024.f) + EPS);
}
__device__ __forceinline__ void norm_mod(const float (&v)[16], float rinv, const float* gam, const float* sc, const float* sh, int lane, float (&h)[16]) {
#pragma unroll
    for (int j = 0; j < 4; ++j) { const int c = j * 256 + lane * 4; const float4 g = *(const float4*)(gam + c), s = *(const float4*)(sc + c), b = *(const float4*)(sh + c);
        h[4 * j] = v[4 * j] * rinv * g.x * (1.f + s.x) + b.x; h[4 * j + 1] = v[4 * j + 1] * rinv * g.y * (1.f + s.y) + b.y;
        h[4 * j + 2] = v[4 * j + 2] * rinv * g.z * (1.f + s.z) + b.z; h[4 * j + 3] = v[4 * j + 3] * rinv * g.w * (1.f + s.w) + b.w; }
}
__device__ __forceinline__ void store_row_bf16(bf16* hr, int lane, const float (&h)[16]) {
#pragma unroll
    for (int j = 0; j < 4; ++j) { uint2 w; w.x = pk2(h[4 * j], h[4 * j + 1]); w.y = pk2(h[4 * j + 2], h[4 * j + 3]); *(uint2*)(hr + j * 256 + lane * 4) = w; }
}
__device__ __forceinline__ int modrow_of(int r) { return r < TL ? (r >> 12) : 8; }

__device__ __forceinline__ void p1_norm1(const Ctx& C, int l, const float* xl, const float* xc) {
    float na[16], nb[16];
#define P1_ROWP(r_) ((r_) < TL ? xl + (size_t)(r_) * DM : xc + (size_t)((r_) - TL) * DM)
#define P1_DO(v_, r_) do { const float rinv = row_rinv(v_); const float* mod = LM + modrow_of(r_) * 2048; float h[16]; \
        norm_mod(v_, rinv, LM + 9 * 2048, mod + 1024, mod, C.lane, h); store_row_bf16(C.H() + (size_t)(r_) * DM, C.lane, h); } while (0)
    if (C.gw < TA) load_row(P1_ROWP(C.gw), C.lane, na);
    if (C.gw + C.nw < TA) load_row(P1_ROWP(C.gw + C.nw), C.lane, nb);
    float* LM = (float*)C.lds;
    for (int i = C.tid; i < 9 * 512; i += 512) { const int rw = i >> 9, c4 = (i & 511) * 4; *(float4*)(LM + rw * 2048 + c4) = *(const float4*)(C.MOD() + (size_t)(l * 9 + rw) * INW + c4); }
    if (C.tid < 256) *(float4*)(LM + 9 * 2048 + C.tid * 4) = *(const float4*)(C.p->norm1_g + l * DM + C.tid * 4);
    __syncthreads();
    for (int r = C.gw; r < TA; r += 2 * C.nw) {
        float v[16];
#pragma unroll
        for (int i = 0; i < 16; ++i) v[i] = na[i];
        { const int rn = r + 2 * C.nw; if (rn < TA) load_row(P1_ROWP(rn), C.lane, na); }
        P1_DO(v, r);
        const int r2 = r + C.nw;
        if (r2 < TA) {
#pragma unroll
            for (int i = 0; i < 16; ++i) v[i] = nb[i];
            { const int rn = r2 + 2 * C.nw; if (rn < TA) load_row(P1_ROWP(rn), C.lane, nb); }
            P1_DO(v, r2);
        }
    }
#undef P1_ROWP
#undef P1_DO
}

struct EpiInProj {
    static constexpr bool PERM = true, AFTER_DRAIN = false; static constexpr int NST = RELAX_NST(16);
    bf16* P; const float2* rope; const float* lbl; int dry;
    template <int MODE> __device__ __forceinline__ void tile(const f32x4 (&acc)[2][2][4][2], bf16* base, int row0, int colb, const float* lp) const {
        f32x4 lb0[2], lb1[2];
        if (MODE == 3) {
#pragma unroll
            for (int bj = 0; bj < 2; ++bj) { lb0[bj] = *(const f32x4*)(lp + bj * 128); lb1[bj] = *(const f32x4*)(lp + bj * 128 + 4); } }
        float4 rc[2][4][2];
        if (MODE == 1) {
#pragma unroll
            for (int ai = 0; ai < 2; ++ai)
#pragma unroll
                for (int m = 0; m < 4; ++m) { const float4* rp = (const float4*)(rope + (size_t)((row0 + ai * 128 + m * 16) & 4095) * 32 + ((colb & 63) >> 1)); rc[ai][m][0] = rp[0]; rc[ai][m][1] = rp[1]; }
            asm volatile("" ::: "memory"); }
#pragma unroll
        for (int ai = 0; ai < 2; ++ai)
#pragma unroll
            for (int m = 0; m < 4; ++m) { const int row = row0 + ai * 128 + m * 16;
#pragma unroll
                for (int bj = 0; bj < 2; ++bj) { const int col = colb + bj * 128; f32x4 v0 = acc[ai][bj][m][0], v1 = acc[ai][bj][m][1];
                    if (MODE == 1) { const float4 c01 = rc[ai][m][0], c23 = rc[ai][m][1]; const f32x4 a = v0, b = v1;
                        v0[0] = a[0] * c01.x - a[1] * c01.y; v0[1] = a[0] * c01.y + a[1] * c01.x; v0[2] = a[2] * c01.z - a[3] * c01.w; v0[3] = a[2] * c01.w + a[3] * c01.z;
                        v1[0] = b[0] * c23.x - b[1] * c23.y; v1[1] = b[0] * c23.y + b[1] * c23.x; v1[2] = b[2] * c23.z - b[3] * c23.w; v1[3] = b[2] * c23.w + b[3] * c23.z; }
                    if (MODE == 2) {
#pragma unroll
                        for (int i = 0; i < 4; ++i) { v0[i] = v0[i] * __builtin_amdgcn_rcpf(1.f + __expf(-v0[i])); v1[i] = v1[i] * __builtin_amdgcn_rcpf(1.f + __expf(-v1[i])); } }
                    if (MODE == 3) {
#pragma unroll
                        for (int i = 0; i < 4; ++i) { v0[i] = fmaxf(lb0[bj][i] + (1.f - lb0[bj][i]) * __builtin_amdgcn_rcpf(1.f + __expf(-v0[i])), 1e-30f);
                                                      v1[i] = fmaxf(lb1[bj][i] + (1.f - lb1[bj][i]) * __builtin_amdgcn_rcpf(1.f + __expf(-v1[i])), 1e-30f); } }
                    u32x4 w; w.x = pg8::cvt_pk_bf16(v0[0], v0[1]); w.y = pg8::cvt_pk_bf16(v0[2], v0[3]); w.z = pg8::cvt_pk_bf16(v1[0], v1[1]); w.w = pg8::cvt_pk_bf16(v1[2], v1[3]);
                    if (!dry) *(u32x4*)(base + (size_t)row * GW + col) = w; } }
    }
    __device__ __forceinline__ void operator()(const f32x4 (&acc)[2][2][4][2], const pg8::Unit& u, int wr, int wc, int fr, int fq) const {
        const int grp = __builtin_amdgcn_readfirstlane(u.pn >> 1), pm = __builtin_amdgcn_readfirstlane(u.pm); bf16* base = P + (size_t)grp * GSTRIDE;
        const int colb = (u.pn & 1) * 256 + wc * 32 + 8 * fq, row0 = pm * 256 + wr * 64 + fr;
        if (grp < 2 && pm < TL / 256) tile<1>(acc, base, row0, colb, nullptr);
        else if (grp == 3) tile<2>(acc, base, row0, colb, nullptr);
        else if (grp == 4 || grp == 5) tile<3>(acc, base, row0, colb, lbl + (grp - 4) * 512 + colb);
        else tile<0>(acc, base, row0, colb, nullptr);
    }
};
template <int PASS> struct EpiMerge {
    static constexpr bool PERM = true, AFTER_DRAIN = false; static constexpr int NST = 0;
    bf16* M; const bf16* G;
    __device__ __forceinline__ void operator()(const f32x4 (&acc)[2][2][4][2], const pg8::Unit& u, int wr, int wc, int fr, int fq) const {
        const bf16* gb = G + (size_t)(u.pn >> 1) * GSTRIDE; const int gcol = (u.pn & 1) * 256 + wc * 32 + 8 * fq, mcol = u.pn * 256 + wc * 32 + 8 * fq;
        const int row0 = u.pm * 256 + wr * 64 + fr;
        uint4 gw[4][2], mw[4][2]; u32x4 res[4][2];
#pragma unroll
        for (int ai = 0; ai < 2; ++ai) {
#pragma unroll
            for (int m = 0; m < 4; ++m)
#pragma unroll
                for (int bj = 0; bj < 2; ++bj) { const int row = row0 + ai * 128 + m * 16; gw[m][bj] = *(const uint4*)(gb + (size_t)row * GW + gcol + bj * 128);
                    if (PASS == 1) mw[m][bj] = *(const uint4*)(M + (size_t)row * DM + mcol + bj * 128); }
            if (ai == 1) { asm volatile("" ::: "memory");
#pragma unroll
                for (int m = 0; m < 4; ++m)
#pragma unroll
                    for (int bj = 0; bj < 2; ++bj) *(u32x4*)(M + (size_t)(row0 + m * 16) * DM + mcol + bj * 128) = res[m][bj]; }
#pragma unroll
            for (int m = 0; m < 4; ++m)
#pragma unroll
                for (int bj = 0; bj < 2; ++bj) { float g[8]; unpack8(gw[m][bj], g);
                    const f32x4 v0 = acc[ai][bj][m][0], v1 = acc[ai][bj][m][1];
                    float o[8];
#pragma unroll
                    for (int i = 0; i < 4; ++i) { o[i] = sigm(g[i]) * v0[i]; o[4 + i] = sigm(g[4 + i]) * v1[i]; }
                    if (PASS == 1) { float pm_[8]; unpack8(mw[m][bj], pm_);
#pragma unroll
                        for (int i = 0; i < 8; ++i) o[i] += pm_[i]; }
                    u32x4 w; w.x = pg8::cvt_pk_bf16(o[0], o[1]); w.y = pg8::cvt_pk_bf16(o[2], o[3]); w.z = pg8::cvt_pk_bf16(o[4], o[5]); w.w = pg8::cvt_pk_bf16(o[6], o[7]);
                    if (ai == 0) res[m][bj] = w; else *(u32x4*)(M + (size_t)(row0 + 128 + m * 16) * DM + mcol + bj * 128) = w; }
        }
    }
};
template <bool SRC32> struct EpiOut {
    static constexpr bool PERM = true, AFTER_DRAIN = false; static constexpr int NST = 0;
    const float* xl_src; const float* xc_src; bf16* xs; const float* mod; int dry;
    __device__ __forceinline__ void operator()(const f32x4 (&acc)[2][2][4][2], const pg8::Unit& u, int wr, int wc, int fr, int fq) const {
        const bool lat = u.pm < TL / 256; const int mr = lat ? (u.pm >> 4) : 8;
        const int col0 = u.pn * 256 + wc * 32 + 8 * fq; const float* gate = mod + (size_t)mr * INW + 2048 + col0;
        const float* src = lat ? xl_src : xc_src - (size_t)TL * DM;
        f32x4 gv[2][2];
#pragma unroll
        for (int bj = 0; bj < 2; ++bj)
#pragma unroll
            for (int n = 0; n < 2; ++n) gv[bj][n] = *(const f32x4*)(gate + bj * 128 + n * 4);
        const size_t offb = (size_t)(u.pm * 256 + wr * 64 + fr) * DM + col0;
        f32x4 fa[4][2][2]; uint4 ba[4][2]; u32x4 res[4][2];
#pragma unroll
        for (int ai = 0; ai < 2; ++ai) {
#pragma unroll
            for (int m = 0; m < 4; ++m)
#pragma unroll
                for (int bj = 0; bj < 2; ++bj) { const size_t o = offb + (size_t)(ai * 128 + m * 16) * DM + bj * 128;
                    if (SRC32) { fa[m][bj][0] = *(const f32x4*)(src + o); fa[m][bj][1] = *(const f32x4*)(src + o + 4); } else ba[m][bj] = *(const uint4*)(xs + o); }
            if (ai == 1) { asm volatile("" ::: "memory");
#pragma unroll
                for (int m = 0; m < 4; ++m)
#pragma unroll
                    for (int bj = 0; bj < 2; ++bj) { if (!dry) *(u32x4*)(xs + offb + (size_t)(m * 16) * DM + bj * 128) = res[m][bj]; } }
#pragma unroll
            for (int m = 0; m < 4; ++m)
#pragma unroll
                for (int bj = 0; bj < 2; ++bj) { float x[8];
                    if (SRC32) {
#pragma unroll
                        for (int i = 0; i < 4; ++i) { x[i] = fa[m][bj][0][i]; x[4 + i] = fa[m][bj][1][i]; } }
                    else unpack8(ba[m][bj], x);
                    const f32x4 v0 = acc[ai][bj][m][0], v1 = acc[ai][bj][m][1];
#pragma unroll
                    for (int i = 0; i < 4; ++i) { x[i] += gv[bj][0][i] * v0[i]; x[4 + i] += gv[bj][1][i] * v1[i]; }
                    u32x4 w; w.x = pg8::cvt_pk_bf16(x[0], x[1]); w.y = pg8::cvt_pk_bf16(x[2], x[3]); w.z = pg8::cvt_pk_bf16(x[4], x[5]); w.w = pg8::cvt_pk_bf16(x[6], x[7]);
                    if (ai == 0) res[m][bj] = w; else if (!dry) *(u32x4*)(xs + offb + (size_t)(128 + m * 16) * DM + bj * 128) = w; }
        }
    }
};
struct EpiGateUp {
    static constexpr bool PERM = true, AFTER_DRAIN = false; static constexpr int NST = RELAX_NST(8);
    bf16* A;
    __device__ __forceinline__ void operator()(const f32x4 (&acc)[2][2][4][2], const pg8::Unit& u, int wr, int wc, int fr, int fq) const {
        const int col = (u.pn & 3) * 128 + wc * 32 + 8 * fq;
#pragma unroll
        for (int ai = 0; ai < 2; ++ai)
#pragma unroll
            for (int m = 0; m < 4; ++m) { const int row = u.pm * 256 + ai * 128 + wr * 64 + m * 16 + fr; float o[8];
#pragma unroll
                for (int i = 0; i < 4; ++i) { o[i] = silu(acc[ai][0][m][0][i]) * acc[ai][1][m][0][i]; o[4 + i] = silu(acc[ai][0][m][1][i]) * acc[ai][1][m][1][i]; }
                u32x4 w; w.x = pg8::cvt_pk_bf16(o[0], o[1]); w.y = pg8::cvt_pk_bf16(o[2], o[3]); w.z = pg8::cvt_pk_bf16(o[4], o[5]); w.w = pg8::cvt_pk_bf16(o[6], o[7]);
                *(u32x4*)(A + (size_t)row * 512 + col) = w; }
    }
};
struct EpiDown {
    static constexpr bool PERM = true, AFTER_DRAIN = false; static constexpr int NST = 0;
    bf16* Y; int dry;
    __device__ __forceinline__ void operator()(const f32x4 (&acc)[2][2][4][2], const pg8::Unit& u, int wr, int wc, int fr, int fq) const {
        const int col = (u.pn & 3) * 256 + wc * 32 + 8 * fq;
#pragma unroll
        for (int ai = 0; ai < 2; ++ai)
#pragma unroll
            for (int m = 0; m < 4; ++m) { const int row = u.pm * 256 + ai * 128 + wr * 64 + m * 16 + fr;
#pragma unroll
                for (int bj = 0; bj < 2; ++bj) { const f32x4 v0 = acc[ai][bj][m][0], v1 = acc[ai][bj][m][1];
                    u32x4 w; w.x = pg8::cvt_pk_bf16(v0[0], v0[1]); w.y = pg8::cvt_pk_bf16(v0[2], v0[3]); w.z = pg8::cvt_pk_bf16(v1[0], v1[1]); w.w = pg8::cvt_pk_bf16(v1[2], v1[3]);
                    if (!dry) *(u32x4*)(Y + (size_t)row * DM + col + bj * 128) = w; } }
    }
};
struct MoeOrder {
    static constexpr bool GATHER = false;
    const int* tab; int G, c;
    __device__ __forceinline__ bool next(int i, pg8::Unit& u) const {
        const int L = i * G + c, MT = tab[16]; if (L >= MT * 4) return false;
        const int mt = L >> 2; int e = 0;
#pragma unroll
        for (int j = 1; j < 16; ++j) e += (mt >= tab[j]) ? 1 : 0;
        u.pm = mt; u.pn = e * 4 + (L & 3); return true;
    }
    __device__ __forceinline__ void a_ready(const pg8::Unit&) const {}
    __device__ __forceinline__ void done(const pg8::Unit&) const {}
};
struct MoeOrderG {
    static constexpr bool GATHER = true;
    const int* tab; const int* s2t; int G, c;
    __device__ __forceinline__ bool next(int i, pg8::Unit& u) const {
        const int L = i * G + c, MT = tab[16]; if (L >= MT * 4) return false;
        const int mt = L >> 2; int e = 0;
#pragma unroll
        for (int j = 1; j < 16; ++j) e += (mt >= tab[j]) ? 1 : 0;
        u.pm = mt; u.pn = e * 4 + (L & 3); return true;
    }
    __device__ __forceinline__ void gather4(const pg8::Unit& u, int R0, int (&ix)[4]) const {
        const int e = u.pn >> 2, te = u.pm - tab[e], ce = tab[17 + e];
        const int4 v = *(const int4*)(s2t + (size_t)e * S2T_CAP + te * 256 + R0 * 4);
        const int g0 = te * 256 + R0;
        ix[0] = (g0 < ce) ? v.x : 0; ix[1] = (g0 + 64 < ce) ? v.y : 0; ix[2] = (g0 + 128 < ce) ? v.z : 0; ix[3] = (g0 + 192 < ce) ? v.w : 0;
    }
    __device__ __forceinline__ void a_ready(const pg8::Unit&) const {}
    __device__ __forceinline__ void done(const pg8::Unit&) const {}
};
__device__ __forceinline__ void moe_table(const Ctx& C, int l) {
    __syncthreads();
    if (C.wave == 0) { const unsigned* cnt = C.CNT(l);
        const unsigned ce = (C.lane < 16) ? __hip_atomic_load(cnt + C.lane, __ATOMIC_RELAXED, __HIP_MEMORY_SCOPE_AGENT) : 0u;
        const int t = (int)((ce + 255u) >> 8); int inc = t;
#pragma unroll
        for (int o = 1; o < 16; o <<= 1) { const int up = __shfl_up(inc, o); if (C.lane >= o) inc += up; }
        if (C.lane < 16) { C.TAB()[C.lane] = inc - t; C.TAB()[17 + C.lane] = (int)ce; }
        if (C.lane == 15) C.TAB()[16] = inc; }
    __syncthreads();
}

typedef pg8::bf16x8 bf16x8;
typedef unsigned u32x2 __attribute__((ext_vector_type(2)));
__device__ __forceinline__ bf16x8 ld16(const bf16* p) { return *(const bf16x8*)p; }
__device__ __forceinline__ bf16x8 ld8x2(const bf16* p0, const bf16* p1) { const u32x2 a = *(const u32x2*)p0, b = *(const u32x2*)p1; u32x4 w; w.x = a.x; w.y = a.y; w.z = b.x; w.w = b.y; return __builtin_bit_cast(bf16x8, w); }
__device__ __forceinline__ bf16x8 pack8(const f32x4 a, const f32x4 b) { u32x4 w; w.x = pg8::cvt_pk_bf16(a[0], a[1]); w.y = pg8::cvt_pk_bf16(a[2], a[3]); w.z = pg8::cvt_pk_bf16(b[0], b[1]); w.w = pg8::cvt_pk_bf16(b[2], b[3]); return __builtin_bit_cast(bf16x8, w); }
#define MFMA16(a, b, c) __builtin_amdgcn_mfma_f32_16x16x32_bf16(a, b, c, 0, 0, 0)

#define SCHEDB_A() asm volatile("" ::: "memory")
#define REP9(M) M(0) M(1) M(2) M(3) M(4) M(5) M(6) M(7) M(8)
constexpr int AT_R1 = 0, AT_CK = 73728, AT_CV = 106496, AT_RB = 139264;
__device__ __forceinline__ int kswz(int key, int p) { return key * 128 + ((p ^ ((key >> 1) & 7)) << 4); }
typedef short s16x4 __attribute__((ext_vector_type(4)));
__device__ __forceinline__ bf16x8 tr2(const unsigned char* p0, const unsigned char* p1) {
    const s16x4 a = __builtin_amdgcn_ds_read_tr16_b64_v4i16((LAS s16x4*)p0), b = __builtin_amdgcn_ds_read_tr16_b64_v4i16((LAS s16x4*)p1);
    return __builtin_shufflevector(a, b, 0, 1, 2, 3, 4, 5, 6, 7); }
__device__ __forceinline__ void p3_attn2(const Ctx& C, int l, bool dry = false) {
    unsigned char* L = C.lds; LAS unsigned char* Ll = (LAS unsigned char*)C.lds;
    const bf16* Qb = C.GRP(0); const bf16* Kb = C.GRP(1); const bf16* Vb = C.GRP(2); bf16* Ob = C.GRP(0);
    const int lq = C.lane & 15, g = C.lane >> 4;
    const int ngroups = 256 + (l == 0 ? 64 : 0);
    const f32x4 z4 = {0.f, 0.f, 0.f, 0.f};
    const float C1 = 0.125f * 1.4426950408889634f;
    unsigned* qctr = C.CTL() + CW_CNT + 1024 + l * 64 + (dry ? 32 : 0) + C.rep * 2048;
    volatile int* qslot = (volatile int*)(C.lds + LDS_STAGE) + 40;
    const int kl = C.lane >> 3, kpiece = (C.lane & 7) ^ ((4 * (C.wave & 1) + (kl >> 1)) & 7), vpiece = (C.lane & 7) ^ (((kl >> 1) & 3) << 1);
    const size_t kthr = (size_t)(C.wave * 8 + kl) * GW + kpiece * 8, vthr = (size_t)(C.wave * 8 + kl) * GW + vpiece * 8;
    const int tq = (C.lane >> 2) & 3, tp = C.lane & 3, txr = (2 * g + (tq >> 1)) & 3;
    int tro[4];
#pragma unroll
    for (int dt = 0; dt < 4; ++dt) tro[dt] = (4 * g + tq) * 128 + (((dt ^ txr) << 5) + 8 * tp);
    for (int qit = 0;; ++qit) {
        __syncthreads();
#ifdef STATIC_Q
        if (C.tid == 0) { *qslot = C.bid + qit * C.G; }
#else
        if (C.tid == 0) *qslot = (int)atomicAdd(qctr, 1u);
#endif
        __syncthreads();
        const int gid = *qslot;
        if (gid >= ngroups) break;
        const bool latg = gid < 256; const int bh = latg ? (gid >> 2) : (gid - 256); const int b = bh >> 3, h = bh & 7;
        { const bf16* ck0 = Kb + (size_t)(TL + b * 256) * GW + h * 64 + kthr; const bf16* cv0 = Vb + (size_t)(TL + b * 256) * GW + h * 64 + vthr;
#pragma unroll
          for (int it = 0; it < 4; ++it) {
              __builtin_amdgcn_global_load_lds((const unsigned*)(ck0 + (size_t)it * 64 * GW), (LAS unsigned*)(Ll + AT_CK + (it * 8 + C.wave) * 1024), 16, 0, 0);
              __builtin_amdgcn_global_load_lds((const unsigned*)(cv0 + (size_t)it * 64 * GW), (LAS unsigned*)(Ll + AT_CV + (it * 8 + C.wave) * 1024), 16, 0, 0); } }
        if (C.tid < 480) { const int dr = C.tid >> 5, dc = C.tid & 31; ((float*)(L + AT_RB))[C.tid] = (dc < 31) ? 1.4426950408889634f * C.p->rel_bias[((size_t)(l * 8 + h) * 15 + dr) * 31 + dc] : 0.f; }
        const int nun = latg ? 8 : 2;
        bf16x8 nq0, nq1;
        { const int qr = latg ? b * 4096 + ((gid & 3) * 16 + (C.wave >> 2)) * 64 + (C.wave & 3) * 16 : TL + b * 256 + C.wave * 16;
          const bf16* qp = Qb + (size_t)(qr + lq) * GW + h * 64 + 8 * g; nq0 = ld16(qp); nq1 = ld16(qp + 32); }
        for (int ui = 0; ui < nun; ++ui) {
            int gr = 0, gc0 = 0, qrow0, rsu = 0, nru = 1, rsw = 0;
            if (latg) { const int gr0 = ((gid & 3) * 8 + ui) * 2; gr = gr0 + (C.wave >> 2); gc0 = (C.wave & 3) * 16; qrow0 = b * 4096 + gr * 64 + gc0;
                rsu = min(max(gr0 - 4, 0), 56); nru = min(9, 64 - rsu); rsw = min(max(gr - 4, 0), 56); }
            else qrow0 = TL + b * 256 + (ui * 8 + C.wave) * 16;
            const int u0 = min(max(gc0 - 8, 0), 32);
            const bf16x8 q0 = nq0, q1 = nq1;
            asm volatile("s_waitcnt vmcnt(0)" ::: "memory");
            __syncthreads();
            if (latg) { const bf16* kb0 = Kb + (size_t)(b * 4096 + rsu * 64) * GW + h * 64 + kthr;
#pragma unroll
                for (int it = 0; it < 9; ++it) if (it < 8 || nru == 9)
                    __builtin_amdgcn_global_load_lds((const unsigned*)(kb0 + (size_t)it * 64 * GW), (LAS unsigned*)(Ll + AT_R1 + (it * 8 + C.wave) * 1024), 16, 0, 0); }
            if (ui + 1 < nun) { const int u1 = ui + 1;
                const int qr = latg ? b * 4096 + (((gid & 3) * 8 + u1) * 2 + (C.wave >> 2)) * 64 + (C.wave & 3) * 16 : TL + b * 256 + (u1 * 8 + C.wave) * 16;
                const bf16* qp = Qb + (size_t)(qr + lq) * GW + h * 64 + 8 * g; nq0 = ld16(qp); nq1 = ld16(qp + 32); }
            asm volatile("" ::: "memory");
            f32x4 oc[4] = {z4, z4, z4, z4}; float mc, sc;
            { f32x4 s[16];
              const unsigned char* ck0 = L + AT_CK + kswz(lq, g), *ck1 = L + AT_CK + kswz(lq, 4 + g);
#pragma unroll
              for (int ct = 0; ct < 16; ++ct) { f32x4 a = MFMA16(*(const bf16x8*)(ck0 + ct * 2048), q0, z4); a = MFMA16(*(const bf16x8*)(ck1 + ct * 2048), q1, a); s[ct] = a; }
              float mx = -1e30f;
#pragma unroll
              for (int i = 0; i < 16; ++i) mx = fmaxf(fmaxf(fmaxf(mx, s[i][0]), fmaxf(s[i][1], s[i][2])), s[i][3]);
              mx = fmaxf(mx, __shfl_xor(mx, 16)); mx = fmaxf(mx, __shfl_xor(mx, 32));
              mx *= C1;
              float sum = 0.f;
#pragma unroll
              for (int i = 0; i < 16; ++i) {
#pragma unroll
                  for (int r = 0; r < 4; ++r) { const float e = __builtin_amdgcn_exp2f(fmaf(s[i][r], C1, -mx)); s[i][r] = e; sum += e; } }
              sum += __shfl_xor(sum, 16); sum += __shfl_xor(sum, 32);
              mc = mx; sc = sum;
#pragma unroll
              for (int cb = 0; cb < 8; ++cb) { const bf16x8 pb = pack8(s[2 * cb], s[2 * cb + 1]);
                  const unsigned char* vp = L + AT_CV + cb * 4096;
#pragma unroll
                  for (int dt = 0; dt < 4; ++dt) oc[dt] = MFMA16(tr2(vp + tro[dt], vp + tro[dt] + 2048), pb, oc[dt]); } }
            float inv = 1.f / sc;
            if (latg) {
                asm volatile("s_waitcnt vmcnt(0)" ::: "memory");
                __syncthreads();
                const int gcq = gc0 + lq, csq = min(max(gcq - 8, 0), 48);
                bool val[8]; int bo[8];
#pragma unroll
                for (int hr = 0; hr < 8; ++hr) { const int kc = u0 + 16 * (hr >> 2) + 4 * g + (hr & 3); val[hr] = (kc >= csq) && (kc < csq + 16); bo[hr] = min(max(kc - gcq + 15, 0), 30) * 4; }
                const unsigned char* rb = L + AT_RB + (rsw - gr + 7) * 128;
                const int key0 = (rsw - rsu) * 64 + u0 + lq;
                const unsigned char* wk0 = L + AT_R1 + kswz(key0, g), *wk1 = L + AT_R1 + kswz(key0, 4 + g);
                f32x4 s[16];
#pragma unroll
                for (int wt = 0; wt < 16; ++wt) { const int wrow = wt >> 1, half = wt & 1;
                    f32x4 a = MFMA16(*(const bf16x8*)(wk0 + wrow * 8192 + half * 2048), q0, z4); a = MFMA16(*(const bf16x8*)(wk1 + wrow * 8192 + half * 2048), q1, a);
#pragma unroll
                    for (int r = 0; r < 4; ++r) a[r] = val[half * 4 + r] ? fmaf(a[r], C1, *(const float*)(rb + wrow * 128 + bo[half * 4 + r])) : -1e30f;
                    s[wt] = a; }
                __syncthreads();
                { const bf16* vb0 = Vb + (size_t)(b * 4096 + rsu * 64) * GW + h * 64 + vthr;
#pragma unroll
                  for (int it = 0; it < 9; ++it) if (it < 8 || nru == 9)
                      __builtin_amdgcn_global_load_lds((const unsigned*)(vb0 + (size_t)it * 64 * GW), (LAS unsigned*)(Ll + AT_R1 + (it * 8 + C.wave) * 1024), 16, 0, 0); }
                float mx = -1e30f;
#pragma unroll
                for (int i = 0; i < 16; ++i) mx = fmaxf(fmaxf(fmaxf(mx, s[i][0]), fmaxf(s[i][1], s[i][2])), s[i][3]);
                mx = fmaxf(mx, __shfl_xor(mx, 16)); mx = fmaxf(mx, __shfl_xor(mx, 32));
                float sum = 0.f;
#pragma unroll
                for (int i = 0; i < 16; ++i) {
#pragma unroll
                    for (int r = 0; r < 4; ++r) { const float e = __builtin_amdgcn_exp2f(s[i][r] - mx); s[i][r] = e; sum += e; } }
                sum += __shfl_xor(sum, 16); sum += __shfl_xor(sum, 32);
                asm volatile("s_waitcnt vmcnt(0)" ::: "memory");
                __syncthreads();
                f32x4 ow[4] = {z4, z4, z4, z4};
                const unsigned char* vpw = L + AT_R1 + ((rsw - rsu) * 64 + u0) * 128;
#pragma unroll
                for (int wrow = 0; wrow < 8; ++wrow) { const bf16x8 pb = pack8(s[2 * wrow], s[2 * wrow + 1]);
#pragma unroll
                    for (int dt = 0; dt < 4; ++dt) ow[dt] = MFMA16(tr2(vpw + wrow * 8192 + tro[dt], vpw + wrow * 8192 + tro[dt] + 2048), pb, ow[dt]); }
                const float m = fmaxf(mc, mx), fc = __builtin_amdgcn_exp2f(mc - m), fw = __builtin_amdgcn_exp2f(mx - m);
                inv = 1.f / (sc * fc + sum * fw);
#pragma unroll
                for (int dt = 0; dt < 4; ++dt) oc[dt] = oc[dt] * fc + ow[dt] * fw;
            }
            bf16* op = Ob + (size_t)(qrow0 + lq) * GW + h * 64 + 4 * g;
#pragma unroll
            for (int dt = 0; dt < 4; ++dt) { u32x2 w; w.x = pg8::cvt_pk_bf16(oc[dt][0] * inv, oc[dt][1] * inv); w.y = pg8::cvt_pk_bf16(oc[dt][2] * inv, oc[dt][3] * inv); if (!dry) *(u32x2*)(op + 16 * dt) = w; }
        }
    }
    __syncthreads();
}

#define LBAR() do { asm volatile("s_waitcnt lgkmcnt(0)" ::: "memory"); __builtin_amdgcn_s_barrier(); asm volatile("" ::: "memory"); } while (0)
__device__ __forceinline__ float ex2(float x) { return __builtin_amdgcn_exp2f(x); }
__device__ __forceinline__ int scan_row(int b, int dir, int s) { return dir == 0 ? (s < NCTX ? TL + b * NCTX + s : b * SEQ + (s - NCTX)) : (s < NCTX ? TL + b * NCTX + (NCTX - 1 - s) : b * SEQ + (SEQ - 1 - (s - NCTX))); }
__device__ __forceinline__ unsigned rot16(unsigned x) { return (x >> 16) | (x << 16); }
constexpr int S6_QT = 0, S6_KT = 17408, S6_QS = 34816, S6_DB = 52224, S6_KST = 0, S6_VT = 18432, S6_DV = 27648, S6_BUF = 28160, S6_TOT = 108544, S6_XP = 112640, S6_SPX = 118784;
__device__ __forceinline__ void p3_scan6(const Ctx& C, int l) {
    unsigned char* L = C.lds;
    const int kp = C.tid & 63, seg = C.tid >> 6, lq = C.lane & 15, g = C.lane >> 4, vt = C.wave & 3, th = C.wave >> 2;
    const bf16* HQ = C.GRP(3); const bf16* HIT = C.GRP(6);
    const f32x4 z4 = {0.f, 0.f, 0.f, 0.f};
    for (int u = C.bid; u < 128; u += C.G) {
        const int vh = u & 1, dir = (u >> 1) & 1, h = (u >> 2) & 3, b = u >> 4;
        const bf16* HF = C.GRP(dir ? 5 : 4); bf16* OUT = C.H() + (size_t)dir * GSTRIDE;
        const int sgn = dir ? -1 : 1;
        unsigned char* const spx = L + S6_SPX + C.tid * 16 + (C.wave << 10);
        f32x4 S[4];
        unsigned zz = 0u; asm volatile("" : "+v"(zz));
        const u32x4 zq = {zz, zz, zz, zz};
#pragma unroll
        for (int i = 0; i < 4; ++i) S[i] = __builtin_bit_cast(f32x4, zq);
        *(bf16x8*)(spx) = __builtin_bit_cast(bf16x8, zq); *(bf16x8*)(spx + 1024) = __builtin_bit_cast(bf16x8, zq);
        unsigned gva[8], qva[8], gvb[8], qvb[8]; uint4 vva[1], vvb[1];
        float c0[8], c1[8];
        unsigned ost[4]; int prow0 = 0;
#pragma unroll
        for (int i = 0; i < 4; ++i) ost[i] = 0u;
        f32x4 o[2];
#define S6_LOADS(CC_, GV_, QV_, VV_) do { const int cc_ = (CC_); const int row0_ = scan_row(b, dir, 64 * cc_); \
            _Pragma("unroll") for (int i = 0; i < 8; ++i) { const size_t ro = (size_t)(row0_ + sgn * (8 * C.wave + i)) * GW + h * 128; GV_[i] = *(const unsigned*)(HF + ro + 2 * kp); QV_[i] = *(const unsigned*)(HQ + ro + 2 * kp); } \
            VV_[0] = *(const uint4*)(HIT + (size_t)row0_ * GW + h * 128 + vh * 64 + C.wave * 8 + (ptrdiff_t)(sgn * C.lane) * GW); } while (0)
#define S6_G1(GV_) do { float r0 = 1.f, r1 = 1.f;        \
            _Pragma("unroll") for (int i = 0; i < 8; ++i) { r0 *= bflo(GV_[i]); r1 *= bfhi(GV_[i]); c0[i] = r0; c1[i] = r1; } \
            *(float2*)(L + S6_TOT + (seg * 128 + 2 * kp) * 4) = make_float2(r0, r1); } while (0)
#define S6_G2(BO_, QV_, VV_) do { unsigned char* B_ = L + S6_DB + (BO_); \
            float po0 = 1.f, po1 = 1.f, pb0 = 1.f, pb1 = 1.f, pl0 = 1.f, pl1 = 1.f; \
            float2 tt_[8]; \
            _Pragma("unroll") for (int j = 0; j < 8; ++j) tt_[j] = *(const float2*)(L + S6_TOT + (j * 128 + 2 * kp) * 4);        \
            __builtin_amdgcn_sched_barrier(0); \
            _Pragma("unroll") for (int j = 0; j < 8; ++j) { const float2 t = tt_[j]; \
                if (j < seg) { po0 *= t.x; po1 *= t.y; } if (j < 4) { pb0 *= t.x; pb1 *= t.y; } pl0 *= t.x; pl1 *= t.y; } \
            const float TINY = 7.8886e-31f;     \
            const float ib0 = __builtin_amdgcn_rcpf(fmaxf(pb0, TINY)), ib1 = __builtin_amdgcn_rcpf(fmaxf(pb1, TINY)); \
            const float s0_ = po0 * ib0, s1_ = po1 * ib1;              \
            const float el0 = pl0 * ib0, el1 = pl1 * ib1;                \
            float rp0 = __builtin_amdgcn_rcpf(fmaxf(s0_, TINY)), rp1 = __builtin_amdgcn_rcpf(fmaxf(s1_, TINY)); \
            float ks0[8], ks1[8]; \
            _Pragma("unroll") for (int i = 0; i < 8; ++i) { const float e0 = fmaxf(s0_ * c0[i], TINY), e1 = fmaxf(s1_ * c1[i], TINY); \
                const float rr0 = __builtin_amdgcn_rcpf(e0), rr1 = __builtin_amdgcn_rcpf(e1); \
                const float kt0 = rr0 - rp0, kt1 = rr1 - rp1; rp0 = rr0; rp1 = rr1; const int t = 8 * seg + i; \
                { const float qa = bflo(QV_[i]) * e0, qb = bfhi(QV_[i]) * e1; *(unsigned*)(L + S6_QT + t * 272 + 4 * kp) = pg8::cvt_pk_bf16(qa, qb); *(unsigned*)(L + S6_QS + t * 272 + 4 * kp) = pg8::cvt_pk_bf16(qa * pb0, qb * pb1); } \
                *(unsigned*)(L + S6_KT + t * 272 + 4 * kp) = pg8::cvt_pk_bf16(kt0, kt1); \
                ks0[i] = kt0 * el0; ks1[i] = kt1 * el1; } \
            *(uint4*)(B_ + S6_KST + (2 * kp) * 144 + seg * 16) = make_uint4(pg8::cvt_pk_bf16(ks0[0], ks0[1]), pg8::cvt_pk_bf16(ks0[2], ks0[3]), pg8::cvt_pk_bf16(ks0[4], ks0[5]), pg8::cvt_pk_bf16(ks0[6], ks0[7])); \
            *(uint4*)(B_ + S6_KST + (2 * kp + 1) * 144 + seg * 16) = make_uint4(pg8::cvt_pk_bf16(ks1[0], ks1[1]), pg8::cvt_pk_bf16(ks1[2], ks1[3]), pg8::cvt_pk_bf16(ks1[4], ks1[5]), pg8::cvt_pk_bf16(ks1[6], ks1[7])); \
            if (seg == 0) { *(float2*)(B_ + S6_DV + 8 * kp) = make_float2(pl0, pl1); } \
            { const uint4 w = VV_[0]; unsigned char* dp = B_ + S6_VT + (C.wave * 8) * 144 + C.lane * 2; \
                *(bf16*)(dp) = (bf16)(w.x & 0xffffu); *(bf16*)(dp + 144) = (bf16)(w.x >> 16); *(bf16*)(dp + 288) = (bf16)(w.y & 0xffffu); *(bf16*)(dp + 432) = (bf16)(w.y >> 16); \
                *(bf16*)(dp + 576) = (bf16)(w.z & 0xffffu); *(bf16*)(dp + 720) = (bf16)(w.z >> 16); *(bf16*)(dp + 864) = (bf16)(w.w & 0xffffu); *(bf16*)(dp + 1008) = (bf16)(w.w >> 16); } } while (0)
#define S6_MA(BO_) do { \
            const unsigned char* slo = L + S6_SPX + (vt << 11) + C.lane * 16; \
            const bf16x8 sp0 = *(const bf16x8*)(slo), sp1 = *(const bf16x8*)(slo + 1024), sp2 = *(const bf16x8*)(slo + 8192), sp3 = *(const bf16x8*)(slo + 9216);        \
            bf16x8 qa[2][4]; \
            _Pragma("unroll") for (int ti = 0; ti < 2; ++ti) _Pragma("unroll") for (int ks = 0; ks < 4; ++ks) { const unsigned char* sb = L + S6_QS + (16 * (2 * th + ti) + lq) * 272 + 8 * g + 64 * ks; qa[ti][ks] = ld8x2((const bf16*)(sb), (const bf16*)(sb + 32)); } \
            const int xt = (C.wave < 2) ? C.wave : 2 + ((C.wave - 2) >> 1), xs = (C.wave < 2) ? 0 : ((C.wave - 2) & 1); \
            __builtin_amdgcn_sched_barrier(0); \
            { f32x4 o0 = z4, o1 = z4; \
              o0 = MFMA16(qa[0][0], sp0, o0); o1 = MFMA16(qa[1][0], sp0, o1); o0 = MFMA16(qa[0][1], sp1, o0); o1 = MFMA16(qa[1][1], sp1, o1); \
              o0 = MFMA16(qa[0][2], sp2, o0); o1 = MFMA16(qa[1][2], sp2, o1); o0 = MFMA16(qa[0][3], sp3, o0); o1 = MFMA16(qa[1][3], sp3, o1); o[0] = o0; o[1] = o1; } \
            if (C.wave < 6) { const unsigned char* qb = L + S6_QT + (16 * xt + lq) * 272 + g * 16; bf16x8 qf[4], kf[2][4]; \
                _Pragma("unroll") for (int ks = 0; ks < 4; ++ks) qf[ks] = *(const bf16x8*)(qb + ks * 64); \
                _Pragma("unroll") for (int hf = 0; hf < 2; ++hf) { const unsigned char* kb = L + S6_KT + (16 * (2 * xs + hf) + lq) * 272 + g * 16; \
                    _Pragma("unroll") for (int ks = 0; ks < 4; ++ks) kf[hf][ks] = *(const bf16x8*)(kb + ks * 64); } \
                __builtin_amdgcn_sched_barrier(0); \
                const int tcol = 16 * xt + lq; f32x4 X0 = z4, X1 = z4; \
                _Pragma("unroll") for (int ks = 0; ks < 4; ++ks) { X0 = MFMA16(kf[0][ks], qf[ks], X0); X1 = MFMA16(kf[1][ks], qf[ks], X1); } \
                _Pragma("unroll") for (int r = 0; r < 4; ++r) { X0[r] = (16 * (2 * xs) + 4 * g + r <= tcol) ? X0[r] : 0.f; X1[r] = (16 * (2 * xs + 1) + 4 * g + r <= tcol) ? X1[r] : 0.f; } \
                *(bf16x8*)(L + S6_XP + C.wave * 1024 + C.lane * 16) = pack8(X0, X1); } } while (0)
#define S6_MB(BO_, ROW0_) do { const unsigned char* B_ = L + S6_DB + (BO_); \
            { const unsigned char* vb = B_ + S6_VT + (16 * vt + lq) * 144 + 8 * g; \
              const bf16x8 vq0 = ld8x2((const bf16*)vb, (const bf16*)(vb + 32)), vq1 = ld8x2((const bf16*)(vb + 64), (const bf16*)(vb + 96)); \
              const unsigned char* xp = L + S6_XP + C.lane * 16 + (th ? 2048 : 0); \
              const bf16x8 x0 = *(const bf16x8*)(xp), x1 = *(const bf16x8*)(xp + 1024); \
              const unsigned char* vb2 = B_ + S6_VT + (16 * vt + lq) * 144 + g * 16; const bf16x8 vf0 = *(const bf16x8*)vb2, vf1 = *(const bf16x8*)(vb2 + 64); \
              if (th == 0) { __builtin_amdgcn_sched_barrier(0); o[0] = MFMA16(x0, vq0, o[0]); o[1] = MFMA16(x1, vq0, o[1]); } \
              else { const bf16x8 x2 = *(const bf16x8*)(xp + 2048), x3 = *(const bf16x8*)(xp + 3072); __builtin_amdgcn_sched_barrier(0); \
                     o[0] = MFMA16(x0, vq0, o[0]); o[1] = MFMA16(x2, vq0, o[1]); o[0] = MFMA16(x1, vq1, o[0]); o[1] = MFMA16(x3, vq1, o[1]); } \
              f32x4 dsc[4]; bf16x8 ka[4], kb2[4]; \
              _Pragma("unroll") for (int i = 0; i < 4; ++i) { const int kt = 4 * th + i; dsc[i] = *(const f32x4*)(B_ + S6_DV + (16 * kt + 4 * g) * 4); const unsigned char* kb = B_ + S6_KST + (16 * kt + lq) * 144 + g * 16; \
                  ka[i] = *(const bf16x8*)kb; kb2[i] = *(const bf16x8*)(kb + 64); } \
              __builtin_amdgcn_sched_barrier(0); \
              _Pragma("unroll") for (int ti = 0; ti < 2; ++ti) { ost[2 * ti] = pg8::cvt_pk_bf16(o[ti][0], o[ti][1]); ost[2 * ti + 1] = pg8::cvt_pk_bf16(o[ti][2], o[ti][3]); } \
              prow0 = (ROW0_); \
              _Pragma("unroll") for (int i = 0; i < 4; ++i) S[i] = MFMA16(ka[i], vf0, S[i] * dsc[i]); \
              _Pragma("unroll") for (int i = 0; i < 4; ++i) S[i] = MFMA16(kb2[i], vf1, S[i]); \
              *(bf16x8*)(spx) = pack8(S[0], S[1]); *(bf16x8*)(spx + 1024) = pack8(S[2], S[3]); } } while (0)
#define S6_STORE() do { _Pragma("unroll") for (int ti = 0; ti < 2; ++ti) { bf16* op = OUT + (size_t)(prow0 + sgn * (16 * (2 * th + ti) + 4 * g)) * GW + h * 128 + vh * 64 + 16 * vt + lq; \
                op[0] = (bf16)(ost[2 * ti] & 0xffffu); op[(ptrdiff_t)sgn * GW] = (bf16)(ost[2 * ti] >> 16); op[(ptrdiff_t)(2 * sgn) * GW] = (bf16)(ost[2 * ti + 1] & 0xffffu); op[(ptrdiff_t)(3 * sgn) * GW] = (bf16)(ost[2 * ti + 1] >> 16); } } while (0)
#define S6_STEP(CC_, GV_, QV_, VV_) do { const int c_ = (CC_); \
            if (c_ + 1 < 68) S6_G1(GV_); \
            S6_MA((c_ & 1) * S6_BUF); \
            LBAR(); \
            if (c_ > 0) S6_STORE(); \
            if (c_ + 1 < 68) { S6_G2(((c_ + 1) & 1) * S6_BUF, QV_, VV_); if (c_ + 3 < 68) S6_LOADS(c_ + 3, GV_, QV_, VV_); } \
            __builtin_amdgcn_sched_barrier(0); \
            S6_MB((c_ & 1) * S6_BUF, scan_row(b, dir, 64 * c_)); \
            LBAR(); } while (0)
        S6_LOADS(0, gva, qva, vva); S6_LOADS(1, gvb, qvb, vvb);
        S6_G1(gva);
        LBAR();
        S6_G2(0, qva, vva); S6_LOADS(2, gva, qva, vva);
        LBAR();
        for (int c2 = 0; c2 < 68; c2 += 2) {
            S6_STEP(c2, gvb, qvb, vvb);
            S6_STEP(c2 + 1, gva, qva, vva);
        }
        S6_STORE();
#undef S6_LOADS
#undef S6_G1
#undef S6_G2
#undef S6_MA
#undef S6_MB
#undef S6_STORE
#undef S6_STEP
        __syncthreads();
    }
}

__device__ __forceinline__ void p3c_headnorm(const Ctx& C, int l, bool dry = false) {
    const int nrows = (l == 0) ? TA : TL;
    bf16* OF = C.H(); const bf16* OB = C.H() + GSTRIDE; const bf16* HG = C.GRP(7);
    float gn[8];
    { const float* gain = C.p->hg_norm_g + l * 128 + (C.lane & 15) * 8;
#pragma unroll
      for (int i = 0; i < 8; ++i) gn[i] = gain[i]; }
    const uint4 z = make_uint4(0u, 0u, 0u, 0u);
    uint4 a0 = z, b0 = z, g0 = z, a1 = z, b1 = z, g1 = z;
#define P3C_LD(A_, B_, G_, r_) do { const size_t o_ = (size_t)(r_) * GW + C.lane * 8; A_ = *(const uint4*)(OF + o_); B_ = *(const uint4*)(OB + o_); G_ = *(const uint4*)(HG + o_); } while (0)
#define P3C_DO(A_, B_, G_, r_) do { float a[8], b[8], g[8]; unpack8(A_, a); unpack8(B_, b); unpack8(G_, g); \
        { const int rn_ = (r_) + 2 * C.nw; if (rn_ < nrows) P3C_LD(A_, B_, G_, rn_); } \
        float ss = 0.f; \
        _Pragma("unroll") for (int i = 0; i < 8; ++i) { a[i] += b[i]; ss += a[i] * a[i]; } \
        ss += __shfl_xor(ss, 1); ss += __shfl_xor(ss, 2); ss += __shfl_xor(ss, 4); ss += __shfl_xor(ss, 8); \
        const float rinv = rsqrtf(ss * (1.f / 128.f) + EPS); float o[8]; \
        _Pragma("unroll") for (int i = 0; i < 8; ++i) o[i] = a[i] * rinv * gn[i] * silu(g[i]); \
        uint4 w; w.x = pk2(o[0], o[1]); w.y = pk2(o[2], o[3]); w.z = pk2(o[4], o[5]); w.w = pk2(o[6], o[7]); \
        if (!dry) *(uint4*)(OF + (size_t)(r_) * GW + C.lane * 8) = w; } while (0)
    if (C.gw < nrows) P3C_LD(a0, b0, g0, C.gw);
    if (C.gw + C.nw < nrows) P3C_LD(a1, b1, g1, C.gw + C.nw);
    for (int r = C.gw; r < nrows; r += 2 * C.nw) {
        P3C_DO(a0, b0, g0, r);
        const int r2 = r + C.nw;
        if (r2 < nrows) P3C_DO(a1, b1, g1, r2);
    }
#undef P3C_LD
#undef P3C_DO
}

__device__ __forceinline__ int e_of(const Ctx& C, int i) { return C.TOKE()[i]; }
__device__ __forceinline__ void p5_norm2_router(const Ctx& C, int l, int dry = 0) {
    unsigned char* WH = C.lds; unsigned char* WL = C.lds + 32768;
    unsigned* lcnt = (unsigned*)(C.lds + 65536);
    float* lgs = (float*)(C.lds + 66048) + C.wave * 576;
    float* LA = (float*)(C.lds + 84480); float* LS = LA + 9 * 1024;
    for (int c = C.tid; c < 1024; c += 512) { const float4* src = (const float4*)(C.p->w_router + c * 16);
        const int pos = ((c >> 5) * 64 + ((c >> 3) & 3) * 16) * 8 + (c & 7);
#pragma unroll
        for (int q = 0; q < 4; ++q) { const float4 w4 = src[q]; const float wv[4] = {w4.x, w4.y, w4.z, w4.w};
#pragma unroll
            for (int i = 0; i < 4; ++i) { const unsigned hi = f2bf(wv[i]); const unsigned lo = f2bf(wv[i] - bf2f(hi)); const int p = pos + (4 * q + i) * 8;
                ((bf16*)WH)[p] = (bf16)hi; ((bf16*)WL)[p] = (bf16)lo; } } }
    for (int i = C.tid; i < 9 * 256; i += 512) { const int rw = i >> 8, c4 = (i & 255) * 4; const float* mrow = C.MOD() + (size_t)(l * 9 + rw) * INW;
        const float4 sc = *(const float4*)(mrow + 4096 + c4), sh = *(const float4*)(mrow + 3072 + c4), gm = *(const float4*)(C.p->norm2_g + l * DM + c4);
        *(float4*)(LA + rw * 1024 + c4) = make_float4(gm.x * (1.f + sc.x), gm.y * (1.f + sc.y), gm.z * (1.f + sc.z), gm.w * (1.f + sc.w)); *(float4*)(LS + rw * 1024 + c4) = sh; }
    if (C.tid < 32) lcnt[C.tid] = 0u;
    __syncthreads();
    const int nrows = (l == 0) ? TA : TL, nbat = nrows >> 4;
    const int n = C.lane & 15, kg = C.lane >> 4;
    int rslot = 0;
    for (int bt = C.gw; bt < nbat; bt += C.nw) {
        const int row = bt * 16 + n; const bf16* xp = C.XB() + (size_t)row * DM + 8 * kg; bf16* hp = C.H() + (size_t)row * DM + 8 * kg;
        const float* la = LA + modrow_of(bt * 16) * 1024 + 8 * kg; const float* ls = LS + modrow_of(bt * 16) * 1024 + 8 * kg;
        float ss = 0.f;
        { uint4 qa[8], qb[8];
#pragma unroll
          for (int j = 0; j < 8; ++j) qa[j] = *(const uint4*)(xp + j * 32);
#pragma unroll
          for (int grp = 0; grp < 4; ++grp) {
              if (grp < 3) {
#pragma unroll
                  for (int j = 0; j < 8; ++j) { if (grp & 1) qa[j] = *(const uint4*)(xp + ((grp + 1) * 8 + j) * 32); else qb[j] = *(const uint4*)(xp + ((grp + 1) * 8 + j) * 32); } }
              __builtin_amdgcn_sched_barrier(0);
#pragma unroll
              for (int j = 0; j < 8; ++j) { float f[8]; unpack8((grp & 1) ? qb[j] : qa[j], f);
#pragma unroll
                  for (int i = 0; i < 8; ++i) ss += f[i] * f[i]; }
              __builtin_amdgcn_sched_barrier(0); } }
        ss += __shfl_xor(ss, 16); ss += __shfl_xor(ss, 32);
        const float rinv = rsqrtf(ss * (1.f / 1024.f) + EPS);
        f32x4 acc = {0.f, 0.f, 0.f, 0.f};
        { uint4 qq[3][4];
#pragma unroll
          for (int j = 0; j < 4; ++j) { qq[0][j] = *(const uint4*)(xp + j * 32); qq[1][j] = *(const uint4*)(xp + (4 + j) * 32); }
#pragma unroll
          for (int grp = 0; grp < 8; ++grp) {
              if (grp < 6) {
#pragma unroll
                  for (int j = 0; j < 4; ++j) qq[(grp + 2) % 3][j] = *(const uint4*)(xp + ((grp + 2) * 4 + j) * 32); }
              __builtin_amdgcn_sched_barrier(0);
#pragma unroll
              for (int j = 0; j < 4; ++j) { const int ks = grp * 4 + j; float f[8]; unpack8(qq[grp % 3][j], f);
                  const float4 a0 = *(const float4*)(la + ks * 32), a1 = *(const float4*)(la + ks * 32 + 4), s0 = *(const float4*)(ls + ks * 32), s1 = *(const float4*)(ls + ks * 32 + 4);
                  const float av[8] = {a0.x, a0.y, a0.z, a0.w, a1.x, a1.y, a1.z, a1.w}, sv[8] = {s0.x, s0.y, s0.z, s0.w, s1.x, s1.y, s1.z, s1.w};
                  float h[8], hl[8];
#pragma unroll
                  for (int i = 0; i < 8; ++i) h[i] = (f[i] * rinv) * av[i] + sv[i];
                  u32x4 hi; hi.x = pg8::cvt_pk_bf16(h[0], h[1]); hi.y = pg8::cvt_pk_bf16(h[2], h[3]); hi.z = pg8::cvt_pk_bf16(h[4], h[5]); hi.w = pg8::cvt_pk_bf16(h[6], h[7]);
                  hl[0] = h[0] - bflo(hi.x); hl[1] = h[1] - bfhi(hi.x); hl[2] = h[2] - bflo(hi.y); hl[3] = h[3] - bfhi(hi.y);
                  hl[4] = h[4] - bflo(hi.z); hl[5] = h[5] - bfhi(hi.z); hl[6] = h[6] - bflo(hi.w); hl[7] = h[7] - bfhi(hi.w);
                  u32x4 lo; lo.x = pg8::cvt_pk_bf16(hl[0], hl[1]); lo.y = pg8::cvt_pk_bf16(hl[2], hl[3]); lo.z = pg8::cvt_pk_bf16(hl[4], hl[5]); lo.w = pg8::cvt_pk_bf16(hl[6], hl[7]);
                  if (dry != 1) *(u32x4*)(hp + ks * 32) = hi;
                  const bf16x8 wh = *(const bf16x8*)(WH + (ks * 64 + C.lane) * 16), wl = *(const bf16x8*)(WL + (ks * 64 + C.lane) * 16);
                  const bf16x8 bh = __builtin_bit_cast(bf16x8, hi), bl = __builtin_bit_cast(bf16x8, lo);
                  acc = MFMA16(wh, bh, acc); acc = MFMA16(wh, bl, acc); acc = MFMA16(wl, bh, acc); }
              __builtin_amdgcn_sched_barrier(0); } }
        *(f32x4*)(lgs + (rslot + n) * 16 + 4 * kg) = acc;
        rslot += 16;
    }
    float rb[16];
#pragma unroll
    for (int e = 0; e < 16; ++e) rb[e] = C.p->router_bias[e];
    { const int r = (C.gw + (C.lane >> 4) * C.nw) * 16 + (C.lane & 15);
      if (C.lane < rslot && r < nrows) {
        float lg[16];
#pragma unroll
        for (int q = 0; q < 4; ++q) { const float4 t = *(const float4*)(lgs + C.lane * 16 + 4 * q); lg[4 * q] = t.x; lg[4 * q + 1] = t.y; lg[4 * q + 2] = t.z; lg[4 * q + 3] = t.w; }
        float bestg = -1e30f; int e0 = 0, e1 = 1; float s0 = 0.f, s1 = 0.f;
#pragma unroll
        for (int g = 0; g < 4; ++g) {
            float sc[4], gbv[4];
#pragma unroll
            for (int j = 0; j < 4; ++j) { sc[j] = __builtin_amdgcn_rcpf(1.f + __expf(-lg[4 * g + j])); gbv[j] = sc[j] + rb[4 * g + j]; }
            int i0 = 0; float b0 = gbv[0], u0 = sc[0];
#pragma unroll
            for (int j = 1; j < 4; ++j) if (gbv[j] > b0) { b0 = gbv[j]; i0 = j; u0 = sc[j]; }
            int i1 = -1; float b1 = -1e30f, u1 = 0.f;
#pragma unroll
            for (int j = 0; j < 4; ++j) if (j != i0 && gbv[j] > b1) { b1 = gbv[j]; i1 = j; u1 = sc[j]; }
            const float gs = b0 + b1;
            if (gs > bestg) { bestg = gs; e0 = 4 * g + i0; e1 = 4 * g + i1; s0 = u0; s1 = u1; }
        }
        if (!dry) {
            const float den = s0 + s1;
            const int r0 = (int)atomicAdd(lcnt + e0, 1u), r1 = (int)atomicAdd(lcnt + e1, 1u);
            C.TOKE()[2 * r] = e0; C.TOKE()[2 * r + 1] = e1; C.TOKW()[2 * r] = s0 / den; C.TOKW()[2 * r + 1] = s1 / den; C.TOKS()[2 * r] = r0; C.TOKS()[2 * r + 1] = r1;
        }
      } }
    __syncthreads();
    if (C.tid < 16 && !dry) lcnt[16 + C.tid] = atomicAdd(C.CNT(l) + C.tid, lcnt[C.tid]);
    __syncthreads();
    { const int r = (C.gw + (C.lane >> 4) * C.nw) * 16 + (C.lane & 15); if (!dry && C.lane < rslot && r < nrows) {
#pragma unroll
        for (int k = 0; k < 2; ++k) { const int e = e_of(C, 2 * r + k), gk = C.TOKS()[2 * r + k] + (int)lcnt[16 + e]; C.TOKS()[2 * r + k] = gk;
            C.S2T()[(size_t)e * S2T_CAP + (gk >> 8) * 256 + (gk & 63) * 4 + ((gk & 255) >> 6)] = r; } } }
    __syncthreads();
}

__device__ __forceinline__ int slot_of(const Ctx& C, int i) { return C.TAB()[C.TOKE()[i]] * 256 + C.TOKS()[i]; }
__device__ __forceinline__ void p9_combine(const Ctx& C, int l, bool dry = false) {
    moe_table(C, l);
    const int nrows = (l == 0) ? TA : TL; const bf16* YS = C.XS();
    float* LG = (float*)C.lds; float* LN = LG + 9 * 1024; float* LGAM = LN + (l == 0 ? 9 * 2048 : 0);
    for (int i = C.tid; i < 9 * 256; i += 512) { const int rw = i >> 8, c4 = (i & 255) * 4; *(float4*)(LG + rw * 1024 + c4) = *(const float4*)(C.MOD() + (size_t)(l * 9 + rw) * INW + 5120 + c4); }
    if (l == 0) for (int i = C.tid; i < 9 * 512; i += 512) { const int rw = i >> 9, c4 = (i & 511) * 4; *(float4*)(LN + rw * 2048 + c4) = *(const float4*)(C.MOD() + (size_t)(9 + rw) * INW + c4); }
    if (C.tid < 256) *(float4*)(LGAM + C.tid * 4) = *(const float4*)((l == 0 ? C.p->norm1_g + DM : C.p->final_g) + C.tid * 4);
    __syncthreads();
    uint2 nx[4], nya[4], nyb[4]; float nw0 = 0.f, nw1 = 0.f; int ns0 = 0, ns1 = 0;
#pragma unroll
    for (int j = 0; j < 4; ++j) { nya[j] = make_uint2(0u, 0u); nyb[j] = nya[j]; nx[j] = nya[j]; }
    if (C.gw < nrows) { const int r = C.gw; load_row_raw(C.XB() + (size_t)r * DM, C.lane, nx);
        const int s0 = slot_of(C, 2 * r), s1 = slot_of(C, 2 * r + 1); nw0 = C.TOKW()[2 * r]; nw1 = C.TOKW()[2 * r + 1];
#pragma unroll
        for (int j = 0; j < 4; ++j) { const int c = j * 256 + C.lane * 4; nya[j] = *(const uint2*)(YS + (size_t)s0 * DM + c); nyb[j] = *(const uint2*)(YS + (size_t)s1 * DM + c); }
        if (r + C.nw < nrows) { ns0 = slot_of(C, 2 * (r + C.nw)); ns1 = slot_of(C, 2 * (r + C.nw) + 1); } }
    for (int r = C.gw; r < nrows; r += C.nw) {
        float v[16]; uint2 ya[4], yb[4]; const float w0 = nw0, w1 = nw1;
        unpack_row(nx, v);
#pragma unroll
        for (int j = 0; j < 4; ++j) { ya[j] = nya[j]; yb[j] = nyb[j]; }
        { const int rn = r + C.nw; if (rn < nrows) { load_row_raw(C.XB() + (size_t)rn * DM, C.lane, nx);
            nw0 = C.TOKW()[2 * rn]; nw1 = C.TOKW()[2 * rn + 1];
#pragma unroll
            for (int j = 0; j < 4; ++j) { const int c = j * 256 + C.lane * 4; nya[j] = *(const uint2*)(YS + (size_t)ns0 * DM + c); nyb[j] = *(const uint2*)(YS + (size_t)ns1 * DM + c); }
            const int rnn = rn + C.nw; if (rnn < nrows) { ns0 = slot_of(C, 2 * rnn); ns1 = slot_of(C, 2 * rnn + 1); } } }
        const float* gate = LG + modrow_of(r) * 1024;
#pragma unroll
        for (int j = 0; j < 4; ++j) { const int c = j * 256 + C.lane * 4; const uint2 a = ya[j], b = yb[j]; const float4 g = *(const float4*)(gate + c);
            v[4 * j] += g.x * (w0 * bflo(a.x) + w1 * bflo(b.x)); v[4 * j + 1] += g.y * (w0 * bfhi(a.x) + w1 * bfhi(b.x));
            v[4 * j + 2] += g.z * (w0 * bflo(a.y) + w1 * bflo(b.y)); v[4 * j + 3] += g.w * (w0 * bfhi(a.y) + w1 * bfhi(b.y)); }
        const float rinv = row_rinv(v);
        if (l == 0) {
            if (!dry) store_row_bf16(C.XB() + (size_t)r * DM, C.lane, v);
            float h[16]; const float* mod1 = LN + modrow_of(r) * 2048;
            norm_mod(v, rinv, LGAM, mod1 + 1024, mod1, C.lane, h);
            if (!dry) store_row_bf16(C.H() + (size_t)r * DM, C.lane, h);
        } else {
#pragma unroll
            for (int j = 0; j < 4; ++j) { const int c = j * 256 + C.lane * 4; const float4 g = *(const float4*)(LGAM + c);
                if (!dry) *(float4*)(C.p->out + (size_t)r * DM + c) = make_float4(v[4 * j] * rinv * g.x, v[4 * j + 1] * rinv * g.y, v[4 * j + 2] * rinv * g.z, v[4 * j + 3] * rinv * g.w); }
        }
    }
}


__device__ __forceinline__ void stagger(int bid, unsigned ticks) {
    const unsigned long long t0 = __builtin_amdgcn_s_memrealtime(); const unsigned long long want = (unsigned long long)((unsigned)(bid >> 6) * ticks);
    while (__builtin_amdgcn_s_memrealtime() - t0 < want) __builtin_amdgcn_s_sleep(4);
}
#ifndef PHMASK
#define PHMASK 0xFFFFu
#endif
#define PHON(i) (((PHMASK) >> (i)) & 1u)
#ifndef SCANFN
#define SCANFN p3_scan6
#endif
#ifdef USE_VCU
#define MOE_VCU(C) (((C).G % 8 == 0) ? ((C).bid % 8) * ((C).G / 8) + (C).bid / 8 : (C).bid)
#else
#define MOE_VCU(C) ((C).bid)
#endif
#ifndef MOE_ALIGN
#define MOE_ALIGN true
#endif
#ifndef P2_ALIGN
#define P2_ALIGN false
#endif
#ifndef GEMM_ALIGN
#define GEMM_ALIGN true
#endif
#ifndef P2_SP2
#define P2_SP2 true
#endif
#ifndef STAGGER_P2
#define STAGGER_P2 0
#endif
constexpr int NPH = 20;
__global__ void __launch_bounds__(512, 2) mk_fwd(Params p) {
    extern __shared__ __attribute__((aligned(16))) unsigned char lds_raw[];
    LAS unsigned char* ldsl = (LAS unsigned char*)lds_raw;
    const int wv_ = __builtin_amdgcn_readfirstlane((int)threadIdx.x >> 6);
    if (threadIdx.x < 128) ((LAS unsigned*)(ldsl + LDS_STAGE))[threadIdx.x] = 0u;
    __syncthreads();
    XcdBarrier bar = xcd_barrier_post((unsigned*)(p.ws + WS_CTL) + CW_BAR + p.li * XCD_BAR_WORDS, (volatile LAS unsigned*)(ldsl + LDS_STAGE) + LDSW_BAR, wv_ == 0 ? 1u : 0u);
#define MKCTX() Ctx C; { unsigned long long kp_ = (unsigned long long)__builtin_amdgcn_kernarg_segment_ptr(); asm volatile("" : "+s"(kp_)); C.p.q = (ParamsK)kp_; } \
    C.ws = C.p->ws; C.lds = lds_raw; { unsigned z_ = 0u; asm volatile("" : "+s"(z_)); int t_ = wv_ * 64 + (int)__builtin_amdgcn_mbcnt_hi(~0u, __builtin_amdgcn_mbcnt_lo(~0u, z_)), g_ = gridDim.x, b_ = blockIdx.x; asm volatile("" : "+v"(t_), "+s"(g_), "+s"(b_)); C.tid = t_; C.G = g_; C.bid = b_; } \
    C.lane = C.tid & 63; C.wave = __builtin_amdgcn_readfirstlane(C.tid >> 6); C.gw = C.bid * 8 + C.wave; C.nw = C.G * 8; C.rep = rep_;
    const int lo = p.lo, hi = p.hi;
#define IN(k) (lo <= (k) && (k) < hi)
#ifdef PROBE_BAR
#define SEAM(k) do { if (IN((k) + 1)) { xcd_barrier(bar); xcd_barrier(bar); xcd_barrier(bar); } } while (0)
#else
#define SEAM(k) do { if (IN((k) + 1)) xcd_barrier(bar); } while (0)
#endif

#ifdef PROBE_FWD2
    for (int rep_ = 0; rep_ < 2 + p.pad; ++rep_) {
#else
    const int rep_ = 0; {
#endif
    if (PHON(0) && IN(0)) { MKCTX(); p0_prologue(C);
#ifdef PROBE_P0
        __syncthreads(); p0_prologue(C);
#endif
        SEAM(0); }
    if (PHON(1) && IN(1)) { MKCTX(); p1_norm1(C, 0, C.p->x, C.p->ctx);
#ifdef PROBE_P1
        for (int rep = 0; rep < 4 + C.p->pad; ++rep) p1_norm1(C, 0, C.p->x, C.p->ctx);
#endif
        SEAM(1); }
    for (int l = 0; l < 2; ++l) {
        const int pb = 2 + 9 * l;
        const int mrows = (l == 0) ? TA : TL;
        if (PHON(2) && IN(pb + 0)) {
            MKCTX();
            pg8::Gemm g{C.H(), C.WIN_T(), TA, INW, DM}; pg8::StaticOrder S; S.init(TA, INW, C.G, C.bid);
            EpiInProj E{C.GRP(0), C.ROPE(), C.LB() + l * 1024, 0};
#if STAGGER_P2 > 0
            stagger(C.bid, STAGGER_P2);
#endif
            pg8::gemm_phase<EpiInProj, pg8::StaticOrder, P2_ALIGN, P2_SP2>(ldsl, g, S, E, C.tid);
#ifdef PROBE_P2
            __syncthreads(); pg8::gemm_phase<EpiInProj, pg8::StaticOrder, P2_ALIGN, P2_SP2>(ldsl, g, S, E, C.tid);
#endif
#ifdef PROBE_P2DRY
            { __syncthreads(); EpiInProj E2 = E; E2.dry = 1 - C.p->pad; pg8::gemm_phase<EpiInProj, pg8::StaticOrder, P2_ALIGN, P2_SP2>(ldsl, g, S, E2, C.tid); }
#endif
            SEAM(pb + 0);
        }
        if (PHON(3) && IN(pb + 1)) {
            MKCTX();
#ifndef NO_SCAN
#ifdef PROBE_SCAN2
            for (int rep = 0; rep < 2 + C.p->pad; ++rep) SCANFN(C, l);
#else
            SCANFN(C, l);
#endif
#endif
#ifdef PROBE_ATTN2
            p3_attn(C, l, C.p->pad == 0);
#endif
#ifdef PROBE_ATTN3
            for (int rep = 0; rep < 2 + C.p->pad; ++rep) { p3_attn2(C, l, rep == 0); __syncthreads(); }
#else
#ifndef NO_ATTN
            p3_attn2(C, l);
#endif
#endif
            SEAM(pb + 1);
        }
        if (PHON(4) && IN(pb + 2)) { MKCTX();
#ifdef PROBE_P3C
            for (int rep = 0; rep < 4 + C.p->pad; ++rep) p3c_headnorm(C, l, C.p->pad == 0);
#endif
            p3c_headnorm(C, l); SEAM(pb + 2); }
        if (PHON(5) && IN(pb + 3)) {
            MKCTX();
            pg8::StaticOrder S; S.init(mrows, DM, C.G, C.bid);
            { pg8::Gemm g{C.GRP(0), C.WNA_T(), mrows, DM, 512}; EpiMerge<0> E{C.MB(), C.GRP(8)}; pg8::gemm_phase<EpiMerge<0>, pg8::StaticOrder, GEMM_ALIGN, true>(ldsl, g, S, E, C.tid); }
#ifdef PROBE_P4A
            __syncthreads();
            { pg8::Gemm g{C.GRP(0), C.WNA_T(), mrows, DM, 512}; EpiMerge<0> E{C.MB(), C.GRP(8)}; pg8::gemm_phase<EpiMerge<0>, pg8::StaticOrder, GEMM_ALIGN, true>(ldsl, g, S, E, C.tid); }
#endif
            __syncthreads();
            { pg8::Gemm g{C.H(), C.WHG_T(), mrows, DM, 512}; EpiMerge<1> E{C.MB(), C.GRP(10)}; pg8::gemm_phase<EpiMerge<1>, pg8::StaticOrder, GEMM_ALIGN, true>(ldsl, g, S, E, C.tid); }
            if (l == 0) conv_experts(C, 1, 32);
            SEAM(pb + 3);
        }
        if (PHON(6) && IN(pb + 4)) {
            MKCTX();
            pg8::StaticOrder S; S.init(mrows, DM, C.G, C.bid);
            pg8::Gemm g{C.MB(), C.WOUT_T(), mrows, DM, DM};
            if (l == 0) { EpiOut<true> E{C.p->x, C.p->ctx, C.XB(), C.MOD(), 0}; pg8::gemm_phase<EpiOut<true>, pg8::StaticOrder, GEMM_ALIGN, true>(ldsl, g, S, E, C.tid); }
            else { EpiOut<false> E{nullptr, nullptr, C.XB(), C.MOD() + (size_t)9 * INW, 0};
#ifdef PROBE_P4B
                { EpiOut<false> E2 = E; E2.dry = 1 - C.p->pad; pg8::gemm_phase<EpiOut<false>, pg8::StaticOrder, GEMM_ALIGN, true>(ldsl, g, S, E2, C.tid); __syncthreads(); }
#endif
                pg8::gemm_phase<EpiOut<false>, pg8::StaticOrder, GEMM_ALIGN, true>(ldsl, g, S, E, C.tid); }
            if (l == 0) conv_experts(C, 0, 32);
#ifdef PROBE_CONVX
            for (int rep = 0; rep < 1 + C.p->pad; ++rep) conv_experts(C, l, 0);
#endif
            SEAM(pb + 4);
        }
        if (PHON(7) && IN(pb + 5)) { MKCTX();
#ifdef PROBE_P5
            for (int rep = 0; rep < 4 + C.p->pad; ++rep) p5_norm2_router(C, l, C.p->pad == 0);
#endif
            p5_norm2_router(C, l); SEAM(pb + 5); }
        if (PHON(9) && IN(pb + 6)) {
            MKCTX();
            moe_table(C, l);
            MoeOrderG S{C.TAB(), C.S2T(), C.G, MOE_VCU(C)};
            pg8::Gemm g{C.H(), C.WEGU(l), TA, 16384, DM}; EpiGateUp E{C.ACT()};
            pg8::gemm_phase<EpiGateUp, MoeOrderG, MOE_ALIGN, true>(ldsl, g, S, E, C.tid);
#ifdef PROBE_P7
            __syncthreads(); pg8::gemm_phase<EpiGateUp, MoeOrderG, MOE_ALIGN, true>(ldsl, g, S, E, C.tid);
#endif
            SEAM(pb + 6);
        }
        if (PHON(10) && IN(pb + 7)) {
            MKCTX();
            moe_table(C, l);
            MoeOrder S{C.TAB(), C.G, MOE_VCU(C)};
            pg8::Gemm g{C.ACT(), C.WED(l), SLOT_ROWS, 16384, 512}; EpiDown E{C.XS(), 0};
#ifdef PROBE_P8DRY
            { EpiDown E2{C.XS(), 1 - C.p->pad}; pg8::gemm_phase<EpiDown, MoeOrder, MOE_ALIGN, true>(ldsl, g, S, E2, C.tid); __syncthreads(); }
#endif
            pg8::gemm_phase<EpiDown, MoeOrder, MOE_ALIGN, true>(ldsl, g, S, E, C.tid);
#ifdef PROBE_P8
            __syncthreads(); pg8::gemm_phase<EpiDown, MoeOrder, MOE_ALIGN, true>(ldsl, g, S, E, C.tid);
#endif
            SEAM(pb + 7);
        }
        if (PHON(11) && IN(pb + 8)) { MKCTX();
#ifdef PROBE_P9
            for (int rep = 0; rep < 4 + C.p->pad; ++rep) p9_combine(C, l, C.p->pad == 0);
#endif
            p9_combine(C, l); if (l == 0) conv_mixer(C, 1); SEAM(pb + 8); }
    }
#ifdef PROBE_FWD2
    if (rep_ == 0) xcd_barrier(bar);
#endif
    }
#undef IN
#undef SEAM
}

#ifndef MK_SPLIT
#define MK_SPLIT 0
#endif
extern "C" void kernel_launch(void* const* d_in, const int* in_sizes, int n_in, void* d_out, int out_size, void* d_ws, size_t ws_size, hipStream_t stream) {
    static int grid = 0;
    if (grid == 0) {
        if (n_in != 22 || ws_size < WS_END) { fprintf(stderr, "kernel_launch: unexpected n_in %d / ws_size %zu (need %zu)\n", n_in, ws_size, (size_t)WS_END); grid = -1; return; }
        int dev = 0, cus = 0, per_cu = 0;
        if (hipGetDevice(&dev) != hipSuccess || hipDeviceGetAttribute(&cus, hipDeviceAttributeMultiprocessorCount, dev) != hipSuccess) { grid = -1; return; }
        if (hipFuncSetAttribute((const void*)mk_fwd, hipFuncAttributeMaxDynamicSharedMemorySize, LDS_BYTES) != hipSuccess) { fprintf(stderr, "kernel_launch: hipFuncSetAttribute failed\n"); grid = -1; return; }
        if (hipOccupancyMaxActiveBlocksPerMultiprocessor(&per_cu, (const void*)mk_fwd, 512, LDS_BYTES) != hipSuccess || per_cu < 1) fprintf(stderr, "kernel_launch: occupancy query says %d\n", per_cu);
        (void)hipGetLastError();
        grid = cus;
    }
    if (grid < 0) return;
    if (hipMemsetAsync((char*)d_ws + WS_CTL, 0, CTL_BYTES, stream) != hipSuccess) return;
    Params p{};
    const float** pp = (const float**)&p;
    for (int i = 0; i < 22; ++i) pp[i] = (const float*)d_in[i];
    p.out = (float*)d_out; p.ws = (unsigned char*)d_ws; p.pad = 0;
#if MK_SPLIT
    for (int k = 0; k < NPH; ++k) { p.lo = k; p.hi = k + 1; p.li = k; hipLaunchKernelGGL(mk_fwd, dim3(grid), dim3(512), LDS_BYTES, stream, p); }
#else
    p.lo = 0; p.hi = NPH; p.li = 0;
    hipLaunchKernelGGL(mk_fwd, dim3(grid), dim3(512), LDS_BYTES, stream, p);
#endif
}
```
